# Optimizing an MI355X kernel written in HIP

```python
import math
import jax, jax.numpy as jnp
from jax import lax
import numpy as np

D_MODEL = 1024
BATCH = 2
SEQ = 8192
DEPTH = 2

GRID_W = 64
CTX_LEN = 256
N_EVEN = (DEPTH + 1) // 2
N_ODD = DEPTH // 2
ALPHA = (2 * DEPTH) ** 0.25
BETA = (8 * DEPTH) ** -0.25
ROPE_BASE = 10000.0
Q_BLOCK = 128
LN_EPS = 1e-5
RMS_EPS = 1e-6
N_MOD = 6

HEAD_DIM = 64
DIFF_HEADS = 4
DIFF_V = 2 * HEAD_DIM
NA_HEADS = 8
NA_ROWS = 8
NA_COLS = 16
MLA_HEADS = 8
MLA_Q_RANK = 384
MLA_KV_RANK = 256
MLA_NOPE = 64
MLA_ROPE = 32
MLA_V = 64
GMLP_GROUPS = 4
GMLP_GROUP_CH = 128
GMLP_CHUNK = 128
GMLP_WIDTH = GMLP_GROUPS * GMLP_GROUP_CH
FFN_HIDDEN = -(-8 * D_MODEL // (3 * 256)) * 256

EVEN_SPLITS = [DIFF_HEADS * 2 * HEAD_DIM, DIFF_HEADS * 2 * HEAD_DIM, DIFF_HEADS * DIFF_V,
               NA_HEADS * HEAD_DIM, NA_HEADS * HEAD_DIM, NA_HEADS * HEAD_DIM]
EVEN_IN = sum(EVEN_SPLITS)
EVEN_MIX = DIFF_HEADS * DIFF_V + NA_HEADS * HEAD_DIM
ODD_SPLITS = [MLA_Q_RANK, MLA_KV_RANK, MLA_ROPE, GMLP_WIDTH, GMLP_WIDTH]
ODD_IN = sum(ODD_SPLITS)
ODD_MIX = MLA_HEADS * MLA_V + GMLP_WIDTH

kernel_name = "hybrid_diffnat_mla_gmlp_prefix_dit"


def layer_norm(x, g, b):
    xf = x.astype(jnp.float32)
    mu = jnp.mean(xf, -1, keepdims=True)
    var = jnp.mean(jnp.square(xf - mu), -1, keepdims=True)
    return ((xf - mu) * lax.rsqrt(var + LN_EPS) * g.astype(jnp.float32) + b.astype(jnp.float32)).astype(x.dtype)


def rms_norm(x, g):
    xf = x.astype(jnp.float32)
    ms = jnp.mean(jnp.square(xf), -1, keepdims=True)
    return (xf * lax.rsqrt(ms + RMS_EPS) * g.astype(jnp.float32)).astype(x.dtype)


def rope_1d(x, pos):
    d = x.shape[-1]
    inv = jnp.power(ROPE_BASE, -jnp.arange(0, d, 2, dtype=jnp.float32) / d)
    ang = pos.astype(jnp.float32)[:, None] * inv[None, :]
    cos, sin = jnp.cos(ang).astype(x.dtype), jnp.sin(ang).astype(x.dtype)
    x1, x2 = x[..., : d // 2], x[..., d // 2:]
    return jnp.concatenate([x1 * cos - x2 * sin, x2 * cos + x1 * sin], -1)


def rope_2d(x, row, col):
    h = x.shape[-1] // 2
    return jnp.concatenate([rope_1d(x[..., :h], row), rope_1d(x[..., h:], col)], -1)


def split_cols(p, sizes):
    return jnp.split(p, np.cumsum(sizes)[:-1].tolist(), axis=-1)


def heads(t, n):
    b, s, _ = t.shape
    return t.reshape(b, s, n, -1).transpose(0, 2, 1, 3)


def diff_heads(t):
    b, s, _ = t.shape
    return t.reshape(b, s, DIFF_HEADS, 2, HEAD_DIM).transpose(0, 2, 3, 1, 4)


def merge(o):
    b, h, s, d = o.shape
    return o.transpose(0, 2, 1, 3).reshape(b, s, h * d)


def softmax_attention(q, k, v, scale):
    b, h, t, dq = q.shape
    nb = t // Q_BLOCK
    qb = q.reshape(b, h, nb, Q_BLOCK, dq).transpose(2, 0, 1, 3, 4)

    def block(qi):
        s = jnp.einsum('bhqd,bhkd->bhqk', qi, k).astype(jnp.float32) * scale
        p = jax.nn.softmax(s, axis=-1).astype(v.dtype)
        return jnp.einsum('bhqk,bhkd->bhqd', p, v)

    o = lax.map(block, qb)
    return o.transpose(1, 2, 0, 3, 4).reshape(b, h, t, v.shape[-1])


def diff_attention(q, k, v, lam):
    b, h, _, t, dh = q.shape
    nb = t // Q_BLOCK
    scale = dh ** -0.5
    qb = q.reshape(b, h, 2, nb, Q_BLOCK, dh).transpose(3, 0, 1, 2, 4, 5)

    def block(qi):
        s = jnp.einsum('bhmqd,bhmkd->bhmqk', qi, k).astype(jnp.float32) * scale
        p = jax.nn.softmax(s, axis=-1)
        a = (p[:, :, 0] - lam * p[:, :, 1]).astype(v.dtype)
        return jnp.einsum('bhqk,bhkd->bhqd', a, v)

    o = lax.map(block, qb)
    return o.transpose(1, 2, 0, 3, 4).reshape(b, h, t, v.shape[-1])


def neighbourhood_attention(q, k, v, k_ctx, v_ctx, rpb):
    b, h, s, dh = q.shape
    rows = s // GRID_W
    wr = min(NA_ROWS, rows)
    wc = NA_COLS
    nw = wr * wc
    scale = dh ** -0.5
    kg = k.reshape(b, h, rows, GRID_W, dh)
    vg = v.reshape(b, h, rows, GRID_W, dh)
    r = jnp.arange(rows)
    cidx = jnp.arange(GRID_W)
    row_start = jnp.clip(r - wr // 2, 0, rows - wr)
    col_start = jnp.clip(cidx - wc // 2, 0, GRID_W - wc)
    col_keys = col_start[:, None] + jnp.arange(wc)[None, :]
    row_off = row_start[:, None] + jnp.arange(wr)[None, :] - r[:, None] + (NA_ROWS - 1)
    col_off = col_keys - cidx[:, None] + (NA_COLS - 1)
    qr = q.reshape(b, h, rows, GRID_W, dh).transpose(2, 0, 1, 3, 4)

    def row_block(args):
        q_row, start, roff = args
        k_rows = lax.dynamic_slice_in_dim(kg, start, wr, axis=2)
        v_rows = lax.dynamic_slice_in_dim(vg, start, wr, axis=2)
        k_win = k_rows[:, :, :, col_keys].transpose(0, 1, 3, 2, 4, 5).reshape(b, h, GRID_W, nw, dh)
        v_win = v_rows[:, :, :, col_keys].transpose(0, 1, 3, 2, 4, 5).reshape(b, h, GRID_W, nw, dh)
        bias = rpb[:, roff[:, None, None], col_off[None, :, :]]
        bias = bias.transpose(0, 2, 1, 3).reshape(h, GRID_W, nw).astype(jnp.float32)
        s_win = jnp.einsum('bhqd,bhqkd->bhqk', q_row, k_win).astype(jnp.float32) * scale + bias
        s_ctx = jnp.einsum('bhqd,bhkd->bhqk', q_row, k_ctx).astype(jnp.float32) * scale
        p = jax.nn.softmax(jnp.concatenate([s_win, s_ctx], -1), axis=-1).astype(v.dtype)
        return (jnp.einsum('bhqk,bhqkd->bhqd', p[..., :nw], v_win)
                + jnp.einsum('bhqk,bhkd->bhqd', p[..., nw:], v_ctx))

    o = lax.map(row_block, (qr, row_start, row_off))
    return o.transpose(1, 2, 0, 3, 4).reshape(b, h, s, dh)


def even_mixer(p_x, p_c, w_out, diff_lam, diff_subln_g, na_rpb, layer_idx, need_ctx):
    s = p_x.shape[1]
    t = jnp.arange(s)
    row, col = t // GRID_W, t % GRID_W
    aq_x, ak_x, av_x, bq_x, bk_x, bv_x = split_cols(p_x, EVEN_SPLITS)
    aq_c, ak_c, av_c, bq_c, bk_c, bv_c = split_cols(p_c, EVEN_SPLITS)
    lambda_init = 0.8 - 0.6 * math.exp(-0.3 * layer_idx)
    lf = diff_lam.astype(jnp.float32)
    lam = jnp.exp(jnp.sum(lf[0] * lf[1])) - jnp.exp(jnp.sum(lf[2] * lf[3])) + lambda_init

    def diff_out(o):
        return merge(rms_norm(o, diff_subln_g) * (1.0 - lambda_init))

    ka_c, va_c = diff_heads(ak_c), heads(av_c, DIFF_HEADS)
    kb_c, vb_c = heads(bk_c, NA_HEADS), heads(bv_c, NA_HEADS)
    qa_x = rope_2d(diff_heads(aq_x), row, col)
    ka_x = rope_2d(diff_heads(ak_x), row, col)
    oa_x = diff_attention(qa_x, jnp.concatenate([ka_x, ka_c], axis=3),
                          jnp.concatenate([heads(av_x, DIFF_HEADS), va_c], axis=2), lam)
    ob_x = neighbourhood_attention(heads(bq_x, NA_HEADS), heads(bk_x, NA_HEADS), heads(bv_x, NA_HEADS),
                                   kb_c, vb_c, na_rpb)
    y_x = jnp.concatenate([diff_out(oa_x), merge(ob_x)], -1) @ w_out
    if not need_ctx:
        return y_x, None
    oa_c = diff_attention(diff_heads(aq_c), ka_c, va_c, lam)
    ob_c = softmax_attention(heads(bq_c, NA_HEADS), kb_c, vb_c, HEAD_DIM ** -0.5)
    y_c = jnp.concatenate([diff_out(oa_c), merge(ob_c)], -1) @ w_out
    return y_x, y_c


def odd_mixer(p_x, p_c, w_out, mla_q_norm_g, mla_w_uq, mla_kv_norm_g, mla_w_ukv,
              gmlp_ln_g, gmlp_ln_b, gmlp_ws, gmlp_b, need_ctx):
    s = p_x.shape[1]
    t = jnp.arange(s)
    pos = (t // GRID_W, t % GRID_W)
    cq_x, ckv_x, kr_x, gu_x, gv_x = split_cols(p_x, ODD_SPLITS)
    cq_c, ckv_c, kr_c, gu_c, gv_c = split_cols(p_c, ODD_SPLITS)
    scale = (MLA_NOPE + MLA_ROPE) ** -0.5

    def mla_q(cq, rpos):
        q = heads(rms_norm(cq, mla_q_norm_g) @ mla_w_uq, MLA_HEADS)
        q_nope, q_rope = q[..., :MLA_NOPE], q[..., MLA_NOPE:]
        if rpos is not None:
            q_rope = rope_2d(q_rope, *rpos)
        return jnp.concatenate([q_nope, q_rope], -1)

    def mla_kv(ckv, kr, rpos):
        kv = heads(rms_norm(ckv, mla_kv_norm_g) @ mla_w_ukv, MLA_HEADS)
        k_nope, v = kv[..., :MLA_NOPE], kv[..., MLA_NOPE:]
        k_rope = kr[:, None]
        if rpos is not None:
            k_rope = rope_2d(k_rope, *rpos)
        k = jnp.concatenate([k_nope, jnp.broadcast_to(k_rope, k_nope.shape[:-1] + (MLA_ROPE,))], -1)
        return k, v

    def chunk_gmlp(gu, gv):
        b, tl, _ = gu.shape
        u = jax.nn.gelu(gu, approximate=False)
        v = layer_norm(jax.nn.gelu(gv, approximate=False), gmlp_ln_g, gmlp_ln_b)
        v = v.reshape(b, tl // GMLP_CHUNK, GMLP_CHUNK, GMLP_GROUPS, GMLP_GROUP_CH)
        mixed = jnp.einsum('gij,bnjgc->bnigc', gmlp_ws, v) + gmlp_b.T[:, :, None]
        return u * mixed.reshape(b, tl, GMLP_WIDTH)

    k_c, v_c = mla_kv(ckv_c, kr_c, None)
    k_x, v_x = mla_kv(ckv_x, kr_x, pos)
    oc_x = softmax_attention(mla_q(cq_x, pos), jnp.concatenate([k_x, k_c], axis=2),
                             jnp.concatenate([v_x, v_c], axis=2), scale)
    y_x = jnp.concatenate([merge(oc_x), chunk_gmlp(gu_x, gv_x)], -1) @ w_out
    if not need_ctx:
        return y_x, None
    oc_c = softmax_attention(mla_q(cq_c, None), k_c, v_c, scale)
    y_c = jnp.concatenate([merge(oc_c), chunk_gmlp(gu_c, gv_c)], -1) @ w_out
    return y_x, y_c


def modulation(cond, w, b):
    return (jax.nn.silu(cond) @ w + b).reshape(cond.shape[:-1] + (N_MOD, cond.shape[-1]))


def modulate(h, m, k):
    return h * (1.0 + m[..., k + 1, :]) + m[..., k, :]


def swiglu(u, w_in, w_out):
    g, a = jnp.split(u @ w_in, 2, axis=-1)
    return (jax.nn.silu(g) * a) @ w_out


def setup_inputs(seed: int = 0) -> dict:
    key = jax.random.key(seed)
    ks = iter(jax.random.split(key, 32))

    def nrm(shape, s):
        return s * jax.random.normal(next(ks), shape, jnp.float32)

    D = D_MODEL
    return {
        "x": nrm((BATCH, SEQ, D), 1.0),
        "c": nrm((BATCH, D), 1.0),
        "ctx": nrm((BATCH, CTX_LEN, D), 1.0),
        "c_ctx": nrm((D,), 1.0),
        "mod_w": nrm((DEPTH, D, N_MOD * D), D ** -0.5),
        "mod_b": nrm((DEPTH, N_MOD * D), 0.01),
        "ln_mix_g": 1.0 + nrm((DEPTH, D), 0.02),
        "ln_mix_b": nrm((DEPTH, D), 0.02),
        "ln_ffn_g": 1.0 + nrm((DEPTH, D), 0.02),
        "ln_ffn_b": nrm((DEPTH, D), 0.02),
        "ffn_w_in": nrm((DEPTH, D, 2 * FFN_HIDDEN), D ** -0.5),
        "ffn_w_out": nrm((DEPTH, FFN_HIDDEN, D), BETA * FFN_HIDDEN ** -0.5),
        "ev_w_in": nrm((N_EVEN, D, EVEN_IN), D ** -0.5),
        "ev_w_out": nrm((N_EVEN, EVEN_MIX, D), BETA * EVEN_MIX ** -0.5),
        "diff_lambda": nrm((N_EVEN, 4, HEAD_DIM), 0.1),
        "diff_subln_g": 1.0 + nrm((N_EVEN, DIFF_V), 0.02),
        "na_rpb": nrm((N_EVEN, NA_HEADS, 2 * NA_ROWS - 1, 2 * NA_COLS - 1), 0.05),
        "od_w_in": nrm((N_ODD, D, ODD_IN), D ** -0.5),
        "od_w_out": nrm((N_ODD, ODD_MIX, D), BETA * ODD_MIX ** -0.5),
        "mla_q_norm_g": 1.0 + nrm((N_ODD, MLA_Q_RANK), 0.02),
        "mla_w_uq": nrm((N_ODD, MLA_Q_RANK, MLA_HEADS * (MLA_NOPE + MLA_ROPE)), MLA_Q_RANK ** -0.5),
        "mla_kv_norm_g": 1.0 + nrm((N_ODD, MLA_KV_RANK), 0.02),
        "mla_w_ukv": nrm((N_ODD, MLA_KV_RANK, MLA_HEADS * (MLA_NOPE + MLA_V)), MLA_KV_RANK ** -0.5),
        "gmlp_ln_g": 1.0 + nrm((N_ODD, GMLP_WIDTH), 0.02),
        "gmlp_ln_b": nrm((N_ODD, GMLP_WIDTH), 0.02),
        "gmlp_ws": nrm((N_ODD, GMLP_GROUPS, GMLP_CHUNK, GMLP_CHUNK), GMLP_CHUNK ** -0.5),
        "gmlp_b": 1.0 + nrm((N_ODD, GMLP_GROUPS, GMLP_CHUNK), 0.02),
    }


def reference(x, c, ctx, c_ctx, mod_w, mod_b, ln_mix_g, ln_mix_b, ln_ffn_g, ln_ffn_b,
              ffn_w_in, ffn_w_out, ev_w_in, ev_w_out, diff_lambda, diff_subln_g, na_rpb,
              od_w_in, od_w_out, mla_q_norm_g, mla_w_uq, mla_kv_norm_g, mla_w_ukv,
              gmlp_ln_g, gmlp_ln_b, gmlp_ws, gmlp_b):
    h_x, h_c = x, ctx
    for i in range(DEPTH):
        last = i == DEPTH - 1
        j = i // 2
        m_x = modulation(c, mod_w[i], mod_b[i])[:, None]
        m_c = modulation(c_ctx, mod_w[i], mod_b[i])[None, None]
        u_x, u_c = modulate(h_x, m_x, 0), modulate(h_c, m_c, 0)
        if i % 2 == 0:
            y_x, y_c = even_mixer(u_x @ ev_w_in[j], u_c @ ev_w_in[j], ev_w_out[j], diff_lambda[j],
                                  diff_subln_g[j], na_rpb[j], i, not last)
        else:
            y_x, y_c = odd_mixer(u_x @ od_w_in[j], u_c @ od_w_in[j], od_w_out[j], mla_q_norm_g[j],
                                 mla_w_uq[j], mla_kv_norm_g[j], mla_w_ukv[j], gmlp_ln_g[j],
                                 gmlp_ln_b[j], gmlp_ws[j], gmlp_b[j], not last)
        h_x = layer_norm(ALPHA * h_x + m_x[..., 2, :] * y_x, ln_mix_g[i], ln_mix_b[i])
        y_x = swiglu(modulate(h_x, m_x, 3), ffn_w_in[i], ffn_w_out[i])
        h_x = layer_norm(ALPHA * h_x + m_x[..., 5, :] * y_x, ln_ffn_g[i], ln_ffn_b[i])
        if not last:
            h_c = layer_norm(ALPHA * h_c + m_c[..., 2, :] * y_c, ln_mix_g[i], ln_mix_b[i])
            y_c = swiglu(modulate(h_c, m_c, 3), ffn_w_in[i], ffn_w_out[i])
            h_c = layer_norm(ALPHA * h_c + m_c[..., 5, :] * y_c, ln_ffn_g[i], ln_ffn_b[i])
    return h_x
```

```cpp
#include <hip/hip_runtime.h>
#include <hip/hip_cooperative_groups.h>
#include <cstdio>
#include <cstdint>
#include <cmath>
namespace cg = cooperative_groups;
namespace pg8 {
#define PG8_LAS __attribute__((address_space(3)))
typedef unsigned short bf16_t;
typedef short bf16x8 __attribute__((ext_vector_type(8)));
typedef float f32x4 __attribute__((ext_vector_type(4)));
typedef unsigned u32x4 __attribute__((ext_vector_type(4)));
typedef float f32x2 __attribute__((ext_vector_type(2)));
constexpr int BM = 256, BK = 64, HALF = 128, HTB = HALF * BK * 2  , STAGE_BYTES = 8 * HTB, NXCD = 8, WGM = 8;

__host__ __device__ __forceinline__ int lds_byte(int r, int c) { const int st = (r >> 4) * 2 + (c >> 5), rr = r & 15, cc = c & 31, ob = rr * 64 + cc * 2; return st * 1024 + (ob ^ (((ob >> 9) & 1) << 5)); }
__host__ __device__ __forceinline__ void stage_rc(int b, int& R, int& C) { const int st = b / 1024, sb = b % 1024, swz = sb ^ (((sb >> 9) & 1) << 5); R = (st >> 1) * 16 + swz / 64; C = (st & 1) * 32 + (swz % 64) / 2; }
__host__ __device__ __forceinline__ int perm32(int rho) { const int n = rho >> 4, i = rho & 15; return 8 * (i >> 2) + 4 * n + (i & 3); }

struct Unit { int pm, pn; };
struct Gemm { const bf16_t* A; const bf16_t* Bt; int M, N, K, lda, ldb; };

struct StaticOrder {
    int nM, nN, nwg, G, c;
    __host__ __device__ void init(int M, int N, int G_, int c_) { nM = M / BM; nN = N / BM; nwg = nM * nN; G = G_; c = c_; }
    __host__ __device__ bool next(int i, Unit& u) const {
        const long L = (long)i * G + c; if (L >= nwg) return false;
        int wgid = (int)L; { const int q = nwg / NXCD, r = nwg % NXCD, xcd = wgid % NXCD, off = wgid / NXCD; wgid = (xcd < r ? xcd * (q + 1) : r * (q + 1) + (xcd - r) * q) + off; }
        const int nig = WGM * nN, gid = wgid / nig, fm = gid * WGM, gsz = (nM - fm) < WGM ? (nM - fm) : WGM;
        u.pm = fm + ((wgid % nig) % gsz); u.pn = (wgid % nig) / gsz; return true;
    }
    __device__ __forceinline__ void a_ready(const Unit&) const {}
    __device__ __forceinline__ void done(const Unit&) const {}
};

__device__ __forceinline__ unsigned cvt_pk_bf16(float lo, float hi) { unsigned r; asm volatile("v_cvt_pk_bf16_f32 %0, %1, %2" : "=v"(r) : "v"(lo), "v"(hi)); return r; }
__device__ __forceinline__ f32x2 gelu_pk(f32x2 v) {
    const f32x2 av = __builtin_elementwise_abs(v), d = av * 0.2316418882f + 1.0f;
    f32x2 t; t.x = __builtin_amdgcn_rcpf(d.x); t.y = __builtin_amdgcn_rcpf(d.y);
    f32x2 q = t * 0.5307027145f + (-0.7265760135f); q = q * t + 0.7107068705f; q = q * t + (-0.142248368f); q = q * t + 0.127414796f; q = q * t;
    const f32x2 s = (v * v) * (-0.72134752044f);
    f32x2 e; e.x = __builtin_amdgcn_exp2f(s.x); e.y = __builtin_amdgcn_exp2f(s.y);
    const f32x2 m = v * (q * e), r = v - m;
    f32x2 o; o.x = v.x < 0.f ? m.x : r.x; o.y = v.y < 0.f ? m.y : r.y; return o;
}
template <class Epi, class Sched, bool ALIGN_EPI = false, bool SP2 = false>
__device__ __forceinline__ void gemm_phase(PG8_LAS unsigned char* lds, const Gemm g, const Sched& S, const Epi& E) {
    int tid = threadIdx.x; asm volatile("" : "+v"(tid));
    const int wid = __builtin_amdgcn_readfirstlane(tid >> 6), lane = tid & 63, wr = wid >> 2, wc = wid & 3, fr = lane & 15, fq = lane >> 4;
    const int K = g.K, nt = K / BK;
    unsigned voffA[2], voffB[2];
#pragma unroll
    for (int i = 0; i < 2; ++i) { int R, C; stage_rc(tid * 16 + i * 8192, R, C); const int Rb = Epi::PERM ? ((R & ~31) + perm32(R & 31)) : R;
        voffA[i] = (unsigned)(R * g.lda + C) * 2u; voffB[i] = (unsigned)(Rb * g.ldb + C) * 2u; }
    const size_t kstep = (size_t)(BK * 2);
    const size_t hstep = (size_t)HALF * g.ldb * 2;
    const size_t tstep = 2 * hstep; const size_t hstepA = (size_t)HALF * g.lda * 2, tstepA = 2 * hstepA;
    const unsigned ldsw = (unsigned)wid * 1024u;
    const int aoff = lds_byte(wr * 64 + fr, fq * 8), boff = lds_byte(wc * 32 + fr, fq * 8);
#define PG8_SA(b, h) (((b) * 2 + (h)) * HTB)
#define PG8_SB(b, h) ((4 + (b) * 2 + (h)) * HTB)
#define PG8_STAGE(bufoff, gbase, voff) do { _Pragma("unroll") for (int _i = 0; _i < 2; ++_i) \
        __builtin_amdgcn_global_load_lds((const unsigned*)((const char*)(gbase) + (voff)[_i]), (PG8_LAS unsigned*)(lds + (bufoff) + ldsw + _i * 8192), 16, 0, 0); } while (0)
#define PG8_LDA(dst, b, h) do { _Pragma("unroll") for (int m = 0; m < 4; ++m) _Pragma("unroll") for (int k = 0; k < 2; ++k) dst[m][k] = *(const PG8_LAS bf16x8*)(lds + PG8_SA(b, h) + aoff + m * 2048 + k * 1024); } while (0)
#define PG8_LDB(dst, b, h) do { _Pragma("unroll") for (int n = 0; n < 2; ++n) _Pragma("unroll") for (int k = 0; k < 2; ++k) dst[n][k] = *(const PG8_LAS bf16x8*)(lds + PG8_SB(b, h) + boff + n * 2048 + k * 1024); } while (0)
#define PG8_MMA(ai, bj, At, Bt) do { __builtin_amdgcn_s_setprio(1); _Pragma("unroll") for (int m = 0; m < 4; ++m) _Pragma("unroll") for (int n = 0; n < 2; ++n) _Pragma("unroll") for (int k = 0; k < 2; ++k) \
        acc[ai][bj][m][n] = __builtin_amdgcn_mfma_f32_16x16x32_bf16(Bt[n][k], At[m][k], acc[ai][bj][m][n], 0, 0, 0); __builtin_amdgcn_s_setprio(0); } while (0)
#define PG8_WAIT_V(n) asm volatile("s_waitcnt vmcnt(" #n ")" ::: "memory")
#define PG8_WAIT_L(n) asm volatile("s_waitcnt lgkmcnt(" #n ")" ::: "memory")
#define PG8_BAR __builtin_amdgcn_s_barrier()
#define PG8_SCHED __builtin_amdgcn_sched_barrier(0)
    Unit cur, nxt; int ui = 0;
    if (!S.next(0, cur)) return;
    f32x4 acc[2][2][4][2];
#pragma unroll
    for (int a = 0; a < 2; ++a)
#pragma unroll
        for (int b = 0; b < 2; ++b)
#pragma unroll
            for (int m = 0; m < 4; ++m)
#pragma unroll
                for (int n = 0; n < 2; ++n) acc[a][b][m][n] = (f32x4){0.f, 0.f, 0.f, 0.f};
    bf16x8 At[4][2], B0[2][2], B1[2][2];
    const char* cA = (const char*)g.A + (size_t)cur.pm * tstepA; const char* cB = (const char*)g.Bt + (size_t)cur.pn * tstep;
    S.a_ready(cur);
    if constexpr (SP2) {
        PG8_STAGE(PG8_SB(0, 0), cB, voffB); PG8_STAGE(PG8_SB(0, 1), cB + hstep, voffB); PG8_STAGE(PG8_SA(0, 0), cA, voffA); PG8_STAGE(PG8_SA(0, 1), cA + hstepA, voffA);
        if (wr == 1) PG8_BAR;
        PG8_WAIT_V(2); PG8_BAR;
        PG8_STAGE(PG8_SB(1, 0), cB + kstep, voffB); PG8_STAGE(PG8_SA(1, 0), cA + kstep, voffA); PG8_STAGE(PG8_SB(1, 1), cB + hstep + kstep, voffB);
        PG8_WAIT_V(6); PG8_BAR;
    } else {
        PG8_STAGE(PG8_SB(0, 0), cB, voffB); PG8_STAGE(PG8_SA(0, 0), cA, voffA); PG8_STAGE(PG8_SB(0, 1), cB + hstep, voffB); PG8_STAGE(PG8_SA(0, 1), cA + hstepA, voffA);
        if (wr == 1) PG8_BAR;
        PG8_WAIT_V(4); PG8_BAR;
        PG8_STAGE(PG8_SB(1, 0), cB + kstep, voffB); PG8_STAGE(PG8_SA(1, 0), cA + kstep, voffA); PG8_STAGE(PG8_SB(1, 1), cB + hstep + kstep, voffB);
        PG8_WAIT_V(6); PG8_BAR;
    }
    for (;;) {
        const bool has_next = S.next(ui + 1, nxt);
        const char* nA = has_next ? (const char*)g.A + (size_t)nxt.pm * tstepA : cA; const char* nB = has_next ? (const char*)g.Bt + (size_t)nxt.pn * tstep : cB;
#pragma nounroll
        for (int t = 0; t < nt; t += 2) {
            const bool last = (t == nt - 2);
            const char* a1 = cA + (size_t)(t + 1) * kstep;
            const char* a2 = last ? nA : cA + (size_t)(t + 2) * kstep; const char* b2 = last ? nB : cB + (size_t)(t + 2) * kstep;
            const char* a3 = a2 + kstep; const char* b3 = b2 + kstep;
            if (last && has_next) S.a_ready(nxt);
            if constexpr (SP2) {
            PG8_LDB(B0, 0, 0); PG8_LDB(B1, 0, 1); PG8_SCHED; PG8_LDA(At, 0, 0); PG8_STAGE(PG8_SA(1, 1), a1 + hstepA, voffA);
            PG8_WAIT_V(8); PG8_WAIT_L(0); PG8_BAR; PG8_MMA(0, 0, At, B0); PG8_MMA(0, 1, At, B1); PG8_BAR; PG8_SCHED;
            PG8_LDA(At, 0, 1); PG8_STAGE(PG8_SB(0, 0), b2, voffB); PG8_STAGE(PG8_SB(0, 1), b2 + hstep, voffB); PG8_STAGE(PG8_SA(0, 0), a2, voffA);
            PG8_WAIT_V(8); PG8_WAIT_L(0); PG8_BAR; PG8_MMA(1, 0, At, B0); PG8_MMA(1, 1, At, B1); PG8_BAR; PG8_SCHED;
            PG8_LDB(B0, 1, 0); PG8_LDB(B1, 1, 1); PG8_SCHED; PG8_LDA(At, 1, 0); PG8_STAGE(PG8_SA(0, 1), a2 + hstepA, voffA);
            PG8_WAIT_V(8); PG8_WAIT_L(0); PG8_BAR; PG8_MMA(0, 0, At, B0); PG8_MMA(0, 1, At, B1); PG8_BAR; PG8_SCHED;
            PG8_LDA(At, 1, 1); PG8_STAGE(PG8_SB(1, 0), b3, voffB); PG8_STAGE(PG8_SB(1, 1), b3 + hstep, voffB); PG8_STAGE(PG8_SA(1, 0), a3, voffA);
            PG8_WAIT_V(8); PG8_WAIT_L(0); PG8_BAR; PG8_MMA(1, 0, At, B0); PG8_MMA(1, 1, At, B1); PG8_BAR; PG8_SCHED;
            } else {
            PG8_LDB(B0, 0, 0); PG8_SCHED; PG8_LDA(At, 0, 0); PG8_STAGE(PG8_SA(1, 1), a1 + hstepA, voffA);
            PG8_WAIT_L(8); PG8_BAR; PG8_WAIT_L(0); PG8_MMA(0, 0, At, B0); PG8_BAR; PG8_SCHED;
            PG8_LDB(B1, 0, 1); PG8_STAGE(PG8_SB(0, 0), b2, voffB);
            PG8_BAR; PG8_WAIT_L(0); PG8_MMA(0, 1, At, B1); PG8_BAR;
            PG8_LDA(At, 0, 1); PG8_STAGE(PG8_SA(0, 0), a2, voffA);
            PG8_BAR; PG8_WAIT_L(0); PG8_MMA(1, 0, At, B0); PG8_BAR; PG8_SCHED;
            PG8_STAGE(PG8_SB(0, 1), b2 + hstep, voffB);
            PG8_WAIT_V(6); PG8_BAR; PG8_MMA(1, 1, At, B1); PG8_BAR;
            PG8_LDB(B0, 1, 0); PG8_SCHED; PG8_LDA(At, 1, 0); PG8_STAGE(PG8_SA(0, 1), a2 + hstepA, voffA);
            PG8_WAIT_L(8); PG8_BAR; PG8_WAIT_L(0); PG8_MMA(0, 0, At, B0); PG8_BAR; PG8_SCHED;
            PG8_LDB(B1, 1, 1); PG8_STAGE(PG8_SB(1, 0), b3, voffB);
            PG8_BAR; PG8_WAIT_L(0); PG8_MMA(0, 1, At, B1); PG8_BAR;
            PG8_LDA(At, 1, 1); PG8_STAGE(PG8_SA(1, 0), a3, voffA);
            PG8_BAR; PG8_WAIT_L(0); PG8_MMA(1, 0, At, B0); PG8_BAR; PG8_SCHED;
            PG8_STAGE(PG8_SB(1, 1), b3 + hstep, voffB);
            PG8_WAIT_V(6); PG8_BAR; PG8_MMA(1, 1, At, B1); PG8_BAR;
            }
        }
        if constexpr (ALIGN_EPI) { if (wr == 0) PG8_BAR; }
        if constexpr (!Epi::AFTER_DRAIN) { E(acc, cur, wr, wc, fr, fq); S.done(cur); }
        if (!has_next) break;
#pragma unroll
        for (int a = 0; a < 2; ++a)
#pragma unroll
            for (int b = 0; b < 2; ++b)
#pragma unroll
                for (int m = 0; m < 4; ++m)
#pragma unroll
                    for (int n = 0; n < 2; ++n) acc[a][b][m][n] = (f32x4){0.f, 0.f, 0.f, 0.f};
        cur = nxt; cA = nA; cB = nB; ++ui;
        if constexpr (ALIGN_EPI) { if (wr == 1) PG8_BAR; }
    }
    PG8_WAIT_V(0);
    if constexpr (!ALIGN_EPI) { if (wr == 0) PG8_BAR; }
    PG8_BAR;
    if constexpr (Epi::AFTER_DRAIN) { E.fused(acc, cur, wr, wc, fr, fq, lds, wid, lane); S.done(cur); }
#undef PG8_SA
#undef PG8_SB
#undef PG8_STAGE
#undef PG8_LDA
#undef PG8_LDB
#undef PG8_MMA
#undef PG8_WAIT_V
#undef PG8_WAIT_L
#undef PG8_BAR
#undef PG8_SCHED
}
}

using pg8::bf16_t; using pg8::f32x4; using pg8::u32x4; using pg8::Unit;
#define LAS __attribute__((address_space(3)))
typedef unsigned u32x2 __attribute__((ext_vector_type(2)));
typedef float f32x2v __attribute__((ext_vector_type(2)));
typedef float f32x16 __attribute__((ext_vector_type(16)));
typedef short bf16x8 __attribute__((ext_vector_type(8)));
typedef short s16x4 __attribute__((ext_vector_type(4)));
typedef short v4i16_t __attribute__((ext_vector_type(4)));

constexpr int SEQ_ = 8192, DM = 1024, ML = 16384, MT = 16896, FH = 2816;
constexpr int PW0 = 3072;
constexpr int PW1 = 1792;
constexpr int STP = 112;
constexpr float ALPHA_ = 1.4142135623730951f;
constexpr float LOG2E_ = 1.4426950408889634f;
constexpr float QS64 = 0.125f * 1.4426950408889634f;
constexpr float QS96 = (float)(1.4426950408889634 / 9.797958971132712);
constexpr float LAMBDA_INIT = 0.2f;

constexpr size_t MiB_ = 1u << 20;
constexpr size_t O_EVIN = 0, O_EVOUT = O_EVIN + 6291456, O_FFIN0 = O_EVOUT + 2097152, O_FFOUT0 = O_FFIN0 + 11534336;
constexpr size_t O_FFIN1 = O_FFOUT0 + 5767168, O_FFOUT1 = O_FFIN1 + 11534336, O_ODIN = O_FFOUT1 + 5767168, O_ODOUT = O_ODIN + 3670016;
constexpr size_t O_UQ = O_ODOUT + 2097152, O_UKV = O_UQ + 589824, O_GWS = O_UKV + 524288, O_MOD = O_GWS + 131072, O_TAB32 = O_MOD + 147456, O_TAB16 = O_TAB32 + 16384;
constexpr size_t O_SLOT0 = 48 * MiB_, O_SLOT1 = 51 * MiB_, O_SLOT2 = 145 * MiB_, O_SLOT3 = 148 * MiB_;
static_assert(O_TAB16 + 8192 <= O_SLOT0 && O_SLOT1 + (size_t)16896 * 128 <= 54 * MiB_, "ws map");
constexpr size_t O_Q1 = 0;
static_assert((size_t)ML * 768 * 2 <= O_FFIN1, "Q1 overlay");
constexpr size_t O_P = 54 * MiB_, O_H = 153 * MiB_, O_U = 219 * MiB_, WS_NEED = 253 * MiB_, O_BAR = 252 * MiB_, O_CNT = O_BAR + 16384, O_PCNT = O_CNT + 4 * 66 * 256, O_XCNT = O_PCNT + 2 * 8 * 256, CTL_BYTES = 16384 + 4 * 66 * 256 + 2 * 8 * 256 + 128 * 256;
constexpr size_t O_ODIFF = O_H, O_AMIX0 = O_U, O_ACT = O_P, O_P1 = O_P, O_AMIX1 = 112 * MiB_, O_STATS = 144 * MiB_, O_KV1 = O_U;
static_assert(O_P1 + (size_t)MT * PW1 * 2 <= O_AMIX1 && O_STATS + (size_t)MT * STP * 4 <= O_H, "ws map 2");

__device__ __forceinline__ unsigned f2bf(float f) { unsigned u = __builtin_bit_cast(unsigned, f); return (u + 0x7fffu + ((u >> 16) & 1u)) >> 16; }
typedef __bf16 bf16x2_hw __attribute__((ext_vector_type(2)));
__device__ __forceinline__ unsigned pk2(float lo, float hi) { f32x2v v = {lo, hi}; bf16x2_hw b = __builtin_convertvector(v, bf16x2_hw); return __builtin_bit_cast(unsigned, b); }
__device__ __forceinline__ float bf2f(unsigned short b) { return __builtin_bit_cast(float, (unsigned)b << 16); }
__device__ __forceinline__ float wave_sum(float v) {
#pragma unroll
    for (int o = 1; o < 64; o <<= 1) v += __shfl_xor(v, o);
    return v;
}
__device__ __forceinline__ float gelu_exact(float v) { return 0.5f * v * (1.0f + erff(v * 0.70710678118654752f)); }
__device__ __forceinline__ int modset(int pm) { return pm < 32 ? 0 : (pm < 64 ? 1 : 2); }

struct EpiIn0 {
    static constexpr bool PERM = true, AFTER_DRAIN = false;
    bf16_t* P; const float* tab32;
    __device__ __forceinline__ void operator()(const f32x4 (&acc)[2][2][4][2], const Unit& u, int wr, int wc, int fr, int fq) const {
        asm volatile("" : "+v"(fr), "+v"(fq));
        const int region = u.pn >> 1;
        const bool rope = (region <= 1) && (u.pm < 64);
        const float sc = (region == 0 || region == 3) ? QS64 : 1.f;
        const float sgn = (fq < 2) ? -1.f : 1.f;
#pragma unroll
        for (int ai = 0; ai < 2; ++ai)
#pragma unroll
            for (int m = 0; m < 4; ++m) {
                const int row = u.pm * 256 + ai * 128 + wr * 64 + m * 16 + fr;
                const int t = row & 8191; const int pos = (wc & 1) ? (t & 63) : (t >> 6);
                const float* tb = tab32 + (pos * 16 + 8 * (fq & 1)) * 2;
#pragma unroll
                for (int bj = 0; bj < 2; ++bj) {
                    const int col = u.pn * 256 + bj * 128 + wc * 32 + 8 * fq;
                    float v[8];
#pragma unroll
                    for (int i = 0; i < 4; ++i) { v[i] = acc[ai][bj][m][0][i]; v[4 + i] = acc[ai][bj][m][1][i]; }
                    if (rope) {
                        const f32x4 t0 = *(const f32x4*)tb, t1 = *(const f32x4*)(tb + 4), t2 = *(const f32x4*)(tb + 8), t3 = *(const f32x4*)(tb + 12);
                        const float cs[8] = {t0[0], t0[2], t1[0], t1[2], t2[0], t2[2], t3[0], t3[2]};
                        const float sn[8] = {t0[1], t0[3], t1[1], t1[3], t2[1], t2[3], t3[1], t3[3]};
#pragma unroll
                        for (int i = 0; i < 8; ++i) { const float pr = __shfl_xor(v[i], 32); v[i] = v[i] * cs[i] + sgn * pr * sn[i]; }
                    }
                    u32x4 w; w.x = pk2(v[0] * sc, v[1] * sc); w.y = pk2(v[2] * sc, v[3] * sc); w.z = pk2(v[4] * sc, v[5] * sc); w.w = pk2(v[6] * sc, v[7] * sc);
                    *(u32x4*)(P + (size_t)row * PW0 + col) = w;
                }
            }
    }
};
struct EpiRes {
    static constexpr bool PERM = true, AFTER_DRAIN = false;
    const float* hx; const float* hc; float* Z; const float* gate;
    __device__ __forceinline__ void operator()(const f32x4 (&acc)[2][2][4][2], const Unit& u, int wr, int wc, int fr, int fq) const {
        asm volatile("" : "+v"(fr), "+v"(fq));
        const float* gp = gate + modset(u.pm) * 6144;
#pragma unroll
        for (int bj = 0; bj < 2; ++bj) {
            const int col = u.pn * 256 + bj * 128 + wc * 32 + 8 * fq;
            const f32x4 g0 = *(const f32x4*)(gp + col), g1 = *(const f32x4*)(gp + col + 4);
#pragma unroll
            for (int ai = 0; ai < 2; ++ai)
#pragma unroll
                for (int m = 0; m < 4; ++m) {
                    const int row = u.pm * 256 + ai * 128 + wr * 64 + m * 16 + fr;
                    const float* hb = (u.pm < 64) ? hx + (size_t)row * DM : hc + (size_t)(row - ML) * DM;
                    const f32x4 h0 = *(const f32x4*)(hb + col), h1 = *(const f32x4*)(hb + col + 4);
                    const f32x4 z0 = h0 * ALPHA_ + g0 * acc[ai][bj][m][0], z1 = h1 * ALPHA_ + g1 * acc[ai][bj][m][1];
                    float* zp = Z + (size_t)row * DM + col;
                    *(f32x4*)zp = z0; *(f32x4*)(zp + 4) = z1;
                }
        }
    }
};

struct PanelOrder {
    int nP, c;
    __device__ void init(int M, int c_) { nP = M / 256; c = c_; }
    __device__ bool next(int i, Unit& u) const {
        const int rem = nP - 64 * i;
        if (rem >= 64) { const int x = c & 7, j = c >> 3; u.pm = 64 * i + 8 * x + (j & 7); u.pn = j >> 3; return true; }
        if (rem > 0 && c < 4 * rem) { u.pm = 64 * i + (c >> 2); u.pn = c & 3; return true; }
        return false;
    }
    __device__ __forceinline__ void a_ready(const Unit&) const {}
    __device__ __forceinline__ void done(const Unit&) const {}
};
struct TailOrder {
    int c;
    __device__ bool next(int i, Unit& u) const { if (i > 0 || c >= 32) return false; u.pm = 64 + (c >> 4); u.pn = (c >> 2) & 3; return true; }
    __device__ __forceinline__ void a_ready(const Unit&) const {}
    __device__ __forceinline__ void done(const Unit&) const {}
};
template <bool HIN16, bool HOUT16>
struct EpiResLN {
    static constexpr bool PERM = true, AFTER_DRAIN = false;
    const void* hx; const void* hc; const float* gate;
    unsigned* cnt; unsigned long long* slots; const float* lg; const float* lb; void* dst; bf16_t* U; const float* modl; int kmod;
    float* part_buf; unsigned* part_cnt; int part;
    __device__ __forceinline__ void operator()(const f32x4 (&acc)[2][2][4][2], const Unit& u, int wr, int wc, int fr, int fq) const {
        asm volatile("" : "+v"(fr), "+v"(fq));
        const int set = modset(u.pm);
        const float* gp = gate + set * 6144;
        const int colb = u.pn * 256 + wc * 32 + 8 * fq;
        const int tunit = (u.pm - 64) * 4 + u.pn;
        int tid_ = threadIdx.x; asm volatile("" : "+v"(tid_));
        if (part_buf && part != 0) {
            float* pb = part_buf + ((size_t)(tunit * 3 + part - 1) * 32 * 512 + tid_) * 4;
#pragma unroll
            for (int ai = 0; ai < 2; ++ai)
#pragma unroll
                for (int bj = 0; bj < 2; ++bj)
#pragma unroll
                    for (int m = 0; m < 4; ++m)
#pragma unroll
                        for (int hf = 0; hf < 2; ++hf) {
                            const f32x4 v = acc[ai][bj][m][hf]; float* dp = pb + (size_t)((((ai * 2 + bj) * 4 + m) * 2 + hf) * 512) * 4;
                            asm volatile("global_store_dwordx4 %0, %1, off sc1" :: "v"(dp), "v"(v) : "memory");
                        }
            asm volatile("s_waitcnt vmcnt(0)" ::: "memory"); __builtin_amdgcn_s_barrier(); asm volatile("" ::: "memory");
            if (threadIdx.x == 0) __hip_atomic_fetch_add(part_cnt + 64 * tunit, 1u, __ATOMIC_RELAXED, __HIP_MEMORY_SCOPE_AGENT);
            return;
        }
        if (part_buf) {
            if (threadIdx.x == 0) {
                unsigned sp = 0;
                while (__hip_atomic_load(part_cnt + 64 * tunit, __ATOMIC_RELAXED, __HIP_MEMORY_SCOPE_AGENT) < 3u) { __builtin_amdgcn_s_sleep(1); if (++sp > (1u << 24)) break; }
                __builtin_amdgcn_fence(__ATOMIC_ACQUIRE, "agent"); asm volatile("s_waitcnt vmcnt(0)" ::: "memory");
            }
            asm volatile("s_waitcnt vmcnt(0) lgkmcnt(0)" ::: "memory"); __builtin_amdgcn_s_barrier(); asm volatile("" ::: "memory");
        }
        const float* pb0 = part_buf ? part_buf + ((size_t)(tunit * 3) * 32 * 512 + tid_) * 4 : nullptr;
        f32x4 z[2][4][2][2];
        {
            f32x4 g[2][2];
#pragma unroll
            for (int bj = 0; bj < 2; ++bj) { g[bj][0] = *(const f32x4*)(gp + colb + bj * 128); g[bj][1] = *(const f32x4*)(gp + colb + bj * 128 + 4); }
#pragma unroll
            for (int ai = 0; ai < 2; ++ai)
#pragma unroll
                for (int m = 0; m < 4; ++m) {
                    const int r = ai * 128 + wr * 64 + m * 16 + fr, row = u.pm * 256 + r;
                    const size_t hoff = ((u.pm < 64) ? (size_t)row * DM : (size_t)(row - ML) * DM) + colb;
                    const float* hb = (const float*)((u.pm < 64) ? hx : hc) + hoff;
                    const bf16_t* hb16 = (const bf16_t*)((u.pm < 64) ? hx : hc) + hoff;
                    float s = 0.f, q = 0.f;
#pragma unroll
                    for (int bj = 0; bj < 2; ++bj) {
                        f32x4 h0, h1;
                        if (HIN16) { const u32x4 hw = *(const u32x4*)(hb16 + bj * 128);
                            h0 = (f32x4){__uint_as_float(hw[0] << 16), __uint_as_float(hw[0] & 0xffff0000u), __uint_as_float(hw[1] << 16), __uint_as_float(hw[1] & 0xffff0000u)};
                            h1 = (f32x4){__uint_as_float(hw[2] << 16), __uint_as_float(hw[2] & 0xffff0000u), __uint_as_float(hw[3] << 16), __uint_as_float(hw[3] & 0xffff0000u)}; }
                        else { h0 = *(const f32x4*)(hb + bj * 128); h1 = *(const f32x4*)(hb + bj * 128 + 4); }
                        f32x4 a0 = acc[ai][bj][m][0], a1 = acc[ai][bj][m][1];
                        if (part_buf) {
#pragma unroll
                            for (int pp = 0; pp < 3; ++pp) { const float* pq = pb0 + (size_t)(pp * 32 + ((ai * 2 + bj) * 4 + m) * 2) * 512 * 4;
                                a0 += *(const f32x4*)pq; a1 += *(const f32x4*)(pq + 512 * 4); }
                        }
                        const f32x4 z0 = h0 * ALPHA_ + g[bj][0] * a0, z1 = h1 * ALPHA_ + g[bj][1] * a1;
                        z[ai][m][bj][0] = z0; z[ai][m][bj][1] = z1;
                        s += (z0[0] + z0[1]) + (z0[2] + z0[3]) + (z1[0] + z1[1]) + (z1[2] + z1[3]);
                        q += (z0[0] * z0[0] + z0[1] * z0[1]) + (z0[2] * z0[2] + z0[3] * z0[3]) + (z1[0] * z1[0] + z1[1] * z1[1]) + (z1[2] * z1[2] + z1[3] * z1[3]);
                    }
                    s += __shfl_xor(s, 16); s += __shfl_xor(s, 32); q += __shfl_xor(q, 16); q += __shfl_xor(q, 32);
                    if (fq == 0) __hip_atomic_store(slots + ((size_t)(u.pm * 256 + r) * 16 + u.pn * 4 + wc), ((unsigned long long)__float_as_uint(q) << 32) | __float_as_uint(s), __ATOMIC_RELAXED, __HIP_MEMORY_SCOPE_AGENT);
                    if (m == 3) asm volatile("" ::: "memory");
                }
        }
        asm volatile("s_waitcnt vmcnt(0)" ::: "memory"); __builtin_amdgcn_s_barrier(); asm volatile("" ::: "memory");
        if (threadIdx.x == 0) {
            unsigned* cw = cnt + 64 * u.pm;
            __hip_atomic_fetch_add(cw, 1u, __ATOMIC_RELAXED, __HIP_MEMORY_SCOPE_AGENT);
            unsigned sp = 0;
            while (__hip_atomic_load(cw, __ATOMIC_RELAXED, __HIP_MEMORY_SCOPE_AGENT) < 4u) { __builtin_amdgcn_s_sleep(1); if (++sp > (1u << 24)) break; }
            __builtin_amdgcn_fence(__ATOMIC_ACQUIRE, "agent"); asm volatile("s_waitcnt vmcnt(0)" ::: "memory");
        }
        asm volatile("s_waitcnt vmcnt(0) lgkmcnt(0)" ::: "memory"); __builtin_amdgcn_s_barrier(); asm volatile("" ::: "memory");
        const float* mp = U ? modl + set * 6144 + kmod * 1024 + colb : nullptr;
        f32x4 sv[2][4][2];
#pragma unroll
        for (int ai = 0; ai < 2; ++ai)
#pragma unroll
            for (int m = 0; m < 4; ++m) {
                const int r = ai * 128 + wr * 64 + m * 16 + fr;
                const f32x4* sl = (const f32x4*)(slots + ((size_t)(u.pm * 256 + r) * 16 + fq * 4));
                sv[ai][m][0] = sl[0]; sv[ai][m][1] = sl[1];
            }
        float mean_[2][4], rstd_[2][4];
#pragma unroll
        for (int ai = 0; ai < 2; ++ai)
#pragma unroll
            for (int m = 0; m < 4; ++m) {
                float s = (sv[ai][m][0][0] + sv[ai][m][0][2]) + (sv[ai][m][1][0] + sv[ai][m][1][2]);
                float q = (sv[ai][m][0][1] + sv[ai][m][0][3]) + (sv[ai][m][1][1] + sv[ai][m][1][3]);
                s += __shfl_xor(s, 16); s += __shfl_xor(s, 32); q += __shfl_xor(q, 16); q += __shfl_xor(q, 32);
                const float mean = s * (1.f / DM);
                mean_[ai][m] = mean; rstd_[ai][m] = 1.f / sqrtf(fmaxf(q * (1.f / DM) - mean * mean, 0.f) + 1e-5f);
            }
        asm volatile("" ::: "memory");
#pragma unroll
        for (int bj = 0; bj < 2; ++bj) {
            const int col = colb + bj * 128;
            const f32x4 lg0 = *(const f32x4*)(lg + col), lg1 = *(const f32x4*)(lg + col + 4), lb0 = *(const f32x4*)(lb + col), lb1 = *(const f32x4*)(lb + col + 4);
            f32x4 sh0 = {}, sh1 = {}, sc0 = {}, sc1 = {};
            if (U) { sh0 = *(const f32x4*)(mp + bj * 128); sh1 = *(const f32x4*)(mp + bj * 128 + 4); sc0 = *(const f32x4*)(mp + 1024 + bj * 128) + 1.f; sc1 = *(const f32x4*)(mp + 1024 + bj * 128 + 4) + 1.f; }
#pragma unroll
            for (int ai = 0; ai < 2; ++ai)
#pragma unroll
                for (int m = 0; m < 4; ++m) {
                    const int r = ai * 128 + wr * 64 + m * 16 + fr, row = u.pm * 256 + r;
                    const float mean = mean_[ai][m], rstd = rstd_[ai][m];
                    const f32x4 h0 = (z[ai][m][bj][0] - mean) * rstd * lg0 + lb0, h1 = (z[ai][m][bj][1] - mean) * rstd * lg1 + lb1;
                    if (HOUT16) *(u32x4*)((bf16_t*)dst + (size_t)row * DM + col) = (u32x4){pk2(h0[0], h0[1]), pk2(h0[2], h0[3]), pk2(h1[0], h1[1]), pk2(h1[2], h1[3])};
                    else { float* dp = (float*)dst + (size_t)row * DM + col; *(f32x4*)dp = h0; *(f32x4*)(dp + 4) = h1; }
                    if (U) { const f32x4 u0 = h0 * sc0 + sh0, u1 = h1 * sc1 + sh1;
                        *(u32x4*)(U + (size_t)row * DM + col) = (u32x4){pk2(u0[0], u0[1]), pk2(u0[2], u0[3]), pk2(u1[0], u1[1]), pk2(u1[2], u1[3])}; }
                }
            asm volatile("" ::: "memory");
        }
    }
};
struct EpiFfn {
    static constexpr bool PERM = true, AFTER_DRAIN = false;
    bf16_t* ACT;
    __device__ __forceinline__ void operator()(const f32x4 (&acc)[2][2][4][2], const Unit& u, int wr, int wc, int fr, int fq) const {
        asm volatile("" : "+v"(fr), "+v"(fq));
        const int hcol = u.pn * 128 + wc * 32 + 8 * fq;
#pragma unroll
        for (int ai = 0; ai < 2; ++ai)
#pragma unroll
            for (int m = 0; m < 4; ++m) {
                const int row = u.pm * 256 + ai * 128 + wr * 64 + m * 16 + fr;
                float o[8];
#pragma unroll
                for (int i = 0; i < 8; ++i) { const float g = acc[ai][0][m][i >> 2][i & 3], a = acc[ai][1][m][i >> 2][i & 3]; o[i] = g * __builtin_amdgcn_rcpf(1.f + __builtin_amdgcn_exp2f(-1.4426950408889634f * g)) * a; }
                u32x4 w; w.x = pk2(o[0], o[1]); w.y = pk2(o[2], o[3]); w.z = pk2(o[4], o[5]); w.w = pk2(o[6], o[7]);
                *(u32x4*)(ACT + (size_t)row * FH + hcol) = w;
            }
    }
};
struct EpiIn1 {
    static constexpr bool PERM = true, AFTER_DRAIN = false;
    bf16_t* P1; float* stats; const float* tab16;
    __device__ __forceinline__ void operator()(const f32x4 (&acc)[2][2][4][2], const Unit& u, int wr, int wc, int fr, int fq) const {
        asm volatile("" : "+v"(fr), "+v"(fq));
#pragma unroll
        for (int bj = 0; bj < 2; ++bj) {
            const int col32 = u.pn * 256 + bj * 128 + wc * 32, col = col32 + 8 * fq, grp = col32 >> 5;
            if (col32 >= 672 && col32 < 768) continue;
            const int kind = (col32 < 640) ? 0 : (col32 < 672 ? 1 : (col32 < 1280 ? 2 : 3));
#pragma unroll
            for (int ai = 0; ai < 2; ++ai)
#pragma unroll
                for (int m = 0; m < 4; ++m) {
                    const int row = u.pm * 256 + ai * 128 + wr * 64 + m * 16 + fr;
                    float v[8];
#pragma unroll
                    for (int i = 0; i < 4; ++i) { v[i] = acc[ai][bj][m][0][i]; v[4 + i] = acc[ai][bj][m][1][i]; }
                    if (kind == 1) {
                        if (u.pm < 64) {
                            const int t = row & 8191; const int pos = (fq & 2) ? (t & 63) : (t >> 6);
                            const float* tb = tab16 + pos * 16;
                            const f32x4 t0 = *(const f32x4*)tb, t1 = *(const f32x4*)(tb + 4), t2 = *(const f32x4*)(tb + 8), t3 = *(const f32x4*)(tb + 12);
                            const float cs[8] = {t0[0], t0[2], t1[0], t1[2], t2[0], t2[2], t3[0], t3[2]};
                            const float sn[8] = {t0[1], t0[3], t1[1], t1[3], t2[1], t2[3], t3[1], t3[3]};
                            const float sgn = (fq & 1) ? 1.f : -1.f;
#pragma unroll
                            for (int i = 0; i < 8; ++i) { const float pr = __shfl_xor(v[i], 16); v[i] = v[i] * cs[i] + sgn * pr * sn[i]; }
                        }
                    } else if (kind >= 2) {
#pragma unroll
                        for (int i = 0; i < 8; i += 2) { const pg8::f32x2 gv2 = pg8::gelu_pk((pg8::f32x2){v[i], v[i + 1]}); v[i] = gv2.x; v[i + 1] = gv2.y; }
                    }
                    if (kind == 0 || kind == 3) {
                        float s = 0.f, q = 0.f;
#pragma unroll
                        for (int i = 0; i < 8; ++i) { s += v[i]; q += v[i] * v[i]; }
                        s += __shfl_xor(s, 16); s += __shfl_xor(s, 32); q += __shfl_xor(q, 16); q += __shfl_xor(q, 32);
                        if (fq == 0) *(f32x2v*)(stats + (size_t)row * STP + grp * 2) = (f32x2v){s, q};
                    }
                    u32x4 w; w.x = pk2(v[0], v[1]); w.y = pk2(v[2], v[3]); w.z = pk2(v[4], v[5]); w.w = pk2(v[6], v[7]);
                    *(u32x4*)(P1 + (size_t)row * PW1 + col) = w;
                    asm volatile("" ::: "memory");
                }
        }
    }
};
struct EpiQ1 {
    static constexpr bool PERM = true, AFTER_DRAIN = false;
    bf16_t* Q1; const float* stats; const float* tab16;
    __device__ __forceinline__ void operator()(const f32x4 (&acc)[2][2][4][2], const Unit& u, int wr, int wc, int fr, int fq) const {
        asm volatile("" : "+v"(fr), "+v"(fq));
#pragma unroll
        for (int ai = 0; ai < 2; ++ai)
#pragma unroll
            for (int m = 0; m < 4; ++m) {
                const int row = u.pm * 256 + ai * 128 + wr * 64 + m * 16 + fr;
                const float* sp = stats + (size_t)row * STP + fq * 6;
                float q = sp[1] + sp[3] + sp[5];
                q += __shfl_xor(q, 16); q += __shfl_xor(q, 32);
                const float rs = QS96 / sqrtf(q * (1.f / 384.f) + 1e-6f);
                const int t = row & 8191; const int pos = (fq & 2) ? (t & 63) : (t >> 6);
                const float* tb = tab16 + pos * 16;
                const float sgn = (fq & 1) ? 1.f : -1.f;
#pragma unroll
                for (int bj = 0; bj < 2; ++bj) {
                    const int col32 = u.pn * 256 + bj * 128 + wc * 32, col = col32 + 8 * fq;
                    const bool rope = ((col32 >> 5) % 3) == 2;
                    float v[8];
#pragma unroll
                    for (int i = 0; i < 4; ++i) { v[i] = acc[ai][bj][m][0][i]; v[4 + i] = acc[ai][bj][m][1][i]; }
                    if (rope) {
                        const f32x4 t0 = *(const f32x4*)tb, t1 = *(const f32x4*)(tb + 4), t2 = *(const f32x4*)(tb + 8), t3 = *(const f32x4*)(tb + 12);
                        const float cs[8] = {t0[0], t0[2], t1[0], t1[2], t2[0], t2[2], t3[0], t3[2]};
                        const float sn[8] = {t0[1], t0[3], t1[1], t1[3], t2[1], t2[3], t3[1], t3[3]};
#pragma unroll
                        for (int i = 0; i < 8; ++i) { const float pr = __shfl_xor(v[i], 16); v[i] = v[i] * cs[i] + sgn * pr * sn[i]; }
                    }
                    u32x4 w; w.x = pk2(v[0] * rs, v[1] * rs); w.y = pk2(v[2] * rs, v[3] * rs); w.z = pk2(v[4] * rs, v[5] * rs); w.w = pk2(v[6] * rs, v[7] * rs);
                    *(u32x4*)(Q1 + (size_t)row * 768 + col) = w;
                }
                asm volatile("" ::: "memory");
            }
    }
};
struct EpiKV1 {
    static constexpr bool PERM = true, AFTER_DRAIN = false;
    bf16_t* KV1; const float* stats;
    __device__ __forceinline__ void operator()(const f32x4 (&acc)[2][2][4][2], const Unit& u, int wr, int wc, int fr, int fq) const {
        asm volatile("" : "+v"(fr), "+v"(fq));
#pragma unroll
        for (int ai = 0; ai < 2; ++ai)
#pragma unroll
            for (int m = 0; m < 4; ++m) {
                const int row = u.pm * 256 + ai * 128 + wr * 64 + m * 16 + fr;
                const float* sp = stats + (size_t)row * STP + 24 + fq * 4;
                float q = sp[1] + sp[3];
                q += __shfl_xor(q, 16); q += __shfl_xor(q, 32);
                const float rs = 1.f / sqrtf(q * (1.f / 256.f) + 1e-6f);
#pragma unroll
                for (int bj = 0; bj < 2; ++bj) {
                    const int col = u.pn * 256 + bj * 128 + wc * 32 + 8 * fq;
                    const f32x4 a = acc[ai][bj][m][0] * rs, b = acc[ai][bj][m][1] * rs;
                    u32x4 w; w.x = pk2(a[0], a[1]); w.y = pk2(a[2], a[3]); w.z = pk2(b[0], b[1]); w.w = pk2(b[2], b[3]);
                    *(u32x4*)(KV1 + (size_t)row * 1024 + col) = w;
                }
                asm volatile("" ::: "memory");
            }
    }
};

struct AttnDesc {
    const bf16_t* Q; int qpitch;
    const bf16_t* K; int kpitch;
    const bf16_t* K2; int k2pitch;
    const bf16_t* V; int vpitch;
    float* Of; bf16_t* Ob; int opitch;
    int qrow0;
    int ntiles, nlat, lat_row0, ctx_row0;
    int na_rowlo, na_gr0;
    const float* rpb;
    float lam; const float* subg;
};
__device__ __forceinline__ s16x4 tr_read(const LAS unsigned char* p) { return __builtin_bit_cast(s16x4, __builtin_amdgcn_ds_read_tr16_b64_v4i16((LAS v4i16_t*)p)); }


__device__ __forceinline__ void glds16(const void* gsrc, unsigned lds_dst) { unsigned keep;
    asm volatile("s_mov_b32 %0, m0\n\ts_mov_b32 m0, %2\n\ts_nop 0\n\tglobal_load_lds_dwordx4 %1, off\n\ts_mov_b32 m0, %0" : "=&s"(keep) : "v"(gsrc), "s"(lds_dst) : "memory"); }
template <int NDB>
__device__ __forceinline__ void att_softmax(f32x16& p0, f32x16& p1, f32x16 (&o)[NDB], float& mrun, float& lrun, bool& first, bf16x8 (&pf)[4]) {
    float ra = __builtin_fmaxf(__builtin_fmaxf(p0[0], p0[1]), p1[0]), rb = __builtin_fmaxf(__builtin_fmaxf(p0[2], p0[3]), p1[1]);
    ra = __builtin_fmaxf(__builtin_fmaxf(ra, p1[2]), p1[3]);
#pragma unroll
    for (int r = 4; r < 16; r += 4) { ra = __builtin_fmaxf(__builtin_fmaxf(ra, p0[r]), p0[r + 1]); rb = __builtin_fmaxf(__builtin_fmaxf(rb, p0[r + 2]), p0[r + 3]);
        ra = __builtin_fmaxf(__builtin_fmaxf(ra, p1[r]), p1[r + 1]); rb = __builtin_fmaxf(__builtin_fmaxf(rb, p1[r + 2]), p1[r + 3]); }
    float rm = __builtin_fmaxf(ra, rb);
    { auto rr = __builtin_amdgcn_permlane32_swap(__float_as_uint(rm), __float_as_uint(rm), false, false); rm = __builtin_fmaxf(__uint_as_float(rr[0]), __uint_as_float(rr[1])); }
    if (first || __any(rm > mrun + 8.f)) {
        const float mn = first ? rm : __builtin_fmaxf(mrun, rm);
        if (!first) { const float al = __builtin_amdgcn_exp2f(mrun - mn); lrun *= al;
#pragma unroll
            for (int i = 0; i < NDB; ++i) o[i] *= al; }
        mrun = mn; first = false;
    }
    float ls = 0.f;
#pragma unroll
    for (int r = 0; r < 16; ++r) { p0[r] = __builtin_amdgcn_exp2f(p0[r] - mrun); p1[r] = __builtin_amdgcn_exp2f(p1[r] - mrun); ls += p0[r] + p1[r]; }
    lrun += ls;
#pragma unroll
    for (int j = 0; j < 4; ++j) {
        u32x4 pw;
#pragma unroll
        for (int e = 0; e < 4; ++e) { const int r = 8 * (j & 1) + 2 * e; pw[e] = (j < 2) ? pk2(p0[r], p0[r + 1]) : pk2(p1[r], p1[r + 1]); }
        pf[j] = __builtin_bit_cast(bf16x8, pw);
    }
}
template <int NDB, int VS>
__device__ __forceinline__ void att_pv(f32x16 (&o)[NDB], const bf16x8 (&pf)[4], const LAS unsigned char* vb) {
#pragma unroll
    for (int j = 0; j < 4; ++j)
#pragma unroll
        for (int db = 0; db < NDB; ++db) {
            const s16x4 lo = tr_read(vb + (16 * j) * VS + db * 64), hh = tr_read(vb + (16 * j + 8) * VS + db * 64);
            const bf16x8 vf = (bf16x8){lo[0], lo[1], lo[2], lo[3], hh[0], hh[1], hh[2], hh[3]};
            o[db] = __builtin_amdgcn_mfma_f32_32x32x16_bf16(vf, pf[j], o[db], 0, 0, 0);
        }
}
template <int DQ, int DV, bool NA, int OMODE>
__device__ __forceinline__ void attn_unit(const AttnDesc d, LAS unsigned char* lds) {
    constexpr int KS = DQ * 2 + 16, VS = DV * 2 + 64;
    constexpr int KBUF = NA ? 64 * KS : (8192 + (DQ == 96 ? 4096 : 0)), VBUF = NA ? 64 * VS : 64 * DV * 2;
    constexpr int NBUF = NA ? 2 : 3;
    constexpr int OFF_K = 0, OFF_V = NBUF * KBUF, OFF_RPB = OFF_V + NBUF * VBUF;
    constexpr int NQF = DQ / 16, NDB = DV / 32;
    int tid = threadIdx.x; asm volatile("" : "+v"(tid));
    const int lane = tid & 63, w = __builtin_amdgcn_readfirstlane(tid >> 6), r32 = lane & 31, hi = lane >> 5;
    bf16x8 qf[NQF];
    { const bf16_t* qp = d.Q + (size_t)(d.qrow0 + 32 * w + r32) * d.qpitch + 8 * hi;
#pragma unroll
      for (int d0 = 0; d0 < NQF; ++d0) qf[d0] = *(const bf16x8*)(qp + 16 * d0); }
    LAS float* rpbL = (LAS float*)(lds + OFF_RPB);
    if (NA) { for (int i = tid; i < 465; i += 512) rpbL[i] = d.rpb[i] * LOG2E_; }
    const int kkey = tid >> 3, kch = tid & 7;
    const int k2key = tid >> 2, k2ch = tid & 3;
    u32x4 kA, kB, vA, vB;
#define ATT_TROW(i) ((i) < d.nlat ? d.lat_row0 + 64 * (i) : d.ctx_row0 + 64 * ((i) - d.nlat))
#define ATT_LOAD(i) do { const int tr_ = ATT_TROW(i); \
        kA = *(const u32x4*)(d.K + (size_t)(tr_ + kkey) * d.kpitch + kch * 8); \
        if (DQ == 96) { if (tid < 256) kB = *(const u32x4*)(d.K2 + (size_t)(tr_ + k2key) * d.k2pitch + k2ch * 8); } \
        if (DV == 128) { vA = *(const u32x4*)(d.V + (size_t)(tr_ + (tid >> 4)) * d.vpitch + (tid & 15) * 8); vB = *(const u32x4*)(d.V + (size_t)(tr_ + 32 + (tid >> 4)) * d.vpitch + (tid & 15) * 8); } \
        else { vA = *(const u32x4*)(d.V + (size_t)(tr_ + kkey) * d.vpitch + kch * 8); } } while (0)
#define ATT_STORE(b) do { \
        *(LAS u32x4*)(lds + OFF_K + (b) * KBUF + kkey * KS + kch * 16) = kA; \
        if (DQ == 96) { if (tid < 256) *(LAS u32x4*)(lds + OFF_K + (b) * KBUF + k2key * KS + 128 + k2ch * 16) = kB; } \
        if (DV == 128) { *(LAS u32x4*)(lds + OFF_V + (b) * VBUF + (tid >> 4) * VS + (tid & 15) * 16) = vA; *(LAS u32x4*)(lds + OFF_V + (b) * VBUF + (32 + (tid >> 4)) * VS + (tid & 15) * 16) = vB; } \
        else { *(LAS u32x4*)(lds + OFF_V + (b) * VBUF + kkey * VS + kch * 16) = vA; } } while (0)
    const int nt = d.ntiles;
    const unsigned ldsb = (unsigned)(uintptr_t)lds;
    int gko, gk2o = 0, gvo0, gvo1 = 0;
    { const int kr = 8 * w + (lane >> 3), kc = (lane & 7) ^ ((kr >> 1) & 7); gko = kr * d.kpitch + kc * 8;
      if (DQ == 96) { const int rr = 16 * (w & 3) + (lane >> 2), rc = (lane & 3) ^ ((rr >> 2) & 3); gk2o = rr * d.k2pitch + rc * 8; }
      if (DV == 128) { const int pos = lane & 15, sp = pos >> 2, sub = pos & 3;
          const int r0 = 8 * w + (lane >> 4), r1 = r0 + 4;
          gvo0 = r0 * d.vpitch + ((sp - r0) & 3) * 32 + sub * 8; gvo1 = r1 * d.vpitch + ((sp - r1) & 3) * 32 + sub * 8; }
      else { const int sr = 4 * w + (lane >> 4), pos = lane & 15, sp = pos >> 2, sub = pos & 3, x = (sp - sr) & 3;
          gvo0 = (2 * sr + (x >> 1)) * d.vpitch + (x & 1) * 32 + sub * 8; } }
#define ATT_DMA(i, slot) do { const int tr_ = ATT_TROW(i); \
        glds16(d.K + ((size_t)tr_ * d.kpitch + gko), (unsigned)__builtin_amdgcn_readfirstlane(ldsb + OFF_K + (slot) * KBUF + w * 1024)); \
        if (DQ == 96) { if (w < 4) glds16(d.K2 + ((size_t)tr_ * d.k2pitch + gk2o), (unsigned)__builtin_amdgcn_readfirstlane(ldsb + OFF_K + (slot) * KBUF + 8192 + w * 1024)); } \
        if (DV == 128) { glds16(d.V + ((size_t)tr_ * d.vpitch + gvo0), (unsigned)__builtin_amdgcn_readfirstlane(ldsb + OFF_V + (slot) * VBUF + w * 2048)); \
                         glds16(d.V + ((size_t)tr_ * d.vpitch + gvo1), (unsigned)__builtin_amdgcn_readfirstlane(ldsb + OFF_V + (slot) * VBUF + w * 2048 + 1024)); } \
        else glds16(d.V + ((size_t)tr_ * d.vpitch + gvo0), (unsigned)__builtin_amdgcn_readfirstlane(ldsb + OFF_V + (slot) * VBUF + w * 1024)); } while (0)
    if (NA) { ATT_LOAD(0); ATT_STORE(0); }
    else { ATT_DMA(0, 0); if (nt > 1) ATT_DMA(1, 1); asm volatile("s_waitcnt vmcnt(0)" ::: "memory"); }
    __syncthreads();
    f32x16 o[NDB];
#pragma unroll
    for (int i = 0; i < NDB; ++i) o[i] = (f32x16){};
    float mrun = 0.f, lrun = 0.f; bool first = true;
    const int gr = d.na_gr0 + (w >> 1);
    const int rs_ = gr - 4 < 0 ? 0 : (gr - 4 > 120 ? 120 : gr - 4);
    const int qc = 32 * (w & 1) + r32;
    const int cs_ = qc - 8 < 0 ? 0 : (qc - 8 > 48 ? 48 : qc - 8);
    unsigned namask0 = 0u, namask1 = 0u;
    if (NA) {
#pragma unroll
        for (int r = 0; r < 16; ++r) { const int kc0 = (r & 3) + 8 * (r >> 2) + 4 * hi, kc1 = kc0 + 32;
            namask0 |= (kc0 >= cs_ && kc0 < cs_ + 16) ? (1u << r) : 0u; namask1 |= (kc1 >= cs_ && kc1 < cs_ + 16) ? (1u << r) : 0u; }
    }
    const int koffr = r32 * KS + hi * 16;
    const int voffr = (4 * hi + ((lane & 15) >> 2)) * VS + ((lane >> 4) & 1) * 32 + (lane & 3) * 8;
    int kro[NQF], vro[NDB];
    { const int q_ = (lane & 15) >> 2, gi_ = (lane >> 4) & 1, p_ = lane & 3;
#pragma unroll
      for (int d0 = 0; d0 < NQF; ++d0) kro[d0] = d0 < 4 ? r32 * 128 + (((2 * d0 + hi) ^ ((r32 >> 1) & 7)) << 4) : 8192 + r32 * 64 + (((2 * (d0 - 4) + hi) ^ ((r32 >> 2) & 3)) << 4);
#pragma unroll
      for (int db = 0; db < NDB; ++db) vro[db] = DV == 128 ? (4 * hi + q_) * 256 + (((db + q_) & 3) << 6) + 32 * gi_ + 8 * p_
                                                             : (2 * hi + (q_ >> 1)) * 256 + (((2 * (q_ & 1) + db + 2 * hi + (q_ >> 1)) & 3) << 6) + 32 * gi_ + 8 * p_; }
    constexpr int VJ = DV == 128 ? 4096 : 2048, VE = DV == 128 ? 2048 : 1024;
    if constexpr (!NA) {
        f32x16 pA0, pA1, pB0, pB1; bf16x8 pf[4];
        int bc = 0, bn = 1, bn2 = 2;
#define ATT_BAR() asm volatile("s_waitcnt vmcnt(0) lgkmcnt(0)\n\ts_barrier" ::: "memory")
#define ATT_QK(P0, P1, slot) do { const LAS unsigned char* kb_ = lds + OFF_K + (slot) * KBUF; \
        bf16x8 ka_[NQF], kc_[NQF];       \
        _Pragma("unroll") for (int d0 = 0; d0 < NQF; ++d0) { ka_[d0] = *(const LAS bf16x8*)(kb_ + kro[d0]); kc_[d0] = *(const LAS bf16x8*)(kb_ + kro[d0] + (d0 < 4 ? 4096 : 2048)); } \
        __builtin_amdgcn_sched_barrier(0); \
        _Pragma("unroll") for (int d0 = 0; d0 < NQF; ++d0) { \
            const bf16x8 a0_ = ka_[d0], a1_ = kc_[d0]; \
            if (d0 == 0) { P0 = __builtin_amdgcn_mfma_f32_32x32x16_bf16(a0_, qf[0], (f32x16){}, 0, 0, 0); P1 = __builtin_amdgcn_mfma_f32_32x32x16_bf16(a1_, qf[0], (f32x16){}, 0, 0, 0); } \
            else { P0 = __builtin_amdgcn_mfma_f32_32x32x16_bf16(a0_, qf[d0], P0, 0, 0, 0); P1 = __builtin_amdgcn_mfma_f32_32x32x16_bf16(a1_, qf[d0], P1, 0, 0, 0); } } } while (0)
#define ATT_STEP(C0, C1, N0, N1, tt) do { \
        if ((tt) + 2 < nt) ATT_DMA((tt) + 2, bn2);        \
        if ((tt) + 1 < nt) ATT_QK(N0, N1, bn); \
        s16x4 vlo_[NDB][4], vhh_[NDB][4]; \
        if (DV == 64) { const LAS unsigned char* vb_ = lds + OFF_V + bc * VBUF;     \
            _Pragma("unroll") for (int db = 0; db < NDB; ++db) _Pragma("unroll") for (int j = 0; j < 4; ++j) { vlo_[db][j] = tr_read(vb_ + vro[db] + j * VJ); vhh_[db][j] = tr_read(vb_ + vro[db] + j * VJ + VE); } } \
        __builtin_amdgcn_sched_barrier(0); \
        att_softmax<NDB>(C0, C1, o, mrun, lrun, first, pf); \
        if (DV == 64) { __builtin_amdgcn_sched_barrier(0); \
            _Pragma("unroll") for (int j = 0; j < 4; ++j) _Pragma("unroll") for (int db = 0; db < NDB; ++db) { \
                const bf16x8 vf_ = (bf16x8){vlo_[db][j][0], vlo_[db][j][1], vlo_[db][j][2], vlo_[db][j][3], vhh_[db][j][0], vhh_[db][j][1], vhh_[db][j][2], vhh_[db][j][3]}; \
                o[db] = __builtin_amdgcn_mfma_f32_32x32x16_bf16(vf_, pf[j], o[db], 0, 0, 0); } } \
        else { const LAS unsigned char* vb_ = lds + OFF_V + bc * VBUF; \
            _Pragma("unroll") for (int j = 0; j < 4; ++j) _Pragma("unroll") for (int db = 0; db < NDB; ++db) { \
                const s16x4 lo_ = tr_read(vb_ + vro[db] + j * VJ), hh_ = tr_read(vb_ + vro[db] + j * VJ + VE); \
                const bf16x8 vf_ = (bf16x8){lo_[0], lo_[1], lo_[2], lo_[3], hh_[0], hh_[1], hh_[2], hh_[3]}; \
                o[db] = __builtin_amdgcn_mfma_f32_32x32x16_bf16(vf_, pf[j], o[db], 0, 0, 0); } } \
        ATT_BAR(); \
        { const int t_ = bc; bc = bn; bn = bn2; bn2 = t_; } } while (0)
        ATT_QK(pA0, pA1, 0);
        int t = 0;
#pragma nounroll
        for (; t + 1 < nt; t += 2) {
            ATT_STEP(pA0, pA1, pB0, pB1, t);
            ATT_STEP(pB0, pB1, pA0, pA1, t + 1);
        }
        if (t < nt) ATT_STEP(pA0, pA1, pB0, pB1, t);
#undef ATT_STEP
#undef ATT_QK
#undef ATT_BAR
    } else {
#pragma nounroll
    for (int t = 0; t < nt; ++t) {
        const int cur = t & 1;
        if (t + 1 < nt) ATT_LOAD(t + 1);
        bool active = true;
        if (NA) { if (t < d.nlat) { const int krow = d.na_rowlo + t; active = (krow >= rs_) && (krow < rs_ + 8); } }
        if (active) {
            const LAS unsigned char* kb = lds + OFF_K + cur * KBUF + koffr;
            f32x16 p0, p1;
#pragma unroll
            for (int d0 = 0; d0 < NQF; ++d0) {
                const bf16x8 a0 = *(const LAS bf16x8*)(kb + d0 * 32), a1 = *(const LAS bf16x8*)(kb + 32 * KS + d0 * 32);
                if (d0 == 0) { p0 = __builtin_amdgcn_mfma_f32_32x32x16_bf16(a0, qf[0], (f32x16){}, 0, 0, 0); p1 = __builtin_amdgcn_mfma_f32_32x32x16_bf16(a1, qf[0], (f32x16){}, 0, 0, 0); }
                else { p0 = __builtin_amdgcn_mfma_f32_32x32x16_bf16(a0, qf[d0], p0, 0, 0, 0); p1 = __builtin_amdgcn_mfma_f32_32x32x16_bf16(a1, qf[d0], p1, 0, 0, 0); }
            }
            if (NA) { if (t < d.nlat) {
                const int roff = d.na_rowlo + t - gr + 7;
                const LAS float* bp = rpbL + roff * 31 + (4 * hi - qc + 15);
#pragma unroll
                for (int r = 0; r < 16; ++r) {
                    const int c0 = (r & 3) + 8 * (r >> 2);
                    const float b0 = bp[c0], b1 = bp[c0 + 32];
                    p0[r] = ((namask0 >> r) & 1u) ? p0[r] + b0 : -INFINITY;
                    p1[r] = ((namask1 >> r) & 1u) ? p1[r] + b1 : -INFINITY;
                }
            } }
            float ra = __builtin_fmaxf(__builtin_fmaxf(p0[0], p0[1]), p1[0]), rb = __builtin_fmaxf(__builtin_fmaxf(p0[2], p0[3]), p1[1]);
            ra = __builtin_fmaxf(__builtin_fmaxf(ra, p1[2]), p1[3]);
#pragma unroll
            for (int r = 4; r < 16; r += 4) { ra = __builtin_fmaxf(__builtin_fmaxf(ra, p0[r]), p0[r + 1]); rb = __builtin_fmaxf(__builtin_fmaxf(rb, p0[r + 2]), p0[r + 3]);
                ra = __builtin_fmaxf(__builtin_fmaxf(ra, p1[r]), p1[r + 1]); rb = __builtin_fmaxf(__builtin_fmaxf(rb, p1[r + 2]), p1[r + 3]); }
            float rm = __builtin_fmaxf(ra, rb);
            { auto rr = __builtin_amdgcn_permlane32_swap(__float_as_uint(rm), __float_as_uint(rm), false, false); rm = __builtin_fmaxf(__uint_as_float(rr[0]), __uint_as_float(rr[1])); }
            if (first || __any(rm > mrun + 8.f)) {
                const float mn = first ? rm : __builtin_fmaxf(mrun, rm);
                if (!first) { const float al = __builtin_amdgcn_exp2f(mrun - mn); lrun *= al;
#pragma unroll
                    for (int i = 0; i < NDB; ++i) o[i] *= al; }
                mrun = mn; first = false;
            }
            float ls = 0.f;
#pragma unroll
            for (int r = 0; r < 16; ++r) { p0[r] = __builtin_amdgcn_exp2f(p0[r] - mrun); p1[r] = __builtin_amdgcn_exp2f(p1[r] - mrun); ls += p0[r] + p1[r]; }
            lrun += ls;
            bf16x8 pf[4];
#pragma unroll
            for (int j = 0; j < 4; ++j) {
                u32x4 pw;
#pragma unroll
                for (int e = 0; e < 4; ++e) { const int r = 8 * (j & 1) + 2 * e; pw[e] = (j < 2) ? pk2(p0[r], p0[r + 1]) : pk2(p1[r], p1[r + 1]); }
                pf[j] = __builtin_bit_cast(bf16x8, pw);
            }
            const LAS unsigned char* vb = lds + OFF_V + cur * VBUF + voffr;
#pragma unroll
            for (int db = 0; db < NDB; ++db)
#pragma unroll
                for (int j = 0; j < 4; ++j) {
                    const s16x4 lo = tr_read(vb + (16 * j) * VS + db * 64), hh = tr_read(vb + (16 * j + 8) * VS + db * 64);
                    const bf16x8 vf = (bf16x8){lo[0], lo[1], lo[2], lo[3], hh[0], hh[1], hh[2], hh[3]};
                    o[db] = __builtin_amdgcn_mfma_f32_32x32x16_bf16(vf, pf[j], o[db], 0, 0, 0);
                }
        }
        if (t + 1 < nt) ATT_STORE(cur ^ 1);
        __syncthreads();
    }
    }
#undef ATT_TROW
#undef ATT_LOAD
#undef ATT_DMA
#undef ATT_STORE
    lrun += __shfl_xor(lrun, 32);
    const float inv = 1.f / lrun;
    const size_t orow = (size_t)(d.qrow0 + 32 * w + r32) * d.opitch;
    if (OMODE == 2) {
#pragma unroll
        for (int db = 0; db < NDB; ++db)
#pragma unroll
            for (int rg = 0; rg < 4; ++rg)
                *(u32x2*)(d.Ob + orow + 32 * db + 8 * rg + 4 * hi) = (u32x2){pk2(o[db][4 * rg] * inv, o[db][4 * rg + 1] * inv), pk2(o[db][4 * rg + 2] * inv, o[db][4 * rg + 3] * inv)};
    } else if (OMODE == 3) {
        float ss = 0.f;
#pragma unroll
        for (int db = 0; db < NDB; ++db)
#pragma unroll
            for (int rg = 0; rg < 4; ++rg) {
                const u32x2 st = *(const u32x2*)(d.Ob + orow + 32 * db + 8 * rg + 4 * hi);
                const float a1 = __uint_as_float(st[0] << 16), b1 = __uint_as_float(st[0] & 0xffff0000u), c1 = __uint_as_float(st[1] << 16), e1 = __uint_as_float(st[1] & 0xffff0000u);
                const float li = d.lam * inv;
                const float a = a1 - li * o[db][4 * rg], b = b1 - li * o[db][4 * rg + 1], c = c1 - li * o[db][4 * rg + 2], e = e1 - li * o[db][4 * rg + 3];
                o[db][4 * rg] = a; o[db][4 * rg + 1] = b; o[db][4 * rg + 2] = c; o[db][4 * rg + 3] = e;
                ss += (a * a + b * b) + (c * c + e * e);
            }
        ss += __shfl_xor(ss, 32);
        const float rs = (1.f - LAMBDA_INIT) / sqrtf(ss * (1.f / 128.f) + 1e-6f);
#pragma unroll
        for (int db = 0; db < NDB; ++db)
#pragma unroll
            for (int rg = 0; rg < 4; ++rg) {
                const int dc = 32 * db + 8 * rg + 4 * hi;
                const f32x4 g = *(const f32x4*)(d.subg + dc);
                *(u32x2*)(d.Ob + orow + dc) = (u32x2){pk2(o[db][4 * rg] * rs * g[0], o[db][4 * rg + 1] * rs * g[1]), pk2(o[db][4 * rg + 2] * rs * g[2], o[db][4 * rg + 3] * rs * g[3])};
            }
    } else {
#pragma unroll
        for (int db = 0; db < NDB; ++db)
#pragma unroll
            for (int rg = 0; rg < 4; ++rg) {
                const int dc = 32 * db + 8 * rg + 4 * hi;
                const float a = o[db][4 * rg] * inv, b = o[db][4 * rg + 1] * inv, c = o[db][4 * rg + 2] * inv, e = o[db][4 * rg + 3] * inv;
                if (OMODE == 1) *(f32x4*)(d.Of + orow + dc) = (f32x4){a, b, c, e};
                else *(u32x2*)(d.Ob + orow + dc) = (u32x2){pk2(a, b), pk2(c, e)};
            }
    }
}


__device__ __forceinline__ void attn_unit_mla2(const AttnDesc d, LAS unsigned char* lds) {
    constexpr int NQF = 6, NDB = 2, KBUF = 12288, VBUF = 8192, OFF_K = 0, OFF_V = 3 * KBUF, VJ = 2048, VE = 1024;
    int tid = threadIdx.x; asm volatile("" : "+v"(tid));
    const int lane = tid & 63, w = __builtin_amdgcn_readfirstlane(tid >> 6), r32 = lane & 31, hi = lane >> 5;
    bf16x8 qf[2][NQF];
#pragma unroll
    for (int qb = 0; qb < 2; ++qb) { const bf16_t* qp = d.Q + (size_t)(d.qrow0 + 64 * w + 32 * qb + r32) * d.qpitch + 8 * hi;
#pragma unroll
        for (int d0 = 0; d0 < NQF; ++d0) qf[qb][d0] = *(const bf16x8*)(qp + 16 * d0); }
    const unsigned ldsb = (unsigned)(uintptr_t)lds;
    int gko, gk2o, gvo0;
    { const int kr = 8 * w + (lane >> 3), kc = (lane & 7) ^ ((kr >> 1) & 7); gko = kr * d.kpitch + kc * 8;
      const int rr = 16 * (w & 3) + (lane >> 2), rc = (lane & 3) ^ ((rr >> 2) & 3); gk2o = rr * d.k2pitch + rc * 8;
      const int sr = 4 * w + (lane >> 4), pos = lane & 15, sp = pos >> 2, sub = pos & 3, x = (sp - sr) & 3;
      gvo0 = (2 * sr + (x >> 1)) * d.vpitch + (x & 1) * 32 + sub * 8; }
#define M2_TROW(i) ((i) < d.nlat ? d.lat_row0 + 64 * (i) : d.ctx_row0 + 64 * ((i) - d.nlat))
#define M2_DMA(i, slot) do { const int tr_ = M2_TROW(i); \
        glds16(d.K + ((size_t)tr_ * d.kpitch + gko), (unsigned)__builtin_amdgcn_readfirstlane(ldsb + OFF_K + (slot) * KBUF + w * 1024)); \
        if (w < 4) glds16(d.K2 + ((size_t)tr_ * d.k2pitch + gk2o), (unsigned)__builtin_amdgcn_readfirstlane(ldsb + OFF_K + (slot) * KBUF + 8192 + w * 1024)); \
        glds16(d.V + ((size_t)tr_ * d.vpitch + gvo0), (unsigned)__builtin_amdgcn_readfirstlane(ldsb + OFF_V + (slot) * VBUF + w * 1024)); } while (0)
    const int nt = d.ntiles;
    M2_DMA(0, 0); if (nt > 1) M2_DMA(1, 1);
    asm volatile("s_waitcnt vmcnt(0)" ::: "memory");
    __syncthreads();
    int kro[NQF], vro[NDB];
    { const int q_ = (lane & 15) >> 2, gi_ = (lane >> 4) & 1, p_ = lane & 3;
#pragma unroll
      for (int d0 = 0; d0 < NQF; ++d0) kro[d0] = d0 < 4 ? r32 * 128 + (((2 * d0 + hi) ^ ((r32 >> 1) & 7)) << 4) : 8192 + r32 * 64 + (((2 * (d0 - 4) + hi) ^ ((r32 >> 2) & 3)) << 4);
#pragma unroll
      for (int db = 0; db < NDB; ++db) vro[db] = (2 * hi + (q_ >> 1)) * 256 + (((2 * (q_ & 1) + db + 2 * hi + (q_ >> 1)) & 3) << 6) + 32 * gi_ + 8 * p_; }
    f32x16 o0[NDB], o1[NDB];
#pragma unroll
    for (int i = 0; i < NDB; ++i) { o0[i] = (f32x16){}; o1[i] = (f32x16){}; }
    float m0 = 0.f, l0 = 0.f, m1 = 0.f, l1 = 0.f; bool f0 = true, f1 = true;
    int bc = 0, bn2 = 2;
#pragma nounroll
    for (int t = 0; t < nt; ++t) {
        if (t + 2 < nt) M2_DMA(t + 2, bn2);
        const LAS unsigned char* kb_ = lds + OFF_K + bc * KBUF;
        bf16x8 ka_[NQF], kc_[NQF];
#pragma unroll
        for (int d0 = 0; d0 < NQF; ++d0) { ka_[d0] = *(const LAS bf16x8*)(kb_ + kro[d0]); kc_[d0] = *(const LAS bf16x8*)(kb_ + kro[d0] + (d0 < 4 ? 4096 : 2048)); }
        __builtin_amdgcn_sched_barrier(0);
        f32x16 pa0, pa1, pb0, pb1;
#pragma unroll
        for (int d0 = 0; d0 < NQF; ++d0) {
            if (d0 == 0) { pa0 = __builtin_amdgcn_mfma_f32_32x32x16_bf16(ka_[0], qf[0][0], (f32x16){}, 0, 0, 0); pa1 = __builtin_amdgcn_mfma_f32_32x32x16_bf16(kc_[0], qf[0][0], (f32x16){}, 0, 0, 0);
                           pb0 = __builtin_amdgcn_mfma_f32_32x32x16_bf16(ka_[0], qf[1][0], (f32x16){}, 0, 0, 0); pb1 = __builtin_amdgcn_mfma_f32_32x32x16_bf16(kc_[0], qf[1][0], (f32x16){}, 0, 0, 0); }
            else { pa0 = __builtin_amdgcn_mfma_f32_32x32x16_bf16(ka_[d0], qf[0][d0], pa0, 0, 0, 0); pa1 = __builtin_amdgcn_mfma_f32_32x32x16_bf16(kc_[d0], qf[0][d0], pa1, 0, 0, 0);
                   pb0 = __builtin_amdgcn_mfma_f32_32x32x16_bf16(ka_[d0], qf[1][d0], pb0, 0, 0, 0); pb1 = __builtin_amdgcn_mfma_f32_32x32x16_bf16(kc_[d0], qf[1][d0], pb1, 0, 0, 0); }
        }
        s16x4 vlo_[NDB][4], vhh_[NDB][4];
        { const LAS unsigned char* vb_ = lds + OFF_V + bc * VBUF;
#pragma unroll
          for (int db = 0; db < NDB; ++db)
#pragma unroll
            for (int j = 0; j < 4; ++j) { vlo_[db][j] = tr_read(vb_ + vro[db] + j * VJ); vhh_[db][j] = tr_read(vb_ + vro[db] + j * VJ + VE); } }
        __builtin_amdgcn_sched_barrier(0);
        bf16x8 pf0[4], pf1[4];
        att_softmax<NDB>(pa0, pa1, o0, m0, l0, f0, pf0);
        att_softmax<NDB>(pb0, pb1, o1, m1, l1, f1, pf1);
        __builtin_amdgcn_sched_barrier(0);
#pragma unroll
        for (int j = 0; j < 4; ++j)
#pragma unroll
            for (int db = 0; db < NDB; ++db) {
                const bf16x8 vf_ = (bf16x8){vlo_[db][j][0], vlo_[db][j][1], vlo_[db][j][2], vlo_[db][j][3], vhh_[db][j][0], vhh_[db][j][1], vhh_[db][j][2], vhh_[db][j][3]};
                o0[db] = __builtin_amdgcn_mfma_f32_32x32x16_bf16(vf_, pf0[j], o0[db], 0, 0, 0);
                o1[db] = __builtin_amdgcn_mfma_f32_32x32x16_bf16(vf_, pf1[j], o1[db], 0, 0, 0);
            }
        asm volatile("s_waitcnt vmcnt(0) lgkmcnt(0)\n\ts_barrier" ::: "memory");
        bc = bc == 2 ? 0 : bc + 1; bn2 = bn2 == 2 ? 0 : bn2 + 1;
    }
#undef M2_DMA
#undef M2_TROW
    l0 += __shfl_xor(l0, 32); l1 += __shfl_xor(l1, 32);
    const float inv0 = 1.f / l0, inv1 = 1.f / l1;
#pragma unroll
    for (int qb = 0; qb < 2; ++qb) {
        const size_t orow = (size_t)(d.qrow0 + 64 * w + 32 * qb + r32) * d.opitch; const float inv = qb ? inv1 : inv0;
#pragma unroll
        for (int db = 0; db < NDB; ++db)
#pragma unroll
            for (int rg = 0; rg < 4; ++rg) { const int dc = 32 * db + 8 * rg + 4 * hi;
                const f32x16& oo = qb ? o1[db] : o0[db];
                *(u32x2*)(d.Ob + orow + dc) = (u32x2){pk2(oo[4 * rg] * inv, oo[4 * rg + 1] * inv), pk2(oo[4 * rg + 2] * inv, oo[4 * rg + 3] * inv)}; }
    }
}


template <int PART>
__device__ __forceinline__ void attn_unit_diff2(const AttnDesc d, LAS unsigned char* lds, bf16_t* xch, unsigned* xcnt) {
    constexpr int NQF = 4, NDB = 4, KBUF = 8192, VBUF = 16384, OFF_K = 0, OFF_V = 3 * KBUF, OFF_Q = OFF_V + 3 * VBUF, VJ = 4096, VE = 2048;
    int tid = threadIdx.x; asm volatile("" : "+v"(tid));
    const int lane = tid & 63, w = __builtin_amdgcn_readfirstlane(tid >> 6), r32 = lane & 31, hi = lane >> 5;
    const unsigned ldsb = (unsigned)(uintptr_t)lds;
#pragma unroll
    for (int i = 0; i < 8; ++i) { const int r = 8 * i + (lane >> 3), c = (lane & 7) ^ ((r >> 1) & 7);
        glds16(d.Q + ((size_t)(d.qrow0 + 64 * w + r) * d.qpitch + c * 8), (unsigned)__builtin_amdgcn_readfirstlane(ldsb + OFF_Q + w * 8192 + i * 1024)); }
    int gko, gvo0, gvo1;
    { const int kr = 8 * w + (lane >> 3), kc = (lane & 7) ^ ((kr >> 1) & 7); gko = kr * d.kpitch + kc * 8;
      const int pos = lane & 15, sp = pos >> 2, sub = pos & 3, r0 = 8 * w + (lane >> 4), r1 = r0 + 4;
      gvo0 = r0 * d.vpitch + ((sp - r0) & 3) * 32 + sub * 8; gvo1 = r1 * d.vpitch + ((sp - r1) & 3) * 32 + sub * 8; }
#define D2_TROW(i) ((i) < d.nlat ? d.lat_row0 + 64 * (i) : d.ctx_row0 + 64 * ((i) - d.nlat))
#define D2_DMA(i, slot) do { const int tr_ = D2_TROW(i); \
        glds16(d.K + ((size_t)tr_ * d.kpitch + gko), (unsigned)__builtin_amdgcn_readfirstlane(ldsb + OFF_K + (slot) * KBUF + w * 1024)); \
        glds16(d.V + ((size_t)tr_ * d.vpitch + gvo0), (unsigned)__builtin_amdgcn_readfirstlane(ldsb + OFF_V + (slot) * VBUF + w * 2048)); \
        glds16(d.V + ((size_t)tr_ * d.vpitch + gvo1), (unsigned)__builtin_amdgcn_readfirstlane(ldsb + OFF_V + (slot) * VBUF + w * 2048 + 1024)); } while (0)
    const int nt = d.ntiles;
    D2_DMA(0, 0); if (nt > 1) D2_DMA(1, 1);
    asm volatile("s_waitcnt vmcnt(0)" ::: "memory");
    __syncthreads();
    int kro[NQF], vro[NDB];
    { const int q_ = (lane & 15) >> 2, gi_ = (lane >> 4) & 1, p_ = lane & 3;
#pragma unroll
      for (int d0 = 0; d0 < NQF; ++d0) kro[d0] = r32 * 128 + (((2 * d0 + hi) ^ ((r32 >> 1) & 7)) << 4);
#pragma unroll
      for (int db = 0; db < NDB; ++db) vro[db] = (4 * hi + q_) * 256 + (((db + q_) & 3) << 6) + 32 * gi_ + 8 * p_; }
    f32x16 o0[NDB], o1[NDB];
#pragma unroll
    for (int i = 0; i < NDB; ++i) { o0[i] = (f32x16){}; o1[i] = (f32x16){}; }
    float m0 = 0.f, l0 = 0.f, m1 = 0.f, l1 = 0.f; bool f0 = true, f1 = true;
    int bc = 0, bn2 = 2;
    const LAS unsigned char* qim = lds + OFF_Q + w * 8192;
#pragma nounroll
    for (int t = 0; t < nt; ++t) {
        if (t + 2 < nt) D2_DMA(t + 2, bn2);
        const LAS unsigned char* kb_ = lds + OFF_K + bc * KBUF;
        f32x16 pa0, pa1, pb0, pb1;
#pragma unroll
        for (int dh = 0; dh < NQF; dh += 2) {
            bf16x8 ka[2], kc[2], qa[2], qb[2];
#pragma unroll
            for (int e = 0; e < 2; ++e) { ka[e] = *(const LAS bf16x8*)(kb_ + kro[dh + e]); kc[e] = *(const LAS bf16x8*)(kb_ + kro[dh + e] + 4096);
                                          qa[e] = *(const LAS bf16x8*)(qim + kro[dh + e]); qb[e] = *(const LAS bf16x8*)(qim + kro[dh + e] + 4096); }
            __builtin_amdgcn_sched_barrier(0);
#pragma unroll
            for (int e = 0; e < 2; ++e) {
                if (dh + e == 0) { pa0 = __builtin_amdgcn_mfma_f32_32x32x16_bf16(ka[e], qa[e], (f32x16){}, 0, 0, 0); pa1 = __builtin_amdgcn_mfma_f32_32x32x16_bf16(kc[e], qa[e], (f32x16){}, 0, 0, 0);
                                   pb0 = __builtin_amdgcn_mfma_f32_32x32x16_bf16(ka[e], qb[e], (f32x16){}, 0, 0, 0); pb1 = __builtin_amdgcn_mfma_f32_32x32x16_bf16(kc[e], qb[e], (f32x16){}, 0, 0, 0); }
                else { pa0 = __builtin_amdgcn_mfma_f32_32x32x16_bf16(ka[e], qa[e], pa0, 0, 0, 0); pa1 = __builtin_amdgcn_mfma_f32_32x32x16_bf16(kc[e], qa[e], pa1, 0, 0, 0);
                       pb0 = __builtin_amdgcn_mfma_f32_32x32x16_bf16(ka[e], qb[e], pb0, 0, 0, 0); pb1 = __builtin_amdgcn_mfma_f32_32x32x16_bf16(kc[e], qb[e], pb1, 0, 0, 0); }
            }
        }
        __builtin_amdgcn_sched_barrier(0);
        bf16x8 pf0[4], pf1[4];
        att_softmax<NDB>(pa0, pa1, o0, m0, l0, f0, pf0);
        att_softmax<NDB>(pb0, pb1, o1, m1, l1, f1, pf1);
        __builtin_amdgcn_sched_barrier(0);
        { const LAS unsigned char* vb_ = lds + OFF_V + bc * VBUF;
#pragma unroll
          for (int j = 0; j < 4; ++j)
#pragma unroll
            for (int db = 0; db < NDB; ++db) {
                const s16x4 lo_ = tr_read(vb_ + vro[db] + j * VJ), hh_ = tr_read(vb_ + vro[db] + j * VJ + VE);
                const bf16x8 vf_ = (bf16x8){lo_[0], lo_[1], lo_[2], lo_[3], hh_[0], hh_[1], hh_[2], hh_[3]};
                o0[db] = __builtin_amdgcn_mfma_f32_32x32x16_bf16(vf_, pf0[j], o0[db], 0, 0, 0);
                o1[db] = __builtin_amdgcn_mfma_f32_32x32x16_bf16(vf_, pf1[j], o1[db], 0, 0, 0);
            } }
        asm volatile("s_waitcnt vmcnt(0) lgkmcnt(0)\n\ts_barrier" ::: "memory");
        bc = bc == 2 ? 0 : bc + 1; bn2 = bn2 == 2 ? 0 : bn2 + 1;
    }
#undef D2_DMA
#undef D2_TROW
    l0 += __shfl_xor(l0, 32); l1 += __shfl_xor(l1, 32);
    const float inv0 = 1.f / l0, inv1 = 1.f / l1;
    if (PART == 0) {
#pragma unroll
        for (int qb = 0; qb < 2; ++qb) { const size_t xrow = (size_t)(d.qrow0 + 64 * w + 32 * qb + r32) * 128; const float inv = qb ? inv1 : inv0;
#pragma unroll
            for (int db = 0; db < NDB; ++db)
#pragma unroll
                for (int rg = 0; rg < 4; ++rg) { const f32x16& oo = qb ? o1[db] : o0[db];
                    const unsigned long long v = (unsigned long long)pk2(oo[4 * rg] * inv, oo[4 * rg + 1] * inv) | ((unsigned long long)pk2(oo[4 * rg + 2] * inv, oo[4 * rg + 3] * inv) << 32);
                    __hip_atomic_store((unsigned long long*)(xch + xrow + 32 * db + 8 * rg + 4 * hi), v, __ATOMIC_RELAXED, __HIP_MEMORY_SCOPE_AGENT); } }
        asm volatile("s_waitcnt vmcnt(0)" ::: "memory"); __syncthreads();
        if (threadIdx.x == 0) __hip_atomic_fetch_add(xcnt, 1u, __ATOMIC_RELAXED, __HIP_MEMORY_SCOPE_AGENT);
    } else {
        if (threadIdx.x == 0) { unsigned sp = 0;
            while (__hip_atomic_load(xcnt, __ATOMIC_RELAXED, __HIP_MEMORY_SCOPE_AGENT) < 1u) { __builtin_amdgcn_s_sleep(2); if (++sp > (1u << 24)) break; }
            __builtin_amdgcn_fence(__ATOMIC_ACQUIRE, "agent"); asm volatile("s_waitcnt vmcnt(0)" ::: "memory"); }
        __syncthreads();
#pragma unroll
        for (int qb = 0; qb < 2; ++qb) {
            const int row = d.qrow0 + 64 * w + 32 * qb + r32; const size_t xrow = (size_t)row * 128; const float li = d.lam * (qb ? inv1 : inv0);
            float c[NDB][16]; float ss = 0.f;
#pragma unroll
            for (int db = 0; db < NDB; ++db)
#pragma unroll
                for (int rg = 0; rg < 4; ++rg) { const f32x16& oo = qb ? o1[db] : o0[db];
                    const unsigned long long st = __hip_atomic_load((unsigned long long*)(xch + xrow + 32 * db + 8 * rg + 4 * hi), __ATOMIC_RELAXED, __HIP_MEMORY_SCOPE_AGENT);
                    const unsigned s0 = (unsigned)st, s1 = (unsigned)(st >> 32);
                    const float a = __uint_as_float(s0 << 16) - li * oo[4 * rg], b = __uint_as_float(s0 & 0xffff0000u) - li * oo[4 * rg + 1];
                    const float e = __uint_as_float(s1 << 16) - li * oo[4 * rg + 2], g = __uint_as_float(s1 & 0xffff0000u) - li * oo[4 * rg + 3];
                    c[db][4 * rg] = a; c[db][4 * rg + 1] = b; c[db][4 * rg + 2] = e; c[db][4 * rg + 3] = g; ss += (a * a + b * b) + (e * e + g * g); }
            ss += __shfl_xor(ss, 32);
            const float rs = (1.f - LAMBDA_INIT) / sqrtf(ss * (1.f / 128.f) + 1e-6f);
            const size_t orow = (size_t)row * d.opitch;
#pragma unroll
            for (int db = 0; db < NDB; ++db)
#pragma unroll
                for (int rg = 0; rg < 4; ++rg) { const int dc = 32 * db + 8 * rg + 4 * hi; const f32x4 gg = *(const f32x4*)(d.subg + dc);
                    *(u32x2*)(d.Ob + orow + dc) = (u32x2){pk2(c[db][4 * rg] * rs * gg[0], c[db][4 * rg + 1] * rs * gg[1]), pk2(c[db][4 * rg + 2] * rs * gg[2], c[db][4 * rg + 3] * rs * gg[3])}; }
        }
    }
}

__device__ __forceinline__ void p0_item(const float* W, int K, int N, bf16_t* WT, int mode, const float* ksc, LAS float* scr, int item, int lane) {
    const int nblk = N / 32, kb = item / nblk, nb = item % nblk, k0 = 64 * kb, n0 = 32 * nb;
#pragma unroll 8
    for (int i = 0; i < 32; ++i) { const int kk = 2 * i + (lane >> 5); float v = W[(size_t)(k0 + kk) * N + n0 + (lane & 31)]; if (ksc) v *= ksc[k0 + kk]; scr[kk * 33 + (lane & 31)] = v; }
    asm volatile("s_waitcnt lgkmcnt(0)" ::: "memory");
    int nd0 = n0;
    if (mode == 1) { nd0 = (n0 < FH) ? (n0 / 128) * 256 + (n0 % 128) : ((n0 - FH) / 128) * 256 + 128 + ((n0 - FH) % 128); }
    else if (mode == 2) { nd0 = (n0 < 672) ? n0 : n0 + 96; }
    const int c = lane & 7;
#pragma unroll
    for (int j = 0; j < 4; ++j) { const int n = (lane >> 3) + 8 * j; const LAS float* s = scr + (8 * c) * 33 + n;
        u32x4 o; o.x = pk2(s[0 * 33], s[1 * 33]); o.y = pk2(s[2 * 33], s[3 * 33]); o.z = pk2(s[4 * 33], s[5 * 33]); o.w = pk2(s[6 * 33], s[7 * 33]);
        *(u32x4*)(WT + (size_t)(nd0 + n) * K + k0 + 8 * c) = o; }
    asm volatile("s_waitcnt lgkmcnt(0)" ::: "memory");
}
__device__ __forceinline__ void sincos_small(float af, float& s, float& c) {
    const double a = (double)af; const double k = rint(a * 0.6366197723675814); const double r = a - k * 1.5707963267948966;
    const double r2 = r * r;
    const double sp = r * (1.0 + r2 * (-1.0 / 6 + r2 * (1.0 / 120 + r2 * (-1.0 / 5040 + r2 * (1.0 / 362880 + r2 * (-1.0 / 39916800 + r2 * (1.0 / 6227020800.0)))))));
    const double cp = 1.0 + r2 * (-0.5 + r2 * (1.0 / 24 + r2 * (-1.0 / 720 + r2 * (1.0 / 40320 + r2 * (-1.0 / 3628800 + r2 * (1.0 / 479001600.0))))));
    const int q = ((int)k) & 3;
    const double ss = (q == 0) ? sp : (q == 1) ? cp : (q == 2) ? -sp : -cp;
    const double cc = (q == 0) ? cp : (q == 1) ? -sp : (q == 2) ? -cp : sp;
    s = (float)ss; c = (float)cc;
}

#define XB_TMO      128
#define XB_XCNT(j)  (256  + 64 * (j))
#define XB_XSUB(j)  (1280 + 64 * (j))
#define XB_XGEN(j)  (2304 + 64 * (j))
#define XB_TOP      3328
#define XB_TOPGEN   3392
#define XCD_BAR_WORDS 3456
#define XB_SPIN_CAP (1u << 18)

__device__ __forceinline__ unsigned xb_ld(unsigned* p)              { return __hip_atomic_load(p, __ATOMIC_RELAXED, __HIP_MEMORY_SCOPE_AGENT); }
__device__ __forceinline__ unsigned xb_add(unsigned* p, unsigned v) { return __hip_atomic_fetch_add(p, v, __ATOMIC_RELAXED, __HIP_MEMORY_SCOPE_AGENT); }
__device__ __forceinline__ unsigned xb_xcc_id() { return (unsigned)__builtin_amdgcn_s_getreg((3 << 11) | 20) & 0xFu; }
#define XB_SPIN(cond, bar) do { unsigned _sp = 0; while (cond) { __builtin_amdgcn_s_sleep(1); \
    if ((++_sp & 255u) == 0u) { if (xb_ld(&(bar)[XB_TMO])) break; if (_sp > XB_SPIN_CAP) { atomicAdd(&(bar)[XB_TMO], 1u); break; } } } } while (0)

struct XcdBarrier {
    unsigned* bar; unsigned x;
    volatile LAS unsigned* st;
};

__device__ __forceinline__ XcdBarrier xcd_barrier_post(unsigned* bar, volatile LAS unsigned* st) {
    XcdBarrier b; b.bar = bar; b.x = xb_xcc_id(); b.st = st;
    if (threadIdx.x == 0) (void)xb_add(&bar[XB_XCNT(b.x)], 1u);
    return b;
}
__device__ __forceinline__ void xcd_barrier_complete(unsigned* bar, unsigned x, unsigned& nloc, unsigned& nx) {
    const unsigned G = gridDim.x * gridDim.y * gridDim.z;
    unsigned sum, cnt, mine, sp = 0u;
    for (;;) {
        sum = 0u; cnt = 0u; mine = 0u;
#pragma unroll
        for (unsigned j = 0; j < 16; ++j) { const unsigned c = xb_ld(&bar[XB_XCNT(j)]); sum += c; cnt += (c > 0u) ? 1u : 0u; mine = (j == x) ? c : mine; }
        if (sum == G) break;
        __builtin_amdgcn_s_sleep(1);
        if ((++sp & 255u) == 0u) { if (xb_ld(&bar[XB_TMO])) break; if (sp > XB_SPIN_CAP) { atomicAdd(&bar[XB_TMO], 1u); break; } }
    }
    nloc = mine > 0u ? mine : 1u; nx = cnt > 0u ? cnt : 1u;
}

__device__ __forceinline__ void xcd_barrier(const XcdBarrier& b) {
    asm volatile("s_waitcnt vmcnt(0)" ::: "memory");
    __syncthreads();
    if (threadIdx.x == 0) {
        unsigned* bar = b.bar;
        __builtin_amdgcn_s_waitcnt(0);
        unsigned nloc = b.st[0], nx = b.st[1];
        if (nloc == 0u) { xcd_barrier_complete(bar, b.x, nloc, nx); b.st[0] = nloc; b.st[1] = nx; }
        const unsigned old = xb_add(&bar[XB_XSUB(b.x)], 1u);
        const unsigned gen = old / nloc;
        if (old + 1u == (gen + 1u) * nloc) {
            __builtin_amdgcn_fence(__ATOMIC_RELEASE, "agent");
            asm volatile("s_waitcnt vmcnt(0)" ::: "memory");
            const unsigned og = xb_add(&bar[XB_TOP], 1u);
            const unsigned tg = og / nx;
            if (og + 1u == (tg + 1u) * nx) xb_add(&bar[XB_TOPGEN], 1u);
            else XB_SPIN(xb_ld(&bar[XB_TOPGEN]) == tg, bar);
            __builtin_amdgcn_fence(__ATOMIC_ACQUIRE, "agent");
            xb_add(&bar[XB_XGEN(b.x)], 1u);
            asm volatile("s_waitcnt vmcnt(0)" ::: "memory");
        } else {
            XB_SPIN(xb_ld(&bar[XB_XGEN(b.x)]) == gen, bar);
            __builtin_amdgcn_fence(__ATOMIC_ACQUIRE, "agent");
            asm volatile("s_waitcnt vmcnt(0)" ::: "memory");
        }
    }
    __syncthreads();
}

struct Params {
    const float *x, *c, *ctx, *c_ctx, *mod_w, *mod_b, *ln_mix_g, *ln_mix_b, *ln_ffn_g, *ln_ffn_b, *ffn_w_in, *ffn_w_out, *ev_w_in, *ev_w_out,
        *diff_lambda, *diff_subln_g, *na_rpb, *od_w_in, *od_w_out, *mla_q_norm_g, *mla_w_uq, *mla_kv_norm_g, *mla_w_ukv, *gmlp_ln_g, *gmlp_ln_b, *gmlp_ws, *gmlp_b;
    float* out; unsigned char* ws; int lo, hi;
};

__device__ __forceinline__ void ln_rows(float* Z, float* dst, const float* g, const float* b, bf16_t* U, const float* modl, int kmod, int nrows, int gw, int ngw, int lane) {
    for (int row = gw; row < nrows; row += ngw) {
        const f32x4* zr = (const f32x4*)(Z + (size_t)row * DM) + lane;
        f32x4 v[4]; float s = 0.f;
#pragma unroll
        for (int j = 0; j < 4; ++j) { v[j] = zr[64 * j]; s += (v[j][0] + v[j][1]) + (v[j][2] + v[j][3]); }
        const float mean = wave_sum(s) * (1.f / DM); float s2 = 0.f;
#pragma unroll
        for (int j = 0; j < 4; ++j) { v[j] = v[j] - mean; s2 += (v[j][0] * v[j][0] + v[j][1] * v[j][1]) + (v[j][2] * v[j][2] + v[j][3] * v[j][3]); }
        const float rstd = 1.f / sqrtf(wave_sum(s2) * (1.f / DM) + 1e-5f);
        const int set = row < 8192 ? 0 : (row < ML ? 1 : 2);
        const float* mp = modl ? modl + set * 6144 + kmod * 1024 : nullptr;
#pragma unroll
        for (int j = 0; j < 4; ++j) {
            const int col = 256 * j + 4 * lane;
            const f32x4 gg = *(const f32x4*)(g + col), bb = *(const f32x4*)(b + col);
            const f32x4 h = v[j] * rstd * gg + bb;
            *(f32x4*)(dst + (size_t)row * DM + col) = h;
            if (U) { const f32x4 sh = *(const f32x4*)(mp + col), sc = *(const f32x4*)(mp + 1024 + col);
                const f32x4 uu = h * (sc + 1.f) + sh;
                *(u32x2*)(U + (size_t)row * DM + col) = (u32x2){pk2(uu[0], uu[1]), pk2(uu[2], uu[3])}; }
        }
    }
}

typedef const __attribute__((address_space(4))) Params* kparams_t;
__device__ __forceinline__ kparams_t kparams() { kparams_t q = (kparams_t)__builtin_amdgcn_kernarg_segment_ptr(); asm volatile("" : "+s"(q)); return q; }
constexpr int NPHASE = 18;
constexpr int LDS_BYTES = 147456;

__global__ void __launch_bounds__(512) dit_fwd(Params p) {
    extern __shared__ __attribute__((aligned(16))) unsigned char lds_raw[];
    LAS unsigned char* lds = (LAS unsigned char*)lds_raw;
    const int G = gridDim.x, blk = blockIdx.x;
    const int tid = threadIdx.x, lane = tid & 63, wave = __builtin_amdgcn_readfirstlane(tid >> 6);
    const int gw = blk * 8 + wave, ngw = G * 8;
    const int gtid = blk * 512 + tid, ngt = G * 512;
#define Wevin ((bf16_t*)(ws + O_EVIN))
#define Wevout ((bf16_t*)(ws + O_EVOUT))
#define Wffin0 ((bf16_t*)(ws + O_FFIN0))
#define Wffout0 ((bf16_t*)(ws + O_FFOUT0))
#define Wffin1 ((bf16_t*)(ws + O_FFIN1))
#define Wffout1 ((bf16_t*)(ws + O_FFOUT1))
#define Wodin ((bf16_t*)(ws + O_ODIN))
#define Wodout ((bf16_t*)(ws + O_ODOUT))
#define Wuq ((bf16_t*)(ws + O_UQ))
#define Wukv ((bf16_t*)(ws + O_UKV))
#define Gws ((bf16_t*)(ws + O_GWS))
#define mod ((float*)(ws + O_MOD))
#define tab32 ((float*)(ws + O_TAB32))
#define tab16 ((float*)(ws + O_TAB16))
#define P ((bf16_t*)(ws + O_P))
#define H ((float*)(ws + O_H))
#define Hb ((bf16_t*)(ws + O_H))
#define U ((bf16_t*)(ws + O_U))
#define Odiff ((float*)(ws + O_ODIFF))
#define AMIX0 ((bf16_t*)(ws + O_AMIX0))
#define ACT ((bf16_t*)(ws + O_ACT))
#define P1 ((bf16_t*)(ws + O_P1))
#define AMIX1 ((bf16_t*)(ws + O_AMIX1))
#define stats ((float*)(ws + O_STATS))
#define KV1 ((bf16_t*)(ws + O_KV1))
#define Q1 ((bf16_t*)(ws + O_Q1))
#define PHASE_BEGIN kparams_t q = kparams(); unsigned char* ws = q->ws;
    const int lo = p.lo, hi = p.hi;
    volatile LAS unsigned* xst = (volatile LAS unsigned*)(lds + LDS_BYTES - 64);
    if (tid < 2) xst[tid] = 0u;
    __syncthreads();
    XcdBarrier xbar = xcd_barrier_post((unsigned*)(p.ws + O_BAR), xst);
    if (p.hi > 1000) cg::this_grid().sync();
#ifndef PH_MASK
#define PH_MASK 0x3ffff
#endif
#define IN(k) ((((PH_MASK) >> (k)) & 1) && lo <= (k) && (k) < hi)
#define SEAM(k) do { if (hi - lo > 1) xcd_barrier(xbar); } while (0)

    if (IN(0)) { PHASE_BEGIN
        if (blk < 96) {
            LAS float* sl = (LAS float*)lds;
            for (int i = tid; i < 3072; i += 512) { const int set = i >> 10, k = i & 1023; const float cv = set == 0 ? q->c[k] : (set == 1 ? q->c[1024 + k] : q->c_ctx[k]); sl[i] = cv / (1.f + __expf(-cv)); }
            __syncthreads();
            const int layer = blk / 48, chunk = blk % 48;
            const float* W = q->mod_w + (size_t)layer * 1024 * 6144 + chunk * 128 + 2 * lane;
            float a00 = 0.f, a01 = 0.f, a10 = 0.f, a11 = 0.f, a20 = 0.f, a21 = 0.f;
#pragma unroll 16
            for (int k = 128 * wave; k < 128 * wave + 128; ++k) { const f32x2v wv = *(const f32x2v*)(W + (size_t)k * 6144);
                const float s0 = sl[k], s1 = sl[1024 + k], s2 = sl[2048 + k];
                a00 += s0 * wv[0]; a01 += s0 * wv[1]; a10 += s1 * wv[0]; a11 += s1 * wv[1]; a20 += s2 * wv[0]; a21 += s2 * wv[1]; }
            LAS float* red = sl + 3072;
            red[(wave * 3 + 0) * 128 + 2 * lane] = a00; red[(wave * 3 + 0) * 128 + 2 * lane + 1] = a01;
            red[(wave * 3 + 1) * 128 + 2 * lane] = a10; red[(wave * 3 + 1) * 128 + 2 * lane + 1] = a11;
            red[(wave * 3 + 2) * 128 + 2 * lane] = a20; red[(wave * 3 + 2) * 128 + 2 * lane + 1] = a21;
            __syncthreads();
            if (tid < 384) { const int s = tid >> 7, n = tid & 127; float acc = q->mod_b[layer * 6144 + chunk * 128 + n];
#pragma unroll
                for (int w8 = 0; w8 < 8; ++w8) acc += red[(w8 * 3 + s) * 128 + n];
                mod[(layer * 3 + s) * 6144 + chunk * 128 + n] = acc; }
            __syncthreads();
        } else if (blk == 96) {
            for (int i = tid; i < 3072; i += 512) {
                if (i < 2048) { const int pos = i >> 4, f = i & 15; const float inv = exp2f(-(float)f * (13.287712379549449f / 16.f)); float s, c; sincos_small((float)pos * inv, s, c); tab32[2 * i] = c; tab32[2 * i + 1] = s; }
                else { const int j = i - 2048, pos = j >> 3, f = j & 7; const float inv = exp2f(-(float)f * (13.287712379549449f / 8.f)); float s, c; sincos_small((float)pos * inv, s, c); tab16[2 * j] = c; tab16[2 * j + 1] = s; }
            }
        }
        {
            LAS float* scr = (LAS float*)(lds + wave * 16384);
            constexpr int I0 = 16 * 96, I1 = 16 * 32, I2 = 16 * 176, I3 = 44 * 32, I4 = 16 * 53, I5 = 16 * 32, I6 = 6 * 24, I7 = 4 * 32;
            for (int it = gw; it < I0; it += ngw) p0_item(q->ev_w_in, 1024, 3072, Wevin, 0, nullptr, scr, it, lane);
            for (int i = gtid; i < 65536; i += ngt) Gws[i] = (bf16_t)f2bf(q->gmlp_ws[i]);
            for (int i = gtid; i < 96 * 1024 / 2; i += ngt) ((unsigned*)(Wodin + (size_t)672 * 1024))[i] = 0u;
        }
    }
    SEAM(0);
    if (IN(1)) { PHASE_BEGIN
        for (int idx = gtid; idx < MT * 128; idx += ngt) {
            const int row = idx >> 7, c8 = (idx & 127) * 8;
            const float* src = row < ML ? q->x + (size_t)row * DM : q->ctx + (size_t)(row - ML) * DM;
            const int set = row < 8192 ? 0 : (row < ML ? 1 : 2);
            const float* mp = mod + set * 6144;
            const f32x4 v0 = *(const f32x4*)(src + c8), v1 = *(const f32x4*)(src + c8 + 4);
            const f32x4 sh0 = *(const f32x4*)(mp + c8), sh1 = *(const f32x4*)(mp + c8 + 4), sc0 = *(const f32x4*)(mp + 1024 + c8), sc1 = *(const f32x4*)(mp + 1024 + c8 + 4);
            const f32x4 u0 = v0 * (sc0 + 1.f) + sh0, u1 = v1 * (sc1 + 1.f) + sh1;
            *(u32x4*)(U + (size_t)row * DM + c8) = (u32x4){pk2(u0[0], u0[1]), pk2(u0[2], u0[3]), pk2(u1[0], u1[1]), pk2(u1[2], u1[3])};
        }
    }
    SEAM(1);
    if (IN(2)) { PHASE_BEGIN
        pg8::Gemm g{U, Wevin, MT, PW0, 1024, 1024, 1024}; pg8::StaticOrder S; S.init(MT, PW0, G, blk);
        EpiIn0 E{P, tab32};
        pg8::gemm_phase<EpiIn0, pg8::StaticOrder, true, true>(lds, g, S, E);
        if (blk >= 24) {
            LAS float* scr = (LAS float*)(lds + wave * 16384);
            constexpr int I1 = 16 * 32, I2 = 16 * 176, I3 = 44 * 32, I4 = 16 * 53, I5 = 16 * 32, I6 = 6 * 24, I7 = 4 * 32;
            constexpr int NIT = I1 + 2 * I2 + 2 * I3 + I4 + I5 + I6 + I7;
            for (int it = (blk - 24) * 8 + wave; it < NIT; it += (G - 24) * 8) {
                int r = it;
                if (r < I1) { p0_item(q->ev_w_out, 1024, 1024, Wevout, 0, nullptr, scr, r, lane); continue; } r -= I1;
                if (r < I2) { p0_item(q->ffn_w_in, 1024, 5632, Wffin0, 1, nullptr, scr, r, lane); continue; } r -= I2;
                if (r < I2) { p0_item(q->ffn_w_in + (size_t)1024 * 5632, 1024, 5632, Wffin1, 1, nullptr, scr, r, lane); continue; } r -= I2;
                if (r < I3) { p0_item(q->ffn_w_out, 2816, 1024, Wffout0, 0, nullptr, scr, r, lane); continue; } r -= I3;
                if (r < I3) { p0_item(q->ffn_w_out + (size_t)2816 * 1024, 2816, 1024, Wffout1, 0, nullptr, scr, r, lane); continue; } r -= I3;
                if (r < I4) { p0_item(q->od_w_in, 1024, 1696, Wodin, 2, nullptr, scr, r, lane); continue; } r -= I4;
                if (r < I5) { p0_item(q->od_w_out, 1024, 1024, Wodout, 0, nullptr, scr, r, lane); continue; } r -= I5;
                if (r < I6) { p0_item(q->mla_w_uq, 384, 768, Wuq, 0, q->mla_q_norm_g, scr, r, lane); continue; } r -= I6;
                p0_item(q->mla_w_ukv, 256, 1024, Wukv, 0, q->mla_kv_norm_g, scr, r, lane);
            }
        }
    }
    SEAM(2);
    if (IN(3)) { PHASE_BEGIN
        const int xcd = blk & 7, idx = blk >> 3;
        float lam;
        { const float a = q->diff_lambda[lane] * q->diff_lambda[64 + lane], b2 = q->diff_lambda[128 + lane] * q->diff_lambda[192 + lane];
          lam = __expf(wave_sum(a)) - __expf(wave_sum(b2)) + LAMBDA_INIT; }
        {
            const int b = xcd >> 2, h = xcd & 3, part = idx >> 4, qb = idx & 15;
            AttnDesc d{};
            d.qpitch = PW0; d.kpitch = PW0; d.vpitch = PW0; d.V = P + 1024 + h * 128;
            d.Ob = AMIX0 + h * 128; d.opitch = 1024; d.lam = lam; d.subg = q->diff_subln_g;
            d.qrow0 = b * SEQ_ + qb * 512; d.ntiles = 132; d.nlat = 128; d.lat_row0 = b * SEQ_; d.ctx_row0 = ML + b * 256;
            d.Q = P + h * 128 + part * 64; d.K = P + 512 + h * 128 + part * 64;
            bf16_t* xch = (bf16_t*)(ws + O_ODIFF) + (size_t)h * MT * 128;
            unsigned* xcnt = (unsigned*)(ws + O_XCNT) + 64 * ((b * 4 + h) * 16 + qb);
            if (part == 0) attn_unit_diff2<0>(d, lds, xch, xcnt); else attn_unit_diff2<1>(d, lds, xch, xcnt);
        }
        for (int i = 0; i < 2; ++i) {
            const int combo = i * 8 + xcd, rb = idx;
            if (idx >= 32) break;
            const int b = combo >> 3, h = combo & 7;
            int rowlo = 4 * rb - 4; rowlo = rowlo < 0 ? 0 : (rowlo > 120 ? 120 : rowlo);
            int nrt = 128 - rowlo; nrt = nrt > 11 ? 11 : nrt;
            AttnDesc d{};
            d.Q = P + 1536 + h * 64; d.qpitch = PW0; d.K = P + 2048 + h * 64; d.kpitch = PW0; d.V = P + 2560 + h * 64; d.vpitch = PW0;
            d.Of = nullptr; d.Ob = AMIX0 + 512 + h * 64; d.opitch = 1024;
            d.qrow0 = b * SEQ_ + rb * 256; d.ntiles = nrt + 4; d.nlat = nrt; d.lat_row0 = b * SEQ_ + rowlo * 64; d.ctx_row0 = ML + b * 256;
            d.na_rowlo = rowlo; d.na_gr0 = 4 * rb; d.rpb = q->na_rpb + h * 465;
            attn_unit<64, 64, true, 0>(d, lds);
        }
        if (blk < 8) {
            const int b = blk >> 2, h = blk & 3;
            AttnDesc d{};
            d.qpitch = PW0; d.kpitch = PW0; d.vpitch = PW0; d.V = P + 1024 + h * 128;
            d.Ob = AMIX0 + h * 128; d.opitch = 1024; d.lam = lam; d.subg = q->diff_subln_g;
            d.qrow0 = ML + b * 256; d.ntiles = 4; d.nlat = 0; d.lat_row0 = 0; d.ctx_row0 = ML + b * 256;
            d.Q = P + h * 128; d.K = P + 512 + h * 128;
            attn_unit<64, 128, false, 2>(d, lds);
            d.Q = P + h * 128 + 64; d.K = P + 512 + h * 128 + 64;
            attn_unit<64, 128, false, 3>(d, lds);
        } else if (blk >= 16 && blk < 32) {
            const int b = (blk - 16) >> 3, h = (blk - 16) & 7;
            AttnDesc d{};
            d.Q = P + 1536 + h * 64; d.qpitch = PW0; d.K = P + 2048 + h * 64; d.kpitch = PW0; d.V = P + 2560 + h * 64; d.vpitch = PW0;
            d.Ob = AMIX0 + 512 + h * 64; d.opitch = 1024;
            d.qrow0 = ML + b * 256; d.ntiles = 4; d.nlat = 0; d.lat_row0 = 0; d.ctx_row0 = ML + b * 256;
            attn_unit<64, 64, false, 0>(d, lds);
        }
    }
    SEAM(3);
    if (IN(5)) { PHASE_BEGIN
        { pg8::Gemm g{AMIX0, Wevout, ML, 1024, 1024, 1024, 1024}; PanelOrder S; S.init(ML, blk);
          EpiResLN<false, true> E{q->x, q->ctx, mod + 2 * 1024, (unsigned*)(ws + O_CNT), (unsigned long long*)(ws + O_SLOT0), q->ln_mix_g, q->ln_mix_b, H, U, mod, 3, nullptr, nullptr, 0};
          pg8::gemm_phase<EpiResLN<false, true>, PanelOrder, true, true>(lds, g, S, E); }
        { const int part = blk & 3, k0 = part * 256;
          pg8::Gemm g{AMIX0 + k0, Wevout + k0, MT, 1024, 256, 1024, 1024}; TailOrder S{blk};
          EpiResLN<false, true> E{q->x, q->ctx, mod + 2 * 1024, (unsigned*)(ws + O_CNT), (unsigned long long*)(ws + O_SLOT0), q->ln_mix_g, q->ln_mix_b, H, U, mod, 3, (float*)(ws + O_P), (unsigned*)(ws + O_PCNT), part};
          pg8::gemm_phase<EpiResLN<false, true>, TailOrder, true, true>(lds, g, S, E); }
    }
    SEAM(5);
    if (IN(7)) { PHASE_BEGIN
        pg8::Gemm g{U, Wffin0, MT, 5632, 1024, 1024, 1024}; pg8::StaticOrder S; S.init(MT, 5632, G, blk);
        EpiFfn E{ACT};
        pg8::gemm_phase<EpiFfn, pg8::StaticOrder, true, true>(lds, g, S, E);
    }
    SEAM(7);
    if (IN(8)) { PHASE_BEGIN
        { pg8::Gemm g{ACT, Wffout0, ML, 1024, FH, FH, FH}; PanelOrder S; S.init(ML, blk);
          EpiResLN<true, true> E{Hb, Hb + (size_t)ML * DM, mod + 5 * 1024, (unsigned*)(ws + O_CNT) + 66 * 64, (unsigned long long*)(ws + O_SLOT1), q->ln_ffn_g, q->ln_ffn_b, Hb, U, mod + 3 * 6144, 0, nullptr, nullptr, 0};
          pg8::gemm_phase<EpiResLN<true, true>, PanelOrder, true, true>(lds, g, S, E); }
        { const int part = blk & 3, k0 = part < 2 ? part * 768 : 1536 + (part - 2) * 640, kl = part < 2 ? 768 : 640;
          pg8::Gemm g{ACT + k0, Wffout0 + k0, MT, 1024, kl, FH, FH}; TailOrder S{blk};
          EpiResLN<true, true> E{Hb, Hb + (size_t)ML * DM, mod + 5 * 1024, (unsigned*)(ws + O_CNT) + 66 * 64, (unsigned long long*)(ws + O_SLOT1), q->ln_ffn_g, q->ln_ffn_b, Hb, U, mod + 3 * 6144, 0, (float*)(ws + O_SLOT2), (unsigned*)(ws + O_PCNT) + 8 * 64, part};
          pg8::gemm_phase<EpiResLN<true, true>, TailOrder, true, true>(lds, g, S, E); }
    }
    SEAM(8);
    if (IN(10)) { PHASE_BEGIN
        pg8::Gemm g{U, Wodin, MT, PW1, 1024, 1024, 1024}; pg8::StaticOrder S; S.init(MT, PW1, G, blk);
        EpiIn1 E{P1, stats, tab16};
        pg8::gemm_phase<EpiIn1, pg8::StaticOrder, true, true>(lds, g, S, E);
    }
    SEAM(10);
    if (IN(11)) { PHASE_BEGIN
#ifndef NO_Q
        { pg8::Gemm g{P1, Wuq, ML, 768, 384, PW1, 384}; pg8::StaticOrder S; S.init(ML, 768, G, blk);
          EpiQ1 E{Q1, stats, tab16};
          pg8::gemm_phase<EpiQ1, pg8::StaticOrder, true, true>(lds, g, S, E); }
#endif
#ifndef NO_KV
        { pg8::Gemm g{P1 + 384, Wukv, MT, 1024, 256, PW1, 256}; pg8::StaticOrder S; S.init(MT, 1024, G, (blk + 64) & 255);
          EpiKV1 E{KV1, stats};
          pg8::gemm_phase<EpiKV1, pg8::StaticOrder, true, true>(lds, g, S, E); }
#endif
#ifndef NO_GMLP
        const int gm_n = blk >= 192 ? 3 : (blk < 128 ? 2 : 1);
        const int gm_0 = blk >= 192 ? (blk - 192) * 3 : (blk < 128 ? 192 + blk * 2 : 448 + (blk - 128));
        for (int un = gm_0; un < gm_0 + gm_n; ++un) {
            const int chunk = un >> 2, grp = un & 3;
            constexpr int RS = 272;
            LAS unsigned char* wsA = lds; LAS unsigned char* vnT = lds + 128 * RS; LAS float* tst = (LAS float*)(lds + 2 * 128 * RS);
            __syncthreads();
            {
                const int tok = tid >> 2, part = tid & 3; const float* sp = stats + (size_t)(chunk * 128 + tok) * STP + 80 + part * 8;
                float s = sp[0] + sp[2] + sp[4] + sp[6], q = sp[1] + sp[3] + sp[5] + sp[7];
                s += __shfl_xor(s, 1); s += __shfl_xor(s, 2); q += __shfl_xor(q, 1); q += __shfl_xor(q, 2);
                const float mean = s * (1.f / 512.f); const float var = q * (1.f / 512.f) - mean * mean;
                if (part == 0) { tst[2 * tok] = mean; tst[2 * tok + 1] = 1.f / sqrtf(fmaxf(var, 0.f) + 1e-5f); }
            }
#pragma unroll
            for (int i = 0; i < 4; ++i) { const int id = tid + 512 * i, r = id >> 4, ch = id & 15;
                *(LAS u32x4*)(wsA + r * RS + ch * 16) = *(const u32x4*)(Gws + (size_t)grp * 16384 + r * 128 + ch * 8); }
            __syncthreads();
#pragma unroll
            for (int i = 0; i < 4; ++i) { const int id = tid + 512 * i, j = id >> 4, cc = id & 15;
                const u32x4 raw = *(const u32x4*)(P1 + (size_t)(chunk * 128 + j) * PW1 + 1280 + grp * 128 + cc * 8);
                const float mean = tst[2 * j], rstd = tst[2 * j + 1];
                const f32x4 lg0 = *(const f32x4*)(q->gmlp_ln_g + grp * 128 + cc * 8), lg1 = *(const f32x4*)(q->gmlp_ln_g + grp * 128 + cc * 8 + 4);
                const f32x4 lb0 = *(const f32x4*)(q->gmlp_ln_b + grp * 128 + cc * 8), lb1 = *(const f32x4*)(q->gmlp_ln_b + grp * 128 + cc * 8 + 4);
#pragma unroll
                for (int e = 0; e < 8; ++e) { const unsigned wv = raw[e >> 1]; const float x = bf2f((unsigned short)((e & 1) ? (wv >> 16) : (wv & 0xffffu)));
                    const float y = (x - mean) * rstd * (e < 4 ? lg0[e & 3] : lg1[e & 3]) + (e < 4 ? lb0[e & 3] : lb1[e & 3]);
                    *(LAS unsigned short*)(vnT + (cc * 8 + e) * RS + j * 2) = (unsigned short)f2bf(y); } }
            __syncthreads();
            { const int r32 = lane & 31, hh = lane >> 5, ib = wave >> 1;
#pragma unroll
              for (int cbi = 0; cbi < 2; ++cbi) { const int cb = 2 * (wave & 1) + cbi;
                f32x16 dacc = (f32x16){};
#pragma unroll
                for (int ks = 0; ks < 8; ++ks) {
                    const bf16x8 a = *(const LAS bf16x8*)(wsA + (32 * ib + r32) * RS + (16 * ks + 8 * hh) * 2);
                    const bf16x8 bb = *(const LAS bf16x8*)(vnT + (32 * cb + r32) * RS + (16 * ks + 8 * hh) * 2);
                    dacc = __builtin_amdgcn_mfma_f32_32x32x16_bf16(a, bb, dacc, 0, 0, 0); }
                const int c = 32 * cb + r32;
#pragma unroll
                for (int r = 0; r < 16; ++r) { const int i = 32 * ib + (r & 3) + 8 * (r >> 2) + 4 * hh; const int tok = chunk * 128 + i;
                    const float gu = bf2f(P1[(size_t)tok * PW1 + 768 + grp * 128 + c]);
                    const float o = gu * (dacc[r] + q->gmlp_b[grp * 128 + i]);
                    AMIX1[(size_t)tok * 1024 + 512 + grp * 128 + c] = (bf16_t)f2bf(o); } } }
        }
#endif
    }
    SEAM(11);
    if (IN(12)) { PHASE_BEGIN
        const int xcd = blk & 7, idx = blk >> 3;
        {
            const int combo = (idx >> 4) * 8 + xcd, qb = idx & 15;
            const int b = combo >> 3, h = combo & 7;
            AttnDesc d{};
            d.Q = Q1 + h * 96; d.qpitch = 768; d.K = KV1 + h * 128; d.kpitch = 1024; d.K2 = P1 + 640; d.k2pitch = PW1;
            d.V = KV1 + h * 128 + 64; d.vpitch = 1024; d.Ob = AMIX1 + h * 64; d.opitch = 1024;
            d.qrow0 = b * SEQ_ + qb * 512; d.ntiles = 132; d.nlat = 128; d.lat_row0 = b * SEQ_; d.ctx_row0 = ML + b * 256;
            attn_unit_mla2(d, lds);
        }
    }
    SEAM(12);
    if (IN(13)) { PHASE_BEGIN
        pg8::Gemm g{AMIX1, Wodout, ML, 1024, 1024, 1024, 1024}; PanelOrder S; S.init(ML, blk);
        EpiResLN<true, true> E{Hb, Hb + (size_t)ML * DM, mod + 3 * 6144 + 2 * 1024, (unsigned*)(ws + O_CNT) + 2 * 66 * 64, (unsigned long long*)(ws + O_SLOT2), q->ln_mix_g + 1024, q->ln_mix_b + 1024, Hb, U, mod + 3 * 6144, 3, nullptr, nullptr, 0};
        pg8::gemm_phase<EpiResLN<true, true>, PanelOrder, true, true>(lds, g, S, E);
    }
    SEAM(13);
    if (IN(15)) { PHASE_BEGIN
        pg8::Gemm g{U, Wffin1, ML, 5632, 1024, 1024, 1024}; pg8::StaticOrder S; S.init(ML, 5632, G, blk);
        EpiFfn E{ACT};
        pg8::gemm_phase<EpiFfn, pg8::StaticOrder, true, true>(lds, g, S, E);
    }
    SEAM(15);
    if (IN(16)) { PHASE_BEGIN
        pg8::Gemm g{ACT, Wffout1, ML, 1024, FH, FH, FH}; PanelOrder S; S.init(ML, blk);
        EpiResLN<true, false> E{Hb, Hb + (size_t)ML * DM, mod + 3 * 6144 + 5 * 1024, (unsigned*)(ws + O_CNT) + 3 * 66 * 64, (unsigned long long*)(ws + O_SLOT3), q->ln_ffn_g + 1024, q->ln_ffn_b + 1024, q->out, nullptr, nullptr, 0, nullptr, nullptr, 0};
        pg8::gemm_phase<EpiResLN<true, false>, PanelOrder, true, true>(lds, g, S, E);
    }
#undef IN
#undef SEAM
}

#ifndef N_LAUNCH_MODE
#define N_LAUNCH_MODE 1
#endif
extern "C" void kernel_launch(void* const* d_in, const int* in_sizes, int n_in, void* d_out, int out_size, void* d_ws, size_t ws_size, hipStream_t stream) {
    static int grid = 0;
    if (grid == 0) {
        if (n_in != 27 || ws_size < WS_NEED) { fprintf(stderr, "kernel_launch: unexpected inputs (n_in %d, ws %zu)\n", n_in, ws_size); grid = -1; return; }
        int dev = 0, cus = 0, per_cu = 0;
        hipGetDevice(&dev); hipDeviceGetAttribute(&cus, hipDeviceAttributeMultiprocessorCount, dev);
        hipFuncSetAttribute((const void*)dit_fwd, hipFuncAttributeMaxDynamicSharedMemorySize, LDS_BYTES);
        hipOccupancyMaxActiveBlocksPerMultiprocessor(&per_cu, (const void*)dit_fwd, 512, LDS_BYTES);
        (void)hipGetLastError();
        if (per_cu < 1) per_cu = 1;
        grid = cus * per_cu; if (grid > 256) grid = 256;
    }
    if (grid < 0) return;
    if (hipMemsetAsync((char*)d_ws + O_BAR, 0, CTL_BYTES, stream) != hipSuccess) { fprintf(stderr, "memset failed\n"); return; }
    Params p{};
    const float** pp = (const float**)&p;
    for (int i = 0; i < 27; ++i) pp[i] = (const float*)d_in[i];
    p.out = (float*)d_out; p.ws = (unsigned char*)d_ws;
#if N_LAUNCH_MODE == 1
    p.lo = 0; p.hi = NPHASE;
    void* args[] = {&p};
    hipError_t e = hipLaunchCooperativeKernel((const void*)dit_fwd, dim3(grid), dim3(512), args, LDS_BYTES, stream);
    if (e != hipSuccess) fprintf(stderr, "cooperative launch failed: %s (grid %d)\n", hipGetErrorString(e), grid);
#else
    for (int ph = 0; ph < NPHASE; ++ph) { p.lo = ph; p.hi = ph + 1; hipLaunchKernelGGL(dit_fwd, dim3(grid), dim3(512), LDS_BYTES, stream, p); }
#endif
}
```

```cpp
#include <hip/hip_runtime.h>
#include <hip/hip_cooperative_groups.h>
#include <cstdio>
#include <cstdint>
#include <cmath>
namespace cg = cooperative_groups;
namespace pg8 {
#define PG8_LAS __attribute__((address_space(3)))
typedef unsigned short bf16_t;
typedef short bf16x8 __attribute__((ext_vector_type(8)));
typedef float f32x4 __attribute__((ext_vector_type(4)));
typedef unsigned u32x4 __attribute__((ext_vector_type(4)));
typedef float f32x2 __attribute__((ext_vector_type(2)));
constexpr int BM = 256, BK = 64, HALF = 128, HTB = HALF * BK * 2  , STAGE_BYTES = 8 * HTB, NXCD = 8, WGM = 8;

__host__ __device__ __forceinline__ int lds_byte(int r, int c) { const int st = (r >> 4) * 2 + (c >> 5), rr = r & 15, cc = c & 31, ob = rr * 64 + cc * 2; return st * 1024 + (ob ^ (((ob >> 9) & 1) << 5)); }
__host__ __device__ __forceinline__ void stage_rc(int b, int& R, int& C) { const int st = b / 1024, sb = b % 1024, swz = sb ^ (((sb >> 9) & 1) << 5); R = (st >> 1) * 16 + swz / 64; C = (st & 1) * 32 + (swz % 64) / 2; }
__host__ __device__ __forceinline__ int perm32(int rho) { const int n = rho >> 4, i = rho & 15; return 8 * (i >> 2) + 4 * n + (i & 3); }

struct Unit { int pm, pn; };
struct Gemm { const bf16_t* A; const bf16_t* Bt; int M, N, K, lda, ldb; };

struct StaticOrder {
    int nM, nN, nwg, G, c;
    __host__ __device__ void init(int M, int N, int G_, int c_) { nM = M / BM; nN = N / BM; nwg = nM * nN; G = G_; c = c_; }
    __host__ __device__ bool next(int i, Unit& u) const {
        const long L = (long)i * G + c; if (L >= nwg) return false;
        int wgid = (int)L; { const int q = nwg / NXCD, r = nwg % NXCD, xcd = wgid % NXCD, off = wgid / NXCD; wgid = (xcd < r ? xcd * (q + 1) : r * (q + 1) + (xcd - r) * q) + off; }
        const int nig = WGM * nN, gid = wgid / nig, fm = gid * WGM, gsz = (nM - fm) < WGM ? (nM - fm) : WGM;
        u.pm = fm + ((wgid % nig) % gsz); u.pn = (wgid % nig) / gsz; return true;
    }
    __device__ __forceinline__ void a_ready(const Unit&) const {}
    __device__ __forceinline__ void done(const Unit&) const {}
};

__device__ __forceinline__ unsigned cvt_pk_bf16(float lo, float hi) { unsigned r; asm volatile("v_cvt_pk_bf16_f32 %0, %1, %2" : "=v"(r) : "v"(lo), "v"(hi)); return r; }
__device__ __forceinline__ f32x2 gelu_pk(f32x2 v) {
    const f32x2 av = __builtin_elementwise_abs(v), d = av * 0.2316418882f + 1.0f;
    f32x2 t; t.x = __builtin_amdgcn_rcpf(d.x); t.y = __builtin_amdgcn_rcpf(d.y);
    f32x2 q = t * 0.5307027145f + (-0.7265760135f); q = q * t + 0.7107068705f; q = q * t + (-0.142248368f); q = q * t + 0.127414796f; q = q * t;
    const f32x2 s = (v * v) * (-0.72134752044f);
    f32x2 e; e.x = __builtin_amdgcn_exp2f(s.x); e.y = __builtin_amdgcn_exp2f(s.y);
    const f32x2 m = v * (q * e), r = v - m;
    f32x2 o; o.x = v.x < 0.f ? m.x : r.x; o.y = v.y < 0.f ? m.y : r.y; return o;
}
template <class Epi, class Sched, bool ALIGN_EPI = false, bool SP2 = false>
__device__ __forceinline__ void gemm_phase(PG8_LAS unsigned char* lds, const Gemm g, const Sched& S, const Epi& E) {
    int tid = threadIdx.x; asm volatile("" : "+v"(tid));
    const int wid = __builtin_amdgcn_readfirstlane(tid >> 6), lane = tid & 63, wr = wid >> 2, wc = wid & 3, fr = lane & 15, fq = lane >> 4;
    const int K = g.K, nt = K / BK;
    unsigned voffA[2], voffB[2];
#pragma unroll
    for (int i = 0; i < 2; ++i) { int R, C; stage_rc(tid * 16 + i * 8192, R, C); const int Rb = Epi::PERM ? ((R & ~31) + perm32(R & 31)) : R;
        voffA[i] = (unsigned)(R * g.lda + C) * 2u; voffB[i] = (unsigned)(Rb * g.ldb + C) * 2u; }
    const size_t kstep = (size_t)(BK * 2);
    const size_t hstep = (size_t)HALF * g.ldb * 2;
    const size_t tstep = 2 * hstep; const size_t hstepA = (size_t)HALF * g.lda * 2, tstepA = 2 * hstepA;
    const unsigned ldsw = (unsigned)wid * 1024u;
    const int aoff = lds_byte(wr * 64 + fr, fq * 8), boff = lds_byte(wc * 32 + fr, fq * 8);
#define PG8_SA(b, h) (((b) * 2 + (h)) * HTB)
#define PG8_SB(b, h) ((4 + (b) * 2 + (h)) * HTB)
#define PG8_STAGE(bufoff, gbase, voff) do { _Pragma("unroll") for (int _i = 0; _i < 2; ++_i) \
        __builtin_amdgcn_global_load_lds((const unsigned*)((const char*)(gbase) + (voff)[_i]), (PG8_LAS unsigned*)(lds + (bufoff) + ldsw + _i * 8192), 16, 0, 0); } while (0)
#define PG8_LDA(dst, b, h) do { _Pragma("unroll") for (int m = 0; m < 4; ++m) _Pragma("unroll") for (int k = 0; k < 2; ++k) dst[m][k] = *(const PG8_LAS bf16x8*)(lds + PG8_SA(b, h) + aoff + m * 2048 + k * 1024); } while (0)
#define PG8_LDB(dst, b, h) do { _Pragma("unroll") for (int n = 0; n < 2; ++n) _Pragma("unroll") for (int k = 0; k < 2; ++k) dst[n][k] = *(const PG8_LAS bf16x8*)(lds + PG8_SB(b, h) + boff + n * 2048 + k * 1024); } while (0)
#define PG8_MMA(ai, bj, At, Bt) do { __builtin_amdgcn_s_setprio(1); _Pragma("unroll") for (int m = 0; m < 4; ++m) _Pragma("unroll") for (int n = 0; n < 2; ++n) _Pragma("unroll") for (int k = 0; k < 2; ++k) \
        acc[ai][bj][m][n] = __builtin_amdgcn_mfma_f32_16x16x32_bf16(Bt[n][k], At[m][k], acc[ai][bj][m][n], 0, 0, 0); __builtin_amdgcn_s_setprio(0); } while (0)
#define PG8_WAIT_V(n) asm volatile("s_waitcnt vmcnt(" #n ")" ::: "memory")
#define PG8_WAIT_L(n) asm volatile("s_waitcnt lgkmcnt(" #n ")" ::: "memory")
#define PG8_BAR __builtin_amdgcn_s_barrier()
#define PG8_SCHED __builtin_amdgcn_sched_barrier(0)
    Unit cur, nxt; int ui = 0;
    if (!S.next(0, cur)) return;
    f32x4 acc[2][2][4][2];
#pragma unroll
    for (int a = 0; a < 2; ++a)
#pragma unroll
        for (int b = 0; b < 2; ++b)
#pragma unroll
            for (int m = 0; m < 4; ++m)
#pragma unroll
                for (int n = 0; n < 2; ++n) acc[a][b][m][n] = (f32x4){0.f, 0.f, 0.f, 0.f};
    bf16x8 At[4][2], B0[2][2], B1[2][2];
    const char* cA = (const char*)g.A + (size_t)cur.pm * tstepA; const char* cB = (const char*)g.Bt + (size_t)cur.pn * tstep;
    S.a_ready(cur);
    if constexpr (SP2) {
        PG8_STAGE(PG8_SB(0, 0), cB, voffB); PG8_STAGE(PG8_SB(0, 1), cB + hstep, voffB); PG8_STAGE(PG8_SA(0, 0), cA, voffA); PG8_STAGE(PG8_SA(0, 1), cA + hstepA, voffA);
        if (wr == 1) PG8_BAR;
        PG8_WAIT_V(2); PG8_BAR;
        PG8_STAGE(PG8_SB(1, 0), cB + kstep, voffB); PG8_STAGE(PG8_SA(1, 0), cA + kstep, voffA); PG8_STAGE(PG8_SB(1, 1), cB + hstep + kstep, voffB);
        PG8_WAIT_V(6); PG8_BAR;
    } else {
        PG8_STAGE(PG8_SB(0, 0), cB, voffB); PG8_STAGE(PG8_SA(0, 0), cA, voffA); PG8_STAGE(PG8_SB(0, 1), cB + hstep, voffB); PG8_STAGE(PG8_SA(0, 1), cA + hstepA, voffA);
        if (wr == 1) PG8_BAR;
        PG8_WAIT_V(4); PG8_BAR;
        PG8_STAGE(PG8_SB(1, 0), cB + kstep, voffB); PG8_STAGE(PG8_SA(1, 0), cA + kstep, voffA); PG8_STAGE(PG8_SB(1, 1), cB + hstep + kstep, voffB);
        PG8_WAIT_V(6); PG8_BAR;
    }
    for (;;) {
        const bool has_next = S.next(ui + 1, nxt);
        const char* nA = has_next ? (const char*)g.A + (size_t)nxt.pm * tstepA : cA; const char* nB = has_next ? (const char*)g.Bt + (size_t)nxt.pn * tstep : cB;
#pragma nounroll
        for (int t = 0; t < nt; t += 2) {
            const bool last = (t == nt - 2);
            const char* a1 = cA + (size_t)(t + 1) * kstep;
            const char* a2 = last ? nA : cA + (size_t)(t + 2) * kstep; const char* b2 = last ? nB : cB + (size_t)(t + 2) * kstep;
            const char* a3 = a2 + kstep; const char* b3 = b2 + kstep;
            if (last && has_next) S.a_ready(nxt);
            if constexpr (SP2) {
            PG8_LDB(B0, 0, 0); PG8_LDB(B1, 0, 1); PG8_SCHED; PG8_LDA(At, 0, 0); PG8_STAGE(PG8_SA(1, 1), a1 + hstepA, voffA);
            PG8_WAIT_V(8); PG8_WAIT_L(0); PG8_BAR; PG8_MMA(0, 0, At, B0); PG8_MMA(0, 1, At, B1); PG8_BAR; PG8_SCHED;
            PG8_LDA(At, 0, 1); PG8_STAGE(PG8_SB(0, 0), b2, voffB); PG8_STAGE(PG8_SB(0, 1), b2 + hstep, voffB); PG8_STAGE(PG8_SA(0, 0), a2, voffA);
            PG8_WAIT_V(8); PG8_WAIT_L(0); PG8_BAR; PG8_MMA(1, 0, At, B0); PG8_MMA(1, 1, At, B1); PG8_BAR; PG8_SCHED;
            PG8_LDB(B0, 1, 0); PG8_LDB(B1, 1, 1); PG8_SCHED; PG8_LDA(At, 1, 0); PG8_STAGE(PG8_SA(0, 1), a2 + hstepA, voffA);
            PG8_WAIT_V(8); PG8_WAIT_L(0); PG8_BAR; PG8_MMA(0, 0, At, B0); PG8_MMA(0, 1, At, B1); PG8_BAR; PG8_SCHED;
            PG8_LDA(At, 1, 1); PG8_STAGE(PG8_SB(1, 0), b3, voffB); PG8_STAGE(PG8_SB(1, 1), b3 + hstep, voffB); PG8_STAGE(PG8_SA(1, 0), a3, voffA);
            PG8_WAIT_V(8); PG8_WAIT_L(0); PG8_BAR; PG8_MMA(1, 0, At, B0); PG8_MMA(1, 1, At, B1); PG8_BAR; PG8_SCHED;
            } else {
            PG8_LDB(B0, 0, 0); PG8_SCHED; PG8_LDA(At, 0, 0); PG8_STAGE(PG8_SA(1, 1), a1 + hstepA, voffA);
            PG8_WAIT_L(8); PG8_BAR; PG8_WAIT_L(0); PG8_MMA(0, 0, At, B0); PG8_BAR; PG8_SCHED;
            PG8_LDB(B1, 0, 1); PG8_STAGE(PG8_SB(0, 0), b2, voffB);
            PG8_BAR; PG8_WAIT_L(0); PG8_MMA(0, 1, At, B1); PG8_BAR;
            PG8_LDA(At, 0, 1); PG8_STAGE(PG8_SA(0, 0), a2, voffA);
            PG8_BAR; PG8_WAIT_L(0); PG8_MMA(1, 0, At, B0); PG8_BAR; PG8_SCHED;
            PG8_STAGE(PG8_SB(0, 1), b2 + hstep, voffB);
            PG8_WAIT_V(6); PG8_BAR; PG8_MMA(1, 1, At, B1); PG8_BAR;
            PG8_LDB(B0, 1, 0); PG8_SCHED; PG8_LDA(At, 1, 0); PG8_STAGE(PG8_SA(0, 1), a2 + hstepA, voffA);
            PG8_WAIT_L(8); PG8_BAR; PG8_WAIT_L(0); PG8_MMA(0, 0, At, B0); PG8_BAR; PG8_SCHED;
            PG8_LDB(B1, 1, 1); PG8_STAGE(PG8_SB(1, 0), b3, voffB);
            PG8_BAR; PG8_WAIT_L(0); PG8_MMA(0, 1, At, B1); PG8_BAR;
            PG8_LDA(At, 1, 1); PG8_STAGE(PG8_SA(1, 0), a3, voffA);
            PG8_BAR; PG8_WAIT_L(0); PG8_MMA(1, 0, At, B0); PG8_BAR; PG8_SCHED;
            PG8_STAGE(PG8_SB(1, 1), b3 + hstep, voffB);
            PG8_WAIT_V(6); PG8_BAR; PG8_MMA(1, 1, At, B1); PG8_BAR;
            }
        }
        if constexpr (ALIGN_EPI) { if (wr == 0) PG8_BAR; }
        if constexpr (!Epi::AFTER_DRAIN) { E(acc, cur, wr, wc, fr, fq); S.done(cur); }
        if (!has_next) break;
#pragma unroll
        for (int a = 0; a < 2; ++a)
#pragma unroll
            for (int b = 0; b < 2; ++b)
#pragma unroll
                for (int m = 0; m < 4; ++m)
#pragma unroll
                    for (int n = 0; n < 2; ++n) acc[a][b][m][n] = (f32x4){0.f, 0.f, 0.f, 0.f};
        cur = nxt; cA = nA; cB = nB; ++ui;
        if constexpr (ALIGN_EPI) { if (wr == 1) PG8_BAR; }
    }
    PG8_WAIT_V(0);
    if constexpr (!ALIGN_EPI) { if (wr == 0) PG8_BAR; }
    PG8_BAR;
    if constexpr (Epi::AFTER_DRAIN) { E.fused(acc, cur, wr, wc, fr, fq, lds, wid, lane); S.done(cur); }
#undef PG8_SA
#undef PG8_SB
#undef PG8_STAGE
#undef PG8_LDA
#undef PG8_LDB
#undef PG8_MMA
#undef PG8_WAIT_V
#undef PG8_WAIT_L
#undef PG8_BAR
#undef PG8_SCHED
}
}

using pg8::bf16_t; using pg8::f32x4; using pg8::u32x4; using pg8::Unit;
#define LAS __attribute__((address_space(3)))
typedef unsigned u32x2 __attribute__((ext_vector_type(2)));
typedef float f32x2v __attribute__((ext_vector_type(2)));
typedef float f32x16 __attribute__((ext_vector_type(16)));
typedef short bf16x8 __attribute__((ext_vector_type(8)));
typedef short s16x4 __attribute__((ext_vector_type(4)));
typedef short v4i16_t __attribute__((ext_vector_type(4)));

constexpr int SEQ_ = 8192, DM = 1024, ML = 16384, MT = 16896, FH = 2816;
constexpr int PW0 = 3072;
constexpr int PW1 = 1792;
constexpr int STP = 112;
constexpr float ALPHA_ = 1.4142135623730951f;
constexpr float LOG2E_ = 1.4426950408889634f;
constexpr float QS64 = 0.125f * 1.4426950408889634f;
constexpr float QS96 = (float)(1.4426950408889634 / 9.797958971132712);
constexpr float LAMBDA_INIT = 0.2f;

constexpr size_t MiB_ = 1u << 20;
constexpr size_t O_EVIN = 0, O_EVOUT = O_EVIN + 6291456, O_FFIN0 = O_EVOUT + 2097152, O_FFOUT0 = O_FFIN0 + 11534336;
constexpr size_t O_FFIN1 = O_FFOUT0 + 5767168, O_FFOUT1 = O_FFIN1 + 11534336, O_ODIN = O_FFOUT1 + 5767168, O_ODOUT = O_ODIN + 3670016;
constexpr size_t O_UQ = O_ODOUT + 2097152, O_UKV = O_UQ + 589824, O_GWS = O_UKV + 524288, O_MOD = O_GWS + 131072, O_TAB32 = O_MOD + 147456, O_TAB16 = O_TAB32 + 16384;
constexpr size_t O_SLOT0 = 48 * MiB_, O_SLOT1 = 51 * MiB_, O_SLOT2 = 145 * MiB_, O_SLOT3 = 148 * MiB_;
static_assert(O_TAB16 + 8192 <= O_SLOT0 && O_SLOT1 + (size_t)16896 * 128 <= 54 * MiB_, "ws map");
constexpr size_t O_Q1 = 0;
static_assert((size_t)ML * 768 * 2 <= O_FFIN1, "Q1 overlay");
constexpr size_t O_P = 54 * MiB_, O_H = 153 * MiB_, O_U = 219 * MiB_, WS_NEED = 253 * MiB_, O_BAR = 252 * MiB_, O_CNT = O_BAR + 16384, O_PCNT = O_CNT + 4 * 66 * 256, CTL_BYTES = 16384 + 4 * 66 * 256 + 2 * 8 * 256;
constexpr size_t O_ODIFF = O_H, O_AMIX0 = O_U, O_ACT = O_P, O_P1 = O_P, O_AMIX1 = 112 * MiB_, O_STATS = 144 * MiB_, O_KV1 = O_U;
static_assert(O_P1 + (size_t)MT * PW1 * 2 <= O_AMIX1 && O_STATS + (size_t)MT * STP * 4 <= O_H, "ws map 2");

__device__ __forceinline__ unsigned f2bf(float f) { unsigned u = __builtin_bit_cast(unsigned, f); return (u + 0x7fffu + ((u >> 16) & 1u)) >> 16; }
typedef __bf16 bf16x2_hw __attribute__((ext_vector_type(2)));
__device__ __forceinline__ unsigned pk2(float lo, float hi) { f32x2v v = {lo, hi}; bf16x2_hw b = __builtin_convertvector(v, bf16x2_hw); return __builtin_bit_cast(unsigned, b); }
__device__ __forceinline__ float bf2f(unsigned short b) { return __builtin_bit_cast(float, (unsigned)b << 16); }
__device__ __forceinline__ float wave_sum(float v) {
#pragma unroll
    for (int o = 1; o < 64; o <<= 1) v += __shfl_xor(v, o);
    return v;
}
__device__ __forceinline__ float gelu_exact(float v) { return 0.5f * v * (1.0f + erff(v * 0.70710678118654752f)); }
__device__ __forceinline__ int modset(int pm) { return pm < 32 ? 0 : (pm < 64 ? 1 : 2); }

struct EpiIn0 {
    static constexpr bool PERM = true, AFTER_DRAIN = false;
    bf16_t* P; const float* tab32;
    __device__ __forceinline__ void operator()(const f32x4 (&acc)[2][2][4][2], const Unit& u, int wr, int wc, int fr, int fq) const {
        asm volatile("" : "+v"(fr), "+v"(fq));
        const int region = u.pn >> 1;
        const bool rope = (region <= 1) && (u.pm < 64);
        const float sc = (region == 0 || region == 3) ? QS64 : 1.f;
        const float sgn = (fq < 2) ? -1.f : 1.f;
#pragma unroll
        for (int ai = 0; ai < 2; ++ai)
#pragma unroll
            for (int m = 0; m < 4; ++m) {
                const int row = u.pm * 256 + ai * 128 + wr * 64 + m * 16 + fr;
                const int t = row & 8191; const int pos = (wc & 1) ? (t & 63) : (t >> 6);
                const float* tb = tab32 + (pos * 16 + 8 * (fq & 1)) * 2;
#pragma unroll
                for (int bj = 0; bj < 2; ++bj) {
                    const int col = u.pn * 256 + bj * 128 + wc * 32 + 8 * fq;
                    float v[8];
#pragma unroll
                    for (int i = 0; i < 4; ++i) { v[i] = acc[ai][bj][m][0][i]; v[4 + i] = acc[ai][bj][m][1][i]; }
                    if (rope) {
                        const f32x4 t0 = *(const f32x4*)tb, t1 = *(const f32x4*)(tb + 4), t2 = *(const f32x4*)(tb + 8), t3 = *(const f32x4*)(tb + 12);
                        const float cs[8] = {t0[0], t0[2], t1[0], t1[2], t2[0], t2[2], t3[0], t3[2]};
                        const float sn[8] = {t0[1], t0[3], t1[1], t1[3], t2[1], t2[3], t3[1], t3[3]};
#pragma unroll
                        for (int i = 0; i < 8; ++i) { const float pr = __shfl_xor(v[i], 32); v[i] = v[i] * cs[i] + sgn * pr * sn[i]; }
                    }
                    u32x4 w; w.x = pk2(v[0] * sc, v[1] * sc); w.y = pk2(v[2] * sc, v[3] * sc); w.z = pk2(v[4] * sc, v[5] * sc); w.w = pk2(v[6] * sc, v[7] * sc);
                    *(u32x4*)(P + (size_t)row * PW0 + col) = w;
                }
            }
    }
};
struct EpiRes {
    static constexpr bool PERM = true, AFTER_DRAIN = false;
    const float* hx; const float* hc; float* Z; const float* gate;
    __device__ __forceinline__ void operator()(const f32x4 (&acc)[2][2][4][2], const Unit& u, int wr, int wc, int fr, int fq) const {
        asm volatile("" : "+v"(fr), "+v"(fq));
        const float* gp = gate + modset(u.pm) * 6144;
#pragma unroll
        for (int bj = 0; bj < 2; ++bj) {
            const int col = u.pn * 256 + bj * 128 + wc * 32 + 8 * fq;
            const f32x4 g0 = *(const f32x4*)(gp + col), g1 = *(const f32x4*)(gp + col + 4);
#pragma unroll
            for (int ai = 0; ai < 2; ++ai)
#pragma unroll
                for (int m = 0; m < 4; ++m) {
                    const int row = u.pm * 256 + ai * 128 + wr * 64 + m * 16 + fr;
                    const float* hb = (u.pm < 64) ? hx + (size_t)row * DM : hc + (size_t)(row - ML) * DM;
                    const f32x4 h0 = *(const f32x4*)(hb + col), h1 = *(const f32x4*)(hb + col + 4);
                    const f32x4 z0 = h0 * ALPHA_ + g0 * acc[ai][bj][m][0], z1 = h1 * ALPHA_ + g1 * acc[ai][bj][m][1];
                    float* zp = Z + (size_t)row * DM + col;
                    *(f32x4*)zp = z0; *(f32x4*)(zp + 4) = z1;
                }
        }
    }
};

struct PanelOrder {
    int nP, c;
    __device__ void init(int M, int c_) { nP = M / 256; c = c_; }
    __device__ bool next(int i, Unit& u) const {
        const int rem = nP - 64 * i;
        if (rem >= 64) { const int x = c & 7, j = c >> 3; u.pm = 64 * i + 8 * x + (j & 7); u.pn = j >> 3; return true; }
        if (rem > 0 && c < 4 * rem) { u.pm = 64 * i + (c >> 2); u.pn = c & 3; return true; }
        return false;
    }
    __device__ __forceinline__ void a_ready(const Unit&) const {}
    __device__ __forceinline__ void done(const Unit&) const {}
};
struct TailOrder {
    int c;
    __device__ bool next(int i, Unit& u) const { if (i > 0 || c >= 32) return false; u.pm = 64 + (c >> 4); u.pn = (c >> 2) & 3; return true; }
    __device__ __forceinline__ void a_ready(const Unit&) const {}
    __device__ __forceinline__ void done(const Unit&) const {}
};
template <bool HIN16, bool HOUT16>
struct EpiResLN {
    static constexpr bool PERM = true, AFTER_DRAIN = false;
    const void* hx; const void* hc; const float* gate;
    unsigned* cnt; unsigned long long* slots; const float* lg; const float* lb; void* dst; bf16_t* U; const float* modl; int kmod;
    float* part_buf; unsigned* part_cnt; int part;
    __device__ __forceinline__ void operator()(const f32x4 (&acc)[2][2][4][2], const Unit& u, int wr, int wc, int fr, int fq) const {
        asm volatile("" : "+v"(fr), "+v"(fq));
        const int set = modset(u.pm);
        const float* gp = gate + set * 6144;
        const int colb = u.pn * 256 + wc * 32 + 8 * fq;
        const int tunit = (u.pm - 64) * 4 + u.pn;
        int tid_ = threadIdx.x; asm volatile("" : "+v"(tid_));
        if (part_buf && part != 0) {
            float* pb = part_buf + ((size_t)(tunit * 3 + part - 1) * 32 * 512 + tid_) * 4;
#pragma unroll
            for (int ai = 0; ai < 2; ++ai)
#pragma unroll
                for (int bj = 0; bj < 2; ++bj)
#pragma unroll
                    for (int m = 0; m < 4; ++m)
#pragma unroll
                        for (int hf = 0; hf < 2; ++hf) {
                            const f32x4 v = acc[ai][bj][m][hf]; float* dp = pb + (size_t)((((ai * 2 + bj) * 4 + m) * 2 + hf) * 512) * 4;
                            asm volatile("global_store_dwordx4 %0, %1, off sc1" :: "v"(dp), "v"(v) : "memory");
                        }
            asm volatile("s_waitcnt vmcnt(0)" ::: "memory"); __builtin_amdgcn_s_barrier(); asm volatile("" ::: "memory");
            if (threadIdx.x == 0) __hip_atomic_fetch_add(part_cnt + 64 * tunit, 1u, __ATOMIC_RELAXED, __HIP_MEMORY_SCOPE_AGENT);
            return;
        }
        if (part_buf) {
            if (threadIdx.x == 0) {
                unsigned sp = 0;
                while (__hip_atomic_load(part_cnt + 64 * tunit, __ATOMIC_RELAXED, __HIP_MEMORY_SCOPE_AGENT) < 3u) { __builtin_amdgcn_s_sleep(1); if (++sp > (1u << 24)) break; }
                __builtin_amdgcn_fence(__ATOMIC_ACQUIRE, "agent"); asm volatile("s_waitcnt vmcnt(0)" ::: "memory");
            }
            asm volatile("s_waitcnt vmcnt(0) lgkmcnt(0)" ::: "memory"); __builtin_amdgcn_s_barrier(); asm volatile("" ::: "memory");
        }
        const float* pb0 = part_buf ? part_buf + ((size_t)(tunit * 3) * 32 * 512 + tid_) * 4 : nullptr;
        f32x4 z[2][4][2][2];
        {
            f32x4 g[2][2];
#pragma unroll
            for (int bj = 0; bj < 2; ++bj) { g[bj][0] = *(const f32x4*)(gp + colb + bj * 128); g[bj][1] = *(const f32x4*)(gp + colb + bj * 128 + 4); }
#pragma unroll
            for (int ai = 0; ai < 2; ++ai)
#pragma unroll
                for (int m = 0; m < 4; ++m) {
                    const int r = ai * 128 + wr * 64 + m * 16 + fr, row = u.pm * 256 + r;
                    const size_t hoff = ((u.pm < 64) ? (size_t)row * DM : (size_t)(row - ML) * DM) + colb;
                    const float* hb = (const float*)((u.pm < 64) ? hx : hc) + hoff;
                    const bf16_t* hb16 = (const bf16_t*)((u.pm < 64) ? hx : hc) + hoff;
                    float s = 0.f, q = 0.f;
#pragma unroll
                    for (int bj = 0; bj < 2; ++bj) {
                        f32x4 h0, h1;
                        if (HIN16) { const u32x4 hw = *(const u32x4*)(hb16 + bj * 128);
                            h0 = (f32x4){__uint_as_float(hw[0] << 16), __uint_as_float(hw[0] & 0xffff0000u), __uint_as_float(hw[1] << 16), __uint_as_float(hw[1] & 0xffff0000u)};
                            h1 = (f32x4){__uint_as_float(hw[2] << 16), __uint_as_float(hw[2] & 0xffff0000u), __uint_as_float(hw[3] << 16), __uint_as_float(hw[3] & 0xffff0000u)}; }
                        else { h0 = *(const f32x4*)(hb + bj * 128); h1 = *(const f32x4*)(hb + bj * 128 + 4); }
                        f32x4 a0 = acc[ai][bj][m][0], a1 = acc[ai][bj][m][1];
                        if (part_buf) {
#pragma unroll
                            for (int pp = 0; pp < 3; ++pp) { const float* pq = pb0 + (size_t)(pp * 32 + ((ai * 2 + bj) * 4 + m) * 2) * 512 * 4;
                                a0 += *(const f32x4*)pq; a1 += *(const f32x4*)(pq + 512 * 4); }
                        }
                        const f32x4 z0 = h0 * ALPHA_ + g[bj][0] * a0, z1 = h1 * ALPHA_ + g[bj][1] * a1;
                        z[ai][m][bj][0] = z0; z[ai][m][bj][1] = z1;
                        s += (z0[0] + z0[1]) + (z0[2] + z0[3]) + (z1[0] + z1[1]) + (z1[2] + z1[3]);
                        q += (z0[0] * z0[0] + z0[1] * z0[1]) + (z0[2] * z0[2] + z0[3] * z0[3]) + (z1[0] * z1[0] + z1[1] * z1[1]) + (z1[2] * z1[2] + z1[3] * z1[3]);
                    }
                    s += __shfl_xor(s, 16); s += __shfl_xor(s, 32); q += __shfl_xor(q, 16); q += __shfl_xor(q, 32);
                    if (fq == 0) __hip_atomic_store(slots + ((size_t)(u.pm * 256 + r) * 16 + u.pn * 4 + wc), ((unsigned long long)__float_as_uint(q) << 32) | __float_as_uint(s), __ATOMIC_RELAXED, __HIP_MEMORY_SCOPE_AGENT);
                    if (m == 3) asm volatile("" ::: "memory");
                }
        }
        asm volatile("s_waitcnt vmcnt(0)" ::: "memory"); __builtin_amdgcn_s_barrier(); asm volatile("" ::: "memory");
        if (threadIdx.x == 0) {
            unsigned* cw = cnt + 64 * u.pm;
            __hip_atomic_fetch_add(cw, 1u, __ATOMIC_RELAXED, __HIP_MEMORY_SCOPE_AGENT);
            unsigned sp = 0;
            while (__hip_atomic_load(cw, __ATOMIC_RELAXED, __HIP_MEMORY_SCOPE_AGENT) < 4u) { __builtin_amdgcn_s_sleep(1); if (++sp > (1u << 24)) break; }
            __builtin_amdgcn_fence(__ATOMIC_ACQUIRE, "agent"); asm volatile("s_waitcnt vmcnt(0)" ::: "memory");
        }
        asm volatile("s_waitcnt vmcnt(0) lgkmcnt(0)" ::: "memory"); __builtin_amdgcn_s_barrier(); asm volatile("" ::: "memory");
        const float* mp = U ? modl + set * 6144 + kmod * 1024 + colb : nullptr;
        f32x4 sv[2][4][2];
#pragma unroll
        for (int ai = 0; ai < 2; ++ai)
#pragma unroll
            for (int m = 0; m < 4; ++m) {
                const int r = ai * 128 + wr * 64 + m * 16 + fr;
                const f32x4* sl = (const f32x4*)(slots + ((size_t)(u.pm * 256 + r) * 16 + fq * 4));
                sv[ai][m][0] = sl[0]; sv[ai][m][1] = sl[1];
            }
        float mean_[2][4], rstd_[2][4];
#pragma unroll
        for (int ai = 0; ai < 2; ++ai)
#pragma unroll
            for (int m = 0; m < 4; ++m) {
                float s = (sv[ai][m][0][0] + sv[ai][m][0][2]) + (sv[ai][m][1][0] + sv[ai][m][1][2]);
                float q = (sv[ai][m][0][1] + sv[ai][m][0][3]) + (sv[ai][m][1][1] + sv[ai][m][1][3]);
                s += __shfl_xor(s, 16); s += __shfl_xor(s, 32); q += __shfl_xor(q, 16); q += __shfl_xor(q, 32);
                const float mean = s * (1.f / DM);
                mean_[ai][m] = mean; rstd_[ai][m] = 1.f / sqrtf(fmaxf(q * (1.f / DM) - mean * mean, 0.f) + 1e-5f);
            }
        asm volatile("" ::: "memory");
#pragma unroll
        for (int bj = 0; bj < 2; ++bj) {
            const int col = colb + bj * 128;
            const f32x4 lg0 = *(const f32x4*)(lg + col), lg1 = *(const f32x4*)(lg + col + 4), lb0 = *(const f32x4*)(lb + col), lb1 = *(const f32x4*)(lb + col + 4);
            f32x4 sh0 = {}, sh1 = {}, sc0 = {}, sc1 = {};
            if (U) { sh0 = *(const f32x4*)(mp + bj * 128); sh1 = *(const f32x4*)(mp + bj * 128 + 4); sc0 = *(const f32x4*)(mp + 1024 + bj * 128) + 1.f; sc1 = *(const f32x4*)(mp + 1024 + bj * 128 + 4) + 1.f; }
#pragma unroll
            for (int ai = 0; ai < 2; ++ai)
#pragma unroll
                for (int m = 0; m < 4; ++m) {
                    const int r = ai * 128 + wr * 64 + m * 16 + fr, row = u.pm * 256 + r;
                    const float mean = mean_[ai][m], rstd = rstd_[ai][m];
                    const f32x4 h0 = (z[ai][m][bj][0] - mean) * rstd * lg0 + lb0, h1 = (z[ai][m][bj][1] - mean) * rstd * lg1 + lb1;
                    if (HOUT16) *(u32x4*)((bf16_t*)dst + (size_t)row * DM + col) = (u32x4){pk2(h0[0], h0[1]), pk2(h0[2], h0[3]), pk2(h1[0], h1[1]), pk2(h1[2], h1[3])};
                    else { float* dp = (float*)dst + (size_t)row * DM + col; *(f32x4*)dp = h0; *(f32x4*)(dp + 4) = h1; }
                    if (U) { const f32x4 u0 = h0 * sc0 + sh0, u1 = h1 * sc1 + sh1;
                        *(u32x4*)(U + (size_t)row * DM + col) = (u32x4){pk2(u0[0], u0[1]), pk2(u0[2], u0[3]), pk2(u1[0], u1[1]), pk2(u1[2], u1[3])}; }
                }
            asm volatile("" ::: "memory");
        }
    }
};
struct EpiFfn {
    static constexpr bool PERM = true, AFTER_DRAIN = false;
    bf16_t* ACT;
    __device__ __forceinline__ void operator()(const f32x4 (&acc)[2][2][4][2], const Unit& u, int wr, int wc, int fr, int fq) const {
        asm volatile("" : "+v"(fr), "+v"(fq));
        const int hcol = u.pn * 128 + wc * 32 + 8 * fq;
#pragma unroll
        for (int ai = 0; ai < 2; ++ai)
#pragma unroll
            for (int m = 0; m < 4; ++m) {
                const int row = u.pm * 256 + ai * 128 + wr * 64 + m * 16 + fr;
                float o[8];
#pragma unroll
                for (int i = 0; i < 8; ++i) { const float g = acc[ai][0][m][i >> 2][i & 3], a = acc[ai][1][m][i >> 2][i & 3]; o[i] = g * __builtin_amdgcn_rcpf(1.f + __builtin_amdgcn_exp2f(-1.4426950408889634f * g)) * a; }
                u32x4 w; w.x = pk2(o[0], o[1]); w.y = pk2(o[2], o[3]); w.z = pk2(o[4], o[5]); w.w = pk2(o[6], o[7]);
                *(u32x4*)(ACT + (size_t)row * FH + hcol) = w;
            }
    }
};
struct EpiIn1 {
    static constexpr bool PERM = true, AFTER_DRAIN = false;
    bf16_t* P1; float* stats; const float* tab16;
    __device__ __forceinline__ void operator()(const f32x4 (&acc)[2][2][4][2], const Unit& u, int wr, int wc, int fr, int fq) const {
        asm volatile("" : "+v"(fr), "+v"(fq));
#pragma unroll
        for (int bj = 0; bj < 2; ++bj) {
            const int col32 = u.pn * 256 + bj * 128 + wc * 32, col = col32 + 8 * fq, grp = col32 >> 5;
            if (col32 >= 672 && col32 < 768) continue;
            const int kind = (col32 < 640) ? 0 : (col32 < 672 ? 1 : (col32 < 1280 ? 2 : 3));
#pragma unroll
            for (int ai = 0; ai < 2; ++ai)
#pragma unroll
                for (int m = 0; m < 4; ++m) {
                    const int row = u.pm * 256 + ai * 128 + wr * 64 + m * 16 + fr;
                    float v[8];
#pragma unroll
                    for (int i = 0; i < 4; ++i) { v[i] = acc[ai][bj][m][0][i]; v[4 + i] = acc[ai][bj][m][1][i]; }
                    if (kind == 1) {
                        if (u.pm < 64) {
                            const int t = row & 8191; const int pos = (fq & 2) ? (t & 63) : (t >> 6);
                            const float* tb = tab16 + pos * 16;
                            const f32x4 t0 = *(const f32x4*)tb, t1 = *(const f32x4*)(tb + 4), t2 = *(const f32x4*)(tb + 8), t3 = *(const f32x4*)(tb + 12);
                            const float cs[8] = {t0[0], t0[2], t1[0], t1[2], t2[0], t2[2], t3[0], t3[2]};
                            const float sn[8] = {t0[1], t0[3], t1[1], t1[3], t2[1], t2[3], t3[1], t3[3]};
                            const float sgn = (fq & 1) ? 1.f : -1.f;
#pragma unroll
                            for (int i = 0; i < 8; ++i) { const float pr = __shfl_xor(v[i], 16); v[i] = v[i] * cs[i] + sgn * pr * sn[i]; }
                        }
                    } else if (kind >= 2) {
#pragma unroll
                        for (int i = 0; i < 8; i += 2) { const pg8::f32x2 gv2 = pg8::gelu_pk((pg8::f32x2){v[i], v[i + 1]}); v[i] = gv2.x; v[i + 1] = gv2.y; }
                    }
                    if (kind == 0 || kind == 3) {
                        float s = 0.f, q = 0.f;
#pragma unroll
                        for (int i = 0; i < 8; ++i) { s += v[i]; q += v[i] * v[i]; }
                        s += __shfl_xor(s, 16); s += __shfl_xor(s, 32); q += __shfl_xor(q, 16); q += __shfl_xor(q, 32);
                        if (fq == 0) *(f32x2v*)(stats + (size_t)row * STP + grp * 2) = (f32x2v){s, q};
                    }
                    u32x4 w; w.x = pk2(v[0], v[1]); w.y = pk2(v[2], v[3]); w.z = pk2(v[4], v[5]); w.w = pk2(v[6], v[7]);
                    *(u32x4*)(P1 + (size_t)row * PW1 + col) = w;
                    asm volatile("" ::: "memory");
                }
        }
    }
};
struct EpiQ1 {
    static constexpr bool PERM = true, AFTER_DRAIN = false;
    bf16_t* Q1; const float* stats; const float* tab16;
    __device__ __forceinline__ void operator()(const f32x4 (&acc)[2][2][4][2], const Unit& u, int wr, int wc, int fr, int fq) const {
        asm volatile("" : "+v"(fr), "+v"(fq));
#pragma unroll
        for (int ai = 0; ai < 2; ++ai)
#pragma unroll
            for (int m = 0; m < 4; ++m) {
                const int row = u.pm * 256 + ai * 128 + wr * 64 + m * 16 + fr;
                const float* sp = stats + (size_t)row * STP + fq * 6;
                float q = sp[1] + sp[3] + sp[5];
                q += __shfl_xor(q, 16); q += __shfl_xor(q, 32);
                const float rs = QS96 / sqrtf(q * (1.f / 384.f) + 1e-6f);
                const int t = row & 8191; const int pos = (fq & 2) ? (t & 63) : (t >> 6);
                const float* tb = tab16 + pos * 16;
                const float sgn = (fq & 1) ? 1.f : -1.f;
#pragma unroll
                for (int bj = 0; bj < 2; ++bj) {
                    const int col32 = u.pn * 256 + bj * 128 + wc * 32, col = col32 + 8 * fq;
                    const bool rope = ((col32 >> 5) % 3) == 2;
                    float v[8];
#pragma unroll
                    for (int i = 0; i < 4; ++i) { v[i] = acc[ai][bj][m][0][i]; v[4 + i] = acc[ai][bj][m][1][i]; }
                    if (rope) {
                        const f32x4 t0 = *(const f32x4*)tb, t1 = *(const f32x4*)(tb + 4), t2 = *(const f32x4*)(tb + 8), t3 = *(const f32x4*)(tb + 12);
                        const float cs[8] = {t0[0], t0[2], t1[0], t1[2], t2[0], t2[2], t3[0], t3[2]};
                        const float sn[8] = {t0[1], t0[3], t1[1], t1[3], t2[1], t2[3], t3[1], t3[3]};
#pragma unroll
                        for (int i = 0; i < 8; ++i) { const float pr = __shfl_xor(v[i], 16); v[i] = v[i] * cs[i] + sgn * pr * sn[i]; }
                    }
                    u32x4 w; w.x = pk2(v[0] * rs, v[1] * rs); w.y = pk2(v[2] * rs, v[3] * rs); w.z = pk2(v[4] * rs, v[5] * rs); w.w = pk2(v[6] * rs, v[7] * rs);
                    *(u32x4*)(Q1 + (size_t)row * 768 + col) = w;
                }
                asm volatile("" ::: "memory");
            }
    }
};
struct EpiKV1 {
    static constexpr bool PERM = true, AFTER_DRAIN = false;
    bf16_t* KV1; const float* stats;
    __device__ __forceinline__ void operator()(const f32x4 (&acc)[2][2][4][2], const Unit& u, int wr, int wc, int fr, int fq) const {
        asm volatile("" : "+v"(fr), "+v"(fq));
#pragma unroll
        for (int ai = 0; ai < 2; ++ai)
#pragma unroll
            for (int m = 0; m < 4; ++m) {
                const int row = u.pm * 256 + ai * 128 + wr * 64 + m * 16 + fr;
                const float* sp = stats + (size_t)row * STP + 24 + fq * 4;
                float q = sp[1] + sp[3];
                q += __shfl_xor(q, 16); q += __shfl_xor(q, 32);
                const float rs = 1.f / sqrtf(q * (1.f / 256.f) + 1e-6f);
#pragma unroll
                for (int bj = 0; bj < 2; ++bj) {
                    const int col = u.pn * 256 + bj * 128 + wc * 32 + 8 * fq;
                    const f32x4 a = acc[ai][bj][m][0] * rs, b = acc[ai][bj][m][1] * rs;
                    u32x4 w; w.x = pk2(a[0], a[1]); w.y = pk2(a[2], a[3]); w.z = pk2(b[0], b[1]); w.w = pk2(b[2], b[3]);
                    *(u32x4*)(KV1 + (size_t)row * 1024 + col) = w;
                }
                asm volatile("" ::: "memory");
            }
    }
};

struct AttnDesc {
    const bf16_t* Q; int qpitch;
    const bf16_t* K; int kpitch;
    const bf16_t* K2; int k2pitch;
    const bf16_t* V; int vpitch;
    float* Of; bf16_t* Ob; int opitch;
    int qrow0;
    int ntiles, nlat, lat_row0, ctx_row0;
    int na_rowlo, na_gr0;
    const float* rpb;
    float lam; const float* subg;
};
__device__ __forceinline__ s16x4 tr_read(const LAS unsigned char* p) { return __builtin_bit_cast(s16x4, __builtin_amdgcn_ds_read_tr16_b64_v4i16((LAS v4i16_t*)p)); }


__device__ __forceinline__ void glds16(const void* gsrc, unsigned lds_dst) { unsigned keep;
    asm volatile("s_mov_b32 %0, m0\n\ts_mov_b32 m0, %2\n\ts_nop 0\n\tglobal_load_lds_dwordx4 %1, off\n\ts_mov_b32 m0, %0" : "=&s"(keep) : "v"(gsrc), "s"(lds_dst) : "memory"); }
template <int NDB>
__device__ __forceinline__ void att_softmax(f32x16& p0, f32x16& p1, f32x16 (&o)[NDB], float& mrun, float& lrun, bool& first, bf16x8 (&pf)[4]) {
    float ra = __builtin_fmaxf(__builtin_fmaxf(p0[0], p0[1]), p1[0]), rb = __builtin_fmaxf(__builtin_fmaxf(p0[2], p0[3]), p1[1]);
    ra = __builtin_fmaxf(__builtin_fmaxf(ra, p1[2]), p1[3]);
#pragma unroll
    for (int r = 4; r < 16; r += 4) { ra = __builtin_fmaxf(__builtin_fmaxf(ra, p0[r]), p0[r + 1]); rb = __builtin_fmaxf(__builtin_fmaxf(rb, p0[r + 2]), p0[r + 3]);
        ra = __builtin_fmaxf(__builtin_fmaxf(ra, p1[r]), p1[r + 1]); rb = __builtin_fmaxf(__builtin_fmaxf(rb, p1[r + 2]), p1[r + 3]); }
    float rm = __builtin_fmaxf(ra, rb);
    { auto rr = __builtin_amdgcn_permlane32_swap(__float_as_uint(rm), __float_as_uint(rm), false, false); rm = __builtin_fmaxf(__uint_as_float(rr[0]), __uint_as_float(rr[1])); }
    if (first || __any(rm > mrun + 8.f)) {
        const float mn = first ? rm : __builtin_fmaxf(mrun, rm);
        if (!first) { const float al = __builtin_amdgcn_exp2f(mrun - mn); lrun *= al;
#pragma unroll
            for (int i = 0; i < NDB; ++i) o[i] *= al; }
        mrun = mn; first = false;
    }
    float ls = 0.f;
#pragma unroll
    for (int r = 0; r < 16; ++r) { p0[r] = __builtin_amdgcn_exp2f(p0[r] - mrun); p1[r] = __builtin_amdgcn_exp2f(p1[r] - mrun); ls += p0[r] + p1[r]; }
    lrun += ls;
#pragma unroll
    for (int j = 0; j < 4; ++j) {
        u32x4 pw;
#pragma unroll
        for (int e = 0; e < 4; ++e) { const int r = 8 * (j & 1) + 2 * e; pw[e] = (j < 2) ? pk2(p0[r], p0[r + 1]) : pk2(p1[r], p1[r + 1]); }
        pf[j] = __builtin_bit_cast(bf16x8, pw);
    }
}
template <int NDB, int VS>
__device__ __forceinline__ void att_pv(f32x16 (&o)[NDB], const bf16x8 (&pf)[4], const LAS unsigned char* vb) {
#pragma unroll
    for (int j = 0; j < 4; ++j)
#pragma unroll
        for (int db = 0; db < NDB; ++db) {
            const s16x4 lo = tr_read(vb + (16 * j) * VS + db * 64), hh = tr_read(vb + (16 * j + 8) * VS + db * 64);
            const bf16x8 vf = (bf16x8){lo[0], lo[1], lo[2], lo[3], hh[0], hh[1], hh[2], hh[3]};
            o[db] = __builtin_amdgcn_mfma_f32_32x32x16_bf16(vf, pf[j], o[db], 0, 0, 0);
        }
}
template <int DQ, int DV, bool NA, int OMODE>
__device__ __forceinline__ void attn_unit(const AttnDesc d, LAS unsigned char* lds) {
    constexpr int KS = DQ * 2 + 16, VS = DV * 2 + 64;
    constexpr int KBUF = NA ? 64 * KS : (8192 + (DQ == 96 ? 4096 : 0)), VBUF = NA ? 64 * VS : 64 * DV * 2;
    constexpr int NBUF = NA ? 2 : 3;
    constexpr int OFF_K = 0, OFF_V = NBUF * KBUF, OFF_RPB = OFF_V + NBUF * VBUF;
    constexpr int NQF = DQ / 16, NDB = DV / 32;
    int tid = threadIdx.x; asm volatile("" : "+v"(tid));
    const int lane = tid & 63, w = __builtin_amdgcn_readfirstlane(tid >> 6), r32 = lane & 31, hi = lane >> 5;
    bf16x8 qf[NQF];
    { const bf16_t* qp = d.Q + (size_t)(d.qrow0 + 32 * w + r32) * d.qpitch + 8 * hi;
#pragma unroll
      for (int d0 = 0; d0 < NQF; ++d0) qf[d0] = *(const bf16x8*)(qp + 16 * d0); }
    LAS float* rpbL = (LAS float*)(lds + OFF_RPB);
    if (NA) { for (int i = tid; i < 465; i += 512) rpbL[i] = d.rpb[i] * LOG2E_; }
    const int kkey = tid >> 3, kch = tid & 7;
    const int k2key = tid >> 2, k2ch = tid & 3;
    u32x4 kA, kB, vA, vB;
#define ATT_TROW(i) ((i) < d.nlat ? d.lat_row0 + 64 * (i) : d.ctx_row0 + 64 * ((i) - d.nlat))
#define ATT_LOAD(i) do { const int tr_ = ATT_TROW(i); \
        kA = *(const u32x4*)(d.K + (size_t)(tr_ + kkey) * d.kpitch + kch * 8); \
        if (DQ == 96) { if (tid < 256) kB = *(const u32x4*)(d.K2 + (size_t)(tr_ + k2key) * d.k2pitch + k2ch * 8); } \
        if (DV == 128) { vA = *(const u32x4*)(d.V + (size_t)(tr_ + (tid >> 4)) * d.vpitch + (tid & 15) * 8); vB = *(const u32x4*)(d.V + (size_t)(tr_ + 32 + (tid >> 4)) * d.vpitch + (tid & 15) * 8); } \
        else { vA = *(const u32x4*)(d.V + (size_t)(tr_ + kkey) * d.vpitch + kch * 8); } } while (0)
#define ATT_STORE(b) do { \
        *(LAS u32x4*)(lds + OFF_K + (b) * KBUF + kkey * KS + kch * 16) = kA; \
        if (DQ == 96) { if (tid < 256) *(LAS u32x4*)(lds + OFF_K + (b) * KBUF + k2key * KS + 128 + k2ch * 16) = kB; } \
        if (DV == 128) { *(LAS u32x4*)(lds + OFF_V + (b) * VBUF + (tid >> 4) * VS + (tid & 15) * 16) = vA; *(LAS u32x4*)(lds + OFF_V + (b) * VBUF + (32 + (tid >> 4)) * VS + (tid & 15) * 16) = vB; } \
        else { *(LAS u32x4*)(lds + OFF_V + (b) * VBUF + kkey * VS + kch * 16) = vA; } } while (0)
    const int nt = d.ntiles;
    const unsigned ldsb = (unsigned)(uintptr_t)lds;
    int gko, gk2o = 0, gvo0, gvo1 = 0;
    { const int kr = 8 * w + (lane >> 3), kc = (lane & 7) ^ ((kr >> 1) & 7); gko = kr * d.kpitch + kc * 8;
      if (DQ == 96) { const int rr = 16 * (w & 3) + (lane >> 2), rc = (lane & 3) ^ ((rr >> 2) & 3); gk2o = rr * d.k2pitch + rc * 8; }
      if (DV == 128) { const int pos = lane & 15, sp = pos >> 2, sub = pos & 3;
          const int r0 = 8 * w + (lane >> 4), r1 = r0 + 4;
          gvo0 = r0 * d.vpitch + ((sp - r0) & 3) * 32 + sub * 8; gvo1 = r1 * d.vpitch + ((sp - r1) & 3) * 32 + sub * 8; }
      else { const int sr = 4 * w + (lane >> 4), pos = lane & 15, sp = pos >> 2, sub = pos & 3, x = (sp - sr) & 3;
          gvo0 = (2 * sr + (x >> 1)) * d.vpitch + (x & 1) * 32 + sub * 8; } }
#define ATT_DMA(i, slot) do { const int tr_ = ATT_TROW(i); \
        glds16(d.K + ((size_t)tr_ * d.kpitch + gko), (unsigned)__builtin_amdgcn_readfirstlane(ldsb + OFF_K + (slot) * KBUF + w * 1024)); \
        if (DQ == 96) { if (w < 4) glds16(d.K2 + ((size_t)tr_ * d.k2pitch + gk2o), (unsigned)__builtin_amdgcn_readfirstlane(ldsb + OFF_K + (slot) * KBUF + 8192 + w * 1024)); } \
        if (DV == 128) { glds16(d.V + ((size_t)tr_ * d.vpitch + gvo0), (unsigned)__builtin_amdgcn_readfirstlane(ldsb + OFF_V + (slot) * VBUF + w * 2048)); \
                         glds16(d.V + ((size_t)tr_ * d.vpitch + gvo1), (unsigned)__builtin_amdgcn_readfirstlane(ldsb + OFF_V + (slot) * VBUF + w * 2048 + 1024)); } \
        else glds16(d.V + ((size_t)tr_ * d.vpitch + gvo0), (unsigned)__builtin_amdgcn_readfirstlane(ldsb + OFF_V + (slot) * VBUF + w * 1024)); } while (0)
    if (NA) { ATT_LOAD(0); ATT_STORE(0); }
    else { ATT_DMA(0, 0); if (nt > 1) ATT_DMA(1, 1); asm volatile("s_waitcnt vmcnt(0)" ::: "memory"); }
    __syncthreads();
    f32x16 o[NDB];
#pragma unroll
    for (int i = 0; i < NDB; ++i) o[i] = (f32x16){};
    float mrun = 0.f, lrun = 0.f; bool first = true;
    const int gr = d.na_gr0 + (w >> 1);
    const int rs_ = gr - 4 < 0 ? 0 : (gr - 4 > 120 ? 120 : gr - 4);
    const int qc = 32 * (w & 1) + r32;
    const int cs_ = qc - 8 < 0 ? 0 : (qc - 8 > 48 ? 48 : qc - 8);
    unsigned namask0 = 0u, namask1 = 0u;
    if (NA) {
#pragma unroll
        for (int r = 0; r < 16; ++r) { const int kc0 = (r & 3) + 8 * (r >> 2) + 4 * hi, kc1 = kc0 + 32;
            namask0 |= (kc0 >= cs_ && kc0 < cs_ + 16) ? (1u << r) : 0u; namask1 |= (kc1 >= cs_ && kc1 < cs_ + 16) ? (1u << r) : 0u; }
    }
    const int koffr = r32 * KS + hi * 16;
    const int voffr = (4 * hi + ((lane & 15) >> 2)) * VS + ((lane >> 4) & 1) * 32 + (lane & 3) * 8;
    int kro[NQF], vro[NDB];
    { const int q_ = (lane & 15) >> 2, gi_ = (lane >> 4) & 1, p_ = lane & 3;
#pragma unroll
      for (int d0 = 0; d0 < NQF; ++d0) kro[d0] = d0 < 4 ? r32 * 128 + (((2 * d0 + hi) ^ ((r32 >> 1) & 7)) << 4) : 8192 + r32 * 64 + (((2 * (d0 - 4) + hi) ^ ((r32 >> 2) & 3)) << 4);
#pragma unroll
      for (int db = 0; db < NDB; ++db) vro[db] = DV == 128 ? (4 * hi + q_) * 256 + (((db + q_) & 3) << 6) + 32 * gi_ + 8 * p_
                                                             : (2 * hi + (q_ >> 1)) * 256 + (((2 * (q_ & 1) + db + 2 * hi + (q_ >> 1)) & 3) << 6) + 32 * gi_ + 8 * p_; }
    constexpr int VJ = DV == 128 ? 4096 : 2048, VE = DV == 128 ? 2048 : 1024;
    if constexpr (!NA) {
        f32x16 pA0, pA1, pB0, pB1; bf16x8 pf[4];
        int bc = 0, bn = 1, bn2 = 2;
#define ATT_BAR() asm volatile("s_waitcnt vmcnt(0) lgkmcnt(0)\n\ts_barrier" ::: "memory")
#define ATT_QK(P0, P1, slot) do { const LAS unsigned char* kb_ = lds + OFF_K + (slot) * KBUF; \
        bf16x8 ka_[NQF], kc_[NQF];       \
        _Pragma("unroll") for (int d0 = 0; d0 < NQF; ++d0) { ka_[d0] = *(const LAS bf16x8*)(kb_ + kro[d0]); kc_[d0] = *(const LAS bf16x8*)(kb_ + kro[d0] + (d0 < 4 ? 4096 : 2048)); } \
        __builtin_amdgcn_sched_barrier(0); \
        _Pragma("unroll") for (int d0 = 0; d0 < NQF; ++d0) { \
            const bf16x8 a0_ = ka_[d0], a1_ = kc_[d0]; \
            if (d0 == 0) { P0 = __builtin_amdgcn_mfma_f32_32x32x16_bf16(a0_, qf[0], (f32x16){}, 0, 0, 0); P1 = __builtin_amdgcn_mfma_f32_32x32x16_bf16(a1_, qf[0], (f32x16){}, 0, 0, 0); } \
            else { P0 = __builtin_amdgcn_mfma_f32_32x32x16_bf16(a0_, qf[d0], P0, 0, 0, 0); P1 = __builtin_amdgcn_mfma_f32_32x32x16_bf16(a1_, qf[d0], P1, 0, 0, 0); } } } while (0)
#define ATT_STEP(C0, C1, N0, N1, tt) do { \
        if ((tt) + 2 < nt) ATT_DMA((tt) + 2, bn2);        \
        if ((tt) + 1 < nt) ATT_QK(N0, N1, bn); \
        s16x4 vlo_[NDB][4], vhh_[NDB][4]; \
        if (DV == 64) { const LAS unsigned char* vb_ = lds + OFF_V + bc * VBUF;     \
            _Pragma("unroll") for (int db = 0; db < NDB; ++db) _Pragma("unroll") for (int j = 0; j < 4; ++j) { vlo_[db][j] = tr_read(vb_ + vro[db] + j * VJ); vhh_[db][j] = tr_read(vb_ + vro[db] + j * VJ + VE); } } \
        __builtin_amdgcn_sched_barrier(0); \
        att_softmax<NDB>(C0, C1, o, mrun, lrun, first, pf); \
        if (DV == 64) { __builtin_amdgcn_sched_barrier(0); \
            _Pragma("unroll") for (int j = 0; j < 4; ++j) _Pragma("unroll") for (int db = 0; db < NDB; ++db) { \
                const bf16x8 vf_ = (bf16x8){vlo_[db][j][0], vlo_[db][j][1], vlo_[db][j][2], vlo_[db][j][3], vhh_[db][j][0], vhh_[db][j][1], vhh_[db][j][2], vhh_[db][j][3]}; \
                o[db] = __builtin_amdgcn_mfma_f32_32x32x16_bf16(vf_, pf[j], o[db], 0, 0, 0); } } \
        else { const LAS unsigned char* vb_ = lds + OFF_V + bc * VBUF; \
            _Pragma("unroll") for (int j = 0; j < 4; ++j) _Pragma("unroll") for (int db = 0; db < NDB; ++db) { \
                const s16x4 lo_ = tr_read(vb_ + vro[db] + j * VJ), hh_ = tr_read(vb_ + vro[db] + j * VJ + VE); \
                const bf16x8 vf_ = (bf16x8){lo_[0], lo_[1], lo_[2], lo_[3], hh_[0], hh_[1], hh_[2], hh_[3]}; \
                o[db] = __builtin_amdgcn_mfma_f32_32x32x16_bf16(vf_, pf[j], o[db], 0, 0, 0); } } \
        ATT_BAR(); \
        { const int t_ = bc; bc = bn; bn = bn2; bn2 = t_; } } while (0)
        ATT_QK(pA0, pA1, 0);
        int t = 0;
#pragma nounroll
        for (; t + 1 < nt; t += 2) {
            ATT_STEP(pA0, pA1, pB0, pB1, t);
            ATT_STEP(pB0, pB1, pA0, pA1, t + 1);
        }
        if (t < nt) ATT_STEP(pA0, pA1, pB0, pB1, t);
#undef ATT_STEP
#undef ATT_QK
#undef ATT_BAR
    } else {
#pragma nounroll
    for (int t = 0; t < nt; ++t) {
        const int cur = t & 1;
        if (t + 1 < nt) ATT_LOAD(t + 1);
        bool active = true;
        if (NA) { if (t < d.nlat) { const int krow = d.na_rowlo + t; active = (krow >= rs_) && (krow < rs_ + 8); } }
        if (active) {
            const LAS unsigned char* kb = lds + OFF_K + cur * KBUF + koffr;
            f32x16 p0, p1;
#pragma unroll
            for (int d0 = 0; d0 < NQF; ++d0) {
                const bf16x8 a0 = *(const LAS bf16x8*)(kb + d0 * 32), a1 = *(const LAS bf16x8*)(kb + 32 * KS + d0 * 32);
                if (d0 == 0) { p0 = __builtin_amdgcn_mfma_f32_32x32x16_bf16(a0, qf[0], (f32x16){}, 0, 0, 0); p1 = __builtin_amdgcn_mfma_f32_32x32x16_bf16(a1, qf[0], (f32x16){}, 0, 0, 0); }
                else { p0 = __builtin_amdgcn_mfma_f32_32x32x16_bf16(a0, qf[d0], p0, 0, 0, 0); p1 = __builtin_amdgcn_mfma_f32_32x32x16_bf16(a1, qf[d0], p1, 0, 0, 0); }
            }
            if (NA) { if (t < d.nlat) {
                const int roff = d.na_rowlo + t - gr + 7;
                const LAS float* bp = rpbL + roff * 31 + (4 * hi - qc + 15);
#pragma unroll
                for (int r = 0; r < 16; ++r) {
                    const int c0 = (r & 3) + 8 * (r >> 2);
                    const float b0 = bp[c0], b1 = bp[c0 + 32];
                    p0[r] = ((namask0 >> r) & 1u) ? p0[r] + b0 : -INFINITY;
                    p1[r] = ((namask1 >> r) & 1u) ? p1[r] + b1 : -INFINITY;
                }
            } }
            float ra = __builtin_fmaxf(__builtin_fmaxf(p0[0], p0[1]), p1[0]), rb = __builtin_fmaxf(__builtin_fmaxf(p0[2], p0[3]), p1[1]);
            ra = __builtin_fmaxf(__builtin_fmaxf(ra, p1[2]), p1[3]);
#pragma unroll
            for (int r = 4; r < 16; r += 4) { ra = __builtin_fmaxf(__builtin_fmaxf(ra, p0[r]), p0[r + 1]); rb = __builtin_fmaxf(__builtin_fmaxf(rb, p0[r + 2]), p0[r + 3]);
                ra = __builtin_fmaxf(__builtin_fmaxf(ra, p1[r]), p1[r + 1]); rb = __builtin_fmaxf(__builtin_fmaxf(rb, p1[r + 2]), p1[r + 3]); }
            float rm = __builtin_fmaxf(ra, rb);
            { auto rr = __builtin_amdgcn_permlane32_swap(__float_as_uint(rm), __float_as_uint(rm), false, false); rm = __builtin_fmaxf(__uint_as_float(rr[0]), __uint_as_float(rr[1])); }
            if (first || __any(rm > mrun + 8.f)) {
                const float mn = first ? rm : __builtin_fmaxf(mrun, rm);
                if (!first) { const float al = __builtin_amdgcn_exp2f(mrun - mn); lrun *= al;
#pragma unroll
                    for (int i = 0; i < NDB; ++i) o[i] *= al; }
                mrun = mn; first = false;
            }
            float ls = 0.f;
#pragma unroll
            for (int r = 0; r < 16; ++r) { p0[r] = __builtin_amdgcn_exp2f(p0[r] - mrun); p1[r] = __builtin_amdgcn_exp2f(p1[r] - mrun); ls += p0[r] + p1[r]; }
            lrun += ls;
            bf16x8 pf[4];
#pragma unroll
            for (int j = 0; j < 4; ++j) {
                u32x4 pw;
#pragma unroll
                for (int e = 0; e < 4; ++e) { const int r = 8 * (j & 1) + 2 * e; pw[e] = (j < 2) ? pk2(p0[r], p0[r + 1]) : pk2(p1[r], p1[r + 1]); }
                pf[j] = __builtin_bit_cast(bf16x8, pw);
            }
            const LAS unsigned char* vb = lds + OFF_V + cur * VBUF + voffr;
#pragma unroll
            for (int db = 0; db < NDB; ++db)
#pragma unroll
                for (int j = 0; j < 4; ++j) {
                    const s16x4 lo = tr_read(vb + (16 * j) * VS + db * 64), hh = tr_read(vb + (16 * j + 8) * VS + db * 64);
                    const bf16x8 vf = (bf16x8){lo[0], lo[1], lo[2], lo[3], hh[0], hh[1], hh[2], hh[3]};
                    o[db] = __builtin_amdgcn_mfma_f32_32x32x16_bf16(vf, pf[j], o[db], 0, 0, 0);
                }
        }
        if (t + 1 < nt) ATT_STORE(cur ^ 1);
        __syncthreads();
    }
    }
#undef ATT_TROW
#undef ATT_LOAD
#undef ATT_DMA
#undef ATT_STORE
    lrun += __shfl_xor(lrun, 32);
    const float inv = 1.f / lrun;
    const size_t orow = (size_t)(d.qrow0 + 32 * w + r32) * d.opitch;
    if (OMODE == 2) {
#pragma unroll
        for (int db = 0; db < NDB; ++db)
#pragma unroll
            for (int rg = 0; rg < 4; ++rg)
                *(u32x2*)(d.Ob + orow + 32 * db + 8 * rg + 4 * hi) = (u32x2){pk2(o[db][4 * rg] * inv, o[db][4 * rg + 1] * inv), pk2(o[db][4 * rg + 2] * inv, o[db][4 * rg + 3] * inv)};
    } else if (OMODE == 3) {
        float ss = 0.f;
#pragma unroll
        for (int db = 0; db < NDB; ++db)
#pragma unroll
            for (int rg = 0; rg < 4; ++rg) {
                const u32x2 st = *(const u32x2*)(d.Ob + orow + 32 * db + 8 * rg + 4 * hi);
                const float a1 = __uint_as_float(st[0] << 16), b1 = __uint_as_float(st[0] & 0xffff0000u), c1 = __uint_as_float(st[1] << 16), e1 = __uint_as_float(st[1] & 0xffff0000u);
                const float li = d.lam * inv;
                const float a = a1 - li * o[db][4 * rg], b = b1 - li * o[db][4 * rg + 1], c = c1 - li * o[db][4 * rg + 2], e = e1 - li * o[db][4 * rg + 3];
                o[db][4 * rg] = a; o[db][4 * rg + 1] = b; o[db][4 * rg + 2] = c; o[db][4 * rg + 3] = e;
                ss += (a * a + b * b) + (c * c + e * e);
            }
        ss += __shfl_xor(ss, 32);
        const float rs = (1.f - LAMBDA_INIT) / sqrtf(ss * (1.f / 128.f) + 1e-6f);
#pragma unroll
        for (int db = 0; db < NDB; ++db)
#pragma unroll
            for (int rg = 0; rg < 4; ++rg) {
                const int dc = 32 * db + 8 * rg + 4 * hi;
                const f32x4 g = *(const f32x4*)(d.subg + dc);
                *(u32x2*)(d.Ob + orow + dc) = (u32x2){pk2(o[db][4 * rg] * rs * g[0], o[db][4 * rg + 1] * rs * g[1]), pk2(o[db][4 * rg + 2] * rs * g[2], o[db][4 * rg + 3] * rs * g[3])};
            }
    } else {
#pragma unroll
        for (int db = 0; db < NDB; ++db)
#pragma unroll
            for (int rg = 0; rg < 4; ++rg) {
                const int dc = 32 * db + 8 * rg + 4 * hi;
                const float a = o[db][4 * rg] * inv, b = o[db][4 * rg + 1] * inv, c = o[db][4 * rg + 2] * inv, e = o[db][4 * rg + 3] * inv;
                if (OMODE == 1) *(f32x4*)(d.Of + orow + dc) = (f32x4){a, b, c, e};
                else *(u32x2*)(d.Ob + orow + dc) = (u32x2){pk2(a, b), pk2(c, e)};
            }
    }
}


__device__ __forceinline__ void attn_unit_mla2(const AttnDesc d, LAS unsigned char* lds) {
    constexpr int NQF = 6, NDB = 2, KBUF = 12288, VBUF = 8192, OFF_K = 0, OFF_V = 3 * KBUF, VJ = 2048, VE = 1024;
    int tid = threadIdx.x; asm volatile("" : "+v"(tid));
    const int lane = tid & 63, w = __builtin_amdgcn_readfirstlane(tid >> 6), r32 = lane & 31, hi = lane >> 5;
    bf16x8 qf[2][NQF];
#pragma unroll
    for (int qb = 0; qb < 2; ++qb) { const bf16_t* qp = d.Q + (size_t)(d.qrow0 + 64 * w + 32 * qb + r32) * d.qpitch + 8 * hi;
#pragma unroll
        for (int d0 = 0; d0 < NQF; ++d0) qf[qb][d0] = *(const bf16x8*)(qp + 16 * d0); }
    const unsigned ldsb = (unsigned)(uintptr_t)lds;
    int gko, gk2o, gvo0;
    { const int kr = 8 * w + (lane >> 3), kc = (lane & 7) ^ ((kr >> 1) & 7); gko = kr * d.kpitch + kc * 8;
      const int rr = 16 * (w & 3) + (lane >> 2), rc = (lane & 3) ^ ((rr >> 2) & 3); gk2o = rr * d.k2pitch + rc * 8;
      const int sr = 4 * w + (lane >> 4), pos = lane & 15, sp = pos >> 2, sub = pos & 3, x = (sp - sr) & 3;
      gvo0 = (2 * sr + (x >> 1)) * d.vpitch + (x & 1) * 32 + sub * 8; }
#define M2_TROW(i) ((i) < d.nlat ? d.lat_row0 + 64 * (i) : d.ctx_row0 + 64 * ((i) - d.nlat))
#define M2_DMA(i, slot) do { const int tr_ = M2_TROW(i); \
        glds16(d.K + ((size_t)tr_ * d.kpitch + gko), (unsigned)__builtin_amdgcn_readfirstlane(ldsb + OFF_K + (slot) * KBUF + w * 1024)); \
        if (w < 4) glds16(d.K2 + ((size_t)tr_ * d.k2pitch + gk2o), (unsigned)__builtin_amdgcn_readfirstlane(ldsb + OFF_K + (slot) * KBUF + 8192 + w * 1024)); \
        glds16(d.V + ((size_t)tr_ * d.vpitch + gvo0), (unsigned)__builtin_amdgcn_readfirstlane(ldsb + OFF_V + (slot) * VBUF + w * 1024)); } while (0)
    const int nt = d.ntiles;
    M2_DMA(0, 0); if (nt > 1) M2_DMA(1, 1);
    asm volatile("s_waitcnt vmcnt(0)" ::: "memory");
    __syncthreads();
    int kro[NQF], vro[NDB];
    { const int q_ = (lane & 15) >> 2, gi_ = (lane >> 4) & 1, p_ = lane & 3;
#pragma unroll
      for (int d0 = 0; d0 < NQF; ++d0) kro[d0] = d0 < 4 ? r32 * 128 + (((2 * d0 + hi) ^ ((r32 >> 1) & 7)) << 4) : 8192 + r32 * 64 + (((2 * (d0 - 4) + hi) ^ ((r32 >> 2) & 3)) << 4);
#pragma unroll
      for (int db = 0; db < NDB; ++db) vro[db] = (2 * hi + (q_ >> 1)) * 256 + (((2 * (q_ & 1) + db + 2 * hi + (q_ >> 1)) & 3) << 6) + 32 * gi_ + 8 * p_; }
    f32x16 o0[NDB], o1[NDB];
#pragma unroll
    for (int i = 0; i < NDB; ++i) { o0[i] = (f32x16){}; o1[i] = (f32x16){}; }
    float m0 = 0.f, l0 = 0.f, m1 = 0.f, l1 = 0.f; bool f0 = true, f1 = true;
    int bc = 0, bn2 = 2;
#pragma nounroll
    for (int t = 0; t < nt; ++t) {
        if (t + 2 < nt) M2_DMA(t + 2, bn2);
        const LAS unsigned char* kb_ = lds + OFF_K + bc * KBUF;
        bf16x8 ka_[NQF], kc_[NQF];
#pragma unroll
        for (int d0 = 0; d0 < NQF; ++d0) { ka_[d0] = *(const LAS bf16x8*)(kb_ + kro[d0]); kc_[d0] = *(const LAS bf16x8*)(kb_ + kro[d0] + (d0 < 4 ? 4096 : 2048)); }
        __builtin_amdgcn_sched_barrier(0);
        f32x16 pa0, pa1, pb0, pb1;
#pragma unroll
        for (int d0 = 0; d0 < NQF; ++d0) {
            if (d0 == 0) { pa0 = __builtin_amdgcn_mfma_f32_32x32x16_bf16(ka_[0], qf[0][0], (f32x16){}, 0, 0, 0); pa1 = __builtin_amdgcn_mfma_f32_32x32x16_bf16(kc_[0], qf[0][0], (f32x16){}, 0, 0, 0);
                           pb0 = __builtin_amdgcn_mfma_f32_32x32x16_bf16(ka_[0], qf[1][0], (f32x16){}, 0, 0, 0); pb1 = __builtin_amdgcn_mfma_f32_32x32x16_bf16(kc_[0], qf[1][0], (f32x16){}, 0, 0, 0); }
            else { pa0 = __builtin_amdgcn_mfma_f32_32x32x16_bf16(ka_[d0], qf[0][d0], pa0, 0, 0, 0); pa1 = __builtin_amdgcn_mfma_f32_32x32x16_bf16(kc_[d0], qf[0][d0], pa1, 0, 0, 0);
                   pb0 = __builtin_amdgcn_mfma_f32_32x32x16_bf16(ka_[d0], qf[1][d0], pb0, 0, 0, 0); pb1 = __builtin_amdgcn_mfma_f32_32x32x16_bf16(kc_[d0], qf[1][d0], pb1, 0, 0, 0); }
        }
        s16x4 vlo_[NDB][4], vhh_[NDB][4];
        { const LAS unsigned char* vb_ = lds + OFF_V + bc * VBUF;
#pragma unroll
          for (int db = 0; db < NDB; ++db)
#pragma unroll
            for (int j = 0; j < 4; ++j) { vlo_[db][j] = tr_read(vb_ + vro[db] + j * VJ); vhh_[db][j] = tr_read(vb_ + vro[db] + j * VJ + VE); } }
        bf16x8 pf0[4], pf1[4];
        att_softmax<NDB>(pa0, pa1, o0, m0, l0, f0, pf0);
        att_softmax<NDB>(pb0, pb1, o1, m1, l1, f1, pf1);
#pragma unroll
        for (int j = 0; j < 4; ++j)
#pragma unroll
            for (int db = 0; db < NDB; ++db) {
                const bf16x8 vf_ = (bf16x8){vlo_[db][j][0], vlo_[db][j][1], vlo_[db][j][2], vlo_[db][j][3], vhh_[db][j][0], vhh_[db][j][1], vhh_[db][j][2], vhh_[db][j][3]};
                o0[db] = __builtin_amdgcn_mfma_f32_32x32x16_bf16(vf_, pf0[j], o0[db], 0, 0, 0);
                o1[db] = __builtin_amdgcn_mfma_f32_32x32x16_bf16(vf_, pf1[j], o1[db], 0, 0, 0);
            }
        asm volatile("s_waitcnt vmcnt(0) lgkmcnt(0)\n\ts_barrier" ::: "memory");
        bc = bc == 2 ? 0 : bc + 1; bn2 = bn2 == 2 ? 0 : bn2 + 1;
    }
#undef M2_DMA
#undef M2_TROW
    l0 += __shfl_xor(l0, 32); l1 += __shfl_xor(l1, 32);
    const float inv0 = 1.f / l0, inv1 = 1.f / l1;
#pragma unroll
    for (int qb = 0; qb < 2; ++qb) {
        const size_t orow = (size_t)(d.qrow0 + 64 * w + 32 * qb + r32) * d.opitch; const float inv = qb ? inv1 : inv0;
#pragma unroll
        for (int db = 0; db < NDB; ++db)
#pragma unroll
            for (int rg = 0; rg < 4; ++rg) { const int dc = 32 * db + 8 * rg + 4 * hi;
                const f32x16& oo = qb ? o1[db] : o0[db];
                *(u32x2*)(d.Ob + orow + dc) = (u32x2){pk2(oo[4 * rg] * inv, oo[4 * rg + 1] * inv), pk2(oo[4 * rg + 2] * inv, oo[4 * rg + 3] * inv)}; }
    }
}

__device__ __forceinline__ void p0_item(const float* W, int K, int N, bf16_t* WT, int mode, const float* ksc, LAS float* scr, int item, int lane) {
    const int nblk = N / 32, kb = item / nblk, nb = item % nblk, k0 = 64 * kb, n0 = 32 * nb;
#pragma unroll 8
    for (int i = 0; i < 32; ++i) { const int kk = 2 * i + (lane >> 5); float v = W[(size_t)(k0 + kk) * N + n0 + (lane & 31)]; if (ksc) v *= ksc[k0 + kk]; scr[kk * 33 + (lane & 31)] = v; }
    asm volatile("s_waitcnt lgkmcnt(0)" ::: "memory");
    int nd0 = n0;
    if (mode == 1) { nd0 = (n0 < FH) ? (n0 / 128) * 256 + (n0 % 128) : ((n0 - FH) / 128) * 256 + 128 + ((n0 - FH) % 128); }
    else if (mode == 2) { nd0 = (n0 < 672) ? n0 : n0 + 96; }
    const int c = lane & 7;
#pragma unroll
    for (int j = 0; j < 4; ++j) { const int n = (lane >> 3) + 8 * j; const LAS float* s = scr + (8 * c) * 33 + n;
        u32x4 o; o.x = pk2(s[0 * 33], s[1 * 33]); o.y = pk2(s[2 * 33], s[3 * 33]); o.z = pk2(s[4 * 33], s[5 * 33]); o.w = pk2(s[6 * 33], s[7 * 33]);
        *(u32x4*)(WT + (size_t)(nd0 + n) * K + k0 + 8 * c) = o; }
    asm volatile("s_waitcnt lgkmcnt(0)" ::: "memory");
}
__device__ __forceinline__ void sincos_small(float af, float& s, float& c) {
    const double a = (double)af; const double k = rint(a * 0.6366197723675814); const double r = a - k * 1.5707963267948966;
    const double r2 = r * r;
    const double sp = r * (1.0 + r2 * (-1.0 / 6 + r2 * (1.0 / 120 + r2 * (-1.0 / 5040 + r2 * (1.0 / 362880 + r2 * (-1.0 / 39916800 + r2 * (1.0 / 6227020800.0)))))));
    const double cp = 1.0 + r2 * (-0.5 + r2 * (1.0 / 24 + r2 * (-1.0 / 720 + r2 * (1.0 / 40320 + r2 * (-1.0 / 3628800 + r2 * (1.0 / 479001600.0))))));
    const int q = ((int)k) & 3;
    const double ss = (q == 0) ? sp : (q == 1) ? cp : (q == 2) ? -sp : -cp;
    const double cc = (q == 0) ? cp : (q == 1) ? -sp : (q == 2) ? -cp : sp;
    s = (float)ss; c = (float)cc;
}

#define XB_TMO      128
#define XB_XCNT(j)  (256  + 64 * (j))
#define XB_XSUB(j)  (1280 + 64 * (j))
#define XB_XGEN(j)  (2304 + 64 * (j))
#define XB_TOP      3328
#define XB_TOPGEN   3392
#define XCD_BAR_WORDS 3456
#define XB_SPIN_CAP (1u << 18)

__device__ __forceinline__ unsigned xb_ld(unsigned* p)              { return __hip_atomic_load(p, __ATOMIC_RELAXED, __HIP_MEMORY_SCOPE_AGENT); }
__device__ __forceinline__ unsigned xb_add(unsigned* p, unsigned v) { return __hip_atomic_fetch_add(p, v, __ATOMIC_RELAXED, __HIP_MEMORY_SCOPE_AGENT); }
__device__ __forceinline__ unsigned xb_xcc_id() { return (unsigned)__builtin_amdgcn_s_getreg((3 << 11) | 20) & 0xFu; }
#define XB_SPIN(cond, bar) do { unsigned _sp = 0; while (cond) { __builtin_amdgcn_s_sleep(1); \
    if ((++_sp & 255u) == 0u) { if (xb_ld(&(bar)[XB_TMO])) break; if (_sp > XB_SPIN_CAP) { atomicAdd(&(bar)[XB_TMO], 1u); break; } } } } while (0)

struct XcdBarrier {
    unsigned* bar; unsigned x;
    volatile LAS unsigned* st;
};

__device__ __forceinline__ XcdBarrier xcd_barrier_post(unsigned* bar, volatile LAS unsigned* st) {
    XcdBarrier b; b.bar = bar; b.x = xb_xcc_id(); b.st = st;
    if (threadIdx.x == 0) (void)xb_add(&bar[XB_XCNT(b.x)], 1u);
    return b;
}
__device__ __forceinline__ void xcd_barrier_complete(unsigned* bar, unsigned x, unsigned& nloc, unsigned& nx) {
    const unsigned G = gridDim.x * gridDim.y * gridDim.z;
    unsigned sum, cnt, mine, sp = 0u;
    for (;;) {
        sum = 0u; cnt = 0u; mine = 0u;
#pragma unroll
        for (unsigned j = 0; j < 16; ++j) { const unsigned c = xb_ld(&bar[XB_XCNT(j)]); sum += c; cnt += (c > 0u) ? 1u : 0u; mine = (j == x) ? c : mine; }
        if (sum == G) break;
        __builtin_amdgcn_s_sleep(1);
        if ((++sp & 255u) == 0u) { if (xb_ld(&bar[XB_TMO])) break; if (sp > XB_SPIN_CAP) { atomicAdd(&bar[XB_TMO], 1u); break; } }
    }
    nloc = mine > 0u ? mine : 1u; nx = cnt > 0u ? cnt : 1u;
}

__device__ __forceinline__ void xcd_barrier(const XcdBarrier& b) {
    asm volatile("s_waitcnt vmcnt(0)" ::: "memory");
    __syncthreads();
    if (threadIdx.x == 0) {
        unsigned* bar = b.bar;
        __builtin_amdgcn_s_waitcnt(0);
        unsigned nloc = b.st[0], nx = b.st[1];
        if (nloc == 0u) { xcd_barrier_complete(bar, b.x, nloc, nx); b.st[0] = nloc; b.st[1] = nx; }
        const unsigned old = xb_add(&bar[XB_XSUB(b.x)], 1u);
        const unsigned gen = old / nloc;
        if (old + 1u == (gen + 1u) * nloc) {
            __builtin_amdgcn_fence(__ATOMIC_RELEASE, "agent");
            asm volatile("s_waitcnt vmcnt(0)" ::: "memory");
            const unsigned og = xb_add(&bar[XB_TOP], 1u);
            const unsigned tg = og / nx;
            if (og + 1u == (tg + 1u) * nx) xb_add(&bar[XB_TOPGEN], 1u);
            else XB_SPIN(xb_ld(&bar[XB_TOPGEN]) == tg, bar);
            __builtin_amdgcn_fence(__ATOMIC_ACQUIRE, "agent");
            xb_add(&bar[XB_XGEN(b.x)], 1u);
            asm volatile("s_waitcnt vmcnt(0)" ::: "memory");
        } else {
            XB_SPIN(xb_ld(&bar[XB_XGEN(b.x)]) == gen, bar);
            __builtin_amdgcn_fence(__ATOMIC_ACQUIRE, "agent");
            asm volatile("s_waitcnt vmcnt(0)" ::: "memory");
        }
    }
    __syncthreads();
}

struct Params {
    const float *x, *c, *ctx, *c_ctx, *mod_w, *mod_b, *ln_mix_g, *ln_mix_b, *ln_ffn_g, *ln_ffn_b, *ffn_w_in, *ffn_w_out, *ev_w_in, *ev_w_out,
        *diff_lambda, *diff_subln_g, *na_rpb, *od_w_in, *od_w_out, *mla_q_norm_g, *mla_w_uq, *mla_kv_norm_g, *mla_w_ukv, *gmlp_ln_g, *gmlp_ln_b, *gmlp_ws, *gmlp_b;
    float* out; unsigned char* ws; int lo, hi;
};

__device__ __forceinline__ void ln_rows(float* Z, float* dst, const float* g, const float* b, bf16_t* U, const float* modl, int kmod, int nrows, int gw, int ngw, int lane) {
    for (int row = gw; row < nrows; row += ngw) {
        const f32x4* zr = (const f32x4*)(Z + (size_t)row * DM) + lane;
        f32x4 v[4]; float s = 0.f;
#pragma unroll
        for (int j = 0; j < 4; ++j) { v[j] = zr[64 * j]; s += (v[j][0] + v[j][1]) + (v[j][2] + v[j][3]); }
        const float mean = wave_sum(s) * (1.f / DM); float s2 = 0.f;
#pragma unroll
        for (int j = 0; j < 4; ++j) { v[j] = v[j] - mean; s2 += (v[j][0] * v[j][0] + v[j][1] * v[j][1]) + (v[j][2] * v[j][2] + v[j][3] * v[j][3]); }
        const float rstd = 1.f / sqrtf(wave_sum(s2) * (1.f / DM) + 1e-5f);
        const int set = row < 8192 ? 0 : (row < ML ? 1 : 2);
        const float* mp = modl ? modl + set * 6144 + kmod * 1024 : nullptr;
#pragma unroll
        for (int j = 0; j < 4; ++j) {
            const int col = 256 * j + 4 * lane;
            const f32x4 gg = *(const f32x4*)(g + col), bb = *(const f32x4*)(b + col);
            const f32x4 h = v[j] * rstd * gg + bb;
            *(f32x4*)(dst + (size_t)row * DM + col) = h;
            if (U) { const f32x4 sh = *(const f32x4*)(mp + col), sc = *(const f32x4*)(mp + 1024 + col);
                const f32x4 uu = h * (sc + 1.f) + sh;
                *(u32x2*)(U + (size_t)row * DM + col) = (u32x2){pk2(uu[0], uu[1]), pk2(uu[2], uu[3])}; }
        }
    }
}

typedef const __attribute__((address_space(4))) Params* kparams_t;
__device__ __forceinline__ kparams_t kparams() { kparams_t q = (kparams_t)__builtin_amdgcn_kernarg_segment_ptr(); asm volatile("" : "+s"(q)); return q; }
constexpr int NPHASE = 18;
constexpr int LDS_BYTES = 147456;

__global__ void __launch_bounds__(512) dit_fwd(Params p) {
    extern __shared__ __attribute__((aligned(16))) unsigned char lds_raw[];
    LAS unsigned char* lds = (LAS unsigned char*)lds_raw;
    const int G = gridDim.x, blk = blockIdx.x;
    const int tid = threadIdx.x, lane = tid & 63, wave = __builtin_amdgcn_readfirstlane(tid >> 6);
    const int gw = blk * 8 + wave, ngw = G * 8;
    const int gtid = blk * 512 + tid, ngt = G * 512;
#define Wevin ((bf16_t*)(ws + O_EVIN))
#define Wevout ((bf16_t*)(ws + O_EVOUT))
#define Wffin0 ((bf16_t*)(ws + O_FFIN0))
#define Wffout0 ((bf16_t*)(ws + O_FFOUT0))
#define Wffin1 ((bf16_t*)(ws + O_FFIN1))
#define Wffout1 ((bf16_t*)(ws + O_FFOUT1))
#define Wodin ((bf16_t*)(ws + O_ODIN))
#define Wodout ((bf16_t*)(ws + O_ODOUT))
#define Wuq ((bf16_t*)(ws + O_UQ))
#define Wukv ((bf16_t*)(ws + O_UKV))
#define Gws ((bf16_t*)(ws + O_GWS))
#define mod ((float*)(ws + O_MOD))
#define tab32 ((float*)(ws + O_TAB32))
#define tab16 ((float*)(ws + O_TAB16))
#define P ((bf16_t*)(ws + O_P))
#define H ((float*)(ws + O_H))
#define Hb ((bf16_t*)(ws + O_H))
#define U ((bf16_t*)(ws + O_U))
#define Odiff ((float*)(ws + O_ODIFF))
#define AMIX0 ((bf16_t*)(ws + O_AMIX0))
#define ACT ((bf16_t*)(ws + O_ACT))
#define P1 ((bf16_t*)(ws + O_P1))
#define AMIX1 ((bf16_t*)(ws + O_AMIX1))
#define stats ((float*)(ws + O_STATS))
#define KV1 ((bf16_t*)(ws + O_KV1))
#define Q1 ((bf16_t*)(ws + O_Q1))
#define PHASE_BEGIN kparams_t q = kparams(); unsigned char* ws = q->ws;
    const int lo = p.lo, hi = p.hi;
    volatile LAS unsigned* xst = (volatile LAS unsigned*)(lds + 131072 + 64);
    if (tid < 2) xst[tid] = 0u;
    __syncthreads();
    XcdBarrier xbar = xcd_barrier_post((unsigned*)(p.ws + O_BAR), xst);
    if (p.hi > 1000) cg::this_grid().sync();
#ifndef PH_MASK
#define PH_MASK 0x3ffff
#endif
#define IN(k) ((((PH_MASK) >> (k)) & 1) && lo <= (k) && (k) < hi)
#define SEAM(k) do { if (hi - lo > 1) xcd_barrier(xbar); } while (0)

    if (IN(0)) { PHASE_BEGIN
        if (blk < 96) {
            LAS float* sl = (LAS float*)lds;
            for (int i = tid; i < 3072; i += 512) { const int set = i >> 10, k = i & 1023; const float cv = set == 0 ? q->c[k] : (set == 1 ? q->c[1024 + k] : q->c_ctx[k]); sl[i] = cv / (1.f + __expf(-cv)); }
            __syncthreads();
            const int layer = blk / 48, chunk = blk % 48;
            const float* W = q->mod_w + (size_t)layer * 1024 * 6144 + chunk * 128 + 2 * lane;
            float a00 = 0.f, a01 = 0.f, a10 = 0.f, a11 = 0.f, a20 = 0.f, a21 = 0.f;
#pragma unroll 16
            for (int k = 128 * wave; k < 128 * wave + 128; ++k) { const f32x2v wv = *(const f32x2v*)(W + (size_t)k * 6144);
                const float s0 = sl[k], s1 = sl[1024 + k], s2 = sl[2048 + k];
                a00 += s0 * wv[0]; a01 += s0 * wv[1]; a10 += s1 * wv[0]; a11 += s1 * wv[1]; a20 += s2 * wv[0]; a21 += s2 * wv[1]; }
            LAS float* red = sl + 3072;
            red[(wave * 3 + 0) * 128 + 2 * lane] = a00; red[(wave * 3 + 0) * 128 + 2 * lane + 1] = a01;
            red[(wave * 3 + 1) * 128 + 2 * lane] = a10; red[(wave * 3 + 1) * 128 + 2 * lane + 1] = a11;
            red[(wave * 3 + 2) * 128 + 2 * lane] = a20; red[(wave * 3 + 2) * 128 + 2 * lane + 1] = a21;
            __syncthreads();
            if (tid < 384) { const int s = tid >> 7, n = tid & 127; float acc = q->mod_b[layer * 6144 + chunk * 128 + n];
#pragma unroll
                for (int w8 = 0; w8 < 8; ++w8) acc += red[(w8 * 3 + s) * 128 + n];
                mod[(layer * 3 + s) * 6144 + chunk * 128 + n] = acc; }
            __syncthreads();
        } else if (blk == 96) {
            for (int i = tid; i < 3072; i += 512) {
                if (i < 2048) { const int pos = i >> 4, f = i & 15; const float inv = exp2f(-(float)f * (13.287712379549449f / 16.f)); float s, c; sincos_small((float)pos * inv, s, c); tab32[2 * i] = c; tab32[2 * i + 1] = s; }
                else { const int j = i - 2048, pos = j >> 3, f = j & 7; const float inv = exp2f(-(float)f * (13.287712379549449f / 8.f)); float s, c; sincos_small((float)pos * inv, s, c); tab16[2 * j] = c; tab16[2 * j + 1] = s; }
            }
        }
        {
            LAS float* scr = (LAS float*)(lds + wave * 16384);
            constexpr int I0 = 16 * 96, I1 = 16 * 32, I2 = 16 * 176, I3 = 44 * 32, I4 = 16 * 53, I5 = 16 * 32, I6 = 6 * 24, I7 = 4 * 32;
            for (int it = gw; it < I0; it += ngw) p0_item(q->ev_w_in, 1024, 3072, Wevin, 0, nullptr, scr, it, lane);
            for (int i = gtid; i < 65536; i += ngt) Gws[i] = (bf16_t)f2bf(q->gmlp_ws[i]);
            for (int i = gtid; i < 96 * 1024 / 2; i += ngt) ((unsigned*)(Wodin + (size_t)672 * 1024))[i] = 0u;
        }
    }
    SEAM(0);
    if (IN(1)) { PHASE_BEGIN
        for (int idx = gtid; idx < MT * 128; idx += ngt) {
            const int row = idx >> 7, c8 = (idx & 127) * 8;
            const float* src = row < ML ? q->x + (size_t)row * DM : q->ctx + (size_t)(row - ML) * DM;
            const int set = row < 8192 ? 0 : (row < ML ? 1 : 2);
            const float* mp = mod + set * 6144;
            const f32x4 v0 = *(const f32x4*)(src + c8), v1 = *(const f32x4*)(src + c8 + 4);
            const f32x4 sh0 = *(const f32x4*)(mp + c8), sh1 = *(const f32x4*)(mp + c8 + 4), sc0 = *(const f32x4*)(mp + 1024 + c8), sc1 = *(const f32x4*)(mp + 1024 + c8 + 4);
            const f32x4 u0 = v0 * (sc0 + 1.f) + sh0, u1 = v1 * (sc1 + 1.f) + sh1;
            *(u32x4*)(U + (size_t)row * DM + c8) = (u32x4){pk2(u0[0], u0[1]), pk2(u0[2], u0[3]), pk2(u1[0], u1[1]), pk2(u1[2], u1[3])};
        }
    }
    SEAM(1);
    if (IN(2)) { PHASE_BEGIN
        pg8::Gemm g{U, Wevin, MT, PW0, 1024, 1024, 1024}; pg8::StaticOrder S; S.init(MT, PW0, G, blk);
        EpiIn0 E{P, tab32};
        pg8::gemm_phase<EpiIn0, pg8::StaticOrder, true, true>(lds, g, S, E);
        if (blk >= 24) {
            LAS float* scr = (LAS float*)(lds + wave * 16384);
            constexpr int I1 = 16 * 32, I2 = 16 * 176, I3 = 44 * 32, I4 = 16 * 53, I5 = 16 * 32, I6 = 6 * 24, I7 = 4 * 32;
            constexpr int NIT = I1 + 2 * I2 + 2 * I3 + I4 + I5 + I6 + I7;
            for (int it = (blk - 24) * 8 + wave; it < NIT; it += (G - 24) * 8) {
                int r = it;
                if (r < I1) { p0_item(q->ev_w_out, 1024, 1024, Wevout, 0, nullptr, scr, r, lane); continue; } r -= I1;
                if (r < I2) { p0_item(q->ffn_w_in, 1024, 5632, Wffin0, 1, nullptr, scr, r, lane); continue; } r -= I2;
                if (r < I2) { p0_item(q->ffn_w_in + (size_t)1024 * 5632, 1024, 5632, Wffin1, 1, nullptr, scr, r, lane); continue; } r -= I2;
                if (r < I3) { p0_item(q->ffn_w_out, 2816, 1024, Wffout0, 0, nullptr, scr, r, lane); continue; } r -= I3;
                if (r < I3) { p0_item(q->ffn_w_out + (size_t)2816 * 1024, 2816, 1024, Wffout1, 0, nullptr, scr, r, lane); continue; } r -= I3;
                if (r < I4) { p0_item(q->od_w_in, 1024, 1696, Wodin, 2, nullptr, scr, r, lane); continue; } r -= I4;
                if (r < I5) { p0_item(q->od_w_out, 1024, 1024, Wodout, 0, nullptr, scr, r, lane); continue; } r -= I5;
                if (r < I6) { p0_item(q->mla_w_uq, 384, 768, Wuq, 0, q->mla_q_norm_g, scr, r, lane); continue; } r -= I6;
                p0_item(q->mla_w_ukv, 256, 1024, Wukv, 0, q->mla_kv_norm_g, scr, r, lane);
            }
        }
    }
    SEAM(2);
    if (IN(3)) { PHASE_BEGIN
        const int xcd = blk & 7, idx = blk >> 3;
        float lam;
        { const float a = q->diff_lambda[lane] * q->diff_lambda[64 + lane], b2 = q->diff_lambda[128 + lane] * q->diff_lambda[192 + lane];
          lam = __expf(wave_sum(a)) - __expf(wave_sum(b2)) + LAMBDA_INIT; }
        {
            const int b = xcd >> 2, h = xcd & 3, qb = idx;
            AttnDesc d{};
            d.qpitch = PW0; d.kpitch = PW0; d.vpitch = PW0; d.V = P + 1024 + h * 128;
            d.Ob = AMIX0 + h * 128; d.opitch = 1024; d.lam = lam; d.subg = q->diff_subln_g;
            d.qrow0 = b * SEQ_ + qb * 256; d.ntiles = 132; d.nlat = 128; d.lat_row0 = b * SEQ_; d.ctx_row0 = ML + b * 256;
            d.Q = P + h * 128; d.K = P + 512 + h * 128;
            attn_unit<64, 128, false, 2>(d, lds);
            d.Q = P + h * 128 + 64; d.K = P + 512 + h * 128 + 64;
            attn_unit<64, 128, false, 3>(d, lds);
        }
        for (int i = 0; i < 2; ++i) {
            const int combo = i * 8 + xcd, rb = idx;
            if (idx >= 32) break;
            const int b = combo >> 3, h = combo & 7;
            int rowlo = 4 * rb - 4; rowlo = rowlo < 0 ? 0 : (rowlo > 120 ? 120 : rowlo);
            int nrt = 128 - rowlo; nrt = nrt > 11 ? 11 : nrt;
            AttnDesc d{};
            d.Q = P + 1536 + h * 64; d.qpitch = PW0; d.K = P + 2048 + h * 64; d.kpitch = PW0; d.V = P + 2560 + h * 64; d.vpitch = PW0;
            d.Of = nullptr; d.Ob = AMIX0 + 512 + h * 64; d.opitch = 1024;
            d.qrow0 = b * SEQ_ + rb * 256; d.ntiles = nrt + 4; d.nlat = nrt; d.lat_row0 = b * SEQ_ + rowlo * 64; d.ctx_row0 = ML + b * 256;
            d.na_rowlo = rowlo; d.na_gr0 = 4 * rb; d.rpb = q->na_rpb + h * 465;
            attn_unit<64, 64, true, 0>(d, lds);
        }
        if (blk < 8) {
            const int b = blk >> 2, h = blk & 3;
            AttnDesc d{};
            d.qpitch = PW0; d.kpitch = PW0; d.vpitch = PW0; d.V = P + 1024 + h * 128;
            d.Ob = AMIX0 + h * 128; d.opitch = 1024; d.lam = lam; d.subg = q->diff_subln_g;
            d.qrow0 = ML + b * 256; d.ntiles = 4; d.nlat = 0; d.lat_row0 = 0; d.ctx_row0 = ML + b * 256;
            d.Q = P + h * 128; d.K = P + 512 + h * 128;
            attn_unit<64, 128, false, 2>(d, lds);
            d.Q = P + h * 128 + 64; d.K = P + 512 + h * 128 + 64;
            attn_unit<64, 128, false, 3>(d, lds);
        } else if (blk >= 16 && blk < 32) {
            const int b = (blk - 16) >> 3, h = (blk - 16) & 7;
            AttnDesc d{};
            d.Q = P + 1536 + h * 64; d.qpitch = PW0; d.K = P + 2048 + h * 64; d.kpitch = PW0; d.V = P + 2560 + h * 64; d.vpitch = PW0;
            d.Ob = AMIX0 + 512 + h * 64; d.opitch = 1024;
            d.qrow0 = ML + b * 256; d.ntiles = 4; d.nlat = 0; d.lat_row0 = 0; d.ctx_row0 = ML + b * 256;
            attn_unit<64, 64, false, 0>(d, lds);
        }
    }
    SEAM(3);
    if (IN(5)) { PHASE_BEGIN
        { pg8::Gemm g{AMIX0, Wevout, ML, 1024, 1024, 1024, 1024}; PanelOrder S; S.init(ML, blk);
          EpiResLN<false, true> E{q->x, q->ctx, mod + 2 * 1024, (unsigned*)(ws + O_CNT), (unsigned long long*)(ws + O_SLOT0), q->ln_mix_g, q->ln_mix_b, H, U, mod, 3, nullptr, nullptr, 0};
          pg8::gemm_phase<EpiResLN<false, true>, PanelOrder, true, true>(lds, g, S, E); }
        { const int part = blk & 3, k0 = part * 256;
          pg8::Gemm g{AMIX0 + k0, Wevout + k0, MT, 1024, 256, 1024, 1024}; TailOrder S{blk};
          EpiResLN<false, true> E{q->x, q->ctx, mod + 2 * 1024, (unsigned*)(ws + O_CNT), (unsigned long long*)(ws + O_SLOT0), q->ln_mix_g, q->ln_mix_b, H, U, mod, 3, (float*)(ws + O_P), (unsigned*)(ws + O_PCNT), part};
          pg8::gemm_phase<EpiResLN<false, true>, TailOrder, true, true>(lds, g, S, E); }
    }
    SEAM(5);
    if (IN(7)) { PHASE_BEGIN
        pg8::Gemm g{U, Wffin0, MT, 5632, 1024, 1024, 1024}; pg8::StaticOrder S; S.init(MT, 5632, G, blk);
        EpiFfn E{ACT};
        pg8::gemm_phase<EpiFfn, pg8::StaticOrder, true, true>(lds, g, S, E);
    }
    SEAM(7);
    if (IN(8)) { PHASE_BEGIN
        { pg8::Gemm g{ACT, Wffout0, ML, 1024, FH, FH, FH}; PanelOrder S; S.init(ML, blk);
          EpiResLN<true, true> E{Hb, Hb + (size_t)ML * DM, mod + 5 * 1024, (unsigned*)(ws + O_CNT) + 66 * 64, (unsigned long long*)(ws + O_SLOT1), q->ln_ffn_g, q->ln_ffn_b, Hb, U, mod + 3 * 6144, 0, nullptr, nullptr, 0};
          pg8::gemm_phase<EpiResLN<true, true>, PanelOrder, true, true>(lds, g, S, E); }
        { const int part = blk & 3, k0 = part < 2 ? part * 768 : 1536 + (part - 2) * 640, kl = part < 2 ? 768 : 640;
          pg8::Gemm g{ACT + k0, Wffout0 + k0, MT, 1024, kl, FH, FH}; TailOrder S{blk};
          EpiResLN<true, true> E{Hb, Hb + (size_t)ML * DM, mod + 5 * 1024, (unsigned*)(ws + O_CNT) + 66 * 64, (unsigned long long*)(ws + O_SLOT1), q->ln_ffn_g, q->ln_ffn_b, Hb, U, mod + 3 * 6144, 0, (float*)(ws + O_SLOT2), (unsigned*)(ws + O_PCNT) + 8 * 64, part};
          pg8::gemm_phase<EpiResLN<true, true>, TailOrder, true, true>(lds, g, S, E); }
    }
    SEAM(8);
    if (IN(10)) { PHASE_BEGIN
        pg8::Gemm g{U, Wodin, MT, PW1, 1024, 1024, 1024}; pg8::StaticOrder S; S.init(MT, PW1, G, blk);
        EpiIn1 E{P1, stats, tab16};
        pg8::gemm_phase<EpiIn1, pg8::StaticOrder, true, true>(lds, g, S, E);
    }
    SEAM(10);
    if (IN(11)) { PHASE_BEGIN
#ifndef NO_Q
        { pg8::Gemm g{P1, Wuq, ML, 768, 384, PW1, 384}; pg8::StaticOrder S; S.init(ML, 768, G, blk);
          EpiQ1 E{Q1, stats, tab16};
          pg8::gemm_phase<EpiQ1, pg8::StaticOrder, true, true>(lds, g, S, E); }
#endif
#ifndef NO_KV
        { pg8::Gemm g{P1 + 384, Wukv, MT, 1024, 256, PW1, 256}; pg8::StaticOrder S; S.init(MT, 1024, G, (blk + 64) & 255);
          EpiKV1 E{KV1, stats};
          pg8::gemm_phase<EpiKV1, pg8::StaticOrder, true, true>(lds, g, S, E); }
#endif
#ifndef NO_GMLP
        const int gm_n = blk >= 192 ? 3 : (blk < 128 ? 2 : 1);
        const int gm_0 = blk >= 192 ? (blk - 192) * 3 : (blk < 128 ? 192 + blk * 2 : 448 + (blk - 128));
        for (int un = gm_0; un < gm_0 + gm_n; ++un) {
            const int chunk = un >> 2, grp = un & 3;
            constexpr int RS = 272;
            LAS unsigned char* wsA = lds; LAS unsigned char* vnT = lds + 128 * RS; LAS float* tst = (LAS float*)(lds + 2 * 128 * RS);
            __syncthreads();
            {
                const int tok = tid >> 2, part = tid & 3; const float* sp = stats + (size_t)(chunk * 128 + tok) * STP + 80 + part * 8;
                float s = sp[0] + sp[2] + sp[4] + sp[6], q = sp[1] + sp[3] + sp[5] + sp[7];
                s += __shfl_xor(s, 1); s += __shfl_xor(s, 2); q += __shfl_xor(q, 1); q += __shfl_xor(q, 2);
                const float mean = s * (1.f / 512.f); const float var = q * (1.f / 512.f) - mean * mean;
                if (part == 0) { tst[2 * tok] = mean; tst[2 * tok + 1] = 1.f / sqrtf(fmaxf(var, 0.f) + 1e-5f); }
            }
#pragma unroll
            for (int i = 0; i < 4; ++i) { const int id = tid + 512 * i, r = id >> 4, ch = id & 15;
                *(LAS u32x4*)(wsA + r * RS + ch * 16) = *(const u32x4*)(Gws + (size_t)grp * 16384 + r * 128 + ch * 8); }
            __syncthreads();
#pragma unroll
            for (int i = 0; i < 4; ++i) { const int id = tid + 512 * i, j = id >> 4, cc = id & 15;
                const u32x4 raw = *(const u32x4*)(P1 + (size_t)(chunk * 128 + j) * PW1 + 1280 + grp * 128 + cc * 8);
                const float mean = tst[2 * j], rstd = tst[2 * j + 1];
                const f32x4 lg0 = *(const f32x4*)(q->gmlp_ln_g + grp * 128 + cc * 8), lg1 = *(const f32x4*)(q->gmlp_ln_g + grp * 128 + cc * 8 + 4);
                const f32x4 lb0 = *(const f32x4*)(q->gmlp_ln_b + grp * 128 + cc * 8), lb1 = *(const f32x4*)(q->gmlp_ln_b + grp * 128 + cc * 8 + 4);
#pragma unroll
                for (int e = 0; e < 8; ++e) { const unsigned wv = raw[e >> 1]; const float x = bf2f((unsigned short)((e & 1) ? (wv >> 16) : (wv & 0xffffu)));
                    const float y = (x - mean) * rstd * (e < 4 ? lg0[e & 3] : lg1[e & 3]) + (e < 4 ? lb0[e & 3] : lb1[e & 3]);
                    *(LAS unsigned short*)(vnT + (cc * 8 + e) * RS + j * 2) = (unsigned short)f2bf(y); } }
            __syncthreads();
            { const int r32 = lane & 31, hh = lane >> 5, ib = wave >> 1;
#pragma unroll
              for (int cbi = 0; cbi < 2; ++cbi) { const int cb = 2 * (wave & 1) + cbi;
                f32x16 dacc = (f32x16){};
#pragma unroll
                for (int ks = 0; ks < 8; ++ks) {
                    const bf16x8 a = *(const LAS bf16x8*)(wsA + (32 * ib + r32) * RS + (16 * ks + 8 * hh) * 2);
                    const bf16x8 bb = *(const LAS bf16x8*)(vnT + (32 * cb + r32) * RS + (16 * ks + 8 * hh) * 2);
                    dacc = __builtin_amdgcn_mfma_f32_32x32x16_bf16(a, bb, dacc, 0, 0, 0); }
                const int c = 32 * cb + r32;
#pragma unroll
                for (int r = 0; r < 16; ++r) { const int i = 32 * ib + (r & 3) + 8 * (r >> 2) + 4 * hh; const int tok = chunk * 128 + i;
                    const float gu = bf2f(P1[(size_t)tok * PW1 + 768 + grp * 128 + c]);
                    const float o = gu * (dacc[r] + q->gmlp_b[grp * 128 + i]);
                    AMIX1[(size_t)tok * 1024 + 512 + grp * 128 + c] = (bf16_t)f2bf(o); } } }
        }
#endif
    }
    SEAM(11);
    if (IN(12)) { PHASE_BEGIN
        const int xcd = blk & 7, idx = blk >> 3;
        {
            const int combo = (idx >> 4) * 8 + xcd, qb = idx & 15;
            const int b = combo >> 3, h = combo & 7;
            AttnDesc d{};
            d.Q = Q1 + h * 96; d.qpitch = 768; d.K = KV1 + h * 128; d.kpitch = 1024; d.K2 = P1 + 640; d.k2pitch = PW1;
            d.V = KV1 + h * 128 + 64; d.vpitch = 1024; d.Ob = AMIX1 + h * 64; d.opitch = 1024;
            d.qrow0 = b * SEQ_ + qb * 512; d.ntiles = 132; d.nlat = 128; d.lat_row0 = b * SEQ_; d.ctx_row0 = ML + b * 256;
            attn_unit_mla2(d, lds);
        }
    }
    SEAM(12);
    if (IN(13)) { PHASE_BEGIN
        pg8::Gemm g{AMIX1, Wodout, ML, 1024, 1024, 1024, 1024}; PanelOrder S; S.init(ML, blk);
        EpiResLN<true, true> E{Hb, Hb + (size_t)ML * DM, mod + 3 * 6144 + 2 * 1024, (unsigned*)(ws + O_CNT) + 2 * 66 * 64, (unsigned long long*)(ws + O_SLOT2), q->ln_mix_g + 1024, q->ln_mix_b + 1024, Hb, U, mod + 3 * 6144, 3, nullptr, nullptr, 0};
        pg8::gemm_phase<EpiResLN<true, true>, PanelOrder, true, true>(lds, g, S, E);
    }
    SEAM(13);
    if (IN(15)) { PHASE_BEGIN
        pg8::Gemm g{U, Wffin1, ML, 5632, 1024, 1024, 1024}; pg8::StaticOrder S; S.init(ML, 5632, G, blk);
        EpiFfn E{ACT};
        pg8::gemm_phase<EpiFfn, pg8::StaticOrder, true, true>(lds, g, S, E);
    }
    SEAM(15);
    if (IN(16)) { PHASE_BEGIN
        pg8::Gemm g{ACT, Wffout1, ML, 1024, FH, FH, FH}; PanelOrder S; S.init(ML, blk);
        EpiResLN<true, false> E{Hb, Hb + (size_t)ML * DM, mod + 3 * 6144 + 5 * 1024, (unsigned*)(ws + O_CNT) + 3 * 66 * 64, (unsigned long long*)(ws + O_SLOT3), q->ln_ffn_g + 1024, q->ln_ffn_b + 1024, q->out, nullptr, nullptr, 0, nullptr, nullptr, 0};
        pg8::gemm_phase<EpiResLN<true, false>, PanelOrder, true, true>(lds, g, S, E);
    }
#undef IN
#undef SEAM
}

#ifndef N_LAUNCH_MODE
#define N_LAUNCH_MODE 1
#endif
extern "C" void kernel_launch(void* const* d_in, const int* in_sizes, int n_in, void* d_out, int out_size, void* d_ws, size_t ws_size, hipStream_t stream) {
    static int grid = 0;
    if (grid == 0) {
        if (n_in != 27 || ws_size < WS_NEED) { fprintf(stderr, "kernel_launch: unexpected inputs (n_in %d, ws %zu)\n", n_in, ws_size); grid = -1; return; }
        int dev = 0, cus = 0, per_cu = 0;
        hipGetDevice(&dev); hipDeviceGetAttribute(&cus, hipDeviceAttributeMultiprocessorCount, dev);
        hipFuncSetAttribute((const void*)dit_fwd, hipFuncAttributeMaxDynamicSharedMemorySize, LDS_BYTES);
        hipOccupancyMaxActiveBlocksPerMultiprocessor(&per_cu, (const void*)dit_fwd, 512, LDS_BYTES);
        (void)hipGetLastError();
        if (per_cu < 1) per_cu = 1;
        grid = cus * per_cu; if (grid > 256) grid = 256;
    }
    if (grid < 0) return;
    if (hipMemsetAsync((char*)d_ws + O_BAR, 0, CTL_BYTES, stream) != hipSuccess) { fprintf(stderr, "memset failed\n"); return; }
    Params p{};
    const float** pp = (const float**)&p;
    for (int i = 0; i < 27; ++i) pp[i] = (const float*)d_in[i];
    p.out = (float*)d_out; p.ws = (unsigned char*)d_ws;
#if N_LAUNCH_MODE == 1
    p.lo = 0; p.hi = NPHASE;
    void* args[] = {&p};
    hipError_t e = hipLaunchCooperativeKernel((const void*)dit_fwd, dim3(grid), dim3(512), args, LDS_BYTES, stream);
    if (e != hipSuccess) fprintf(stderr, "cooperative launch failed: %s (grid %d)\n", hipGetErrorString(e), grid);
#else
    for (int ph = 0; ph < NPHASE; ++ph) { p.lo = ph; p.hi = ph + 1; hipLaunchKernelGGL(dit_fwd, dim3(grid), dim3(512), LDS_BYTES, stream, p); }
#endif
}
```

```cpp
#include <hip/hip_runtime.h>
#include <hip/hip_cooperative_groups.h>
#include <cstdio>
#include <cstdint>
#include <cmath>
namespace cg = cooperative_groups;
namespace pg8 {
#define PG8_LAS __attribute__((address_space(3)))
typedef unsigned short bf16_t;
typedef short bf16x8 __attribute__((ext_vector_type(8)));
typedef float f32x4 __attribute__((ext_vector_type(4)));
typedef unsigned u32x4 __attribute__((ext_vector_type(4)));
typedef float f32x2 __attribute__((ext_vector_type(2)));
constexpr int BM = 256, BK = 64, HALF = 128, HTB = HALF * BK * 2  , STAGE_BYTES = 8 * HTB, NXCD = 8, WGM = 8;

__host__ __device__ __forceinline__ int lds_byte(int r, int c) { const int st = (r >> 4) * 2 + (c >> 5), rr = r & 15, cc = c & 31, ob = rr * 64 + cc * 2; return st * 1024 + (ob ^ (((ob >> 9) & 1) << 5)); }
__host__ __device__ __forceinline__ void stage_rc(int b, int& R, int& C) { const int st = b / 1024, sb = b % 1024, swz = sb ^ (((sb >> 9) & 1) << 5); R = (st >> 1) * 16 + swz / 64; C = (st & 1) * 32 + (swz % 64) / 2; }
__host__ __device__ __forceinline__ int perm32(int rho) { const int n = rho >> 4, i = rho & 15; return 8 * (i >> 2) + 4 * n + (i & 3); }

struct Unit { int pm, pn; };
struct Gemm { const bf16_t* A; const bf16_t* Bt; int M, N, K, lda, ldb; };

struct StaticOrder {
    int nM, nN, nwg, G, c;
    __host__ __device__ void init(int M, int N, int G_, int c_) { nM = M / BM; nN = N / BM; nwg = nM * nN; G = G_; c = c_; }
    __host__ __device__ bool next(int i, Unit& u) const {
        const long L = (long)i * G + c; if (L >= nwg) return false;
        int wgid = (int)L; { const int q = nwg / NXCD, r = nwg % NXCD, xcd = wgid % NXCD, off = wgid / NXCD; wgid = (xcd < r ? xcd * (q + 1) : r * (q + 1) + (xcd - r) * q) + off; }
        const int nig = WGM * nN, gid = wgid / nig, fm = gid * WGM, gsz = (nM - fm) < WGM ? (nM - fm) : WGM;
        u.pm = fm + ((wgid % nig) % gsz); u.pn = (wgid % nig) / gsz; return true;
    }
    __device__ __forceinline__ void a_ready(const Unit&) const {}
    __device__ __forceinline__ void done(const Unit&) const {}
};

__device__ __forceinline__ unsigned cvt_pk_bf16(float lo, float hi) { unsigned r; asm volatile("v_cvt_pk_bf16_f32 %0, %1, %2" : "=v"(r) : "v"(lo), "v"(hi)); return r; }
__device__ __forceinline__ f32x2 gelu_pk(f32x2 v) {
    const f32x2 av = __builtin_elementwise_abs(v), d = av * 0.2316418882f + 1.0f;
    f32x2 t; t.x = __builtin_amdgcn_rcpf(d.x); t.y = __builtin_amdgcn_rcpf(d.y);
    f32x2 q = t * 0.5307027145f + (-0.7265760135f); q = q * t + 0.7107068705f; q = q * t + (-0.142248368f); q = q * t + 0.127414796f; q = q * t;
    const f32x2 s = (v * v) * (-0.72134752044f);
    f32x2 e; e.x = __builtin_amdgcn_exp2f(s.x); e.y = __builtin_amdgcn_exp2f(s.y);
    const f32x2 m = v * (q * e), r = v - m;
    f32x2 o; o.x = v.x < 0.f ? m.x : r.x; o.y = v.y < 0.f ? m.y : r.y; return o;
}
template <class Epi, class Sched, bool ALIGN_EPI = false, bool SP2 = false>
__device__ __forceinline__ void gemm_phase(PG8_LAS unsigned char* lds, const Gemm g, const Sched& S, const Epi& E) {
    int tid = threadIdx.x; asm volatile("" : "+v"(tid));
    const int wid = __builtin_amdgcn_readfirstlane(tid >> 6), lane = tid & 63, wr = wid >> 2, wc = wid & 3, fr = lane & 15, fq = lane >> 4;
    const int K = g.K, nt = K / BK;
    unsigned voffA[2], voffB[2];
#pragma unroll
    for (int i = 0; i < 2; ++i) { int R, C; stage_rc(tid * 16 + i * 8192, R, C); const int Rb = Epi::PERM ? ((R & ~31) + perm32(R & 31)) : R;
        voffA[i] = (unsigned)(R * g.lda + C) * 2u; voffB[i] = (unsigned)(Rb * g.ldb + C) * 2u; }
    const size_t kstep = (size_t)(BK * 2);
    const size_t hstep = (size_t)HALF * g.ldb * 2;
    const size_t tstep = 2 * hstep; const size_t hstepA = (size_t)HALF * g.lda * 2, tstepA = 2 * hstepA;
    const unsigned ldsw = (unsigned)wid * 1024u;
    const int aoff = lds_byte(wr * 64 + fr, fq * 8), boff = lds_byte(wc * 32 + fr, fq * 8);
#define PG8_SA(b, h) (((b) * 2 + (h)) * HTB)
#define PG8_SB(b, h) ((4 + (b) * 2 + (h)) * HTB)
#define PG8_STAGE(bufoff, gbase, voff) do { _Pragma("unroll") for (int _i = 0; _i < 2; ++_i) \
        __builtin_amdgcn_global_load_lds((const unsigned*)((const char*)(gbase) + (voff)[_i]), (PG8_LAS unsigned*)(lds + (bufoff) + ldsw + _i * 8192), 16, 0, 0); } while (0)
#define PG8_LDA(dst, b, h) do { _Pragma("unroll") for (int m = 0; m < 4; ++m) _Pragma("unroll") for (int k = 0; k < 2; ++k) dst[m][k] = *(const PG8_LAS bf16x8*)(lds + PG8_SA(b, h) + aoff + m * 2048 + k * 1024); } while (0)
#define PG8_LDB(dst, b, h) do { _Pragma("unroll") for (int n = 0; n < 2; ++n) _Pragma("unroll") for (int k = 0; k < 2; ++k) dst[n][k] = *(const PG8_LAS bf16x8*)(lds + PG8_SB(b, h) + boff + n * 2048 + k * 1024); } while (0)
#define PG8_MMA(ai, bj, At, Bt) do { __builtin_amdgcn_s_setprio(1); _Pragma("unroll") for (int m = 0; m < 4; ++m) _Pragma("unroll") for (int n = 0; n < 2; ++n) _Pragma("unroll") for (int k = 0; k < 2; ++k) \
        acc[ai][bj][m][n] = __builtin_amdgcn_mfma_f32_16x16x32_bf16(Bt[n][k], At[m][k], acc[ai][bj][m][n], 0, 0, 0); __builtin_amdgcn_s_setprio(0); } while (0)
#define PG8_WAIT_V(n) asm volatile("s_waitcnt vmcnt(" #n ")" ::: "memory")
#define PG8_WAIT_L(n) asm volatile("s_waitcnt lgkmcnt(" #n ")" ::: "memory")
#define PG8_BAR __builtin_amdgcn_s_barrier()
#define PG8_SCHED __builtin_amdgcn_sched_barrier(0)
    Unit cur, nxt; int ui = 0;
    if (!S.next(0, cur)) return;
    f32x4 acc[2][2][4][2];
#pragma unroll
    for (int a = 0; a < 2; ++a)
#pragma unroll
        for (int b = 0; b < 2; ++b)
#pragma unroll
            for (int m = 0; m < 4; ++m)
#pragma unroll
                for (int n = 0; n < 2; ++n) acc[a][b][m][n] = (f32x4){0.f, 0.f, 0.f, 0.f};
    bf16x8 At[4][2], B0[2][2], B1[2][2];
    const char* cA = (const char*)g.A + (size_t)cur.pm * tstepA; const char* cB = (const char*)g.Bt + (size_t)cur.pn * tstep;
    S.a_ready(cur);
    if constexpr (SP2) {
        PG8_STAGE(PG8_SB(0, 0), cB, voffB); PG8_STAGE(PG8_SB(0, 1), cB + hstep, voffB); PG8_STAGE(PG8_SA(0, 0), cA, voffA); PG8_STAGE(PG8_SA(0, 1), cA + hstepA, voffA);
        if (wr == 1) PG8_BAR;
        PG8_WAIT_V(2); PG8_BAR;
        PG8_STAGE(PG8_SB(1, 0), cB + kstep, voffB); PG8_STAGE(PG8_SA(1, 0), cA + kstep, voffA); PG8_STAGE(PG8_SB(1, 1), cB + hstep + kstep, voffB);
        PG8_WAIT_V(6); PG8_BAR;
    } else {
        PG8_STAGE(PG8_SB(0, 0), cB, voffB); PG8_STAGE(PG8_SA(0, 0), cA, voffA); PG8_STAGE(PG8_SB(0, 1), cB + hstep, voffB); PG8_STAGE(PG8_SA(0, 1), cA + hstepA, voffA);
        if (wr == 1) PG8_BAR;
        PG8_WAIT_V(4); PG8_BAR;
        PG8_STAGE(PG8_SB(1, 0), cB + kstep, voffB); PG8_STAGE(PG8_SA(1, 0), cA + kstep, voffA); PG8_STAGE(PG8_SB(1, 1), cB + hstep + kstep, voffB);
        PG8_WAIT_V(6); PG8_BAR;
    }
    for (;;) {
        const bool has_next = S.next(ui + 1, nxt);
        const char* nA = has_next ? (const char*)g.A + (size_t)nxt.pm * tstepA : cA; const char* nB = has_next ? (const char*)g.Bt + (size_t)nxt.pn * tstep : cB;
#pragma nounroll
        for (int t = 0; t < nt; t += 2) {
            const bool last = (t == nt - 2);
            const char* a1 = cA + (size_t)(t + 1) * kstep;
            const char* a2 = last ? nA : cA + (size_t)(t + 2) * kstep; const char* b2 = last ? nB : cB + (size_t)(t + 2) * kstep;
            const char* a3 = a2 + kstep; const char* b3 = b2 + kstep;
            if (last && has_next) S.a_ready(nxt);
            if constexpr (SP2) {
            PG8_LDB(B0, 0, 0); PG8_LDB(B1, 0, 1); PG8_SCHED; PG8_LDA(At, 0, 0); PG8_STAGE(PG8_SA(1, 1), a1 + hstepA, voffA);
            PG8_WAIT_V(8); PG8_WAIT_L(0); PG8_BAR; PG8_MMA(0, 0, At, B0); PG8_MMA(0, 1, At, B1); PG8_BAR; PG8_SCHED;
            PG8_LDA(At, 0, 1); PG8_STAGE(PG8_SB(0, 0), b2, voffB); PG8_STAGE(PG8_SB(0, 1), b2 + hstep, voffB); PG8_STAGE(PG8_SA(0, 0), a2, voffA);
            PG8_WAIT_V(8); PG8_WAIT_L(0); PG8_BAR; PG8_MMA(1, 0, At, B0); PG8_MMA(1, 1, At, B1); PG8_BAR; PG8_SCHED;
            PG8_LDB(B0, 1, 0); PG8_LDB(B1, 1, 1); PG8_SCHED; PG8_LDA(At, 1, 0); PG8_STAGE(PG8_SA(0, 1), a2 + hstepA, voffA);
            PG8_WAIT_V(8); PG8_WAIT_L(0); PG8_BAR; PG8_MMA(0, 0, At, B0); PG8_MMA(0, 1, At, B1); PG8_BAR; PG8_SCHED;
            PG8_LDA(At, 1, 1); PG8_STAGE(PG8_SB(1, 0), b3, voffB); PG8_STAGE(PG8_SB(1, 1), b3 + hstep, voffB); PG8_STAGE(PG8_SA(1, 0), a3, voffA);
            PG8_WAIT_V(8); PG8_WAIT_L(0); PG8_BAR; PG8_MMA(1, 0, At, B0); PG8_MMA(1, 1, At, B1); PG8_BAR; PG8_SCHED;
            } else {
            PG8_LDB(B0, 0, 0); PG8_SCHED; PG8_LDA(At, 0, 0); PG8_STAGE(PG8_SA(1, 1), a1 + hstepA, voffA);
            PG8_WAIT_L(8); PG8_BAR; PG8_WAIT_L(0); PG8_MMA(0, 0, At, B0); PG8_BAR; PG8_SCHED;
            PG8_LDB(B1, 0, 1); PG8_STAGE(PG8_SB(0, 0), b2, voffB);
            PG8_BAR; PG8_WAIT_L(0); PG8_MMA(0, 1, At, B1); PG8_BAR;
            PG8_LDA(At, 0, 1); PG8_STAGE(PG8_SA(0, 0), a2, voffA);
            PG8_BAR; PG8_WAIT_L(0); PG8_MMA(1, 0, At, B0); PG8_BAR; PG8_SCHED;
            PG8_STAGE(PG8_SB(0, 1), b2 + hstep, voffB);
            PG8_WAIT_V(6); PG8_BAR; PG8_MMA(1, 1, At, B1); PG8_BAR;
            PG8_LDB(B0, 1, 0); PG8_SCHED; PG8_LDA(At, 1, 0); PG8_STAGE(PG8_SA(0, 1), a2 + hstepA, voffA);
            PG8_WAIT_L(8); PG8_BAR; PG8_WAIT_L(0); PG8_MMA(0, 0, At, B0); PG8_BAR; PG8_SCHED;
            PG8_LDB(B1, 1, 1); PG8_STAGE(PG8_SB(1, 0), b3, voffB);
            PG8_BAR; PG8_WAIT_L(0); PG8_MMA(0, 1, At, B1); PG8_BAR;
            PG8_LDA(At, 1, 1); PG8_STAGE(PG8_SA(1, 0), a3, voffA);
            PG8_BAR; PG8_WAIT_L(0); PG8_MMA(1, 0, At, B0); PG8_BAR; PG8_SCHED;
            PG8_STAGE(PG8_SB(1, 1), b3 + hstep, voffB);
            PG8_WAIT_V(6); PG8_BAR; PG8_MMA(1, 1, At, B1); PG8_BAR;
            }
        }
        if constexpr (ALIGN_EPI) { if (wr == 0) PG8_BAR; }
        if constexpr (!Epi::AFTER_DRAIN) { E(acc, cur, wr, wc, fr, fq); S.done(cur); }
        if (!has_next) break;
#pragma unroll
        for (int a = 0; a < 2; ++a)
#pragma unroll
            for (int b = 0; b < 2; ++b)
#pragma unroll
                for (int m = 0; m < 4; ++m)
#pragma unroll
                    for (int n = 0; n < 2; ++n) acc[a][b][m][n] = (f32x4){0.f, 0.f, 0.f, 0.f};
        cur = nxt; cA = nA; cB = nB; ++ui;
        if constexpr (ALIGN_EPI) { if (wr == 1) PG8_BAR; }
    }
    PG8_WAIT_V(0);
    if constexpr (!ALIGN_EPI) { if (wr == 0) PG8_BAR; }
    PG8_BAR;
    if constexpr (Epi::AFTER_DRAIN) { E.fused(acc, cur, wr, wc, fr, fq, lds, wid, lane); S.done(cur); }
#undef PG8_SA
#undef PG8_SB
#undef PG8_STAGE
#undef PG8_LDA
#undef PG8_LDB
#undef PG8_MMA
#undef PG8_WAIT_V
#undef PG8_WAIT_L
#undef PG8_BAR
#undef PG8_SCHED
}
}

using pg8::bf16_t; using pg8::f32x4; using pg8::u32x4; using pg8::Unit;
#define LAS __attribute__((address_space(3)))
typedef unsigned u32x2 __attribute__((ext_vector_type(2)));
typedef float f32x2v __attribute__((ext_vector_type(2)));
typedef float f32x16 __attribute__((ext_vector_type(16)));
typedef short bf16x8 __attribute__((ext_vector_type(8)));
typedef short s16x4 __attribute__((ext_vector_type(4)));
typedef short v4i16_t __attribute__((ext_vector_type(4)));

constexpr int SEQ_ = 8192, DM = 1024, ML = 16384, MT = 16896, FH = 2816;
constexpr int PW0 = 3072;
constexpr int PW1 = 1792;
constexpr int STP = 112;
constexpr float ALPHA_ = 1.4142135623730951f;
constexpr float LOG2E_ = 1.4426950408889634f;
constexpr float QS64 = 0.125f * 1.4426950408889634f;
constexpr float QS96 = (float)(1.4426950408889634 / 9.797958971132712);
constexpr float LAMBDA_INIT = 0.2f;

constexpr size_t MiB_ = 1u << 20;
constexpr size_t O_EVIN = 0, O_EVOUT = O_EVIN + 6291456, O_FFIN0 = O_EVOUT + 2097152, O_FFOUT0 = O_FFIN0 + 11534336;
constexpr size_t O_FFIN1 = O_FFOUT0 + 5767168, O_FFOUT1 = O_FFIN1 + 11534336, O_ODIN = O_FFOUT1 + 5767168, O_ODOUT = O_ODIN + 3670016;
constexpr size_t O_UQ = O_ODOUT + 2097152, O_UKV = O_UQ + 589824, O_GWS = O_UKV + 524288, O_MOD = O_GWS + 131072, O_TAB32 = O_MOD + 147456, O_TAB16 = O_TAB32 + 16384;
constexpr size_t O_SLOT0 = 48 * MiB_, O_SLOT1 = 51 * MiB_, O_SLOT2 = 145 * MiB_, O_SLOT3 = 148 * MiB_;
static_assert(O_TAB16 + 8192 <= O_SLOT0 && O_SLOT1 + (size_t)16896 * 128 <= 54 * MiB_, "ws map");
constexpr size_t O_Q1 = 0;
static_assert((size_t)ML * 768 * 2 <= O_FFIN1, "Q1 overlay");
constexpr size_t O_P = 54 * MiB_, O_H = 153 * MiB_, O_U = 219 * MiB_, WS_NEED = 253 * MiB_, O_BAR = 252 * MiB_, O_CNT = O_BAR + 16384, O_PCNT = O_CNT + 4 * 66 * 256, CTL_BYTES = 16384 + 4 * 66 * 256 + 2 * 8 * 256;
constexpr size_t O_ODIFF = O_H, O_AMIX0 = O_U, O_ACT = O_P, O_P1 = O_P, O_AMIX1 = 112 * MiB_, O_STATS = 144 * MiB_, O_KV1 = O_U;
static_assert(O_P1 + (size_t)MT * PW1 * 2 <= O_AMIX1 && O_STATS + (size_t)MT * STP * 4 <= O_H, "ws map 2");

__device__ __forceinline__ unsigned f2bf(float f) { unsigned u = __builtin_bit_cast(unsigned, f); return (u + 0x7fffu + ((u >> 16) & 1u)) >> 16; }
typedef __bf16 bf16x2_hw __attribute__((ext_vector_type(2)));
__device__ __forceinline__ unsigned pk2(float lo, float hi) { f32x2v v = {lo, hi}; bf16x2_hw b = __builtin_convertvector(v, bf16x2_hw); return __builtin_bit_cast(unsigned, b); }
__device__ __forceinline__ float bf2f(unsigned short b) { return __builtin_bit_cast(float, (unsigned)b << 16); }
__device__ __forceinline__ float wave_sum(float v) {
#pragma unroll
    for (int o = 1; o < 64; o <<= 1) v += __shfl_xor(v, o);
    return v;
}
__device__ __forceinline__ float gelu_exact(float v) { return 0.5f * v * (1.0f + erff(v * 0.70710678118654752f)); }
__device__ __forceinline__ int modset(int pm) { return pm < 32 ? 0 : (pm < 64 ? 1 : 2); }

struct EpiIn0 {
    static constexpr bool PERM = true, AFTER_DRAIN = false;
    bf16_t* P; const float* tab32;
    __device__ __forceinline__ void operator()(const f32x4 (&acc)[2][2][4][2], const Unit& u, int wr, int wc, int fr, int fq) const {
        asm volatile("" : "+v"(fr), "+v"(fq));
        const int region = u.pn >> 1;
        const bool rope = (region <= 1) && (u.pm < 64);
        const float sc = (region == 0 || region == 3) ? QS64 : 1.f;
        const float sgn = (fq < 2) ? -1.f : 1.f;
#pragma unroll
        for (int ai = 0; ai < 2; ++ai)
#pragma unroll
            for (int m = 0; m < 4; ++m) {
                const int row = u.pm * 256 + ai * 128 + wr * 64 + m * 16 + fr;
                const int t = row & 8191; const int pos = (wc & 1) ? (t & 63) : (t >> 6);
                const float* tb = tab32 + (pos * 16 + 8 * (fq & 1)) * 2;
#pragma unroll
                for (int bj = 0; bj < 2; ++bj) {
                    const int col = u.pn * 256 + bj * 128 + wc * 32 + 8 * fq;
                    float v[8];
#pragma unroll
                    for (int i = 0; i < 4; ++i) { v[i] = acc[ai][bj][m][0][i]; v[4 + i] = acc[ai][bj][m][1][i]; }
                    if (rope) {
                        const f32x4 t0 = *(const f32x4*)tb, t1 = *(const f32x4*)(tb + 4), t2 = *(const f32x4*)(tb + 8), t3 = *(const f32x4*)(tb + 12);
                        const float cs[8] = {t0[0], t0[2], t1[0], t1[2], t2[0], t2[2], t3[0], t3[2]};
                        const float sn[8] = {t0[1], t0[3], t1[1], t1[3], t2[1], t2[3], t3[1], t3[3]};
#pragma unroll
                        for (int i = 0; i < 8; ++i) { const float pr = __shfl_xor(v[i], 32); v[i] = v[i] * cs[i] + sgn * pr * sn[i]; }
                    }
                    u32x4 w; w.x = pk2(v[0] * sc, v[1] * sc); w.y = pk2(v[2] * sc, v[3] * sc); w.z = pk2(v[4] * sc, v[5] * sc); w.w = pk2(v[6] * sc, v[7] * sc);
                    *(u32x4*)(P + (size_t)row * PW0 + col) = w;
                }
            }
    }
};
struct EpiRes {
    static constexpr bool PERM = true, AFTER_DRAIN = false;
    const float* hx; const float* hc; float* Z; const float* gate;
    __device__ __forceinline__ void operator()(const f32x4 (&acc)[2][2][4][2], const Unit& u, int wr, int wc, int fr, int fq) const {
        asm volatile("" : "+v"(fr), "+v"(fq));
        const float* gp = gate + modset(u.pm) * 6144;
#pragma unroll
        for (int bj = 0; bj < 2; ++bj) {
            const int col = u.pn * 256 + bj * 128 + wc * 32 + 8 * fq;
            const f32x4 g0 = *(const f32x4*)(gp + col), g1 = *(const f32x4*)(gp + col + 4);
#pragma unroll
            for (int ai = 0; ai < 2; ++ai)
#pragma unroll
                for (int m = 0; m < 4; ++m) {
                    const int row = u.pm * 256 + ai * 128 + wr * 64 + m * 16 + fr;
                    const float* hb = (u.pm < 64) ? hx + (size_t)row * DM : hc + (size_t)(row - ML) * DM;
                    const f32x4 h0 = *(const f32x4*)(hb + col), h1 = *(const f32x4*)(hb + col + 4);
                    const f32x4 z0 = h0 * ALPHA_ + g0 * acc[ai][bj][m][0], z1 = h1 * ALPHA_ + g1 * acc[ai][bj][m][1];
                    float* zp = Z + (size_t)row * DM + col;
                    *(f32x4*)zp = z0; *(f32x4*)(zp + 4) = z1;
                }
        }
    }
};

struct PanelOrder {
    int nP, c;
    __device__ void init(int M, int c_) { nP = M / 256; c = c_; }
    __device__ bool next(int i, Unit& u) const {
        const int rem = nP - 64 * i;
        if (rem >= 64) { const int x = c & 7, j = c >> 3; u.pm = 64 * i + 8 * x + (j & 7); u.pn = j >> 3; return true; }
        if (rem > 0 && c < 4 * rem) { u.pm = 64 * i + (c >> 2); u.pn = c & 3; return true; }
        return false;
    }
    __device__ __forceinline__ void a_ready(const Unit&) const {}
    __device__ __forceinline__ void done(const Unit&) const {}
};
struct TailOrder {
    int c;
    __device__ bool next(int i, Unit& u) const { if (i > 0 || c >= 32) return false; u.pm = 64 + (c >> 4); u.pn = (c >> 2) & 3; return true; }
    __device__ __forceinline__ void a_ready(const Unit&) const {}
    __device__ __forceinline__ void done(const Unit&) const {}
};
template <bool HIN16, bool HOUT16>
struct EpiResLN {
    static constexpr bool PERM = true, AFTER_DRAIN = false;
    const void* hx; const void* hc; const float* gate;
    unsigned* cnt; unsigned long long* slots; const float* lg; const float* lb; void* dst; bf16_t* U; const float* modl; int kmod;
    float* part_buf; unsigned* part_cnt; int part;
    __device__ __forceinline__ void operator()(const f32x4 (&acc)[2][2][4][2], const Unit& u, int wr, int wc, int fr, int fq) const {
        asm volatile("" : "+v"(fr), "+v"(fq));
        const int set = modset(u.pm);
        const float* gp = gate + set * 6144;
        const int colb = u.pn * 256 + wc * 32 + 8 * fq;
        const int tunit = (u.pm - 64) * 4 + u.pn;
        int tid_ = threadIdx.x; asm volatile("" : "+v"(tid_));
        if (part_buf && part != 0) {
            float* pb = part_buf + ((size_t)(tunit * 3 + part - 1) * 32 * 512 + tid_) * 4;
#pragma unroll
            for (int ai = 0; ai < 2; ++ai)
#pragma unroll
                for (int bj = 0; bj < 2; ++bj)
#pragma unroll
                    for (int m = 0; m < 4; ++m)
#pragma unroll
                        for (int hf = 0; hf < 2; ++hf) {
                            const f32x4 v = acc[ai][bj][m][hf]; float* dp = pb + (size_t)((((ai * 2 + bj) * 4 + m) * 2 + hf) * 512) * 4;
                            asm volatile("global_store_dwordx4 %0, %1, off sc1" :: "v"(dp), "v"(v) : "memory");
                        }
            asm volatile("s_waitcnt vmcnt(0)" ::: "memory"); __builtin_amdgcn_s_barrier(); asm volatile("" ::: "memory");
            if (threadIdx.x == 0) __hip_atomic_fetch_add(part_cnt + 64 * tunit, 1u, __ATOMIC_RELAXED, __HIP_MEMORY_SCOPE_AGENT);
            return;
        }
        if (part_buf) {
            if (threadIdx.x == 0) {
                unsigned sp = 0;
                while (__hip_atomic_load(part_cnt + 64 * tunit, __ATOMIC_RELAXED, __HIP_MEMORY_SCOPE_AGENT) < 3u) { __builtin_amdgcn_s_sleep(1); if (++sp > (1u << 24)) break; }
                __builtin_amdgcn_fence(__ATOMIC_ACQUIRE, "agent"); asm volatile("s_waitcnt vmcnt(0)" ::: "memory");
            }
            asm volatile("s_waitcnt vmcnt(0) lgkmcnt(0)" ::: "memory"); __builtin_amdgcn_s_barrier(); asm volatile("" ::: "memory");
        }
        const float* pb0 = part_buf ? part_buf + ((size_t)(tunit * 3) * 32 * 512 + tid_) * 4 : nullptr;
        f32x4 z[2][4][2][2];
        {
            f32x4 g[2][2];
#pragma unroll
            for (int bj = 0; bj < 2; ++bj) { g[bj][0] = *(const f32x4*)(gp + colb + bj * 128); g[bj][1] = *(const f32x4*)(gp + colb + bj * 128 + 4); }
#pragma unroll
            for (int ai = 0; ai < 2; ++ai)
#pragma unroll
                for (int m = 0; m < 4; ++m) {
                    const int r = ai * 128 + wr * 64 + m * 16 + fr, row = u.pm * 256 + r;
                    const size_t hoff = ((u.pm < 64) ? (size_t)row * DM : (size_t)(row - ML) * DM) + colb;
                    const float* hb = (const float*)((u.pm < 64) ? hx : hc) + hoff;
                    const bf16_t* hb16 = (const bf16_t*)((u.pm < 64) ? hx : hc) + hoff;
                    float s = 0.f, q = 0.f;
#pragma unroll
                    for (int bj = 0; bj < 2; ++bj) {
                        f32x4 h0, h1;
                        if (HIN16) { const u32x4 hw = *(const u32x4*)(hb16 + bj * 128);
                            h0 = (f32x4){__uint_as_float(hw[0] << 16), __uint_as_float(hw[0] & 0xffff0000u), __uint_as_float(hw[1] << 16), __uint_as_float(hw[1] & 0xffff0000u)};
                            h1 = (f32x4){__uint_as_float(hw[2] << 16), __uint_as_float(hw[2] & 0xffff0000u), __uint_as_float(hw[3] << 16), __uint_as_float(hw[3] & 0xffff0000u)}; }
                        else { h0 = *(const f32x4*)(hb + bj * 128); h1 = *(const f32x4*)(hb + bj * 128 + 4); }
                        f32x4 a0 = acc[ai][bj][m][0], a1 = acc[ai][bj][m][1];
                        if (part_buf) {
#pragma unroll
                            for (int pp = 0; pp < 3; ++pp) { const float* pq = pb0 + (size_t)(pp * 32 + ((ai * 2 + bj) * 4 + m) * 2) * 512 * 4;
                                a0 += *(const f32x4*)pq; a1 += *(const f32x4*)(pq + 512 * 4); }
                        }
                        const f32x4 z0 = h0 * ALPHA_ + g[bj][0] * a0, z1 = h1 * ALPHA_ + g[bj][1] * a1;
                        z[ai][m][bj][0] = z0; z[ai][m][bj][1] = z1;
                        s += (z0[0] + z0[1]) + (z0[2] + z0[3]) + (z1[0] + z1[1]) + (z1[2] + z1[3]);
                        q += (z0[0] * z0[0] + z0[1] * z0[1]) + (z0[2] * z0[2] + z0[3] * z0[3]) + (z1[0] * z1[0] + z1[1] * z1[1]) + (z1[2] * z1[2] + z1[3] * z1[3]);
                    }
                    s += __shfl_xor(s, 16); s += __shfl_xor(s, 32); q += __shfl_xor(q, 16); q += __shfl_xor(q, 32);
                    if (fq == 0) __hip_atomic_store(slots + ((size_t)(u.pm * 256 + r) * 16 + u.pn * 4 + wc), ((unsigned long long)__float_as_uint(q) << 32) | __float_as_uint(s), __ATOMIC_RELAXED, __HIP_MEMORY_SCOPE_AGENT);
                    if (m == 3) asm volatile("" ::: "memory");
                }
        }
        asm volatile("s_waitcnt vmcnt(0)" ::: "memory"); __builtin_amdgcn_s_barrier(); asm volatile("" ::: "memory");
        if (threadIdx.x == 0) {
            unsigned* cw = cnt + 64 * u.pm;
            __hip_atomic_fetch_add(cw, 1u, __ATOMIC_RELAXED, __HIP_MEMORY_SCOPE_AGENT);
            unsigned sp = 0;
            while (__hip_atomic_load(cw, __ATOMIC_RELAXED, __HIP_MEMORY_SCOPE_AGENT) < 4u) { __builtin_amdgcn_s_sleep(1); if (++sp > (1u << 24)) break; }
            __builtin_amdgcn_fence(__ATOMIC_ACQUIRE, "agent"); asm volatile("s_waitcnt vmcnt(0)" ::: "memory");
        }
        asm volatile("s_waitcnt vmcnt(0) lgkmcnt(0)" ::: "memory"); __builtin_amdgcn_s_barrier(); asm volatile("" ::: "memory");
        const float* mp = U ? modl + set * 6144 + kmod * 1024 + colb : nullptr;
        f32x4 sv[2][4][2];
#pragma unroll
        for (int ai = 0; ai < 2; ++ai)
#pragma unroll
            for (int m = 0; m < 4; ++m) {
                const int r = ai * 128 + wr * 64 + m * 16 + fr;
                const f32x4* sl = (const f32x4*)(slots + ((size_t)(u.pm * 256 + r) * 16 + fq * 4));
                sv[ai][m][0] = sl[0]; sv[ai][m][1] = sl[1];
            }
        float mean_[2][4], rstd_[2][4];
#pragma unroll
        for (int ai = 0; ai < 2; ++ai)
#pragma unroll
            for (int m = 0; m < 4; ++m) {
                float s = (sv[ai][m][0][0] + sv[ai][m][0][2]) + (sv[ai][m][1][0] + sv[ai][m][1][2]);
                float q = (sv[ai][m][0][1] + sv[ai][m][0][3]) + (sv[ai][m][1][1] + sv[ai][m][1][3]);
                s += __shfl_xor(s, 16); s += __shfl_xor(s, 32); q += __shfl_xor(q, 16); q += __shfl_xor(q, 32);
                const float mean = s * (1.f / DM);
                mean_[ai][m] = mean; rstd_[ai][m] = 1.f / sqrtf(fmaxf(q * (1.f / DM) - mean * mean, 0.f) + 1e-5f);
            }
        asm volatile("" ::: "memory");
#pragma unroll
        for (int bj = 0; bj < 2; ++bj) {
            const int col = colb + bj * 128;
            const f32x4 lg0 = *(const f32x4*)(lg + col), lg1 = *(const f32x4*)(lg + col + 4), lb0 = *(const f32x4*)(lb + col), lb1 = *(const f32x4*)(lb + col + 4);
            f32x4 sh0 = {}, sh1 = {}, sc0 = {}, sc1 = {};
            if (U) { sh0 = *(const f32x4*)(mp + bj * 128); sh1 = *(const f32x4*)(mp + bj * 128 + 4); sc0 = *(const f32x4*)(mp + 1024 + bj * 128) + 1.f; sc1 = *(const f32x4*)(mp + 1024 + bj * 128 + 4) + 1.f; }
#pragma unroll
            for (int ai = 0; ai < 2; ++ai)
#pragma unroll
                for (int m = 0; m < 4; ++m) {
                    const int r = ai * 128 + wr * 64 + m * 16 + fr, row = u.pm * 256 + r;
                    const float mean = mean_[ai][m], rstd = rstd_[ai][m];
                    const f32x4 h0 = (z[ai][m][bj][0] - mean) * rstd * lg0 + lb0, h1 = (z[ai][m][bj][1] - mean) * rstd * lg1 + lb1;
                    if (HOUT16) *(u32x4*)((bf16_t*)dst + (size_t)row * DM + col) = (u32x4){pk2(h0[0], h0[1]), pk2(h0[2], h0[3]), pk2(h1[0], h1[1]), pk2(h1[2], h1[3])};
                    else { float* dp = (float*)dst + (size_t)row * DM + col; *(f32x4*)dp = h0; *(f32x4*)(dp + 4) = h1; }
                    if (U) { const f32x4 u0 = h0 * sc0 + sh0, u1 = h1 * sc1 + sh1;
                        *(u32x4*)(U + (size_t)row * DM + col) = (u32x4){pk2(u0[0], u0[1]), pk2(u0[2], u0[3]), pk2(u1[0], u1[1]), pk2(u1[2], u1[3])}; }
                }
            asm volatile("" ::: "memory");
        }
    }
};
struct EpiFfn {
    static constexpr bool PERM = true, AFTER_DRAIN = false;
    bf16_t* ACT;
    __device__ __forceinline__ void operator()(const f32x4 (&acc)[2][2][4][2], const Unit& u, int wr, int wc, int fr, int fq) const {
        asm volatile("" : "+v"(fr), "+v"(fq));
        const int hcol = u.pn * 128 + wc * 32 + 8 * fq;
#pragma unroll
        for (int ai = 0; ai < 2; ++ai)
#pragma unroll
            for (int m = 0; m < 4; ++m) {
                const int row = u.pm * 256 + ai * 128 + wr * 64 + m * 16 + fr;
                float o[8];
#pragma unroll
                for (int i = 0; i < 8; ++i) { const float g = acc[ai][0][m][i >> 2][i & 3], a = acc[ai][1][m][i >> 2][i & 3]; o[i] = g * __builtin_amdgcn_rcpf(1.f + __builtin_amdgcn_exp2f(-1.4426950408889634f * g)) * a; }
                u32x4 w; w.x = pk2(o[0], o[1]); w.y = pk2(o[2], o[3]); w.z = pk2(o[4], o[5]); w.w = pk2(o[6], o[7]);
                *(u32x4*)(ACT + (size_t)row * FH + hcol) = w;
            }
    }
};
struct EpiIn1 {
    static constexpr bool PERM = true, AFTER_DRAIN = false;
    bf16_t* P1; float* stats; const float* tab16;
    __device__ __forceinline__ void operator()(const f32x4 (&acc)[2][2][4][2], const Unit& u, int wr, int wc, int fr, int fq) const {
        asm volatile("" : "+v"(fr), "+v"(fq));
#pragma unroll
        for (int bj = 0; bj < 2; ++bj) {
            const int col32 = u.pn * 256 + bj * 128 + wc * 32, col = col32 + 8 * fq, grp = col32 >> 5;
            if (col32 >= 672 && col32 < 768) continue;
            const int kind = (col32 < 640) ? 0 : (col32 < 672 ? 1 : (col32 < 1280 ? 2 : 3));
#pragma unroll
            for (int ai = 0; ai < 2; ++ai)
#pragma unroll
                for (int m = 0; m < 4; ++m) {
                    const int row = u.pm * 256 + ai * 128 + wr * 64 + m * 16 + fr;
                    float v[8];
#pragma unroll
                    for (int i = 0; i < 4; ++i) { v[i] = acc[ai][bj][m][0][i]; v[4 + i] = acc[ai][bj][m][1][i]; }
                    if (kind == 1) {
                        if (u.pm < 64) {
                            const int t = row & 8191; const int pos = (fq & 2) ? (t & 63) : (t >> 6);
                            const float* tb = tab16 + pos * 16;
                            const f32x4 t0 = *(const f32x4*)tb, t1 = *(const f32x4*)(tb + 4), t2 = *(const f32x4*)(tb + 8), t3 = *(const f32x4*)(tb + 12);
                            const float cs[8] = {t0[0], t0[2], t1[0], t1[2], t2[0], t2[2], t3[0], t3[2]};
                            const float sn[8] = {t0[1], t0[3], t1[1], t1[3], t2[1], t2[3], t3[1], t3[3]};
                            const float sgn = (fq & 1) ? 1.f : -1.f;
#pragma unroll
                            for (int i = 0; i < 8; ++i) { const float pr = __shfl_xor(v[i], 16); v[i] = v[i] * cs[i] + sgn * pr * sn[i]; }
                        }
                    } else if (kind >= 2) {
#pragma unroll
                        for (int i = 0; i < 8; i += 2) { const pg8::f32x2 gv2 = pg8::gelu_pk((pg8::f32x2){v[i], v[i + 1]}); v[i] = gv2.x; v[i + 1] = gv2.y; }
                    }
                    if (kind == 0 || kind == 3) {
                        float s = 0.f, q = 0.f;
#pragma unroll
                        for (int i = 0; i < 8; ++i) { s += v[i]; q += v[i] * v[i]; }
                        s += __shfl_xor(s, 16); s += __shfl_xor(s, 32); q += __shfl_xor(q, 16); q += __shfl_xor(q, 32);
                        if (fq == 0) *(f32x2v*)(stats + (size_t)row * STP + grp * 2) = (f32x2v){s, q};
                    }
                    u32x4 w; w.x = pk2(v[0], v[1]); w.y = pk2(v[2], v[3]); w.z = pk2(v[4], v[5]); w.w = pk2(v[6], v[7]);
                    *(u32x4*)(P1 + (size_t)row * PW1 + col) = w;
                    asm volatile("" ::: "memory");
                }
        }
    }
};
struct EpiQ1 {
    static constexpr bool PERM = true, AFTER_DRAIN = false;
    bf16_t* Q1; const float* stats; const float* tab16;
    __device__ __forceinline__ void operator()(const f32x4 (&acc)[2][2][4][2], const Unit& u, int wr, int wc, int fr, int fq) const {
        asm volatile("" : "+v"(fr), "+v"(fq));
#pragma unroll
        for (int ai = 0; ai < 2; ++ai)
#pragma unroll
            for (int m = 0; m < 4; ++m) {
                const int row = u.pm * 256 + ai * 128 + wr * 64 + m * 16 + fr;
                const float* sp = stats + (size_t)row * STP + fq * 6;
                float q = sp[1] + sp[3] + sp[5];
                q += __shfl_xor(q, 16); q += __shfl_xor(q, 32);
                const float rs = QS96 / sqrtf(q * (1.f / 384.f) + 1e-6f);
                const int t = row & 8191; const int pos = (fq & 2) ? (t & 63) : (t >> 6);
                const float* tb = tab16 + pos * 16;
                const float sgn = (fq & 1) ? 1.f : -1.f;
#pragma unroll
                for (int bj = 0; bj < 2; ++bj) {
                    const int col32 = u.pn * 256 + bj * 128 + wc * 32, col = col32 + 8 * fq;
                    const bool rope = ((col32 >> 5) % 3) == 2;
                    float v[8];
#pragma unroll
                    for (int i = 0; i < 4; ++i) { v[i] = acc[ai][bj][m][0][i]; v[4 + i] = acc[ai][bj][m][1][i]; }
                    if (rope) {
                        const f32x4 t0 = *(const f32x4*)tb, t1 = *(const f32x4*)(tb + 4), t2 = *(const f32x4*)(tb + 8), t3 = *(const f32x4*)(tb + 12);
                        const float cs[8] = {t0[0], t0[2], t1[0], t1[2], t2[0], t2[2], t3[0], t3[2]};
                        const float sn[8] = {t0[1], t0[3], t1[1], t1[3], t2[1], t2[3], t3[1], t3[3]};
#pragma unroll
                        for (int i = 0; i < 8; ++i) { const float pr = __shfl_xor(v[i], 16); v[i] = v[i] * cs[i] + sgn * pr * sn[i]; }
                    }
                    u32x4 w; w.x = pk2(v[0] * rs, v[1] * rs); w.y = pk2(v[2] * rs, v[3] * rs); w.z = pk2(v[4] * rs, v[5] * rs); w.w = pk2(v[6] * rs, v[7] * rs);
                    *(u32x4*)(Q1 + (size_t)row * 768 + col) = w;
                }
                asm volatile("" ::: "memory");
            }
    }
};
struct EpiKV1 {
    static constexpr bool PERM = true, AFTER_DRAIN = false;
    bf16_t* KV1; const float* stats;
    __device__ __forceinline__ void operator()(const f32x4 (&acc)[2][2][4][2], const Unit& u, int wr, int wc, int fr, int fq) const {
        asm volatile("" : "+v"(fr), "+v"(fq));
#pragma unroll
        for (int ai = 0; ai < 2; ++ai)
#pragma unroll
            for (int m = 0; m < 4; ++m) {
                const int row = u.pm * 256 + ai * 128 + wr * 64 + m * 16 + fr;
                const float* sp = stats + (size_t)row * STP + 24 + fq * 4;
                float q = sp[1] + sp[3];
                q += __shfl_xor(q, 16); q += __shfl_xor(q, 32);
                const float rs = 1.f / sqrtf(q * (1.f / 256.f) + 1e-6f);
#pragma unroll
                for (int bj = 0; bj < 2; ++bj) {
                    const int col = u.pn * 256 + bj * 128 + wc * 32 + 8 * fq;
                    const f32x4 a = acc[ai][bj][m][0] * rs, b = acc[ai][bj][m][1] * rs;
                    u32x4 w; w.x = pk2(a[0], a[1]); w.y = pk2(a[2], a[3]); w.z = pk2(b[0], b[1]); w.w = pk2(b[2], b[3]);
                    *(u32x4*)(KV1 + (size_t)row * 1024 + col) = w;
                }
                asm volatile("" ::: "memory");
            }
    }
};

struct AttnDesc {
    const bf16_t* Q; int qpitch;
    const bf16_t* K; int kpitch;
    const bf16_t* K2; int k2pitch;
    const bf16_t* V; int vpitch;
    float* Of; bf16_t* Ob; int opitch;
    int qrow0;
    int ntiles, nlat, lat_row0, ctx_row0;
    int na_rowlo, na_gr0;
    const float* rpb;
    float lam; const float* subg;
};
__device__ __forceinline__ s16x4 tr_read(const LAS unsigned char* p) { return __builtin_bit_cast(s16x4, __builtin_amdgcn_ds_read_tr16_b64_v4i16((LAS v4i16_t*)p)); }


__device__ __forceinline__ void glds16(const void* gsrc, unsigned lds_dst) { unsigned keep;
    asm volatile("s_mov_b32 %0, m0\n\ts_mov_b32 m0, %2\n\ts_nop 0\n\tglobal_load_lds_dwordx4 %1, off\n\ts_mov_b32 m0, %0" : "=&s"(keep) : "v"(gsrc), "s"(lds_dst) : "memory"); }
template <int NDB>
__device__ __forceinline__ void att_softmax(f32x16& p0, f32x16& p1, f32x16 (&o)[NDB], float& mrun, float& lrun, bool& first, bf16x8 (&pf)[4]) {
    float ra = __builtin_fmaxf(__builtin_fmaxf(p0[0], p0[1]), p1[0]), rb = __builtin_fmaxf(__builtin_fmaxf(p0[2], p0[3]), p1[1]);
    ra = __builtin_fmaxf(__builtin_fmaxf(ra, p1[2]), p1[3]);
#pragma unroll
    for (int r = 4; r < 16; r += 4) { ra = __builtin_fmaxf(__builtin_fmaxf(ra, p0[r]), p0[r + 1]); rb = __builtin_fmaxf(__builtin_fmaxf(rb, p0[r + 2]), p0[r + 3]);
        ra = __builtin_fmaxf(__builtin_fmaxf(ra, p1[r]), p1[r + 1]); rb = __builtin_fmaxf(__builtin_fmaxf(rb, p1[r + 2]), p1[r + 3]); }
    float rm = __builtin_fmaxf(ra, rb);
    { auto rr = __builtin_amdgcn_permlane32_swap(__float_as_uint(rm), __float_as_uint(rm), false, false); rm = __builtin_fmaxf(__uint_as_float(rr[0]), __uint_as_float(rr[1])); }
    if (first || __any(rm > mrun + 8.f)) {
        const float mn = first ? rm : __builtin_fmaxf(mrun, rm);
        if (!first) { const float al = __builtin_amdgcn_exp2f(mrun - mn); lrun *= al;
#pragma unroll
            for (int i = 0; i < NDB; ++i) o[i] *= al; }
        mrun = mn; first = false;
    }
    float ls = 0.f;
#pragma unroll
    for (int r = 0; r < 16; ++r) { p0[r] = __builtin_amdgcn_exp2f(p0[r] - mrun); p1[r] = __builtin_amdgcn_exp2f(p1[r] - mrun); ls += p0[r] + p1[r]; }
    lrun += ls;
#pragma unroll
    for (int j = 0; j < 4; ++j) {
        u32x4 pw;
#pragma unroll
        for (int e = 0; e < 4; ++e) { const int r = 8 * (j & 1) + 2 * e; pw[e] = (j < 2) ? pk2(p0[r], p0[r + 1]) : pk2(p1[r], p1[r + 1]); }
        pf[j] = __builtin_bit_cast(bf16x8, pw);
    }
}
template <int NDB, int VS>
__device__ __forceinline__ void att_pv(f32x16 (&o)[NDB], const bf16x8 (&pf)[4], const LAS unsigned char* vb) {
#pragma unroll
    for (int j = 0; j < 4; ++j)
#pragma unroll
        for (int db = 0; db < NDB; ++db) {
            const s16x4 lo = tr_read(vb + (16 * j) * VS + db * 64), hh = tr_read(vb + (16 * j + 8) * VS + db * 64);
            const bf16x8 vf = (bf16x8){lo[0], lo[1], lo[2], lo[3], hh[0], hh[1], hh[2], hh[3]};
            o[db] = __builtin_amdgcn_mfma_f32_32x32x16_bf16(vf, pf[j], o[db], 0, 0, 0);
        }
}
template <int DQ, int DV, bool NA, int OMODE>
__device__ __forceinline__ void attn_unit(const AttnDesc d, LAS unsigned char* lds) {
    constexpr int KS = DQ * 2 + 16, VS = DV * 2 + 64;
    constexpr int KBUF = NA ? 64 * KS : (8192 + (DQ == 96 ? 4096 : 0)), VBUF = NA ? 64 * VS : 64 * DV * 2;
    constexpr int NBUF = NA ? 2 : 3;
    constexpr int OFF_K = 0, OFF_V = NBUF * KBUF, OFF_RPB = OFF_V + NBUF * VBUF;
    constexpr int NQF = DQ / 16, NDB = DV / 32;
    int tid = threadIdx.x; asm volatile("" : "+v"(tid));
    const int lane = tid & 63, w = __builtin_amdgcn_readfirstlane(tid >> 6), r32 = lane & 31, hi = lane >> 5;
    bf16x8 qf[NQF];
    { const bf16_t* qp = d.Q + (size_t)(d.qrow0 + 32 * w + r32) * d.qpitch + 8 * hi;
#pragma unroll
      for (int d0 = 0; d0 < NQF; ++d0) qf[d0] = *(const bf16x8*)(qp + 16 * d0); }
    LAS float* rpbL = (LAS float*)(lds + OFF_RPB);
    if (NA) { for (int i = tid; i < 465; i += 512) rpbL[i] = d.rpb[i] * LOG2E_; }
    const int kkey = tid >> 3, kch = tid & 7;
    const int k2key = tid >> 2, k2ch = tid & 3;
    u32x4 kA, kB, vA, vB;
#define ATT_TROW(i) ((i) < d.nlat ? d.lat_row0 + 64 * (i) : d.ctx_row0 + 64 * ((i) - d.nlat))
#define ATT_LOAD(i) do { const int tr_ = ATT_TROW(i); \
        kA = *(const u32x4*)(d.K + (size_t)(tr_ + kkey) * d.kpitch + kch * 8); \
        if (DQ == 96) { if (tid < 256) kB = *(const u32x4*)(d.K2 + (size_t)(tr_ + k2key) * d.k2pitch + k2ch * 8); } \
        if (DV == 128) { vA = *(const u32x4*)(d.V + (size_t)(tr_ + (tid >> 4)) * d.vpitch + (tid & 15) * 8); vB = *(const u32x4*)(d.V + (size_t)(tr_ + 32 + (tid >> 4)) * d.vpitch + (tid & 15) * 8); } \
        else { vA = *(const u32x4*)(d.V + (size_t)(tr_ + kkey) * d.vpitch + kch * 8); } } while (0)
#define ATT_STORE(b) do { \
        *(LAS u32x4*)(lds + OFF_K + (b) * KBUF + kkey * KS + kch * 16) = kA; \
        if (DQ == 96) { if (tid < 256) *(LAS u32x4*)(lds + OFF_K + (b) * KBUF + k2key * KS + 128 + k2ch * 16) = kB; } \
        if (DV == 128) { *(LAS u32x4*)(lds + OFF_V + (b) * VBUF + (tid >> 4) * VS + (tid & 15) * 16) = vA; *(LAS u32x4*)(lds + OFF_V + (b) * VBUF + (32 + (tid >> 4)) * VS + (tid & 15) * 16) = vB; } \
        else { *(LAS u32x4*)(lds + OFF_V + (b) * VBUF + kkey * VS + kch * 16) = vA; } } while (0)
    const int nt = d.ntiles;
    const unsigned ldsb = (unsigned)(uintptr_t)lds;
    int gko, gk2o = 0, gvo0, gvo1 = 0;
    { const int kr = 8 * w + (lane >> 3), kc = (lane & 7) ^ ((kr >> 1) & 7); gko = kr * d.kpitch + kc * 8;
      if (DQ == 96) { const int rr = 16 * (w & 3) + (lane >> 2), rc = (lane & 3) ^ ((rr >> 2) & 3); gk2o = rr * d.k2pitch + rc * 8; }
      if (DV == 128) { const int pos = lane & 15, sp = pos >> 2, sub = pos & 3;
          const int r0 = 8 * w + (lane >> 4), r1 = r0 + 4;
          gvo0 = r0 * d.vpitch + ((sp - r0) & 3) * 32 + sub * 8; gvo1 = r1 * d.vpitch + ((sp - r1) & 3) * 32 + sub * 8; }
      else { const int sr = 4 * w + (lane >> 4), pos = lane & 15, sp = pos >> 2, sub = pos & 3, x = (sp - sr) & 3;
          gvo0 = (2 * sr + (x >> 1)) * d.vpitch + (x & 1) * 32 + sub * 8; } }
#define ATT_DMA(i, slot) do { const int tr_ = ATT_TROW(i); \
        glds16(d.K + ((size_t)tr_ * d.kpitch + gko), (unsigned)__builtin_amdgcn_readfirstlane(ldsb + OFF_K + (slot) * KBUF + w * 1024)); \
        if (DQ == 96) { if (w < 4) glds16(d.K2 + ((size_t)tr_ * d.k2pitch + gk2o), (unsigned)__builtin_amdgcn_readfirstlane(ldsb + OFF_K + (slot) * KBUF + 8192 + w * 1024)); } \
        if (DV == 128) { glds16(d.V + ((size_t)tr_ * d.vpitch + gvo0), (unsigned)__builtin_amdgcn_readfirstlane(ldsb + OFF_V + (slot) * VBUF + w * 2048)); \
                         glds16(d.V + ((size_t)tr_ * d.vpitch + gvo1), (unsigned)__builtin_amdgcn_readfirstlane(ldsb + OFF_V + (slot) * VBUF + w * 2048 + 1024)); } \
        else glds16(d.V + ((size_t)tr_ * d.vpitch + gvo0), (unsigned)__builtin_amdgcn_readfirstlane(ldsb + OFF_V + (slot) * VBUF + w * 1024)); } while (0)
    if (NA) { ATT_LOAD(0); ATT_STORE(0); }
    else { ATT_DMA(0, 0); if (nt > 1) ATT_DMA(1, 1); asm volatile("s_waitcnt vmcnt(0)" ::: "memory"); }
    __syncthreads();
    f32x16 o[NDB];
#pragma unroll
    for (int i = 0; i < NDB; ++i) o[i] = (f32x16){};
    float mrun = 0.f, lrun = 0.f; bool first = true;
    const int gr = d.na_gr0 + (w >> 1);
    const int rs_ = gr - 4 < 0 ? 0 : (gr - 4 > 120 ? 120 : gr - 4);
    const int qc = 32 * (w & 1) + r32;
    const int cs_ = qc - 8 < 0 ? 0 : (qc - 8 > 48 ? 48 : qc - 8);
    unsigned namask0 = 0u, namask1 = 0u;
    if (NA) {
#pragma unroll
        for (int r = 0; r < 16; ++r) { const int kc0 = (r & 3) + 8 * (r >> 2) + 4 * hi, kc1 = kc0 + 32;
            namask0 |= (kc0 >= cs_ && kc0 < cs_ + 16) ? (1u << r) : 0u; namask1 |= (kc1 >= cs_ && kc1 < cs_ + 16) ? (1u << r) : 0u; }
    }
    const int koffr = r32 * KS + hi * 16;
    const int voffr = (4 * hi + ((lane & 15) >> 2)) * VS + ((lane >> 4) & 1) * 32 + (lane & 3) * 8;
    int kro[NQF], vro[NDB];
    { const int q_ = (lane & 15) >> 2, gi_ = (lane >> 4) & 1, p_ = lane & 3;
#pragma unroll
      for (int d0 = 0; d0 < NQF; ++d0) kro[d0] = d0 < 4 ? r32 * 128 + (((2 * d0 + hi) ^ ((r32 >> 1) & 7)) << 4) : 8192 + r32 * 64 + (((2 * (d0 - 4) + hi) ^ ((r32 >> 2) & 3)) << 4);
#pragma unroll
      for (int db = 0; db < NDB; ++db) vro[db] = DV == 128 ? (4 * hi + q_) * 256 + (((db + q_) & 3) << 6) + 32 * gi_ + 8 * p_
                                                             : (2 * hi + (q_ >> 1)) * 256 + (((2 * (q_ & 1) + db + 2 * hi + (q_ >> 1)) & 3) << 6) + 32 * gi_ + 8 * p_; }
    constexpr int VJ = DV == 128 ? 4096 : 2048, VE = DV == 128 ? 2048 : 1024;
    if constexpr (!NA) {
        f32x16 pA0, pA1, pB0, pB1; bf16x8 pf[4];
        int bc = 0, bn = 1, bn2 = 2;
#define ATT_BAR() asm volatile("s_waitcnt vmcnt(0) lgkmcnt(0)\n\ts_barrier" ::: "memory")
#define ATT_QK(P0, P1, slot) do { const LAS unsigned char* kb_ = lds + OFF_K + (slot) * KBUF; \
        bf16x8 ka_[NQF], kc_[NQF];       \
        _Pragma("unroll") for (int d0 = 0; d0 < NQF; ++d0) { ka_[d0] = *(const LAS bf16x8*)(kb_ + kro[d0]); kc_[d0] = *(const LAS bf16x8*)(kb_ + kro[d0] + (d0 < 4 ? 4096 : 2048)); } \
        __builtin_amdgcn_sched_barrier(0); \
        _Pragma("unroll") for (int d0 = 0; d0 < NQF; ++d0) { \
            const bf16x8 a0_ = ka_[d0], a1_ = kc_[d0]; \
            if (d0 == 0) { P0 = __builtin_amdgcn_mfma_f32_32x32x16_bf16(a0_, qf[0], (f32x16){}, 0, 0, 0); P1 = __builtin_amdgcn_mfma_f32_32x32x16_bf16(a1_, qf[0], (f32x16){}, 0, 0, 0); } \
            else { P0 = __builtin_amdgcn_mfma_f32_32x32x16_bf16(a0_, qf[d0], P0, 0, 0, 0); P1 = __builtin_amdgcn_mfma_f32_32x32x16_bf16(a1_, qf[d0], P1, 0, 0, 0); } } } while (0)
#define ATT_STEP(C0, C1, N0, N1, tt) do { \
        if ((tt) + 2 < nt) ATT_DMA((tt) + 2, bn2);        \
        if ((tt) + 1 < nt) ATT_QK(N0, N1, bn); \
        s16x4 vlo_[NDB][4], vhh_[NDB][4]; \
        if (DV == 64) { const LAS unsigned char* vb_ = lds + OFF_V + bc * VBUF;     \
            _Pragma("unroll") for (int db = 0; db < NDB; ++db) _Pragma("unroll") for (int j = 0; j < 4; ++j) { vlo_[db][j] = tr_read(vb_ + vro[db] + j * VJ); vhh_[db][j] = tr_read(vb_ + vro[db] + j * VJ + VE); } } \
        att_softmax<NDB>(C0, C1, o, mrun, lrun, first, pf); \
        if (DV == 64) { \
            _Pragma("unroll") for (int j = 0; j < 4; ++j) _Pragma("unroll") for (int db = 0; db < NDB; ++db) { \
                const bf16x8 vf_ = (bf16x8){vlo_[db][j][0], vlo_[db][j][1], vlo_[db][j][2], vlo_[db][j][3], vhh_[db][j][0], vhh_[db][j][1], vhh_[db][j][2], vhh_[db][j][3]}; \
                o[db] = __builtin_amdgcn_mfma_f32_32x32x16_bf16(vf_, pf[j], o[db], 0, 0, 0); } } \
        else { const LAS unsigned char* vb_ = lds + OFF_V + bc * VBUF; \
            _Pragma("unroll") for (int j = 0; j < 4; ++j) _Pragma("unroll") for (int db = 0; db < NDB; ++db) { \
                const s16x4 lo_ = tr_read(vb_ + vro[db] + j * VJ), hh_ = tr_read(vb_ + vro[db] + j * VJ + VE); \
                const bf16x8 vf_ = (bf16x8){lo_[0], lo_[1], lo_[2], lo_[3], hh_[0], hh_[1], hh_[2], hh_[3]}; \
                o[db] = __builtin_amdgcn_mfma_f32_32x32x16_bf16(vf_, pf[j], o[db], 0, 0, 0); } } \
        ATT_BAR(); \
        { const int t_ = bc; bc = bn; bn = bn2; bn2 = t_; } } while (0)
        ATT_QK(pA0, pA1, 0);
        int t = 0;
#pragma nounroll
        for (; t + 1 < nt; t += 2) {
            ATT_STEP(pA0, pA1, pB0, pB1, t);
            ATT_STEP(pB0, pB1, pA0, pA1, t + 1);
        }
        if (t < nt) ATT_STEP(pA0, pA1, pB0, pB1, t);
#undef ATT_STEP
#undef ATT_QK
#undef ATT_BAR
    } else {
#pragma nounroll
    for (int t = 0; t < nt; ++t) {
        const int cur = t & 1;
        if (t + 1 < nt) ATT_LOAD(t + 1);
        bool active = true;
        if (NA) { if (t < d.nlat) { const int krow = d.na_rowlo + t; active = (krow >= rs_) && (krow < rs_ + 8); } }
        if (active) {
            const LAS unsigned char* kb = lds + OFF_K + cur * KBUF + koffr;
            f32x16 p0, p1;
#pragma unroll
            for (int d0 = 0; d0 < NQF; ++d0) {
                const bf16x8 a0 = *(const LAS bf16x8*)(kb + d0 * 32), a1 = *(const LAS bf16x8*)(kb + 32 * KS + d0 * 32);
                if (d0 == 0) { p0 = __builtin_amdgcn_mfma_f32_32x32x16_bf16(a0, qf[0], (f32x16){}, 0, 0, 0); p1 = __builtin_amdgcn_mfma_f32_32x32x16_bf16(a1, qf[0], (f32x16){}, 0, 0, 0); }
                else { p0 = __builtin_amdgcn_mfma_f32_32x32x16_bf16(a0, qf[d0], p0, 0, 0, 0); p1 = __builtin_amdgcn_mfma_f32_32x32x16_bf16(a1, qf[d0], p1, 0, 0, 0); }
            }
            if (NA) { if (t < d.nlat) {
                const int roff = d.na_rowlo + t - gr + 7;
                const LAS float* bp = rpbL + roff * 31 + (4 * hi - qc + 15);
#pragma unroll
                for (int r = 0; r < 16; ++r) {
                    const int c0 = (r & 3) + 8 * (r >> 2);
                    const float b0 = bp[c0], b1 = bp[c0 + 32];
                    p0[r] = ((namask0 >> r) & 1u) ? p0[r] + b0 : -INFINITY;
                    p1[r] = ((namask1 >> r) & 1u) ? p1[r] + b1 : -INFINITY;
                }
            } }
            float ra = __builtin_fmaxf(__builtin_fmaxf(p0[0], p0[1]), p1[0]), rb = __builtin_fmaxf(__builtin_fmaxf(p0[2], p0[3]), p1[1]);
            ra = __builtin_fmaxf(__builtin_fmaxf(ra, p1[2]), p1[3]);
#pragma unroll
            for (int r = 4; r < 16; r += 4) { ra = __builtin_fmaxf(__builtin_fmaxf(ra, p0[r]), p0[r + 1]); rb = __builtin_fmaxf(__builtin_fmaxf(rb, p0[r + 2]), p0[r + 3]);
                ra = __builtin_fmaxf(__builtin_fmaxf(ra, p1[r]), p1[r + 1]); rb = __builtin_fmaxf(__builtin_fmaxf(rb, p1[r + 2]), p1[r + 3]); }
            float rm = __builtin_fmaxf(ra, rb);
            { auto rr = __builtin_amdgcn_permlane32_swap(__float_as_uint(rm), __float_as_uint(rm), false, false); rm = __builtin_fmaxf(__uint_as_float(rr[0]), __uint_as_float(rr[1])); }
            if (first || __any(rm > mrun + 8.f)) {
                const float mn = first ? rm : __builtin_fmaxf(mrun, rm);
                if (!first) { const float al = __builtin_amdgcn_exp2f(mrun - mn); lrun *= al;
#pragma unroll
                    for (int i = 0; i < NDB; ++i) o[i] *= al; }
                mrun = mn; first = false;
            }
            float ls = 0.f;
#pragma unroll
            for (int r = 0; r < 16; ++r) { p0[r] = __builtin_amdgcn_exp2f(p0[r] - mrun); p1[r] = __builtin_amdgcn_exp2f(p1[r] - mrun); ls += p0[r] + p1[r]; }
            lrun += ls;
            bf16x8 pf[4];
#pragma unroll
            for (int j = 0; j < 4; ++j) {
                u32x4 pw;
#pragma unroll
                for (int e = 0; e < 4; ++e) { const int r = 8 * (j & 1) + 2 * e; pw[e] = (j < 2) ? pk2(p0[r], p0[r + 1]) : pk2(p1[r], p1[r + 1]); }
                pf[j] = __builtin_bit_cast(bf16x8, pw);
            }
            const LAS unsigned char* vb = lds + OFF_V + cur * VBUF + voffr;
#pragma unroll
            for (int db = 0; db < NDB; ++db)
#pragma unroll
                for (int j = 0; j < 4; ++j) {
                    const s16x4 lo = tr_read(vb + (16 * j) * VS + db * 64), hh = tr_read(vb + (16 * j + 8) * VS + db * 64);
                    const bf16x8 vf = (bf16x8){lo[0], lo[1], lo[2], lo[3], hh[0], hh[1], hh[2], hh[3]};
                    o[db] = __builtin_amdgcn_mfma_f32_32x32x16_bf16(vf, pf[j], o[db], 0, 0, 0);
                }
        }
        if (t + 1 < nt) ATT_STORE(cur ^ 1);
        __syncthreads();
    }
    }
#undef ATT_TROW
#undef ATT_LOAD
#undef ATT_DMA
#undef ATT_STORE
    lrun += __shfl_xor(lrun, 32);
    const float inv = 1.f / lrun;
    const size_t orow = (size_t)(d.qrow0 + 32 * w + r32) * d.opitch;
    if (OMODE == 2) {
#pragma unroll
        for (int db = 0; db < NDB; ++db)
#pragma unroll
            for (int rg = 0; rg < 4; ++rg)
                *(u32x2*)(d.Ob + orow + 32 * db + 8 * rg + 4 * hi) = (u32x2){pk2(o[db][4 * rg] * inv, o[db][4 * rg + 1] * inv), pk2(o[db][4 * rg + 2] * inv, o[db][4 * rg + 3] * inv)};
    } else if (OMODE == 3) {
        float ss = 0.f;
#pragma unroll
        for (int db = 0; db < NDB; ++db)
#pragma unroll
            for (int rg = 0; rg < 4; ++rg) {
                const u32x2 st = *(const u32x2*)(d.Ob + orow + 32 * db + 8 * rg + 4 * hi);
                const float a1 = __uint_as_float(st[0] << 16), b1 = __uint_as_float(st[0] & 0xffff0000u), c1 = __uint_as_float(st[1] << 16), e1 = __uint_as_float(st[1] & 0xffff0000u);
                const float li = d.lam * inv;
                const float a = a1 - li * o[db][4 * rg], b = b1 - li * o[db][4 * rg + 1], c = c1 - li * o[db][4 * rg + 2], e = e1 - li * o[db][4 * rg + 3];
                o[db][4 * rg] = a; o[db][4 * rg + 1] = b; o[db][4 * rg + 2] = c; o[db][4 * rg + 3] = e;
                ss += (a * a + b * b) + (c * c + e * e);
            }
        ss += __shfl_xor(ss, 32);
        const float rs = (1.f - LAMBDA_INIT) / sqrtf(ss * (1.f / 128.f) + 1e-6f);
#pragma unroll
        for (int db = 0; db < NDB; ++db)
#pragma unroll
            for (int rg = 0; rg < 4; ++rg) {
                const int dc = 32 * db + 8 * rg + 4 * hi;
                const f32x4 g = *(const f32x4*)(d.subg + dc);
                *(u32x2*)(d.Ob + orow + dc) = (u32x2){pk2(o[db][4 * rg] * rs * g[0], o[db][4 * rg + 1] * rs * g[1]), pk2(o[db][4 * rg + 2] * rs * g[2], o[db][4 * rg + 3] * rs * g[3])};
            }
    } else {
#pragma unroll
        for (int db = 0; db < NDB; ++db)
#pragma unroll
            for (int rg = 0; rg < 4; ++rg) {
                const int dc = 32 * db + 8 * rg + 4 * hi;
                const float a = o[db][4 * rg] * inv, b = o[db][4 * rg + 1] * inv, c = o[db][4 * rg + 2] * inv, e = o[db][4 * rg + 3] * inv;
                if (OMODE == 1) *(f32x4*)(d.Of + orow + dc) = (f32x4){a, b, c, e};
                else *(u32x2*)(d.Ob + orow + dc) = (u32x2){pk2(a, b), pk2(c, e)};
            }
    }
}


__device__ __forceinline__ void attn_unit_mla2(const AttnDesc d, LAS unsigned char* lds) {
    constexpr int NQF = 6, NDB = 2, KBUF = 12288, VBUF = 8192, OFF_K = 0, OFF_V = 3 * KBUF, VJ = 2048, VE = 1024;
    int tid = threadIdx.x; asm volatile("" : "+v"(tid));
    const int lane = tid & 63, w = __builtin_amdgcn_readfirstlane(tid >> 6), r32 = lane & 31, hi = lane >> 5;
    bf16x8 qf[2][NQF];
#pragma unroll
    for (int qb = 0; qb < 2; ++qb) { const bf16_t* qp = d.Q + (size_t)(d.qrow0 + 64 * w + 32 * qb + r32) * d.qpitch + 8 * hi;
#pragma unroll
        for (int d0 = 0; d0 < NQF; ++d0) qf[qb][d0] = *(const bf16x8*)(qp + 16 * d0); }
    const unsigned ldsb = (unsigned)(uintptr_t)lds;
    int gko, gk2o, gvo0;
    { const int kr = 8 * w + (lane >> 3), kc = (lane & 7) ^ ((kr >> 1) & 7); gko = kr * d.kpitch + kc * 8;
      const int rr = 16 * (w & 3) + (lane >> 2), rc = (lane & 3) ^ ((rr >> 2) & 3); gk2o = rr * d.k2pitch + rc * 8;
      const int sr = 4 * w + (lane >> 4), pos = lane & 15, sp = pos >> 2, sub = pos & 3, x = (sp - sr) & 3;
      gvo0 = (2 * sr + (x >> 1)) * d.vpitch + (x & 1) * 32 + sub * 8; }
#define M2_TROW(i) ((i) < d.nlat ? d.lat_row0 + 64 * (i) : d.ctx_row0 + 64 * ((i) - d.nlat))
#define M2_DMA(i, slot) do { const int tr_ = M2_TROW(i); \
        glds16(d.K + ((size_t)tr_ * d.kpitch + gko), (unsigned)__builtin_amdgcn_readfirstlane(ldsb + OFF_K + (slot) * KBUF + w * 1024)); \
        if (w < 4) glds16(d.K2 + ((size_t)tr_ * d.k2pitch + gk2o), (unsigned)__builtin_amdgcn_readfirstlane(ldsb + OFF_K + (slot) * KBUF + 8192 + w * 1024)); \
        glds16(d.V + ((size_t)tr_ * d.vpitch + gvo0), (unsigned)__builtin_amdgcn_readfirstlane(ldsb + OFF_V + (slot) * VBUF + w * 1024)); } while (0)
    const int nt = d.ntiles;
    M2_DMA(0, 0); if (nt > 1) M2_DMA(1, 1);
    asm volatile("s_waitcnt vmcnt(0)" ::: "memory");
    __syncthreads();
    int kro[NQF], vro[NDB];
    { const int q_ = (lane & 15) >> 2, gi_ = (lane >> 4) & 1, p_ = lane & 3;
#pragma unroll
      for (int d0 = 0; d0 < NQF; ++d0) kro[d0] = d0 < 4 ? r32 * 128 + (((2 * d0 + hi) ^ ((r32 >> 1) & 7)) << 4) : 8192 + r32 * 64 + (((2 * (d0 - 4) + hi) ^ ((r32 >> 2) & 3)) << 4);
#pragma unroll
      for (int db = 0; db < NDB; ++db) vro[db] = (2 * hi + (q_ >> 1)) * 256 + (((2 * (q_ & 1) + db + 2 * hi + (q_ >> 1)) & 3) << 6) + 32 * gi_ + 8 * p_; }
    f32x16 o0[NDB], o1[NDB];
#pragma unroll
    for (int i = 0; i < NDB; ++i) { o0[i] = (f32x16){}; o1[i] = (f32x16){}; }
    float m0 = 0.f, l0 = 0.f, m1 = 0.f, l1 = 0.f; bool f0 = true, f1 = true;
    int bc = 0, bn2 = 2;
#pragma nounroll
    for (int t = 0; t < nt; ++t) {
        if (t + 2 < nt) M2_DMA(t + 2, bn2);
        const LAS unsigned char* kb_ = lds + OFF_K + bc * KBUF;
        bf16x8 ka_[NQF], kc_[NQF];
#pragma unroll
        for (int d0 = 0; d0 < NQF; ++d0) { ka_[d0] = *(const LAS bf16x8*)(kb_ + kro[d0]); kc_[d0] = *(const LAS bf16x8*)(kb_ + kro[d0] + (d0 < 4 ? 4096 : 2048)); }
        __builtin_amdgcn_sched_barrier(0);
        f32x16 pa0, pa1, pb0, pb1;
#pragma unroll
        for (int d0 = 0; d0 < NQF; ++d0) {
            if (d0 == 0) { pa0 = __builtin_amdgcn_mfma_f32_32x32x16_bf16(ka_[0], qf[0][0], (f32x16){}, 0, 0, 0); pa1 = __builtin_amdgcn_mfma_f32_32x32x16_bf16(kc_[0], qf[0][0], (f32x16){}, 0, 0, 0);
                           pb0 = __builtin_amdgcn_mfma_f32_32x32x16_bf16(ka_[0], qf[1][0], (f32x16){}, 0, 0, 0); pb1 = __builtin_amdgcn_mfma_f32_32x32x16_bf16(kc_[0], qf[1][0], (f32x16){}, 0, 0, 0); }
            else { pa0 = __builtin_amdgcn_mfma_f32_32x32x16_bf16(ka_[d0], qf[0][d0], pa0, 0, 0, 0); pa1 = __builtin_amdgcn_mfma_f32_32x32x16_bf16(kc_[d0], qf[0][d0], pa1, 0, 0, 0);
                   pb0 = __builtin_amdgcn_mfma_f32_32x32x16_bf16(ka_[d0], qf[1][d0], pb0, 0, 0, 0); pb1 = __builtin_amdgcn_mfma_f32_32x32x16_bf16(kc_[d0], qf[1][d0], pb1, 0, 0, 0); }
        }
        s16x4 vlo_[NDB][4], vhh_[NDB][4];
        { const LAS unsigned char* vb_ = lds + OFF_V + bc * VBUF;
#pragma unroll
          for (int db = 0; db < NDB; ++db)
#pragma unroll
            for (int j = 0; j < 4; ++j) { vlo_[db][j] = tr_read(vb_ + vro[db] + j * VJ); vhh_[db][j] = tr_read(vb_ + vro[db] + j * VJ + VE); } }
        bf16x8 pf0[4], pf1[4];
        att_softmax<NDB>(pa0, pa1, o0, m0, l0, f0, pf0);
        att_softmax<NDB>(pb0, pb1, o1, m1, l1, f1, pf1);
#pragma unroll
        for (int j = 0; j < 4; ++j)
#pragma unroll
            for (int db = 0; db < NDB; ++db) {
                const bf16x8 vf_ = (bf16x8){vlo_[db][j][0], vlo_[db][j][1], vlo_[db][j][2], vlo_[db][j][3], vhh_[db][j][0], vhh_[db][j][1], vhh_[db][j][2], vhh_[db][j][3]};
                o0[db] = __builtin_amdgcn_mfma_f32_32x32x16_bf16(vf_, pf0[j], o0[db], 0, 0, 0);
                o1[db] = __builtin_amdgcn_mfma_f32_32x32x16_bf16(vf_, pf1[j], o1[db], 0, 0, 0);
            }
        asm volatile("s_waitcnt vmcnt(0) lgkmcnt(0)\n\ts_barrier" ::: "memory");
        bc = bc == 2 ? 0 : bc + 1; bn2 = bn2 == 2 ? 0 : bn2 + 1;
    }
#undef M2_DMA
#undef M2_TROW
    l0 += __shfl_xor(l0, 32); l1 += __shfl_xor(l1, 32);
    const float inv0 = 1.f / l0, inv1 = 1.f / l1;
#pragma unroll
    for (int qb = 0; qb < 2; ++qb) {
        const size_t orow = (size_t)(d.qrow0 + 64 * w + 32 * qb + r32) * d.opitch; const float inv = qb ? inv1 : inv0;
#pragma unroll
        for (int db = 0; db < NDB; ++db)
#pragma unroll
            for (int rg = 0; rg < 4; ++rg) { const int dc = 32 * db + 8 * rg + 4 * hi;
                const f32x16& oo = qb ? o1[db] : o0[db];
                *(u32x2*)(d.Ob + orow + dc) = (u32x2){pk2(oo[4 * rg] * inv, oo[4 * rg + 1] * inv), pk2(oo[4 * rg + 2] * inv, oo[4 * rg + 3] * inv)}; }
    }
}

__device__ __forceinline__ void p0_item(const float* W, int K, int N, bf16_t* WT, int mode, const float* ksc, LAS float* scr, int item, int lane) {
    const int nblk = N / 32, kb = item / nblk, nb = item % nblk, k0 = 64 * kb, n0 = 32 * nb;
#pragma unroll 8
    for (int i = 0; i < 32; ++i) { const int kk = 2 * i + (lane >> 5); float v = W[(size_t)(k0 + kk) * N + n0 + (lane & 31)]; if (ksc) v *= ksc[k0 + kk]; scr[kk * 33 + (lane & 31)] = v; }
    asm volatile("s_waitcnt lgkmcnt(0)" ::: "memory");
    int nd0 = n0;
    if (mode == 1) { nd0 = (n0 < FH) ? (n0 / 128) * 256 + (n0 % 128) : ((n0 - FH) / 128) * 256 + 128 + ((n0 - FH) % 128); }
    else if (mode == 2) { nd0 = (n0 < 672) ? n0 : n0 + 96; }
    const int c = lane & 7;
#pragma unroll
    for (int j = 0; j < 4; ++j) { const int n = (lane >> 3) + 8 * j; const LAS float* s = scr + (8 * c) * 33 + n;
        u32x4 o; o.x = pk2(s[0 * 33], s[1 * 33]); o.y = pk2(s[2 * 33], s[3 * 33]); o.z = pk2(s[4 * 33], s[5 * 33]); o.w = pk2(s[6 * 33], s[7 * 33]);
        *(u32x4*)(WT + (size_t)(nd0 + n) * K + k0 + 8 * c) = o; }
    asm volatile("s_waitcnt lgkmcnt(0)" ::: "memory");
}
__device__ __forceinline__ void sincos_small(float af, float& s, float& c) {
    const double a = (double)af; const double k = rint(a * 0.6366197723675814); const double r = a - k * 1.5707963267948966;
    const double r2 = r * r;
    const double sp = r * (1.0 + r2 * (-1.0 / 6 + r2 * (1.0 / 120 + r2 * (-1.0 / 5040 + r2 * (1.0 / 362880 + r2 * (-1.0 / 39916800 + r2 * (1.0 / 6227020800.0)))))));
    const double cp = 1.0 + r2 * (-0.5 + r2 * (1.0 / 24 + r2 * (-1.0 / 720 + r2 * (1.0 / 40320 + r2 * (-1.0 / 3628800 + r2 * (1.0 / 479001600.0))))));
    const int q = ((int)k) & 3;
    const double ss = (q == 0) ? sp : (q == 1) ? cp : (q == 2) ? -sp : -cp;
    const double cc = (q == 0) ? cp : (q == 1) ? -sp : (q == 2) ? -cp : sp;
    s = (float)ss; c = (float)cc;
}

#define XB_TMO      128
#define XB_XCNT(j)  (256  + 64 * (j))
#define XB_XSUB(j)  (1280 + 64 * (j))
#define XB_XGEN(j)  (2304 + 64 * (j))
#define XB_TOP      3328
#define XB_TOPGEN   3392
#define XCD_BAR_WORDS 3456
#define XB_SPIN_CAP (1u << 18)

__device__ __forceinline__ unsigned xb_ld(unsigned* p)              { return __hip_atomic_load(p, __ATOMIC_RELAXED, __HIP_MEMORY_SCOPE_AGENT); }
__device__ __forceinline__ unsigned xb_add(unsigned* p, unsigned v) { return __hip_atomic_fetch_add(p, v, __ATOMIC_RELAXED, __HIP_MEMORY_SCOPE_AGENT); }
__device__ __forceinline__ unsigned xb_xcc_id() { return (unsigned)__builtin_amdgcn_s_getreg((3 << 11) | 20) & 0xFu; }
#define XB_SPIN(cond, bar) do { unsigned _sp = 0; while (cond) { __builtin_amdgcn_s_sleep(1); \
    if ((++_sp & 255u) == 0u) { if (xb_ld(&(bar)[XB_TMO])) break; if (_sp > XB_SPIN_CAP) { atomicAdd(&(bar)[XB_TMO], 1u); break; } } } } while (0)

struct XcdBarrier {
    unsigned* bar; unsigned x;
    volatile LAS unsigned* st;
};

__device__ __forceinline__ XcdBarrier xcd_barrier_post(unsigned* bar, volatile LAS unsigned* st) {
    XcdBarrier b; b.bar = bar; b.x = xb_xcc_id(); b.st = st;
    if (threadIdx.x == 0) (void)xb_add(&bar[XB_XCNT(b.x)], 1u);
    return b;
}
__device__ __forceinline__ void xcd_barrier_complete(unsigned* bar, unsigned x, unsigned& nloc, unsigned& nx) {
    const unsigned G = gridDim.x * gridDim.y * gridDim.z;
    unsigned sum, cnt, mine, sp = 0u;
    for (;;) {
        sum = 0u; cnt = 0u; mine = 0u;
#pragma unroll
        for (unsigned j = 0; j < 16; ++j) { const unsigned c = xb_ld(&bar[XB_XCNT(j)]); sum += c; cnt += (c > 0u) ? 1u : 0u; mine = (j == x) ? c : mine; }
        if (sum == G) break;
        __builtin_amdgcn_s_sleep(1);
        if ((++sp & 255u) == 0u) { if (xb_ld(&bar[XB_TMO])) break; if (sp > XB_SPIN_CAP) { atomicAdd(&bar[XB_TMO], 1u); break; } }
    }
    nloc = mine > 0u ? mine : 1u; nx = cnt > 0u ? cnt : 1u;
}

__device__ __forceinline__ void xcd_barrier(const XcdBarrier& b) {
    asm volatile("s_waitcnt vmcnt(0)" ::: "memory");
    __syncthreads();
    if (threadIdx.x == 0) {
        unsigned* bar = b.bar;
        __builtin_amdgcn_s_waitcnt(0);
        unsigned nloc = b.st[0], nx = b.st[1];
        if (nloc == 0u) { xcd_barrier_complete(bar, b.x, nloc, nx); b.st[0] = nloc; b.st[1] = nx; }
        const unsigned old = xb_add(&bar[XB_XSUB(b.x)], 1u);
        const unsigned gen = old / nloc;
        if (old + 1u == (gen + 1u) * nloc) {
            __builtin_amdgcn_fence(__ATOMIC_RELEASE, "agent");
            asm volatile("s_waitcnt vmcnt(0)" ::: "memory");
            const unsigned og = xb_add(&bar[XB_TOP], 1u);
            const unsigned tg = og / nx;
            if (og + 1u == (tg + 1u) * nx) xb_add(&bar[XB_TOPGEN], 1u);
            else XB_SPIN(xb_ld(&bar[XB_TOPGEN]) == tg, bar);
            __builtin_amdgcn_fence(__ATOMIC_ACQUIRE, "agent");
            xb_add(&bar[XB_XGEN(b.x)], 1u);
            asm volatile("s_waitcnt vmcnt(0)" ::: "memory");
        } else {
            XB_SPIN(xb_ld(&bar[XB_XGEN(b.x)]) == gen, bar);
            __builtin_amdgcn_fence(__ATOMIC_ACQUIRE, "agent");
            asm volatile("s_waitcnt vmcnt(0)" ::: "memory");
        }
    }
    __syncthreads();
}

struct Params {
    const float *x, *c, *ctx, *c_ctx, *mod_w, *mod_b, *ln_mix_g, *ln_mix_b, *ln_ffn_g, *ln_ffn_b, *ffn_w_in, *ffn_w_out, *ev_w_in, *ev_w_out,
        *diff_lambda, *diff_subln_g, *na_rpb, *od_w_in, *od_w_out, *mla_q_norm_g, *mla_w_uq, *mla_kv_norm_g, *mla_w_ukv, *gmlp_ln_g, *gmlp_ln_b, *gmlp_ws, *gmlp_b;
    float* out; unsigned char* ws; int lo, hi;
};

__device__ __forceinline__ void ln_rows(float* Z, float* dst, const float* g, const float* b, bf16_t* U, const float* modl, int kmod, int nrows, int gw, int ngw, int lane) {
    for (int row = gw; row < nrows; row += ngw) {
        const f32x4* zr = (const f32x4*)(Z + (size_t)row * DM) + lane;
        f32x4 v[4]; float s = 0.f;
#pragma unroll
        for (int j = 0; j < 4; ++j) { v[j] = zr[64 * j]; s += (v[j][0] + v[j][1]) + (v[j][2] + v[j][3]); }
        const float mean = wave_sum(s) * (1.f / DM); float s2 = 0.f;
#pragma unroll
        for (int j = 0; j < 4; ++j) { v[j] = v[j] - mean; s2 += (v[j][0] * v[j][0] + v[j][1] * v[j][1]) + (v[j][2] * v[j][2] + v[j][3] * v[j][3]); }
        const float rstd = 1.f / sqrtf(wave_sum(s2) * (1.f / DM) + 1e-5f);
        const int set = row < 8192 ? 0 : (row < ML ? 1 : 2);
        const float* mp = modl ? modl + set * 6144 + kmod * 1024 : nullptr;
#pragma unroll
        for (int j = 0; j < 4; ++j) {
            const int col = 256 * j + 4 * lane;
            const f32x4 gg = *(const f32x4*)(g + col), bb = *(const f32x4*)(b + col);
            const f32x4 h = v[j] * rstd * gg + bb;
            *(f32x4*)(dst + (size_t)row * DM + col) = h;
            if (U) { const f32x4 sh = *(const f32x4*)(mp + col), sc = *(const f32x4*)(mp + 1024 + col);
                const f32x4 uu = h * (sc + 1.f) + sh;
                *(u32x2*)(U + (size_t)row * DM + col) = (u32x2){pk2(uu[0], uu[1]), pk2(uu[2], uu[3])}; }
        }
    }
}

typedef const __attribute__((address_space(4))) Params* kparams_t;
__device__ __forceinline__ kparams_t kparams() { kparams_t q = (kparams_t)__builtin_amdgcn_kernarg_segment_ptr(); asm volatile("" : "+s"(q)); return q; }
constexpr int NPHASE = 18;
constexpr int LDS_BYTES = 147456;

__global__ void __launch_bounds__(512) dit_fwd(Params p) {
    extern __shared__ __attribute__((aligned(16))) unsigned char lds_raw[];
    LAS unsigned char* lds = (LAS unsigned char*)lds_raw;
    const int G = gridDim.x, blk = blockIdx.x;
    const int tid = threadIdx.x, lane = tid & 63, wave = __builtin_amdgcn_readfirstlane(tid >> 6);
    const int gw = blk * 8 + wave, ngw = G * 8;
    const int gtid = blk * 512 + tid, ngt = G * 512;
#define Wevin ((bf16_t*)(ws + O_EVIN))
#define Wevout ((bf16_t*)(ws + O_EVOUT))
#define Wffin0 ((bf16_t*)(ws + O_FFIN0))
#define Wffout0 ((bf16_t*)(ws + O_FFOUT0))
#define Wffin1 ((bf16_t*)(ws + O_FFIN1))
#define Wffout1 ((bf16_t*)(ws + O_FFOUT1))
#define Wodin ((bf16_t*)(ws + O_ODIN))
#define Wodout ((bf16_t*)(ws + O_ODOUT))
#define Wuq ((bf16_t*)(ws + O_UQ))
#define Wukv ((bf16_t*)(ws + O_UKV))
#define Gws ((bf16_t*)(ws + O_GWS))
#define mod ((float*)(ws + O_MOD))
#define tab32 ((float*)(ws + O_TAB32))
#define tab16 ((float*)(ws + O_TAB16))
#define P ((bf16_t*)(ws + O_P))
#define H ((float*)(ws + O_H))
#define Hb ((bf16_t*)(ws + O_H))
#define U ((bf16_t*)(ws + O_U))
#define Odiff ((float*)(ws + O_ODIFF))
#define AMIX0 ((bf16_t*)(ws + O_AMIX0))
#define ACT ((bf16_t*)(ws + O_ACT))
#define P1 ((bf16_t*)(ws + O_P1))
#define AMIX1 ((bf16_t*)(ws + O_AMIX1))
#define stats ((float*)(ws + O_STATS))
#define KV1 ((bf16_t*)(ws + O_KV1))
#define Q1 ((bf16_t*)(ws + O_Q1))
#define PHASE_BEGIN kparams_t q = kparams(); unsigned char* ws = q->ws;
    const int lo = p.lo, hi = p.hi;
    volatile LAS unsigned* xst = (volatile LAS unsigned*)(lds + 131072 + 64);
    if (tid < 2) xst[tid] = 0u;
    __syncthreads();
    XcdBarrier xbar = xcd_barrier_post((unsigned*)(p.ws + O_BAR), xst);
    if (p.hi > 1000) cg::this_grid().sync();
#ifndef PH_MASK
#define PH_MASK 0x3ffff
#endif
#define IN(k) ((((PH_MASK) >> (k)) & 1) && lo <= (k) && (k) < hi)
#define SEAM(k) do { if (hi - lo > 1) xcd_barrier(xbar); } while (0)

    if (IN(0)) { PHASE_BEGIN
        if (blk < 96) {
            LAS float* sl = (LAS float*)lds;
            for (int i = tid; i < 3072; i += 512) { const int set = i >> 10, k = i & 1023; const float cv = set == 0 ? q->c[k] : (set == 1 ? q->c[1024 + k] : q->c_ctx[k]); sl[i] = cv / (1.f + __expf(-cv)); }
            __syncthreads();
            const int layer = blk / 48, chunk = blk % 48;
            const float* W = q->mod_w + (size_t)layer * 1024 * 6144 + chunk * 128 + 2 * lane;
            float a00 = 0.f, a01 = 0.f, a10 = 0.f, a11 = 0.f, a20 = 0.f, a21 = 0.f;
#pragma unroll 16
            for (int k = 128 * wave; k < 128 * wave + 128; ++k) { const f32x2v wv = *(const f32x2v*)(W + (size_t)k * 6144);
                const float s0 = sl[k], s1 = sl[1024 + k], s2 = sl[2048 + k];
                a00 += s0 * wv[0]; a01 += s0 * wv[1]; a10 += s1 * wv[0]; a11 += s1 * wv[1]; a20 += s2 * wv[0]; a21 += s2 * wv[1]; }
            LAS float* red = sl + 3072;
            red[(wave * 3 + 0) * 128 + 2 * lane] = a00; red[(wave * 3 + 0) * 128 + 2 * lane + 1] = a01;
            red[(wave * 3 + 1) * 128 + 2 * lane] = a10; red[(wave * 3 + 1) * 128 + 2 * lane + 1] = a11;
            red[(wave * 3 + 2) * 128 + 2 * lane] = a20; red[(wave * 3 + 2) * 128 + 2 * lane + 1] = a21;
            __syncthreads();
            if (tid < 384) { const int s = tid >> 7, n = tid & 127; float acc = q->mod_b[layer * 6144 + chunk * 128 + n];
#pragma unroll
                for (int w8 = 0; w8 < 8; ++w8) acc += red[(w8 * 3 + s) * 128 + n];
                mod[(layer * 3 + s) * 6144 + chunk * 128 + n] = acc; }
            __syncthreads();
        } else if (blk == 96) {
            for (int i = tid; i < 3072; i += 512) {
                if (i < 2048) { const int pos = i >> 4, f = i & 15; const float inv = exp2f(-(float)f * (13.287712379549449f / 16.f)); float s, c; sincos_small((float)pos * inv, s, c); tab32[2 * i] = c; tab32[2 * i + 1] = s; }
                else { const int j = i - 2048, pos = j >> 3, f = j & 7; const float inv = exp2f(-(float)f * (13.287712379549449f / 8.f)); float s, c; sincos_small((float)pos * inv, s, c); tab16[2 * j] = c; tab16[2 * j + 1] = s; }
            }
        }
        {
            LAS float* scr = (LAS float*)(lds + wave * 16384);
            constexpr int I0 = 16 * 96, I1 = 16 * 32, I2 = 16 * 176, I3 = 44 * 32, I4 = 16 * 53, I5 = 16 * 32, I6 = 6 * 24, I7 = 4 * 32;
            for (int it = gw; it < I0; it += ngw) p0_item(q->ev_w_in, 1024, 3072, Wevin, 0, nullptr, scr, it, lane);
            for (int i = gtid; i < 65536; i += ngt) Gws[i] = (bf16_t)f2bf(q->gmlp_ws[i]);
            for (int i = gtid; i < 96 * 1024 / 2; i += ngt) ((unsigned*)(Wodin + (size_t)672 * 1024))[i] = 0u;
        }
    }
    SEAM(0);
    if (IN(1)) { PHASE_BEGIN
        for (int idx = gtid; idx < MT * 128; idx += ngt) {
            const int row = idx >> 7, c8 = (idx & 127) * 8;
            const float* src = row < ML ? q->x + (size_t)row * DM : q->ctx + (size_t)(row - ML) * DM;
            const int set = row < 8192 ? 0 : (row < ML ? 1 : 2);
            const float* mp = mod + set * 6144;
            const f32x4 v0 = *(const f32x4*)(src + c8), v1 = *(const f32x4*)(src + c8 + 4);
            const f32x4 sh0 = *(const f32x4*)(mp + c8), sh1 = *(const f32x4*)(mp + c8 + 4), sc0 = *(const f32x4*)(mp + 1024 + c8), sc1 = *(const f32x4*)(mp + 1024 + c8 + 4);
            const f32x4 u0 = v0 * (sc0 + 1.f) + sh0, u1 = v1 * (sc1 + 1.f) + sh1;
            *(u32x4*)(U + (size_t)row * DM + c8) = (u32x4){pk2(u0[0], u0[1]), pk2(u0[2], u0[3]), pk2(u1[0], u1[1]), pk2(u1[2], u1[3])};
        }
    }
    SEAM(1);
    if (IN(2)) { PHASE_BEGIN
        pg8::Gemm g{U, Wevin, MT, PW0, 1024, 1024, 1024}; pg8::StaticOrder S; S.init(MT, PW0, G, blk);
        EpiIn0 E{P, tab32};
        pg8::gemm_phase<EpiIn0, pg8::StaticOrder, true, true>(lds, g, S, E);
        if (blk >= 24) {
            LAS float* scr = (LAS float*)(lds + wave * 16384);
            constexpr int I1 = 16 * 32, I2 = 16 * 176, I3 = 44 * 32, I4 = 16 * 53, I5 = 16 * 32, I6 = 6 * 24, I7 = 4 * 32;
            constexpr int NIT = I1 + 2 * I2 + 2 * I3 + I4 + I5 + I6 + I7;
            for (int it = (blk - 24) * 8 + wave; it < NIT; it += (G - 24) * 8) {
                int r = it;
                if (r < I1) { p0_item(q->ev_w_out, 1024, 1024, Wevout, 0, nullptr, scr, r, lane); continue; } r -= I1;
                if (r < I2) { p0_item(q->ffn_w_in, 1024, 5632, Wffin0, 1, nullptr, scr, r, lane); continue; } r -= I2;
                if (r < I2) { p0_item(q->ffn_w_in + (size_t)1024 * 5632, 1024, 5632, Wffin1, 1, nullptr, scr, r, lane); continue; } r -= I2;
                if (r < I3) { p0_item(q->ffn_w_out, 2816, 1024, Wffout0, 0, nullptr, scr, r, lane); continue; } r -= I3;
                if (r < I3) { p0_item(q->ffn_w_out + (size_t)2816 * 1024, 2816, 1024, Wffout1, 0, nullptr, scr, r, lane); continue; } r -= I3;
                if (r < I4) { p0_item(q->od_w_in, 1024, 1696, Wodin, 2, nullptr, scr, r, lane); continue; } r -= I4;
                if (r < I5) { p0_item(q->od_w_out, 1024, 1024, Wodout, 0, nullptr, scr, r, lane); continue; } r -= I5;
                if (r < I6) { p0_item(q->mla_w_uq, 384, 768, Wuq, 0, q->mla_q_norm_g, scr, r, lane); continue; } r -= I6;
                p0_item(q->mla_w_ukv, 256, 1024, Wukv, 0, q->mla_kv_norm_g, scr, r, lane);
            }
        }
    }
    SEAM(2);
    if (IN(3)) { PHASE_BEGIN
        const int xcd = blk & 7, idx = blk >> 3;
        float lam;
        { const float a = q->diff_lambda[lane] * q->diff_lambda[64 + lane], b2 = q->diff_lambda[128 + lane] * q->diff_lambda[192 + lane];
          lam = __expf(wave_sum(a)) - __expf(wave_sum(b2)) + LAMBDA_INIT; }
        {
            const int b = xcd >> 2, h = xcd & 3, qb = idx;
            AttnDesc d{};
            d.qpitch = PW0; d.kpitch = PW0; d.vpitch = PW0; d.V = P + 1024 + h * 128;
            d.Ob = AMIX0 + h * 128; d.opitch = 1024; d.lam = lam; d.subg = q->diff_subln_g;
            d.qrow0 = b * SEQ_ + qb * 256; d.ntiles = 132; d.nlat = 128; d.lat_row0 = b * SEQ_; d.ctx_row0 = ML + b * 256;
            d.Q = P + h * 128; d.K = P + 512 + h * 128;
            attn_unit<64, 128, false, 2>(d, lds);
            d.Q = P + h * 128 + 64; d.K = P + 512 + h * 128 + 64;
            attn_unit<64, 128, false, 3>(d, lds);
        }
        for (int i = 0; i < 2; ++i) {
            const int combo = i * 8 + xcd, rb = idx;
            if (idx >= 32) break;
            const int b = combo >> 3, h = combo & 7;
            int rowlo = 4 * rb - 4; rowlo = rowlo < 0 ? 0 : (rowlo > 120 ? 120 : rowlo);
            int nrt = 128 - rowlo; nrt = nrt > 11 ? 11 : nrt;
            AttnDesc d{};
            d.Q = P + 1536 + h * 64; d.qpitch = PW0; d.K = P + 2048 + h * 64; d.kpitch = PW0; d.V = P + 2560 + h * 64; d.vpitch = PW0;
            d.Of = nullptr; d.Ob = AMIX0 + 512 + h * 64; d.opitch = 1024;
            d.qrow0 = b * SEQ_ + rb * 256; d.ntiles = nrt + 4; d.nlat = nrt; d.lat_row0 = b * SEQ_ + rowlo * 64; d.ctx_row0 = ML + b * 256;
            d.na_rowlo = rowlo; d.na_gr0 = 4 * rb; d.rpb = q->na_rpb + h * 465;
            attn_unit<64, 64, true, 0>(d, lds);
        }
        if (blk < 8) {
            const int b = blk >> 2, h = blk & 3;
            AttnDesc d{};
            d.qpitch = PW0; d.kpitch = PW0; d.vpitch = PW0; d.V = P + 1024 + h * 128;
            d.Ob = AMIX0 + h * 128; d.opitch = 1024; d.lam = lam; d.subg = q->diff_subln_g;
            d.qrow0 = ML + b * 256; d.ntiles = 4; d.nlat = 0; d.lat_row0 = 0; d.ctx_row0 = ML + b * 256;
            d.Q = P + h * 128; d.K = P + 512 + h * 128;
            attn_unit<64, 128, false, 2>(d, lds);
            d.Q = P + h * 128 + 64; d.K = P + 512 + h * 128 + 64;
            attn_unit<64, 128, false, 3>(d, lds);
        } else if (blk >= 16 && blk < 32) {
            const int b = (blk - 16) >> 3, h = (blk - 16) & 7;
            AttnDesc d{};
            d.Q = P + 1536 + h * 64; d.qpitch = PW0; d.K = P + 2048 + h * 64; d.kpitch = PW0; d.V = P + 2560 + h * 64; d.vpitch = PW0;
            d.Ob = AMIX0 + 512 + h * 64; d.opitch = 1024;
            d.qrow0 = ML + b * 256; d.ntiles = 4; d.nlat = 0; d.lat_row0 = 0; d.ctx_row0 = ML + b * 256;
            attn_unit<64, 64, false, 0>(d, lds);
        }
    }
    SEAM(3);
    if (IN(5)) { PHASE_BEGIN
        { pg8::Gemm g{AMIX0, Wevout, ML, 1024, 1024, 1024, 1024}; PanelOrder S; S.init(ML, blk);
          EpiResLN<false, true> E{q->x, q->ctx, mod + 2 * 1024, (unsigned*)(ws + O_CNT), (unsigned long long*)(ws + O_SLOT0), q->ln_mix_g, q->ln_mix_b, H, U, mod, 3, nullptr, nullptr, 0};
          pg8::gemm_phase<EpiResLN<false, true>, PanelOrder, true, true>(lds, g, S, E); }
        { const int part = blk & 3, k0 = part * 256;
          pg8::Gemm g{AMIX0 + k0, Wevout + k0, MT, 1024, 256, 1024, 1024}; TailOrder S{blk};
          EpiResLN<false, true> E{q->x, q->ctx, mod + 2 * 1024, (unsigned*)(ws + O_CNT), (unsigned long long*)(ws + O_SLOT0), q->ln_mix_g, q->ln_mix_b, H, U, mod, 3, (float*)(ws + O_P), (unsigned*)(ws + O_PCNT), part};
          pg8::gemm_phase<EpiResLN<false, true>, TailOrder, true, true>(lds, g, S, E); }
    }
    SEAM(5);
    if (IN(7)) { PHASE_BEGIN
        pg8::Gemm g{U, Wffin0, MT, 5632, 1024, 1024, 1024}; pg8::StaticOrder S; S.init(MT, 5632, G, blk);
        EpiFfn E{ACT};
        pg8::gemm_phase<EpiFfn, pg8::StaticOrder, true, true>(lds, g, S, E);
    }
    SEAM(7);
    if (IN(8)) { PHASE_BEGIN
        { pg8::Gemm g{ACT, Wffout0, ML, 1024, FH, FH, FH}; PanelOrder S; S.init(ML, blk);
          EpiResLN<true, true> E{Hb, Hb + (size_t)ML * DM, mod + 5 * 1024, (unsigned*)(ws + O_CNT) + 66 * 64, (unsigned long long*)(ws + O_SLOT1), q->ln_ffn_g, q->ln_ffn_b, Hb, U, mod + 3 * 6144, 0, nullptr, nullptr, 0};
          pg8::gemm_phase<EpiResLN<true, true>, PanelOrder, true, true>(lds, g, S, E); }
        { const int part = blk & 3, k0 = part < 2 ? part * 768 : 1536 + (part - 2) * 640, kl = part < 2 ? 768 : 640;
          pg8::Gemm g{ACT + k0, Wffout0 + k0, MT, 1024, kl, FH, FH}; TailOrder S{blk};
          EpiResLN<true, true> E{Hb, Hb + (size_t)ML * DM, mod + 5 * 1024, (unsigned*)(ws + O_CNT) + 66 * 64, (unsigned long long*)(ws + O_SLOT1), q->ln_ffn_g, q->ln_ffn_b, Hb, U, mod + 3 * 6144, 0, (float*)(ws + O_SLOT2), (unsigned*)(ws + O_PCNT) + 8 * 64, part};
          pg8::gemm_phase<EpiResLN<true, true>, TailOrder, true, true>(lds, g, S, E); }
    }
    SEAM(8);
    if (IN(10)) { PHASE_BEGIN
        pg8::Gemm g{U, Wodin, MT, PW1, 1024, 1024, 1024}; pg8::StaticOrder S; S.init(MT, PW1, G, blk);
        EpiIn1 E{P1, stats, tab16};
        pg8::gemm_phase<EpiIn1, pg8::StaticOrder, true, true>(lds, g, S, E);
    }
    SEAM(10);
    if (IN(11)) { PHASE_BEGIN
#ifndef NO_Q
        { pg8::Gemm g{P1, Wuq, ML, 768, 384, PW1, 384}; pg8::StaticOrder S; S.init(ML, 768, G, blk);
          EpiQ1 E{Q1, stats, tab16};
          pg8::gemm_phase<EpiQ1, pg8::StaticOrder, true, true>(lds, g, S, E); }
#endif
#ifndef NO_KV
        { pg8::Gemm g{P1 + 384, Wukv, MT, 1024, 256, PW1, 256}; pg8::StaticOrder S; S.init(MT, 1024, G, (blk + 64) & 255);
          EpiKV1 E{KV1, stats};
          pg8::gemm_phase<EpiKV1, pg8::StaticOrder, true, true>(lds, g, S, E); }
#endif
#ifndef NO_GMLP
        const int gm_n = blk >= 192 ? 3 : (blk < 128 ? 2 : 1);
        const int gm_0 = blk >= 192 ? (blk - 192) * 3 : (blk < 128 ? 192 + blk * 2 : 448 + (blk - 128));
        for (int un = gm_0; un < gm_0 + gm_n; ++un) {
            const int chunk = un >> 2, grp = un & 3;
            constexpr int RS = 272;
            LAS unsigned char* wsA = lds; LAS unsigned char* vnT = lds + 128 * RS; LAS float* tst = (LAS float*)(lds + 2 * 128 * RS);
            __syncthreads();
            {
                const int tok = tid >> 2, part = tid & 3; const float* sp = stats + (size_t)(chunk * 128 + tok) * STP + 80 + part * 8;
                float s = sp[0] + sp[2] + sp[4] + sp[6], q = sp[1] + sp[3] + sp[5] + sp[7];
                s += __shfl_xor(s, 1); s += __shfl_xor(s, 2); q += __shfl_xor(q, 1); q += __shfl_xor(q, 2);
                const float mean = s * (1.f / 512.f); const float var = q * (1.f / 512.f) - mean * mean;
                if (part == 0) { tst[2 * tok] = mean; tst[2 * tok + 1] = 1.f / sqrtf(fmaxf(var, 0.f) + 1e-5f); }
            }
#pragma unroll
            for (int i = 0; i < 4; ++i) { const int id = tid + 512 * i, r = id >> 4, ch = id & 15;
                *(LAS u32x4*)(wsA + r * RS + ch * 16) = *(const u32x4*)(Gws + (size_t)grp * 16384 + r * 128 + ch * 8); }
            __syncthreads();
#pragma unroll
            for (int i = 0; i < 4; ++i) { const int id = tid + 512 * i, j = id >> 4, cc = id & 15;
                const u32x4 raw = *(const u32x4*)(P1 + (size_t)(chunk * 128 + j) * PW1 + 1280 + grp * 128 + cc * 8);
                const float mean = tst[2 * j], rstd = tst[2 * j + 1];
                const f32x4 lg0 = *(const f32x4*)(q->gmlp_ln_g + grp * 128 + cc * 8), lg1 = *(const f32x4*)(q->gmlp_ln_g + grp * 128 + cc * 8 + 4);
                const f32x4 lb0 = *(const f32x4*)(q->gmlp_ln_b + grp * 128 + cc * 8), lb1 = *(const f32x4*)(q->gmlp_ln_b + grp * 128 + cc * 8 + 4);
#pragma unroll
                for (int e = 0; e < 8; ++e) { const unsigned wv = raw[e >> 1]; const float x = bf2f((unsigned short)((e & 1) ? (wv >> 16) : (wv & 0xffffu)));
                    const float y = (x - mean) * rstd * (e < 4 ? lg0[e & 3] : lg1[e & 3]) + (e < 4 ? lb0[e & 3] : lb1[e & 3]);
                    *(LAS unsigned short*)(vnT + (cc * 8 + e) * RS + j * 2) = (unsigned short)f2bf(y); } }
            __syncthreads();
            { const int r32 = lane & 31, hh = lane >> 5, ib = wave >> 1;
#pragma unroll
              for (int cbi = 0; cbi < 2; ++cbi) { const int cb = 2 * (wave & 1) + cbi;
                f32x16 dacc = (f32x16){};
#pragma unroll
                for (int ks = 0; ks < 8; ++ks) {
                    const bf16x8 a = *(const LAS bf16x8*)(wsA + (32 * ib + r32) * RS + (16 * ks + 8 * hh) * 2);
                    const bf16x8 bb = *(const LAS bf16x8*)(vnT + (32 * cb + r32) * RS + (16 * ks + 8 * hh) * 2);
                    dacc = __builtin_amdgcn_mfma_f32_32x32x16_bf16(a, bb, dacc, 0, 0, 0); }
                const int c = 32 * cb + r32;
#pragma unroll
                for (int r = 0; r < 16; ++r) { const int i = 32 * ib + (r & 3) + 8 * (r >> 2) + 4 * hh; const int tok = chunk * 128 + i;
                    const float gu = bf2f(P1[(size_t)tok * PW1 + 768 + grp * 128 + c]);
                    const float o = gu * (dacc[r] + q->gmlp_b[grp * 128 + i]);
                    AMIX1[(size_t)tok * 1024 + 512 + grp * 128 + c] = (bf16_t)f2bf(o); } } }
        }
#endif
    }
    SEAM(11);
    if (IN(12)) { PHASE_BEGIN
        const int xcd = blk & 7, idx = blk >> 3;
        {
            const int combo = (idx >> 4) * 8 + xcd, qb = idx & 15;
            const int b = combo >> 3, h = combo & 7;
            AttnDesc d{};
            d.Q = Q1 + h * 96; d.qpitch = 768; d.K = KV1 + h * 128; d.kpitch = 1024; d.K2 = P1 + 640; d.k2pitch = PW1;
            d.V = KV1 + h * 128 + 64; d.vpitch = 1024; d.Ob = AMIX1 + h * 64; d.opitch = 1024;
            d.qrow0 = b * SEQ_ + qb * 512; d.ntiles = 132; d.nlat = 128; d.lat_row0 = b * SEQ_; d.ctx_row0 = ML + b * 256;
            attn_unit_mla2(d, lds);
        }
    }
    SEAM(12);
    if (IN(13)) { PHASE_BEGIN
        pg8::Gemm g{AMIX1, Wodout, ML, 1024, 1024, 1024, 1024}; PanelOrder S; S.init(ML, blk);
        EpiResLN<true, true> E{Hb, Hb + (size_t)ML * DM, mod + 3 * 6144 + 2 * 1024, (unsigned*)(ws + O_CNT) + 2 * 66 * 64, (unsigned long long*)(ws + O_SLOT2), q->ln_mix_g + 1024, q->ln_mix_b + 1024, Hb, U, mod + 3 * 6144, 3, nullptr, nullptr, 0};
        pg8::gemm_phase<EpiResLN<true, true>, PanelOrder, true, true>(lds, g, S, E);
    }
    SEAM(13);
    if (IN(15)) { PHASE_BEGIN
        pg8::Gemm g{U, Wffin1, ML, 5632, 1024, 1024, 1024}; pg8::StaticOrder S; S.init(ML, 5632, G, blk);
        EpiFfn E{ACT};
        pg8::gemm_phase<EpiFfn, pg8::StaticOrder, true, true>(lds, g, S, E);
    }
    SEAM(15);
    if (IN(16)) { PHASE_BEGIN
        pg8::Gemm g{ACT, Wffout1, ML, 1024, FH, FH, FH}; PanelOrder S; S.init(ML, blk);
        EpiResLN<true, false> E{Hb, Hb + (size_t)ML * DM, mod + 3 * 6144 + 5 * 1024, (unsigned*)(ws + O_CNT) + 3 * 66 * 64, (unsigned long long*)(ws + O_SLOT3), q->ln_ffn_g + 1024, q->ln_ffn_b + 1024, q->out, nullptr, nullptr, 0, nullptr, nullptr, 0};
        pg8::gemm_phase<EpiResLN<true, false>, PanelOrder, true, true>(lds, g, S, E);
    }
#undef IN
#undef SEAM
}

#ifndef N_LAUNCH_MODE
#define N_LAUNCH_MODE 1
#endif
extern "C" void kernel_launch(void* const* d_in, const int* in_sizes, int n_in, void* d_out, int out_size, void* d_ws, size_t ws_size, hipStream_t stream) {
    static int grid = 0;
    if (grid == 0) {
        if (n_in != 27 || ws_size < WS_NEED) { fprintf(stderr, "kernel_launch: unexpected inputs (n_in %d, ws %zu)\n", n_in, ws_size); grid = -1; return; }
        int dev = 0, cus = 0, per_cu = 0;
        hipGetDevice(&dev); hipDeviceGetAttribute(&cus, hipDeviceAttributeMultiprocessorCount, dev);
        hipFuncSetAttribute((const void*)dit_fwd, hipFuncAttributeMaxDynamicSharedMemorySize, LDS_BYTES);
        hipOccupancyMaxActiveBlocksPerMultiprocessor(&per_cu, (const void*)dit_fwd, 512, LDS_BYTES);
        (void)hipGetLastError();
        if (per_cu < 1) per_cu = 1;
        grid = cus * per_cu; if (grid > 256) grid = 256;
    }
    if (grid < 0) return;
    if (hipMemsetAsync((char*)d_ws + O_BAR, 0, CTL_BYTES, stream) != hipSuccess) { fprintf(stderr, "memset failed\n"); return; }
    Params p{};
    const float** pp = (const float**)&p;
    for (int i = 0; i < 27; ++i) pp[i] = (const float*)d_in[i];
    p.out = (float*)d_out; p.ws = (unsigned char*)d_ws;
#if N_LAUNCH_MODE == 1
    p.lo = 0; p.hi = NPHASE;
    void* args[] = {&p};
    hipError_t e = hipLaunchCooperativeKernel((const void*)dit_fwd, dim3(grid), dim3(512), args, LDS_BYTES, stream);
    if (e != hipSuccess) fprintf(stderr, "cooperative launch failed: %s (grid %d)\n", hipGetErrorString(e), grid);
#else
    for (int ph = 0; ph < NPHASE; ++ph) { p.lo = ph; p.hi = ph + 1; hipLaunchKernelGGL(dit_fwd, dim3(grid), dim3(512), LDS_BYTES, stream, p); }
#endif
}
```

```cpp
#include <hip/hip_runtime.h>
#include <hip/hip_cooperative_groups.h>
#include <cstdio>
#include <cstdint>
#include <cmath>
namespace cg = cooperative_groups;
namespace pg8 {
#define PG8_LAS __attribute__((address_space(3)))
typedef unsigned short bf16_t;
typedef short bf16x8 __attribute__((ext_vector_type(8)));
typedef float f32x4 __attribute__((ext_vector_type(4)));
typedef unsigned u32x4 __attribute__((ext_vector_type(4)));
typedef float f32x2 __attribute__((ext_vector_type(2)));
constexpr int BM = 256, BK = 64, HALF = 128, HTB = HALF * BK * 2  , STAGE_BYTES = 8 * HTB, NXCD = 8, WGM = 8;

__host__ __device__ __forceinline__ int lds_byte(int r, int c) { const int st = (r >> 4) * 2 + (c >> 5), rr = r & 15, cc = c & 31, ob = rr * 64 + cc * 2; return st * 1024 + (ob ^ (((ob >> 9) & 1) << 5)); }
__host__ __device__ __forceinline__ void stage_rc(int b, int& R, int& C) { const int st = b / 1024, sb = b % 1024, swz = sb ^ (((sb >> 9) & 1) << 5); R = (st >> 1) * 16 + swz / 64; C = (st & 1) * 32 + (swz % 64) / 2; }
__host__ __device__ __forceinline__ int perm32(int rho) { const int n = rho >> 4, i = rho & 15; return 8 * (i >> 2) + 4 * n + (i & 3); }

struct Unit { int pm, pn; };
struct Gemm { const bf16_t* A; const bf16_t* Bt; int M, N, K, lda, ldb; };

struct StaticOrder {
    int nM, nN, nwg, G, c;
    __host__ __device__ void init(int M, int N, int G_, int c_) { nM = M / BM; nN = N / BM; nwg = nM * nN; G = G_; c = c_; }
    __host__ __device__ bool next(int i, Unit& u) const {
        const long L = (long)i * G + c; if (L >= nwg) return false;
        int wgid = (int)L; { const int q = nwg / NXCD, r = nwg % NXCD, xcd = wgid % NXCD, off = wgid / NXCD; wgid = (xcd < r ? xcd * (q + 1) : r * (q + 1) + (xcd - r) * q) + off; }
        const int nig = WGM * nN, gid = wgid / nig, fm = gid * WGM, gsz = (nM - fm) < WGM ? (nM - fm) : WGM;
        u.pm = fm + ((wgid % nig) % gsz); u.pn = (wgid % nig) / gsz; return true;
    }
    __device__ __forceinline__ void a_ready(const Unit&) const {}
    __device__ __forceinline__ void done(const Unit&) const {}
};

__device__ __forceinline__ unsigned cvt_pk_bf16(float lo, float hi) { unsigned r; asm volatile("v_cvt_pk_bf16_f32 %0, %1, %2" : "=v"(r) : "v"(lo), "v"(hi)); return r; }
__device__ __forceinline__ f32x2 gelu_pk(f32x2 v) {
    const f32x2 av = __builtin_elementwise_abs(v), d = av * 0.2316418882f + 1.0f;
    f32x2 t; t.x = __builtin_amdgcn_rcpf(d.x); t.y = __builtin_amdgcn_rcpf(d.y);
    f32x2 q = t * 0.5307027145f + (-0.7265760135f); q = q * t + 0.7107068705f; q = q * t + (-0.142248368f); q = q * t + 0.127414796f; q = q * t;
    const f32x2 s = (v * v) * (-0.72134752044f);
    f32x2 e; e.x = __builtin_amdgcn_exp2f(s.x); e.y = __builtin_amdgcn_exp2f(s.y);
    const f32x2 m = v * (q * e), r = v - m;
    f32x2 o; o.x = v.x < 0.f ? m.x : r.x; o.y = v.y < 0.f ? m.y : r.y; return o;
}
template <class Epi, class Sched, bool ALIGN_EPI = false, bool SP2 = false>
__device__ __forceinline__ void gemm_phase(PG8_LAS unsigned char* lds, const Gemm g, const Sched& S, const Epi& E) {
    int tid = threadIdx.x; asm volatile("" : "+v"(tid));
    const int wid = __builtin_amdgcn_readfirstlane(tid >> 6), lane = tid & 63, wr = wid >> 2, wc = wid & 3, fr = lane & 15, fq = lane >> 4;
    const int K = g.K, nt = K / BK;
    unsigned voffA[2], voffB[2];
#pragma unroll
    for (int i = 0; i < 2; ++i) { int R, C; stage_rc(tid * 16 + i * 8192, R, C); const int Rb = Epi::PERM ? ((R & ~31) + perm32(R & 31)) : R;
        voffA[i] = (unsigned)(R * g.lda + C) * 2u; voffB[i] = (unsigned)(Rb * g.ldb + C) * 2u; }
    const size_t kstep = (size_t)(BK * 2);
    const size_t hstep = (size_t)HALF * g.ldb * 2;
    const size_t tstep = 2 * hstep; const size_t hstepA = (size_t)HALF * g.lda * 2, tstepA = 2 * hstepA;
    const unsigned ldsw = (unsigned)wid * 1024u;
    const int aoff = lds_byte(wr * 64 + fr, fq * 8), boff = lds_byte(wc * 32 + fr, fq * 8);
#define PG8_SA(b, h) (((b) * 2 + (h)) * HTB)
#define PG8_SB(b, h) ((4 + (b) * 2 + (h)) * HTB)
#define PG8_STAGE(bufoff, gbase, voff) do { _Pragma("unroll") for (int _i = 0; _i < 2; ++_i) \
        __builtin_amdgcn_global_load_lds((const unsigned*)((const char*)(gbase) + (voff)[_i]), (PG8_LAS unsigned*)(lds + (bufoff) + ldsw + _i * 8192), 16, 0, 0); } while (0)
#define PG8_LDA(dst, b, h) do { _Pragma("unroll") for (int m = 0; m < 4; ++m) _Pragma("unroll") for (int k = 0; k < 2; ++k) dst[m][k] = *(const PG8_LAS bf16x8*)(lds + PG8_SA(b, h) + aoff + m * 2048 + k * 1024); } while (0)
#define PG8_LDB(dst, b, h) do { _Pragma("unroll") for (int n = 0; n < 2; ++n) _Pragma("unroll") for (int k = 0; k < 2; ++k) dst[n][k] = *(const PG8_LAS bf16x8*)(lds + PG8_SB(b, h) + boff + n * 2048 + k * 1024); } while (0)
#define PG8_MMA(ai, bj, At, Bt) do { __builtin_amdgcn_s_setprio(1); _Pragma("unroll") for (int m = 0; m < 4; ++m) _Pragma("unroll") for (int n = 0; n < 2; ++n) _Pragma("unroll") for (int k = 0; k < 2; ++k) \
        acc[ai][bj][m][n] = __builtin_amdgcn_mfma_f32_16x16x32_bf16(Bt[n][k], At[m][k], acc[ai][bj][m][n], 0, 0, 0); __builtin_amdgcn_s_setprio(0); } while (0)
#define PG8_WAIT_V(n) asm volatile("s_waitcnt vmcnt(" #n ")" ::: "memory")
#define PG8_WAIT_L(n) asm volatile("s_waitcnt lgkmcnt(" #n ")" ::: "memory")
#define PG8_BAR __builtin_amdgcn_s_barrier()
#define PG8_SCHED __builtin_amdgcn_sched_barrier(0)
    Unit cur, nxt; int ui = 0;
    if (!S.next(0, cur)) return;
    f32x4 acc[2][2][4][2];
#pragma unroll
    for (int a = 0; a < 2; ++a)
#pragma unroll
        for (int b = 0; b < 2; ++b)
#pragma unroll
            for (int m = 0; m < 4; ++m)
#pragma unroll
                for (int n = 0; n < 2; ++n) acc[a][b][m][n] = (f32x4){0.f, 0.f, 0.f, 0.f};
    bf16x8 At[4][2], B0[2][2], B1[2][2];
    const char* cA = (const char*)g.A + (size_t)cur.pm * tstepA; const char* cB = (const char*)g.Bt + (size_t)cur.pn * tstep;
    S.a_ready(cur);
    if constexpr (SP2) {
        PG8_STAGE(PG8_SB(0, 0), cB, voffB); PG8_STAGE(PG8_SB(0, 1), cB + hstep, voffB); PG8_STAGE(PG8_SA(0, 0), cA, voffA); PG8_STAGE(PG8_SA(0, 1), cA + hstepA, voffA);
        if (wr == 1) PG8_BAR;
        PG8_WAIT_V(2); PG8_BAR;
        PG8_STAGE(PG8_SB(1, 0), cB + kstep, voffB); PG8_STAGE(PG8_SA(1, 0), cA + kstep, voffA); PG8_STAGE(PG8_SB(1, 1), cB + hstep + kstep, voffB);
        PG8_WAIT_V(6); PG8_BAR;
    } else {
        PG8_STAGE(PG8_SB(0, 0), cB, voffB); PG8_STAGE(PG8_SA(0, 0), cA, voffA); PG8_STAGE(PG8_SB(0, 1), cB + hstep, voffB); PG8_STAGE(PG8_SA(0, 1), cA + hstepA, voffA);
        if (wr == 1) PG8_BAR;
        PG8_WAIT_V(4); PG8_BAR;
        PG8_STAGE(PG8_SB(1, 0), cB + kstep, voffB); PG8_STAGE(PG8_SA(1, 0), cA + kstep, voffA); PG8_STAGE(PG8_SB(1, 1), cB + hstep + kstep, voffB);
        PG8_WAIT_V(6); PG8_BAR;
    }
    for (;;) {
        const bool has_next = S.next(ui + 1, nxt);
        const char* nA = has_next ? (const char*)g.A + (size_t)nxt.pm * tstepA : cA; const char* nB = has_next ? (const char*)g.Bt + (size_t)nxt.pn * tstep : cB;
#pragma nounroll
        for (int t = 0; t < nt; t += 2) {
            const bool last = (t == nt - 2);
            const char* a1 = cA + (size_t)(t + 1) * kstep;
            const char* a2 = last ? nA : cA + (size_t)(t + 2) * kstep; const char* b2 = last ? nB : cB + (size_t)(t + 2) * kstep;
            const char* a3 = a2 + kstep; const char* b3 = b2 + kstep;
            if (last && has_next) S.a_ready(nxt);
            if constexpr (SP2) {
            PG8_LDB(B0, 0, 0); PG8_LDB(B1, 0, 1); PG8_SCHED; PG8_LDA(At, 0, 0); PG8_STAGE(PG8_SA(1, 1), a1 + hstepA, voffA);
            PG8_WAIT_V(8); PG8_WAIT_L(0); PG8_BAR; PG8_MMA(0, 0, At, B0); PG8_MMA(0, 1, At, B1); PG8_BAR; PG8_SCHED;
            PG8_LDA(At, 0, 1); PG8_STAGE(PG8_SB(0, 0), b2, voffB); PG8_STAGE(PG8_SB(0, 1), b2 + hstep, voffB); PG8_STAGE(PG8_SA(0, 0), a2, voffA);
            PG8_WAIT_V(8); PG8_WAIT_L(0); PG8_BAR; PG8_MMA(1, 0, At, B0); PG8_MMA(1, 1, At, B1); PG8_BAR; PG8_SCHED;
            PG8_LDB(B0, 1, 0); PG8_LDB(B1, 1, 1); PG8_SCHED; PG8_LDA(At, 1, 0); PG8_STAGE(PG8_SA(0, 1), a2 + hstepA, voffA);
            PG8_WAIT_V(8); PG8_WAIT_L(0); PG8_BAR; PG8_MMA(0, 0, At, B0); PG8_MMA(0, 1, At, B1); PG8_BAR; PG8_SCHED;
            PG8_LDA(At, 1, 1); PG8_STAGE(PG8_SB(1, 0), b3, voffB); PG8_STAGE(PG8_SB(1, 1), b3 + hstep, voffB); PG8_STAGE(PG8_SA(1, 0), a3, voffA);
            PG8_WAIT_V(8); PG8_WAIT_L(0); PG8_BAR; PG8_MMA(1, 0, At, B0); PG8_MMA(1, 1, At, B1); PG8_BAR; PG8_SCHED;
            } else {
            PG8_LDB(B0, 0, 0); PG8_SCHED; PG8_LDA(At, 0, 0); PG8_STAGE(PG8_SA(1, 1), a1 + hstepA, voffA);
            PG8_WAIT_L(8); PG8_BAR; PG8_WAIT_L(0); PG8_MMA(0, 0, At, B0); PG8_BAR; PG8_SCHED;
            PG8_LDB(B1, 0, 1); PG8_STAGE(PG8_SB(0, 0), b2, voffB);
            PG8_BAR; PG8_WAIT_L(0); PG8_MMA(0, 1, At, B1); PG8_BAR;
            PG8_LDA(At, 0, 1); PG8_STAGE(PG8_SA(0, 0), a2, voffA);
            PG8_BAR; PG8_WAIT_L(0); PG8_MMA(1, 0, At, B0); PG8_BAR; PG8_SCHED;
            PG8_STAGE(PG8_SB(0, 1), b2 + hstep, voffB);
            PG8_WAIT_V(6); PG8_BAR; PG8_MMA(1, 1, At, B1); PG8_BAR;
            PG8_LDB(B0, 1, 0); PG8_SCHED; PG8_LDA(At, 1, 0); PG8_STAGE(PG8_SA(0, 1), a2 + hstepA, voffA);
            PG8_WAIT_L(8); PG8_BAR; PG8_WAIT_L(0); PG8_MMA(0, 0, At, B0); PG8_BAR; PG8_SCHED;
            PG8_LDB(B1, 1, 1); PG8_STAGE(PG8_SB(1, 0), b3, voffB);
            PG8_BAR; PG8_WAIT_L(0); PG8_MMA(0, 1, At, B1); PG8_BAR;
            PG8_LDA(At, 1, 1); PG8_STAGE(PG8_SA(1, 0), a3, voffA);
            PG8_BAR; PG8_WAIT_L(0); PG8_MMA(1, 0, At, B0); PG8_BAR; PG8_SCHED;
            PG8_STAGE(PG8_SB(1, 1), b3 + hstep, voffB);
            PG8_WAIT_V(6); PG8_BAR; PG8_MMA(1, 1, At, B1); PG8_BAR;
            }
        }
        if constexpr (ALIGN_EPI) { if (wr == 0) PG8_BAR; }
        if constexpr (!Epi::AFTER_DRAIN) { E(acc, cur, wr, wc, fr, fq); S.done(cur); }
        if (!has_next) break;
#pragma unroll
        for (int a = 0; a < 2; ++a)
#pragma unroll
            for (int b = 0; b < 2; ++b)
#pragma unroll
                for (int m = 0; m < 4; ++m)
#pragma unroll
                    for (int n = 0; n < 2; ++n) acc[a][b][m][n] = (f32x4){0.f, 0.f, 0.f, 0.f};
        cur = nxt; cA = nA; cB = nB; ++ui;
        if constexpr (ALIGN_EPI) { if (wr == 1) PG8_BAR; }
    }
    PG8_WAIT_V(0);
    if constexpr (!ALIGN_EPI) { if (wr == 0) PG8_BAR; }
    PG8_BAR;
    if constexpr (Epi::AFTER_DRAIN) { E.fused(acc, cur, wr, wc, fr, fq, lds, wid, lane); S.done(cur); }
#undef PG8_SA
#undef PG8_SB
#undef PG8_STAGE
#undef PG8_LDA
#undef PG8_LDB
#undef PG8_MMA
#undef PG8_WAIT_V
#undef PG8_WAIT_L
#undef PG8_BAR
#undef PG8_SCHED
}
}

using pg8::bf16_t; using pg8::f32x4; using pg8::u32x4; using pg8::Unit;
#define LAS __attribute__((address_space(3)))
typedef unsigned u32x2 __attribute__((ext_vector_type(2)));
typedef float f32x2v __attribute__((ext_vector_type(2)));
typedef float f32x16 __attribute__((ext_vector_type(16)));
typedef short bf16x8 __attribute__((ext_vector_type(8)));
typedef short s16x4 __attribute__((ext_vector_type(4)));
typedef short v4i16_t __attribute__((ext_vector_type(4)));

constexpr int SEQ_ = 8192, DM = 1024, ML = 16384, MT = 16896, FH = 2816;
constexpr int PW0 = 3072;
constexpr int PW1 = 1792;
constexpr int STP = 112;
constexpr float ALPHA_ = 1.4142135623730951f;
constexpr float LOG2E_ = 1.4426950408889634f;
constexpr float QS64 = 0.125f * 1.4426950408889634f;
constexpr float QS96 = (float)(1.4426950408889634 / 9.797958971132712);
constexpr float LAMBDA_INIT = 0.2f;

constexpr size_t MiB_ = 1u << 20;
constexpr size_t O_EVIN = 0, O_EVOUT = O_EVIN + 6291456, O_FFIN0 = O_EVOUT + 2097152, O_FFOUT0 = O_FFIN0 + 11534336;
constexpr size_t O_FFIN1 = O_FFOUT0 + 5767168, O_FFOUT1 = O_FFIN1 + 11534336, O_ODIN = O_FFOUT1 + 5767168, O_ODOUT = O_ODIN + 3670016;
constexpr size_t O_UQ = O_ODOUT + 2097152, O_UKV = O_UQ + 589824, O_GWS = O_UKV + 524288, O_MOD = O_GWS + 131072, O_TAB32 = O_MOD + 147456, O_TAB16 = O_TAB32 + 16384;
constexpr size_t O_SLOT0 = 48 * MiB_, O_SLOT1 = 51 * MiB_, O_SLOT2 = 145 * MiB_, O_SLOT3 = 148 * MiB_;
static_assert(O_TAB16 + 8192 <= O_SLOT0 && O_SLOT1 + (size_t)16896 * 128 <= 54 * MiB_, "ws map");
constexpr size_t O_Q1 = 0;
static_assert((size_t)ML * 768 * 2 <= O_FFIN1, "Q1 overlay");
constexpr size_t O_P = 54 * MiB_, O_H = 153 * MiB_, O_U = 219 * MiB_, WS_NEED = 253 * MiB_, O_BAR = 252 * MiB_, O_CNT = O_BAR + 16384, O_PCNT = O_CNT + 4 * 66 * 256, O_XCNT = O_PCNT + 2 * 8 * 256, CTL_BYTES = 16384 + 4 * 66 * 256 + 2 * 8 * 256 + 128 * 256;
constexpr size_t O_ODIFF = O_H, O_AMIX0 = O_U, O_ACT = O_P, O_P1 = O_P, O_AMIX1 = 112 * MiB_, O_STATS = 144 * MiB_, O_KV1 = O_U;
static_assert(O_P1 + (size_t)MT * PW1 * 2 <= O_AMIX1 && O_STATS + (size_t)MT * STP * 4 <= O_H, "ws map 2");

__device__ __forceinline__ unsigned f2bf(float f) { unsigned u = __builtin_bit_cast(unsigned, f); return (u + 0x7fffu + ((u >> 16) & 1u)) >> 16; }
typedef __bf16 bf16x2_hw __attribute__((ext_vector_type(2)));
__device__ __forceinline__ unsigned pk2(float lo, float hi) { f32x2v v = {lo, hi}; bf16x2_hw b = __builtin_convertvector(v, bf16x2_hw); return __builtin_bit_cast(unsigned, b); }
__device__ __forceinline__ float bf2f(unsigned short b) { return __builtin_bit_cast(float, (unsigned)b << 16); }
__device__ __forceinline__ float wave_sum(float v) {
#pragma unroll
    for (int o = 1; o < 64; o <<= 1) v += __shfl_xor(v, o);
    return v;
}
__device__ __forceinline__ float gelu_exact(float v) { return 0.5f * v * (1.0f + erff(v * 0.70710678118654752f)); }
__device__ __forceinline__ int modset(int pm) { return pm < 32 ? 0 : (pm < 64 ? 1 : 2); }

struct EpiIn0 {
    static constexpr bool PERM = true, AFTER_DRAIN = false;
    bf16_t* P; const float* tab32;
    __device__ __forceinline__ void operator()(const f32x4 (&acc)[2][2][4][2], const Unit& u, int wr, int wc, int fr, int fq) const {
        asm volatile("" : "+v"(fr), "+v"(fq));
        const int region = u.pn >> 1;
        const bool rope = (region <= 1) && (u.pm < 64);
        const float sc = (region == 0 || region == 3) ? QS64 : 1.f;
        const float sgn = (fq < 2) ? -1.f : 1.f;
#pragma unroll
        for (int ai = 0; ai < 2; ++ai)
#pragma unroll
            for (int m = 0; m < 4; ++m) {
                const int row = u.pm * 256 + ai * 128 + wr * 64 + m * 16 + fr;
                const int t = row & 8191; const int pos = (wc & 1) ? (t & 63) : (t >> 6);
                const float* tb = tab32 + (pos * 16 + 8 * (fq & 1)) * 2;
#pragma unroll
                for (int bj = 0; bj < 2; ++bj) {
                    const int col = u.pn * 256 + bj * 128 + wc * 32 + 8 * fq;
                    float v[8];
#pragma unroll
                    for (int i = 0; i < 4; ++i) { v[i] = acc[ai][bj][m][0][i]; v[4 + i] = acc[ai][bj][m][1][i]; }
                    if (rope) {
                        const f32x4 t0 = *(const f32x4*)tb, t1 = *(const f32x4*)(tb + 4), t2 = *(const f32x4*)(tb + 8), t3 = *(const f32x4*)(tb + 12);
                        const float cs[8] = {t0[0], t0[2], t1[0], t1[2], t2[0], t2[2], t3[0], t3[2]};
                        const float sn[8] = {t0[1], t0[3], t1[1], t1[3], t2[1], t2[3], t3[1], t3[3]};
#pragma unroll
                        for (int i = 0; i < 8; ++i) { const float pr = __shfl_xor(v[i], 32); v[i] = v[i] * cs[i] + sgn * pr * sn[i]; }
                    }
                    u32x4 w; w.x = pk2(v[0] * sc, v[1] * sc); w.y = pk2(v[2] * sc, v[3] * sc); w.z = pk2(v[4] * sc, v[5] * sc); w.w = pk2(v[6] * sc, v[7] * sc);
                    *(u32x4*)(P + (size_t)row * PW0 + col) = w;
                }
            }
    }
};
struct EpiRes {
    static constexpr bool PERM = true, AFTER_DRAIN = false;
    const float* hx; const float* hc; float* Z; const float* gate;
    __device__ __forceinline__ void operator()(const f32x4 (&acc)[2][2][4][2], const Unit& u, int wr, int wc, int fr, int fq) const {
        asm volatile("" : "+v"(fr), "+v"(fq));
        const float* gp = gate + modset(u.pm) * 6144;
#pragma unroll
        for (int bj = 0; bj < 2; ++bj) {
            const int col = u.pn * 256 + bj * 128 + wc * 32 + 8 * fq;
            const f32x4 g0 = *(const f32x4*)(gp + col), g1 = *(const f32x4*)(gp + col + 4);
#pragma unroll
            for (int ai = 0; ai < 2; ++ai)
#pragma unroll
                for (int m = 0; m < 4; ++m) {
                    const int row = u.pm * 256 + ai * 128 + wr * 64 + m * 16 + fr;
                    const float* hb = (u.pm < 64) ? hx + (size_t)row * DM : hc + (size_t)(row - ML) * DM;
                    const f32x4 h0 = *(const f32x4*)(hb + col), h1 = *(const f32x4*)(hb + col + 4);
                    const f32x4 z0 = h0 * ALPHA_ + g0 * acc[ai][bj][m][0], z1 = h1 * ALPHA_ + g1 * acc[ai][bj][m][1];
                    float* zp = Z + (size_t)row * DM + col;
                    *(f32x4*)zp = z0; *(f32x4*)(zp + 4) = z1;
                }
        }
    }
};

struct PanelOrder {
    int nP, c;
    __device__ void init(int M, int c_) { nP = M / 256; c = c_; }
    __device__ bool next(int i, Unit& u) const {
        const int rem = nP - 64 * i;
        if (rem >= 64) { const int x = c & 7, j = c >> 3; u.pm = 64 * i + 8 * x + (j & 7); u.pn = j >> 3; return true; }
        if (rem > 0 && c < 4 * rem) { u.pm = 64 * i + (c >> 2); u.pn = c & 3; return true; }
        return false;
    }
    __device__ __forceinline__ void a_ready(const Unit&) const {}
    __device__ __forceinline__ void done(const Unit&) const {}
};
struct TailOrder {
    int c;
    __device__ bool next(int i, Unit& u) const { if (i > 0 || c >= 32) return false; u.pm = 64 + (c >> 4); u.pn = (c >> 2) & 3; return true; }
    __device__ __forceinline__ void a_ready(const Unit&) const {}
    __device__ __forceinline__ void done(const Unit&) const {}
};
template <bool HIN16, bool HOUT16>
struct EpiResLN {
    static constexpr bool PERM = true, AFTER_DRAIN = false;
    const void* hx; const void* hc; const float* gate;
    unsigned* cnt; unsigned long long* slots; const float* lg; const float* lb; void* dst; bf16_t* U; const float* modl; int kmod;
    float* part_buf; unsigned* part_cnt; int part;
    __device__ __forceinline__ void operator()(const f32x4 (&acc)[2][2][4][2], const Unit& u, int wr, int wc, int fr, int fq) const {
        asm volatile("" : "+v"(fr), "+v"(fq));
        const int set = modset(u.pm);
        const float* gp = gate + set * 6144;
        const int colb = u.pn * 256 + wc * 32 + 8 * fq;
        const int tunit = (u.pm - 64) * 4 + u.pn;
        int tid_ = threadIdx.x; asm volatile("" : "+v"(tid_));
        if (part_buf && part != 0) {
            float* pb = part_buf + ((size_t)(tunit * 3 + part - 1) * 32 * 512 + tid_) * 4;
#pragma unroll
            for (int ai = 0; ai < 2; ++ai)
#pragma unroll
                for (int bj = 0; bj < 2; ++bj)
#pragma unroll
                    for (int m = 0; m < 4; ++m)
#pragma unroll
                        for (int hf = 0; hf < 2; ++hf) {
                            const f32x4 v = acc[ai][bj][m][hf]; float* dp = pb + (size_t)((((ai * 2 + bj) * 4 + m) * 2 + hf) * 512) * 4;
                            asm volatile("global_store_dwordx4 %0, %1, off sc1" :: "v"(dp), "v"(v) : "memory");
                        }
            asm volatile("s_waitcnt vmcnt(0)" ::: "memory"); __builtin_amdgcn_s_barrier(); asm volatile("" ::: "memory");
            if (threadIdx.x == 0) __hip_atomic_fetch_add(part_cnt + 64 * tunit, 1u, __ATOMIC_RELAXED, __HIP_MEMORY_SCOPE_AGENT);
            return;
        }
        if (part_buf) {
            if (threadIdx.x == 0) {
                unsigned sp = 0;
                while (__hip_atomic_load(part_cnt + 64 * tunit, __ATOMIC_RELAXED, __HIP_MEMORY_SCOPE_AGENT) < 3u) { __builtin_amdgcn_s_sleep(1); if (++sp > (1u << 24)) break; }
                __builtin_amdgcn_fence(__ATOMIC_ACQUIRE, "agent"); asm volatile("s_waitcnt vmcnt(0)" ::: "memory");
            }
            asm volatile("s_waitcnt vmcnt(0) lgkmcnt(0)" ::: "memory"); __builtin_amdgcn_s_barrier(); asm volatile("" ::: "memory");
        }
        const float* pb0 = part_buf ? part_buf + ((size_t)(tunit * 3) * 32 * 512 + tid_) * 4 : nullptr;
        f32x4 z[2][4][2][2];
        {
            f32x4 g[2][2];
#pragma unroll
            for (int bj = 0; bj < 2; ++bj) { g[bj][0] = *(const f32x4*)(gp + colb + bj * 128); g[bj][1] = *(const f32x4*)(gp + colb + bj * 128 + 4); }
#pragma unroll
            for (int ai = 0; ai < 2; ++ai)
#pragma unroll
                for (int m = 0; m < 4; ++m) {
                    const int r = ai * 128 + wr * 64 + m * 16 + fr, row = u.pm * 256 + r;
                    const size_t hoff = ((u.pm < 64) ? (size_t)row * DM : (size_t)(row - ML) * DM) + colb;
                    const float* hb = (const float*)((u.pm < 64) ? hx : hc) + hoff;
                    const bf16_t* hb16 = (const bf16_t*)((u.pm < 64) ? hx : hc) + hoff;
                    float s = 0.f, q = 0.f;
#pragma unroll
                    for (int bj = 0; bj < 2; ++bj) {
                        f32x4 h0, h1;
                        if (HIN16) { const u32x4 hw = *(const u32x4*)(hb16 + bj * 128);
                            h0 = (f32x4){__uint_as_float(hw[0] << 16), __uint_as_float(hw[0] & 0xffff0000u), __uint_as_float(hw[1] << 16), __uint_as_float(hw[1] & 0xffff0000u)};
                            h1 = (f32x4){__uint_as_float(hw[2] << 16), __uint_as_float(hw[2] & 0xffff0000u), __uint_as_float(hw[3] << 16), __uint_as_float(hw[3] & 0xffff0000u)}; }
                        else { h0 = *(const f32x4*)(hb + bj * 128); h1 = *(const f32x4*)(hb + bj * 128 + 4); }
                        f32x4 a0 = acc[ai][bj][m][0], a1 = acc[ai][bj][m][1];
                        if (part_buf) {
#pragma unroll
                            for (int pp = 0; pp < 3; ++pp) { const float* pq = pb0 + (size_t)(pp * 32 + ((ai * 2 + bj) * 4 + m) * 2) * 512 * 4;
                                a0 += *(const f32x4*)pq; a1 += *(const f32x4*)(pq + 512 * 4); }
                        }
                        const f32x4 z0 = h0 * ALPHA_ + g[bj][0] * a0, z1 = h1 * ALPHA_ + g[bj][1] * a1;
                        z[ai][m][bj][0] = z0; z[ai][m][bj][1] = z1;
                        s += (z0[0] + z0[1]) + (z0[2] + z0[3]) + (z1[0] + z1[1]) + (z1[2] + z1[3]);
                        q += (z0[0] * z0[0] + z0[1] * z0[1]) + (z0[2] * z0[2] + z0[3] * z0[3]) + (z1[0] * z1[0] + z1[1] * z1[1]) + (z1[2] * z1[2] + z1[3] * z1[3]);
                    }
                    s += __shfl_xor(s, 16); s += __shfl_xor(s, 32); q += __shfl_xor(q, 16); q += __shfl_xor(q, 32);
                    if (fq == 0) __hip_atomic_store(slots + ((size_t)(u.pm * 256 + r) * 16 + u.pn * 4 + wc), ((unsigned long long)__float_as_uint(q) << 32) | __float_as_uint(s), __ATOMIC_RELAXED, __HIP_MEMORY_SCOPE_AGENT);
                    if (m == 3) asm volatile("" ::: "memory");
                }
        }
        asm volatile("s_waitcnt vmcnt(0)" ::: "memory"); __builtin_amdgcn_s_barrier(); asm volatile("" ::: "memory");
        if (threadIdx.x == 0) {
            unsigned* cw = cnt + 64 * u.pm;
            __hip_atomic_fetch_add(cw, 1u, __ATOMIC_RELAXED, __HIP_MEMORY_SCOPE_AGENT);
            unsigned sp = 0;
            while (__hip_atomic_load(cw, __ATOMIC_RELAXED, __HIP_MEMORY_SCOPE_AGENT) < 4u) { __builtin_amdgcn_s_sleep(1); if (++sp > (1u << 24)) break; }
            __builtin_amdgcn_fence(__ATOMIC_ACQUIRE, "agent"); asm volatile("s_waitcnt vmcnt(0)" ::: "memory");
        }
        asm volatile("s_waitcnt vmcnt(0) lgkmcnt(0)" ::: "memory"); __builtin_amdgcn_s_barrier(); asm volatile("" ::: "memory");
        const float* mp = U ? modl + set * 6144 + kmod * 1024 + colb : nullptr;
        f32x4 sv[2][4][2];
#pragma unroll
        for (int ai = 0; ai < 2; ++ai)
#pragma unroll
            for (int m = 0; m < 4; ++m) {
                const int r = ai * 128 + wr * 64 + m * 16 + fr;
                const f32x4* sl = (const f32x4*)(slots + ((size_t)(u.pm * 256 + r) * 16 + fq * 4));
                sv[ai][m][0] = sl[0]; sv[ai][m][1] = sl[1];
            }
        float mean_[2][4], rstd_[2][4];
#pragma unroll
        for (int ai = 0; ai < 2; ++ai)
#pragma unroll
            for (int m = 0; m < 4; ++m) {
                float s = (sv[ai][m][0][0] + sv[ai][m][0][2]) + (sv[ai][m][1][0] + sv[ai][m][1][2]);
                float q = (sv[ai][m][0][1] + sv[ai][m][0][3]) + (sv[ai][m][1][1] + sv[ai][m][1][3]);
                s += __shfl_xor(s, 16); s += __shfl_xor(s, 32); q += __shfl_xor(q, 16); q += __shfl_xor(q, 32);
                const float mean = s * (1.f / DM);
                mean_[ai][m] = mean; rstd_[ai][m] = 1.f / sqrtf(fmaxf(q * (1.f / DM) - mean * mean, 0.f) + 1e-5f);
            }
        asm volatile("" ::: "memory");
#pragma unroll
        for (int bj = 0; bj < 2; ++bj) {
            const int col = colb + bj * 128;
            const f32x4 lg0 = *(const f32x4*)(lg + col), lg1 = *(const f32x4*)(lg + col + 4), lb0 = *(const f32x4*)(lb + col), lb1 = *(const f32x4*)(lb + col + 4);
            f32x4 sh0 = {}, sh1 = {}, sc0 = {}, sc1 = {};
            if (U) { sh0 = *(const f32x4*)(mp + bj * 128); sh1 = *(const f32x4*)(mp + bj * 128 + 4); sc0 = *(const f32x4*)(mp + 1024 + bj * 128) + 1.f; sc1 = *(const f32x4*)(mp + 1024 + bj * 128 + 4) + 1.f; }
#pragma unroll
            for (int ai = 0; ai < 2; ++ai)
#pragma unroll
                for (int m = 0; m < 4; ++m) {
                    const int r = ai * 128 + wr * 64 + m * 16 + fr, row = u.pm * 256 + r;
                    const float mean = mean_[ai][m], rstd = rstd_[ai][m];
                    const f32x4 h0 = (z[ai][m][bj][0] - mean) * rstd * lg0 + lb0, h1 = (z[ai][m][bj][1] - mean) * rstd * lg1 + lb1;
                    if (HOUT16) *(u32x4*)((bf16_t*)dst + (size_t)row * DM + col) = (u32x4){pk2(h0[0], h0[1]), pk2(h0[2], h0[3]), pk2(h1[0], h1[1]), pk2(h1[2], h1[3])};
                    else { float* dp = (float*)dst + (size_t)row * DM + col; *(f32x4*)dp = h0; *(f32x4*)(dp + 4) = h1; }
                    if (U) { const f32x4 u0 = h0 * sc0 + sh0, u1 = h1 * sc1 + sh1;
                        *(u32x4*)(U + (size_t)row * DM + col) = (u32x4){pk2(u0[0], u0[1]), pk2(u0[2], u0[3]), pk2(u1[0], u1[1]), pk2(u1[2], u1[3])}; }
                }
            asm volatile("" ::: "memory");
        }
    }
};
struct EpiFfn {
    static constexpr bool PERM = true, AFTER_DRAIN = false;
    bf16_t* ACT;
    __device__ __forceinline__ void operator()(const f32x4 (&acc)[2][2][4][2], const Unit& u, int wr, int wc, int fr, int fq) const {
        asm volatile("" : "+v"(fr), "+v"(fq));
        const int hcol = u.pn * 128 + wc * 32 + 8 * fq;
#pragma unroll
        for (int ai = 0; ai < 2; ++ai)
#pragma unroll
            for (int m = 0; m < 4; ++m) {
                const int row = u.pm * 256 + ai * 128 + wr * 64 + m * 16 + fr;
                float o[8];
#pragma unroll
                for (int i = 0; i < 8; ++i) { const float g = acc[ai][0][m][i >> 2][i & 3], a = acc[ai][1][m][i >> 2][i & 3]; o[i] = g * __builtin_amdgcn_rcpf(1.f + __builtin_amdgcn_exp2f(-1.4426950408889634f * g)) * a; }
                u32x4 w; w.x = pk2(o[0], o[1]); w.y = pk2(o[2], o[3]); w.z = pk2(o[4], o[5]); w.w = pk2(o[6], o[7]);
                *(u32x4*)(ACT + (size_t)row * FH + hcol) = w;
            }
    }
};
struct EpiIn1 {
    static constexpr bool PERM = true, AFTER_DRAIN = false;
    bf16_t* P1; float* stats; const float* tab16;
    __device__ __forceinline__ void operator()(const f32x4 (&acc)[2][2][4][2], const Unit& u, int wr, int wc, int fr, int fq) const {
        asm volatile("" : "+v"(fr), "+v"(fq));
#pragma unroll
        for (int bj = 0; bj < 2; ++bj) {
            const int col32 = u.pn * 256 + bj * 128 + wc * 32, col = col32 + 8 * fq, grp = col32 >> 5;
            if (col32 >= 672 && col32 < 768) continue;
            const int kind = (col32 < 640) ? 0 : (col32 < 672 ? 1 : (col32 < 1280 ? 2 : 3));
#pragma unroll
            for (int ai = 0; ai < 2; ++ai)
#pragma unroll
                for (int m = 0; m < 4; ++m) {
                    const int row = u.pm * 256 + ai * 128 + wr * 64 + m * 16 + fr;
                    float v[8];
#pragma unroll
                    for (int i = 0; i < 4; ++i) { v[i] = acc[ai][bj][m][0][i]; v[4 + i] = acc[ai][bj][m][1][i]; }
                    if (kind == 1) {
                        if (u.pm < 64) {
                            const int t = row & 8191; const int pos = (fq & 2) ? (t & 63) : (t >> 6);
                            const float* tb = tab16 + pos * 16;
                            const f32x4 t0 = *(const f32x4*)tb, t1 = *(const f32x4*)(tb + 4), t2 = *(const f32x4*)(tb + 8), t3 = *(const f32x4*)(tb + 12);
                            const float cs[8] = {t0[0], t0[2], t1[0], t1[2], t2[0], t2[2], t3[0], t3[2]};
                            const float sn[8] = {t0[1], t0[3], t1[1], t1[3], t2[1], t2[3], t3[1], t3[3]};
                            const float sgn = (fq & 1) ? 1.f : -1.f;
#pragma unroll
                            for (int i = 0; i < 8; ++i) { const float pr = __shfl_xor(v[i], 16); v[i] = v[i] * cs[i] + sgn * pr * sn[i]; }
                        }
                    } else if (kind >= 2) {
#pragma unroll
                        for (int i = 0; i < 8; i += 2) { const pg8::f32x2 gv2 = pg8::gelu_pk((pg8::f32x2){v[i], v[i + 1]}); v[i] = gv2.x; v[i + 1] = gv2.y; }
                    }
                    if (kind == 0 || kind == 3) {
                        float s = 0.f, q = 0.f;
#pragma unroll
                        for (int i = 0; i < 8; ++i) { s += v[i]; q += v[i] * v[i]; }
                        s += __shfl_xor(s, 16); s += __shfl_xor(s, 32); q += __shfl_xor(q, 16); q += __shfl_xor(q, 32);
                        if (fq == 0) *(f32x2v*)(stats + (size_t)row * STP + grp * 2) = (f32x2v){s, q};
                    }
                    u32x4 w; w.x = pk2(v[0], v[1]); w.y = pk2(v[2], v[3]); w.z = pk2(v[4], v[5]); w.w = pk2(v[6], v[7]);
                    *(u32x4*)(P1 + (size_t)row * PW1 + col) = w;
                    asm volatile("" ::: "memory");
                }
        }
    }
};
struct EpiQ1 {
    static constexpr bool PERM = true, AFTER_DRAIN = false;
    bf16_t* Q1; const float* stats; const float* tab16;
    __device__ __forceinline__ void operator()(const f32x4 (&acc)[2][2][4][2], const Unit& u, int wr, int wc, int fr, int fq) const {
        asm volatile("" : "+v"(fr), "+v"(fq));
#pragma unroll
        for (int ai = 0; ai < 2; ++ai)
#pragma unroll
            for (int m = 0; m < 4; ++m) {
                const int row = u.pm * 256 + ai * 128 + wr * 64 + m * 16 + fr;
                const float* sp = stats + (size_t)row * STP + fq * 6;
                float q = sp[1] + sp[3] + sp[5];
                q += __shfl_xor(q, 16); q += __shfl_xor(q, 32);
                const float rs = QS96 / sqrtf(q * (1.f / 384.f) + 1e-6f);
                const int t = row & 8191; const int pos = (fq & 2) ? (t & 63) : (t >> 6);
                const float* tb = tab16 + pos * 16;
                const float sgn = (fq & 1) ? 1.f : -1.f;
#pragma unroll
                for (int bj = 0; bj < 2; ++bj) {
                    const int col32 = u.pn * 256 + bj * 128 + wc * 32, col = col32 + 8 * fq;
                    const bool rope = ((col32 >> 5) % 3) == 2;
                    float v[8];
#pragma unroll
                    for (int i = 0; i < 4; ++i) { v[i] = acc[ai][bj][m][0][i]; v[4 + i] = acc[ai][bj][m][1][i]; }
                    if (rope) {
                        const f32x4 t0 = *(const f32x4*)tb, t1 = *(const f32x4*)(tb + 4), t2 = *(const f32x4*)(tb + 8), t3 = *(const f32x4*)(tb + 12);
                        const float cs[8] = {t0[0], t0[2], t1[0], t1[2], t2[0], t2[2], t3[0], t3[2]};
                        const float sn[8] = {t0[1], t0[3], t1[1], t1[3], t2[1], t2[3], t3[1], t3[3]};
#pragma unroll
                        for (int i = 0; i < 8; ++i) { const float pr = __shfl_xor(v[i], 16); v[i] = v[i] * cs[i] + sgn * pr * sn[i]; }
                    }
                    u32x4 w; w.x = pk2(v[0] * rs, v[1] * rs); w.y = pk2(v[2] * rs, v[3] * rs); w.z = pk2(v[4] * rs, v[5] * rs); w.w = pk2(v[6] * rs, v[7] * rs);
                    *(u32x4*)(Q1 + (size_t)row * 768 + col) = w;
                }
                asm volatile("" ::: "memory");
            }
    }
};
struct EpiKV1 {
    static constexpr bool PERM = true, AFTER_DRAIN = false;
    bf16_t* KV1; const float* stats;
    __device__ __forceinline__ void operator()(const f32x4 (&acc)[2][2][4][2], const Unit& u, int wr, int wc, int fr, int fq) const {
        asm volatile("" : "+v"(fr), "+v"(fq));
#pragma unroll
        for (int ai = 0; ai < 2; ++ai)
#pragma unroll
            for (int m = 0; m < 4; ++m) {
                const int row = u.pm * 256 + ai * 128 + wr * 64 + m * 16 + fr;
                const float* sp = stats + (size_t)row * STP + 24 + fq * 4;
                float q = sp[1] + sp[3];
                q += __shfl_xor(q, 16); q += __shfl_xor(q, 32);
                const float rs = 1.f / sqrtf(q * (1.f / 256.f) + 1e-6f);
#pragma unroll
                for (int bj = 0; bj < 2; ++bj) {
                    const int col = u.pn * 256 + bj * 128 + wc * 32 + 8 * fq;
                    const f32x4 a = acc[ai][bj][m][0] * rs, b = acc[ai][bj][m][1] * rs;
                    u32x4 w; w.x = pk2(a[0], a[1]); w.y = pk2(a[2], a[3]); w.z = pk2(b[0], b[1]); w.w = pk2(b[2], b[3]);
                    *(u32x4*)(KV1 + (size_t)row * 1024 + col) = w;
                }
                asm volatile("" ::: "memory");
            }
    }
};

struct AttnDesc {
    const bf16_t* Q; int qpitch;
    const bf16_t* K; int kpitch;
    const bf16_t* K2; int k2pitch;
    const bf16_t* V; int vpitch;
    float* Of; bf16_t* Ob; int opitch;
    int qrow0;
    int ntiles, nlat, lat_row0, ctx_row0;
    int na_rowlo, na_gr0;
    const float* rpb;
    float lam; const float* subg;
};
__device__ __forceinline__ s16x4 tr_read(const LAS unsigned char* p) { return __builtin_bit_cast(s16x4, __builtin_amdgcn_ds_read_tr16_b64_v4i16((LAS v4i16_t*)p)); }


__device__ __forceinline__ void glds16(const void* gsrc, unsigned lds_dst) { unsigned keep;
    asm volatile("s_mov_b32 %0, m0\n\ts_mov_b32 m0, %2\n\ts_nop 0\n\tglobal_load_lds_dwordx4 %1, off\n\ts_mov_b32 m0, %0" : "=&s"(keep) : "v"(gsrc), "s"(lds_dst) : "memory"); }
template <int NDB>
__device__ __forceinline__ void att_softmax(f32x16& p0, f32x16& p1, f32x16 (&o)[NDB], float& mrun, float& lrun, bool& first, bf16x8 (&pf)[4]) {
    float ra = __builtin_fmaxf(__builtin_fmaxf(p0[0], p0[1]), p1[0]), rb = __builtin_fmaxf(__builtin_fmaxf(p0[2], p0[3]), p1[1]);
    ra = __builtin_fmaxf(__builtin_fmaxf(ra, p1[2]), p1[3]);
#pragma unroll
    for (int r = 4; r < 16; r += 4) { ra = __builtin_fmaxf(__builtin_fmaxf(ra, p0[r]), p0[r + 1]); rb = __builtin_fmaxf(__builtin_fmaxf(rb, p0[r + 2]), p0[r + 3]);
        ra = __builtin_fmaxf(__builtin_fmaxf(ra, p1[r]), p1[r + 1]); rb = __builtin_fmaxf(__builtin_fmaxf(rb, p1[r + 2]), p1[r + 3]); }
    float rm = __builtin_fmaxf(ra, rb);
    { auto rr = __builtin_amdgcn_permlane32_swap(__float_as_uint(rm), __float_as_uint(rm), false, false); rm = __builtin_fmaxf(__uint_as_float(rr[0]), __uint_as_float(rr[1])); }
    if (first || __any(rm > mrun + 8.f)) {
        const float mn = first ? rm : __builtin_fmaxf(mrun, rm);
        if (!first) { const float al = __builtin_amdgcn_exp2f(mrun - mn); lrun *= al;
#pragma unroll
            for (int i = 0; i < NDB; ++i) o[i] *= al; }
        mrun = mn; first = false;
    }
    float ls = 0.f;
#pragma unroll
    for (int r = 0; r < 16; ++r) { p0[r] = __builtin_amdgcn_exp2f(p0[r] - mrun); p1[r] = __builtin_amdgcn_exp2f(p1[r] - mrun); ls += p0[r] + p1[r]; }
    lrun += ls;
#pragma unroll
    for (int j = 0; j < 4; ++j) {
        u32x4 pw;
#pragma unroll
        for (int e = 0; e < 4; ++e) { const int r = 8 * (j & 1) + 2 * e; pw[e] = (j < 2) ? pk2(p0[r], p0[r + 1]) : pk2(p1[r], p1[r + 1]); }
        pf[j] = __builtin_bit_cast(bf16x8, pw);
    }
}
template <int NDB, int VS>
__device__ __forceinline__ void att_pv(f32x16 (&o)[NDB], const bf16x8 (&pf)[4], const LAS unsigned char* vb) {
#pragma unroll
    for (int j = 0; j < 4; ++j)
#pragma unroll
        for (int db = 0; db < NDB; ++db) {
            const s16x4 lo = tr_read(vb + (16 * j) * VS + db * 64), hh = tr_read(vb + (16 * j + 8) * VS + db * 64);
            const bf16x8 vf = (bf16x8){lo[0], lo[1], lo[2], lo[3], hh[0], hh[1], hh[2], hh[3]};
            o[db] = __builtin_amdgcn_mfma_f32_32x32x16_bf16(vf, pf[j], o[db], 0, 0, 0);
        }
}
template <int DQ, int DV, bool NA, int OMODE>
__device__ __forceinline__ void attn_unit(const AttnDesc d, LAS unsigned char* lds) {
    constexpr int KS = DQ * 2 + 16, VS = DV * 2 + 64;
    constexpr int KBUF = NA ? 64 * KS : (8192 + (DQ == 96 ? 4096 : 0)), VBUF = NA ? 64 * VS : 64 * DV * 2;
    constexpr int NBUF = NA ? 2 : 3;
    constexpr int OFF_K = 0, OFF_V = NBUF * KBUF, OFF_RPB = OFF_V + NBUF * VBUF;
    constexpr int NQF = DQ / 16, NDB = DV / 32;
    int tid = threadIdx.x; asm volatile("" : "+v"(tid));
    const int lane = tid & 63, w = __builtin_amdgcn_readfirstlane(tid >> 6), r32 = lane & 31, hi = lane >> 5;
    bf16x8 qf[NQF];
    { const bf16_t* qp = d.Q + (size_t)(d.qrow0 + 32 * w + r32) * d.qpitch + 8 * hi;
#pragma unroll
      for (int d0 = 0; d0 < NQF; ++d0) qf[d0] = *(const bf16x8*)(qp + 16 * d0); }
    LAS float* rpbL = (LAS float*)(lds + OFF_RPB);
    if (NA) { for (int i = tid; i < 465; i += 512) rpbL[i] = d.rpb[i] * LOG2E_; }
    const int kkey = tid >> 3, kch = tid & 7;
    const int k2key = tid >> 2, k2ch = tid & 3;
    u32x4 kA, kB, vA, vB;
#define ATT_TROW(i) ((i) < d.nlat ? d.lat_row0 + 64 * (i) : d.ctx_row0 + 64 * ((i) - d.nlat))
#define ATT_LOAD(i) do { const int tr_ = ATT_TROW(i); \
        kA = *(const u32x4*)(d.K + (size_t)(tr_ + kkey) * d.kpitch + kch * 8); \
        if (DQ == 96) { if (tid < 256) kB = *(const u32x4*)(d.K2 + (size_t)(tr_ + k2key) * d.k2pitch + k2ch * 8); } \
        if (DV == 128) { vA = *(const u32x4*)(d.V + (size_t)(tr_ + (tid >> 4)) * d.vpitch + (tid & 15) * 8); vB = *(const u32x4*)(d.V + (size_t)(tr_ + 32 + (tid >> 4)) * d.vpitch + (tid & 15) * 8); } \
        else { vA = *(const u32x4*)(d.V + (size_t)(tr_ + kkey) * d.vpitch + kch * 8); } } while (0)
#define ATT_STORE(b) do { \
        *(LAS u32x4*)(lds + OFF_K + (b) * KBUF + kkey * KS + kch * 16) = kA; \
        if (DQ == 96) { if (tid < 256) *(LAS u32x4*)(lds + OFF_K + (b) * KBUF + k2key * KS + 128 + k2ch * 16) = kB; } \
        if (DV == 128) { *(LAS u32x4*)(lds + OFF_V + (b) * VBUF + (tid >> 4) * VS + (tid & 15) * 16) = vA; *(LAS u32x4*)(lds + OFF_V + (b) * VBUF + (32 + (tid >> 4)) * VS + (tid & 15) * 16) = vB; } \
        else { *(LAS u32x4*)(lds + OFF_V + (b) * VBUF + kkey * VS + kch * 16) = vA; } } while (0)
    const int nt = d.ntiles;
    const unsigned ldsb = (unsigned)(uintptr_t)lds;
    int gko, gk2o = 0, gvo0, gvo1 = 0;
    { const int kr = 8 * w + (lane >> 3), kc = (lane & 7) ^ ((kr >> 1) & 7); gko = kr * d.kpitch + kc * 8;
      if (DQ == 96) { const int rr = 16 * (w & 3) + (lane >> 2), rc = (lane & 3) ^ ((rr >> 2) & 3); gk2o = rr * d.k2pitch + rc * 8; }
      if (DV == 128) { const int pos = lane & 15, sp = pos >> 2, sub = pos & 3;
          const int r0 = 8 * w + (lane >> 4), r1 = r0 + 4;
          gvo0 = r0 * d.vpitch + ((sp - r0) & 3) * 32 + sub * 8; gvo1 = r1 * d.vpitch + ((sp - r1) & 3) * 32 + sub * 8; }
      else { const int sr = 4 * w + (lane >> 4), pos = lane & 15, sp = pos >> 2, sub = pos & 3, x = (sp - sr) & 3;
          gvo0 = (2 * sr + (x >> 1)) * d.vpitch + (x & 1) * 32 + sub * 8; } }
#define ATT_DMA(i, slot) do { const int tr_ = ATT_TROW(i); \
        glds16(d.K + ((size_t)tr_ * d.kpitch + gko), (unsigned)__builtin_amdgcn_readfirstlane(ldsb + OFF_K + (slot) * KBUF + w * 1024)); \
        if (DQ == 96) { if (w < 4) glds16(d.K2 + ((size_t)tr_ * d.k2pitch + gk2o), (unsigned)__builtin_amdgcn_readfirstlane(ldsb + OFF_K + (slot) * KBUF + 8192 + w * 1024)); } \
        if (DV == 128) { glds16(d.V + ((size_t)tr_ * d.vpitch + gvo0), (unsigned)__builtin_amdgcn_readfirstlane(ldsb + OFF_V + (slot) * VBUF + w * 2048)); \
                         glds16(d.V + ((size_t)tr_ * d.vpitch + gvo1), (unsigned)__builtin_amdgcn_readfirstlane(ldsb + OFF_V + (slot) * VBUF + w * 2048 + 1024)); } \
        else glds16(d.V + ((size_t)tr_ * d.vpitch + gvo0), (unsigned)__builtin_amdgcn_readfirstlane(ldsb + OFF_V + (slot) * VBUF + w * 1024)); } while (0)
    if (NA) { ATT_LOAD(0); ATT_STORE(0); }
    else { ATT_DMA(0, 0); if (nt > 1) ATT_DMA(1, 1); asm volatile("s_waitcnt vmcnt(0)" ::: "memory"); }
    __syncthreads();
    f32x16 o[NDB];
#pragma unroll
    for (int i = 0; i < NDB; ++i) o[i] = (f32x16){};
    float mrun = 0.f, lrun = 0.f; bool first = true;
    const int gr = d.na_gr0 + (w >> 1);
    const int rs_ = gr - 4 < 0 ? 0 : (gr - 4 > 120 ? 120 : gr - 4);
    const int qc = 32 * (w & 1) + r32;
    const int cs_ = qc - 8 < 0 ? 0 : (qc - 8 > 48 ? 48 : qc - 8);
    unsigned namask0 = 0u, namask1 = 0u;
    if (NA) {
#pragma unroll
        for (int r = 0; r < 16; ++r) { const int kc0 = (r & 3) + 8 * (r >> 2) + 4 * hi, kc1 = kc0 + 32;
            namask0 |= (kc0 >= cs_ && kc0 < cs_ + 16) ? (1u << r) : 0u; namask1 |= (kc1 >= cs_ && kc1 < cs_ + 16) ? (1u << r) : 0u; }
    }
    const int koffr = r32 * KS + hi * 16;
    const int voffr = (4 * hi + ((lane & 15) >> 2)) * VS + ((lane >> 4) & 1) * 32 + (lane & 3) * 8;
    int kro[NQF], vro[NDB];
    { const int q_ = (lane & 15) >> 2, gi_ = (lane >> 4) & 1, p_ = lane & 3;
#pragma unroll
      for (int d0 = 0; d0 < NQF; ++d0) kro[d0] = d0 < 4 ? r32 * 128 + (((2 * d0 + hi) ^ ((r32 >> 1) & 7)) << 4) : 8192 + r32 * 64 + (((2 * (d0 - 4) + hi) ^ ((r32 >> 2) & 3)) << 4);
#pragma unroll
      for (int db = 0; db < NDB; ++db) vro[db] = DV == 128 ? (4 * hi + q_) * 256 + (((db + q_) & 3) << 6) + 32 * gi_ + 8 * p_
                                                             : (2 * hi + (q_ >> 1)) * 256 + (((2 * (q_ & 1) + db + 2 * hi + (q_ >> 1)) & 3) << 6) + 32 * gi_ + 8 * p_; }
    constexpr int VJ = DV == 128 ? 4096 : 2048, VE = DV == 128 ? 2048 : 1024;
    if constexpr (!NA) {
        f32x16 pA0, pA1, pB0, pB1; bf16x8 pf[4];
        int bc = 0, bn = 1, bn2 = 2;
#define ATT_BAR() asm volatile("s_waitcnt vmcnt(0) lgkmcnt(0)\n\ts_barrier" ::: "memory")
#define ATT_QK(P0, P1, slot) do { const LAS unsigned char* kb_ = lds + OFF_K + (slot) * KBUF; \
        bf16x8 ka_[NQF], kc_[NQF];       \
        _Pragma("unroll") for (int d0 = 0; d0 < NQF; ++d0) { ka_[d0] = *(const LAS bf16x8*)(kb_ + kro[d0]); kc_[d0] = *(const LAS bf16x8*)(kb_ + kro[d0] + (d0 < 4 ? 4096 : 2048)); } \
        __builtin_amdgcn_sched_barrier(0); \
        _Pragma("unroll") for (int d0 = 0; d0 < NQF; ++d0) { \
            const bf16x8 a0_ = ka_[d0], a1_ = kc_[d0]; \
            if (d0 == 0) { P0 = __builtin_amdgcn_mfma_f32_32x32x16_bf16(a0_, qf[0], (f32x16){}, 0, 0, 0); P1 = __builtin_amdgcn_mfma_f32_32x32x16_bf16(a1_, qf[0], (f32x16){}, 0, 0, 0); } \
            else { P0 = __builtin_amdgcn_mfma_f32_32x32x16_bf16(a0_, qf[d0], P0, 0, 0, 0); P1 = __builtin_amdgcn_mfma_f32_32x32x16_bf16(a1_, qf[d0], P1, 0, 0, 0); } } } while (0)
#define ATT_STEP(C0, C1, N0, N1, tt) do { \
        if ((tt) + 2 < nt) ATT_DMA((tt) + 2, bn2);        \
        if ((tt) + 1 < nt) ATT_QK(N0, N1, bn); \
        s16x4 vlo_[NDB][4], vhh_[NDB][4]; \
        if (DV == 64) { const LAS unsigned char* vb_ = lds + OFF_V + bc * VBUF;     \
            _Pragma("unroll") for (int db = 0; db < NDB; ++db) _Pragma("unroll") for (int j = 0; j < 4; ++j) { vlo_[db][j] = tr_read(vb_ + vro[db] + j * VJ); vhh_[db][j] = tr_read(vb_ + vro[db] + j * VJ + VE); } } \
        att_softmax<NDB>(C0, C1, o, mrun, lrun, first, pf); \
        if (DV == 64) { \
            _Pragma("unroll") for (int j = 0; j < 4; ++j) _Pragma("unroll") for (int db = 0; db < NDB; ++db) { \
                const bf16x8 vf_ = (bf16x8){vlo_[db][j][0], vlo_[db][j][1], vlo_[db][j][2], vlo_[db][j][3], vhh_[db][j][0], vhh_[db][j][1], vhh_[db][j][2], vhh_[db][j][3]}; \
                o[db] = __builtin_amdgcn_mfma_f32_32x32x16_bf16(vf_, pf[j], o[db], 0, 0, 0); } } \
        else { const LAS unsigned char* vb_ = lds + OFF_V + bc * VBUF; \
            _Pragma("unroll") for (int j = 0; j < 4; ++j) _Pragma("unroll") for (int db = 0; db < NDB; ++db) { \
                const s16x4 lo_ = tr_read(vb_ + vro[db] + j * VJ), hh_ = tr_read(vb_ + vro[db] + j * VJ + VE); \
                const bf16x8 vf_ = (bf16x8){lo_[0], lo_[1], lo_[2], lo_[3], hh_[0], hh_[1], hh_[2], hh_[3]}; \
                o[db] = __builtin_amdgcn_mfma_f32_32x32x16_bf16(vf_, pf[j], o[db], 0, 0, 0); } } \
        ATT_BAR(); \
        { const int t_ = bc; bc = bn; bn = bn2; bn2 = t_; } } while (0)
        ATT_QK(pA0, pA1, 0);
        int t = 0;
#pragma nounroll
        for (; t + 1 < nt; t += 2) {
            ATT_STEP(pA0, pA1, pB0, pB1, t);
            ATT_STEP(pB0, pB1, pA0, pA1, t + 1);
        }
        if (t < nt) ATT_STEP(pA0, pA1, pB0, pB1, t);
#undef ATT_STEP
#undef ATT_QK
#undef ATT_BAR
    } else {
#pragma nounroll
    for (int t = 0; t < nt; ++t) {
        const int cur = t & 1;
        if (t + 1 < nt) ATT_LOAD(t + 1);
        bool active = true;
        if (NA) { if (t < d.nlat) { const int krow = d.na_rowlo + t; active = (krow >= rs_) && (krow < rs_ + 8); } }
        if (active) {
            const LAS unsigned char* kb = lds + OFF_K + cur * KBUF + koffr;
            f32x16 p0, p1;
#pragma unroll
            for (int d0 = 0; d0 < NQF; ++d0) {
                const bf16x8 a0 = *(const LAS bf16x8*)(kb + d0 * 32), a1 = *(const LAS bf16x8*)(kb + 32 * KS + d0 * 32);
                if (d0 == 0) { p0 = __builtin_amdgcn_mfma_f32_32x32x16_bf16(a0, qf[0], (f32x16){}, 0, 0, 0); p1 = __builtin_amdgcn_mfma_f32_32x32x16_bf16(a1, qf[0], (f32x16){}, 0, 0, 0); }
                else { p0 = __builtin_amdgcn_mfma_f32_32x32x16_bf16(a0, qf[d0], p0, 0, 0, 0); p1 = __builtin_amdgcn_mfma_f32_32x32x16_bf16(a1, qf[d0], p1, 0, 0, 0); }
            }
            if (NA) { if (t < d.nlat) {
                const int roff = d.na_rowlo + t - gr + 7;
                const LAS float* bp = rpbL + roff * 31 + (4 * hi - qc + 15);
#pragma unroll
                for (int r = 0; r < 16; ++r) {
                    const int c0 = (r & 3) + 8 * (r >> 2);
                    const float b0 = bp[c0], b1 = bp[c0 + 32];
                    p0[r] = ((namask0 >> r) & 1u) ? p0[r] + b0 : -INFINITY;
                    p1[r] = ((namask1 >> r) & 1u) ? p1[r] + b1 : -INFINITY;
                }
            } }
            float ra = __builtin_fmaxf(__builtin_fmaxf(p0[0], p0[1]), p1[0]), rb = __builtin_fmaxf(__builtin_fmaxf(p0[2], p0[3]), p1[1]);
            ra = __builtin_fmaxf(__builtin_fmaxf(ra, p1[2]), p1[3]);
#pragma unroll
            for (int r = 4; r < 16; r += 4) { ra = __builtin_fmaxf(__builtin_fmaxf(ra, p0[r]), p0[r + 1]); rb = __builtin_fmaxf(__builtin_fmaxf(rb, p0[r + 2]), p0[r + 3]);
                ra = __builtin_fmaxf(__builtin_fmaxf(ra, p1[r]), p1[r + 1]); rb = __builtin_fmaxf(__builtin_fmaxf(rb, p1[r + 2]), p1[r + 3]); }
            float rm = __builtin_fmaxf(ra, rb);
            { auto rr = __builtin_amdgcn_permlane32_swap(__float_as_uint(rm), __float_as_uint(rm), false, false); rm = __builtin_fmaxf(__uint_as_float(rr[0]), __uint_as_float(rr[1])); }
            if (first || __any(rm > mrun + 8.f)) {
                const float mn = first ? rm : __builtin_fmaxf(mrun, rm);
                if (!first) { const float al = __builtin_amdgcn_exp2f(mrun - mn); lrun *= al;
#pragma unroll
                    for (int i = 0; i < NDB; ++i) o[i] *= al; }
                mrun = mn; first = false;
            }
            float ls = 0.f;
#pragma unroll
            for (int r = 0; r < 16; ++r) { p0[r] = __builtin_amdgcn_exp2f(p0[r] - mrun); p1[r] = __builtin_amdgcn_exp2f(p1[r] - mrun); ls += p0[r] + p1[r]; }
            lrun += ls;
            bf16x8 pf[4];
#pragma unroll
            for (int j = 0; j < 4; ++j) {
                u32x4 pw;
#pragma unroll
                for (int e = 0; e < 4; ++e) { const int r = 8 * (j & 1) + 2 * e; pw[e] = (j < 2) ? pk2(p0[r], p0[r + 1]) : pk2(p1[r], p1[r + 1]); }
                pf[j] = __builtin_bit_cast(bf16x8, pw);
            }
            const LAS unsigned char* vb = lds + OFF_V + cur * VBUF + voffr;
#pragma unroll
            for (int db = 0; db < NDB; ++db)
#pragma unroll
                for (int j = 0; j < 4; ++j) {
                    const s16x4 lo = tr_read(vb + (16 * j) * VS + db * 64), hh = tr_read(vb + (16 * j + 8) * VS + db * 64);
                    const bf16x8 vf = (bf16x8){lo[0], lo[1], lo[2], lo[3], hh[0], hh[1], hh[2], hh[3]};
                    o[db] = __builtin_amdgcn_mfma_f32_32x32x16_bf16(vf, pf[j], o[db], 0, 0, 0);
                }
        }
        if (t + 1 < nt) ATT_STORE(cur ^ 1);
        __syncthreads();
    }
    }
#undef ATT_TROW
#undef ATT_LOAD
#undef ATT_DMA
#undef ATT_STORE
    lrun += __shfl_xor(lrun, 32);
    const float inv = 1.f / lrun;
    const size_t orow = (size_t)(d.qrow0 + 32 * w + r32) * d.opitch;
    if (OMODE == 2) {
#pragma unroll
        for (int db = 0; db < NDB; ++db)
#pragma unroll
            for (int rg = 0; rg < 4; ++rg)
                *(u32x2*)(d.Ob + orow + 32 * db + 8 * rg + 4 * hi) = (u32x2){pk2(o[db][4 * rg] * inv, o[db][4 * rg + 1] * inv), pk2(o[db][4 * rg + 2] * inv, o[db][4 * rg + 3] * inv)};
    } else if (OMODE == 3) {
        float ss = 0.f;
#pragma unroll
        for (int db = 0; db < NDB; ++db)
#pragma unroll
            for (int rg = 0; rg < 4; ++rg) {
                const u32x2 st = *(const u32x2*)(d.Ob + orow + 32 * db + 8 * rg + 4 * hi);
                const float a1 = __uint_as_float(st[0] << 16), b1 = __uint_as_float(st[0] & 0xffff0000u), c1 = __uint_as_float(st[1] << 16), e1 = __uint_as_float(st[1] & 0xffff0000u);
                const float li = d.lam * inv;
                const float a = a1 - li * o[db][4 * rg], b = b1 - li * o[db][4 * rg + 1], c = c1 - li * o[db][4 * rg + 2], e = e1 - li * o[db][4 * rg + 3];
                o[db][4 * rg] = a; o[db][4 * rg + 1] = b; o[db][4 * rg + 2] = c; o[db][4 * rg + 3] = e;
                ss += (a * a + b * b) + (c * c + e * e);
            }
        ss += __shfl_xor(ss, 32);
        const float rs = (1.f - LAMBDA_INIT) / sqrtf(ss * (1.f / 128.f) + 1e-6f);
#pragma unroll
        for (int db = 0; db < NDB; ++db)
#pragma unroll
            for (int rg = 0; rg < 4; ++rg) {
                const int dc = 32 * db + 8 * rg + 4 * hi;
                const f32x4 g = *(const f32x4*)(d.subg + dc);
                *(u32x2*)(d.Ob + orow + dc) = (u32x2){pk2(o[db][4 * rg] * rs * g[0], o[db][4 * rg + 1] * rs * g[1]), pk2(o[db][4 * rg + 2] * rs * g[2], o[db][4 * rg + 3] * rs * g[3])};
            }
    } else {
#pragma unroll
        for (int db = 0; db < NDB; ++db)
#pragma unroll
            for (int rg = 0; rg < 4; ++rg) {
                const int dc = 32 * db + 8 * rg + 4 * hi;
                const float a = o[db][4 * rg] * inv, b = o[db][4 * rg + 1] * inv, c = o[db][4 * rg + 2] * inv, e = o[db][4 * rg + 3] * inv;
                if (OMODE == 1) *(f32x4*)(d.Of + orow + dc) = (f32x4){a, b, c, e};
                else *(u32x2*)(d.Ob + orow + dc) = (u32x2){pk2(a, b), pk2(c, e)};
            }
    }
}


__device__ __forceinline__ void attn_unit_mla2(const AttnDesc d, LAS unsigned char* lds) {
    constexpr int NQF = 6, NDB = 2, KBUF = 12288, VBUF = 8192, OFF_K = 0, OFF_V = 3 * KBUF, VJ = 2048, VE = 1024;
    int tid = threadIdx.x; asm volatile("" : "+v"(tid));
    const int lane = tid & 63, w = __builtin_amdgcn_readfirstlane(tid >> 6), r32 = lane & 31, hi = lane >> 5;
    bf16x8 qf[2][NQF];
#pragma unroll
    for (int qb = 0; qb < 2; ++qb) { const bf16_t* qp = d.Q + (size_t)(d.qrow0 + 64 * w + 32 * qb + r32) * d.qpitch + 8 * hi;
#pragma unroll
        for (int d0 = 0; d0 < NQF; ++d0) qf[qb][d0] = *(const bf16x8*)(qp + 16 * d0); }
    const unsigned ldsb = (unsigned)(uintptr_t)lds;
    int gko, gk2o, gvo0;
    { const int kr = 8 * w + (lane >> 3), kc = (lane & 7) ^ ((kr >> 1) & 7); gko = kr * d.kpitch + kc * 8;
      const int rr = 16 * (w & 3) + (lane >> 2), rc = (lane & 3) ^ ((rr >> 2) & 3); gk2o = rr * d.k2pitch + rc * 8;
      const int sr = 4 * w + (lane >> 4), pos = lane & 15, sp = pos >> 2, sub = pos & 3, x = (sp - sr) & 3;
      gvo0 = (2 * sr + (x >> 1)) * d.vpitch + (x & 1) * 32 + sub * 8; }
#define M2_TROW(i) ((i) < d.nlat ? d.lat_row0 + 64 * (i) : d.ctx_row0 + 64 * ((i) - d.nlat))
#define M2_DMA(i, slot) do { const int tr_ = M2_TROW(i); \
        glds16(d.K + ((size_t)tr_ * d.kpitch + gko), (unsigned)__builtin_amdgcn_readfirstlane(ldsb + OFF_K + (slot) * KBUF + w * 1024)); \
        if (w < 4) glds16(d.K2 + ((size_t)tr_ * d.k2pitch + gk2o), (unsigned)__builtin_amdgcn_readfirstlane(ldsb + OFF_K + (slot) * KBUF + 8192 + w * 1024)); \
        glds16(d.V + ((size_t)tr_ * d.vpitch + gvo0), (unsigned)__builtin_amdgcn_readfirstlane(ldsb + OFF_V + (slot) * VBUF + w * 1024)); } while (0)
    const int nt = d.ntiles;
    M2_DMA(0, 0); if (nt > 1) M2_DMA(1, 1);
    asm volatile("s_waitcnt vmcnt(0)" ::: "memory");
    __syncthreads();
    int kro[NQF], vro[NDB];
    { const int q_ = (lane & 15) >> 2, gi_ = (lane >> 4) & 1, p_ = lane & 3;
#pragma unroll
      for (int d0 = 0; d0 < NQF; ++d0) kro[d0] = d0 < 4 ? r32 * 128 + (((2 * d0 + hi) ^ ((r32 >> 1) & 7)) << 4) : 8192 + r32 * 64 + (((2 * (d0 - 4) + hi) ^ ((r32 >> 2) & 3)) << 4);
#pragma unroll
      for (int db = 0; db < NDB; ++db) vro[db] = (2 * hi + (q_ >> 1)) * 256 + (((2 * (q_ & 1) + db + 2 * hi + (q_ >> 1)) & 3) << 6) + 32 * gi_ + 8 * p_; }
    f32x16 o0[NDB], o1[NDB];
#pragma unroll
    for (int i = 0; i < NDB; ++i) { o0[i] = (f32x16){}; o1[i] = (f32x16){}; }
    float m0 = 0.f, l0 = 0.f, m1 = 0.f, l1 = 0.f; bool f0 = true, f1 = true;
    int bc = 0, bn2 = 2;
#pragma nounroll
    for (int t = 0; t < nt; ++t) {
        if (t + 2 < nt) M2_DMA(t + 2, bn2);
        const LAS unsigned char* kb_ = lds + OFF_K + bc * KBUF;
        bf16x8 ka_[NQF], kc_[NQF];
#pragma unroll
        for (int d0 = 0; d0 < NQF; ++d0) { ka_[d0] = *(const LAS bf16x8*)(kb_ + kro[d0]); kc_[d0] = *(const LAS bf16x8*)(kb_ + kro[d0] + (d0 < 4 ? 4096 : 2048)); }
        __builtin_amdgcn_sched_barrier(0);
        f32x16 pa0, pa1, pb0, pb1;
#pragma unroll
        for (int d0 = 0; d0 < NQF; ++d0) {
            if (d0 == 0) { pa0 = __builtin_amdgcn_mfma_f32_32x32x16_bf16(ka_[0], qf[0][0], (f32x16){}, 0, 0, 0); pa1 = __builtin_amdgcn_mfma_f32_32x32x16_bf16(kc_[0], qf[0][0], (f32x16){}, 0, 0, 0);
                           pb0 = __builtin_amdgcn_mfma_f32_32x32x16_bf16(ka_[0], qf[1][0], (f32x16){}, 0, 0, 0); pb1 = __builtin_amdgcn_mfma_f32_32x32x16_bf16(kc_[0], qf[1][0], (f32x16){}, 0, 0, 0); }
            else { pa0 = __builtin_amdgcn_mfma_f32_32x32x16_bf16(ka_[d0], qf[0][d0], pa0, 0, 0, 0); pa1 = __builtin_amdgcn_mfma_f32_32x32x16_bf16(kc_[d0], qf[0][d0], pa1, 0, 0, 0);
                   pb0 = __builtin_amdgcn_mfma_f32_32x32x16_bf16(ka_[d0], qf[1][d0], pb0, 0, 0, 0); pb1 = __builtin_amdgcn_mfma_f32_32x32x16_bf16(kc_[d0], qf[1][d0], pb1, 0, 0, 0); }
        }
        s16x4 vlo_[NDB][4], vhh_[NDB][4];
        { const LAS unsigned char* vb_ = lds + OFF_V + bc * VBUF;
#pragma unroll
          for (int db = 0; db < NDB; ++db)
#pragma unroll
            for (int j = 0; j < 4; ++j) { vlo_[db][j] = tr_read(vb_ + vro[db] + j * VJ); vhh_[db][j] = tr_read(vb_ + vro[db] + j * VJ + VE); } }
        bf16x8 pf0[4], pf1[4];
        att_softmax<NDB>(pa0, pa1, o0, m0, l0, f0, pf0);
        att_softmax<NDB>(pb0, pb1, o1, m1, l1, f1, pf1);
#pragma unroll
        for (int j = 0; j < 4; ++j)
#pragma unroll
            for (int db = 0; db < NDB; ++db) {
                const bf16x8 vf_ = (bf16x8){vlo_[db][j][0], vlo_[db][j][1], vlo_[db][j][2], vlo_[db][j][3], vhh_[db][j][0], vhh_[db][j][1], vhh_[db][j][2], vhh_[db][j][3]};
                o0[db] = __builtin_amdgcn_mfma_f32_32x32x16_bf16(vf_, pf0[j], o0[db], 0, 0, 0);
                o1[db] = __builtin_amdgcn_mfma_f32_32x32x16_bf16(vf_, pf1[j], o1[db], 0, 0, 0);
            }
        asm volatile("s_waitcnt vmcnt(0) lgkmcnt(0)\n\ts_barrier" ::: "memory");
        bc = bc == 2 ? 0 : bc + 1; bn2 = bn2 == 2 ? 0 : bn2 + 1;
    }
#undef M2_DMA
#undef M2_TROW
    l0 += __shfl_xor(l0, 32); l1 += __shfl_xor(l1, 32);
    const float inv0 = 1.f / l0, inv1 = 1.f / l1;
#pragma unroll
    for (int qb = 0; qb < 2; ++qb) {
        const size_t orow = (size_t)(d.qrow0 + 64 * w + 32 * qb + r32) * d.opitch; const float inv = qb ? inv1 : inv0;
#pragma unroll
        for (int db = 0; db < NDB; ++db)
#pragma unroll
            for (int rg = 0; rg < 4; ++rg) { const int dc = 32 * db + 8 * rg + 4 * hi;
                const f32x16& oo = qb ? o1[db] : o0[db];
                *(u32x2*)(d.Ob + orow + dc) = (u32x2){pk2(oo[4 * rg] * inv, oo[4 * rg + 1] * inv), pk2(oo[4 * rg + 2] * inv, oo[4 * rg + 3] * inv)}; }
    }
}


template <int PART>
__device__ __forceinline__ void attn_unit_diff2(const AttnDesc d, LAS unsigned char* lds, bf16_t* xch, unsigned* xcnt) {
    constexpr int NQF = 4, NDB = 4, KBUF = 8192, VBUF = 16384, OFF_K = 0, OFF_V = 3 * KBUF, OFF_Q = OFF_V + 3 * VBUF, VJ = 4096, VE = 2048;
    int tid = threadIdx.x; asm volatile("" : "+v"(tid));
    const int lane = tid & 63, w = __builtin_amdgcn_readfirstlane(tid >> 6), r32 = lane & 31, hi = lane >> 5;
    const unsigned ldsb = (unsigned)(uintptr_t)lds;
#pragma unroll
    for (int i = 0; i < 8; ++i) { const int r = 8 * i + (lane >> 3), c = (lane & 7) ^ ((r >> 1) & 7);
        glds16(d.Q + ((size_t)(d.qrow0 + 64 * w + r) * d.qpitch + c * 8), (unsigned)__builtin_amdgcn_readfirstlane(ldsb + OFF_Q + w * 8192 + i * 1024)); }
    int gko, gvo0, gvo1;
    { const int kr = 8 * w + (lane >> 3), kc = (lane & 7) ^ ((kr >> 1) & 7); gko = kr * d.kpitch + kc * 8;
      const int pos = lane & 15, sp = pos >> 2, sub = pos & 3, r0 = 8 * w + (lane >> 4), r1 = r0 + 4;
      gvo0 = r0 * d.vpitch + ((sp - r0) & 3) * 32 + sub * 8; gvo1 = r1 * d.vpitch + ((sp - r1) & 3) * 32 + sub * 8; }
#define D2_TROW(i) ((i) < d.nlat ? d.lat_row0 + 64 * (i) : d.ctx_row0 + 64 * ((i) - d.nlat))
#define D2_DMA(i, slot) do { const int tr_ = D2_TROW(i); \
        glds16(d.K + ((size_t)tr_ * d.kpitch + gko), (unsigned)__builtin_amdgcn_readfirstlane(ldsb + OFF_K + (slot) * KBUF + w * 1024)); \
        glds16(d.V + ((size_t)tr_ * d.vpitch + gvo0), (unsigned)__builtin_amdgcn_readfirstlane(ldsb + OFF_V + (slot) * VBUF + w * 2048)); \
        glds16(d.V + ((size_t)tr_ * d.vpitch + gvo1), (unsigned)__builtin_amdgcn_readfirstlane(ldsb + OFF_V + (slot) * VBUF + w * 2048 + 1024)); } while (0)
    const int nt = d.ntiles;
    D2_DMA(0, 0); if (nt > 1) D2_DMA(1, 1);
    asm volatile("s_waitcnt vmcnt(0)" ::: "memory");
    __syncthreads();
    int kro[NQF], vro[NDB];
    { const int q_ = (lane & 15) >> 2, gi_ = (lane >> 4) & 1, p_ = lane & 3;
#pragma unroll
      for (int d0 = 0; d0 < NQF; ++d0) kro[d0] = r32 * 128 + (((2 * d0 + hi) ^ ((r32 >> 1) & 7)) << 4);
#pragma unroll
      for (int db = 0; db < NDB; ++db) vro[db] = (4 * hi + q_) * 256 + (((db + q_) & 3) << 6) + 32 * gi_ + 8 * p_; }
    f32x16 o0[NDB], o1[NDB];
#pragma unroll
    for (int i = 0; i < NDB; ++i) { o0[i] = (f32x16){}; o1[i] = (f32x16){}; }
    float m0 = 0.f, l0 = 0.f, m1 = 0.f, l1 = 0.f; bool f0 = true, f1 = true;
    int bc = 0, bn2 = 2;
    const LAS unsigned char* qim = lds + OFF_Q + w * 8192;
#pragma nounroll
    for (int t = 0; t < nt; ++t) {
        if (t + 2 < nt) D2_DMA(t + 2, bn2);
        const LAS unsigned char* kb_ = lds + OFF_K + bc * KBUF;
        f32x16 pa0, pa1, pb0, pb1;
#pragma unroll
        for (int dh = 0; dh < NQF; dh += 2) {
            bf16x8 ka[2], kc[2], qa[2], qb[2];
#pragma unroll
            for (int e = 0; e < 2; ++e) { ka[e] = *(const LAS bf16x8*)(kb_ + kro[dh + e]); kc[e] = *(const LAS bf16x8*)(kb_ + kro[dh + e] + 4096);
                                          qa[e] = *(const LAS bf16x8*)(qim + kro[dh + e]); qb[e] = *(const LAS bf16x8*)(qim + kro[dh + e] + 4096); }
            __builtin_amdgcn_sched_barrier(0);
#pragma unroll
            for (int e = 0; e < 2; ++e) {
                if (dh + e == 0) { pa0 = __builtin_amdgcn_mfma_f32_32x32x16_bf16(ka[e], qa[e], (f32x16){}, 0, 0, 0); pa1 = __builtin_amdgcn_mfma_f32_32x32x16_bf16(kc[e], qa[e], (f32x16){}, 0, 0, 0);
                                   pb0 = __builtin_amdgcn_mfma_f32_32x32x16_bf16(ka[e], qb[e], (f32x16){}, 0, 0, 0); pb1 = __builtin_amdgcn_mfma_f32_32x32x16_bf16(kc[e], qb[e], (f32x16){}, 0, 0, 0); }
                else { pa0 = __builtin_amdgcn_mfma_f32_32x32x16_bf16(ka[e], qa[e], pa0, 0, 0, 0); pa1 = __builtin_amdgcn_mfma_f32_32x32x16_bf16(kc[e], qa[e], pa1, 0, 0, 0);
                       pb0 = __builtin_amdgcn_mfma_f32_32x32x16_bf16(ka[e], qb[e], pb0, 0, 0, 0); pb1 = __builtin_amdgcn_mfma_f32_32x32x16_bf16(kc[e], qb[e], pb1, 0, 0, 0); }
            }
        }
        bf16x8 pf0[4], pf1[4];
        att_softmax<NDB>(pa0, pa1, o0, m0, l0, f0, pf0);
        att_softmax<NDB>(pb0, pb1, o1, m1, l1, f1, pf1);
        { const LAS unsigned char* vb_ = lds + OFF_V + bc * VBUF;
#pragma unroll
          for (int j = 0; j < 4; ++j)
#pragma unroll
            for (int db = 0; db < NDB; ++db) {
                const s16x4 lo_ = tr_read(vb_ + vro[db] + j * VJ), hh_ = tr_read(vb_ + vro[db] + j * VJ + VE);
                const bf16x8 vf_ = (bf16x8){lo_[0], lo_[1], lo_[2], lo_[3], hh_[0], hh_[1], hh_[2], hh_[3]};
                o0[db] = __builtin_amdgcn_mfma_f32_32x32x16_bf16(vf_, pf0[j], o0[db], 0, 0, 0);
                o1[db] = __builtin_amdgcn_mfma_f32_32x32x16_bf16(vf_, pf1[j], o1[db], 0, 0, 0);
            } }
        asm volatile("s_waitcnt vmcnt(0) lgkmcnt(0)\n\ts_barrier" ::: "memory");
        bc = bc == 2 ? 0 : bc + 1; bn2 = bn2 == 2 ? 0 : bn2 + 1;
    }
#undef D2_DMA
#undef D2_TROW
    l0 += __shfl_xor(l0, 32); l1 += __shfl_xor(l1, 32);
    const float inv0 = 1.f / l0, inv1 = 1.f / l1;
    if (PART == 0) {
#pragma unroll
        for (int qb = 0; qb < 2; ++qb) { const size_t xrow = (size_t)(d.qrow0 + 64 * w + 32 * qb + r32) * 128; const float inv = qb ? inv1 : inv0;
#pragma unroll
            for (int db = 0; db < NDB; ++db)
#pragma unroll
                for (int rg = 0; rg < 4; ++rg) { const f32x16& oo = qb ? o1[db] : o0[db];
                    const unsigned long long v = (unsigned long long)pk2(oo[4 * rg] * inv, oo[4 * rg + 1] * inv) | ((unsigned long long)pk2(oo[4 * rg + 2] * inv, oo[4 * rg + 3] * inv) << 32);
                    __hip_atomic_store((unsigned long long*)(xch + xrow + 32 * db + 8 * rg + 4 * hi), v, __ATOMIC_RELAXED, __HIP_MEMORY_SCOPE_AGENT); } }
        asm volatile("s_waitcnt vmcnt(0)" ::: "memory"); __syncthreads();
        if (threadIdx.x == 0) __hip_atomic_fetch_add(xcnt, 1u, __ATOMIC_RELAXED, __HIP_MEMORY_SCOPE_AGENT);
    } else {
        if (threadIdx.x == 0) { unsigned sp = 0;
            while (__hip_atomic_load(xcnt, __ATOMIC_RELAXED, __HIP_MEMORY_SCOPE_AGENT) < 1u) { __builtin_amdgcn_s_sleep(2); if (++sp > (1u << 24)) break; }
            __builtin_amdgcn_fence(__ATOMIC_ACQUIRE, "agent"); asm volatile("s_waitcnt vmcnt(0)" ::: "memory"); }
        __syncthreads();
#pragma unroll
        for (int qb = 0; qb < 2; ++qb) {
            const int row = d.qrow0 + 64 * w + 32 * qb + r32; const size_t xrow = (size_t)row * 128; const float li = d.lam * (qb ? inv1 : inv0);
            float c[NDB][16]; float ss = 0.f;
#pragma unroll
            for (int db = 0; db < NDB; ++db)
#pragma unroll
                for (int rg = 0; rg < 4; ++rg) { const f32x16& oo = qb ? o1[db] : o0[db];
                    const unsigned long long st = __hip_atomic_load((unsigned long long*)(xch + xrow + 32 * db + 8 * rg + 4 * hi), __ATOMIC_RELAXED, __HIP_MEMORY_SCOPE_AGENT);
                    const unsigned s0 = (unsigned)st, s1 = (unsigned)(st >> 32);
                    const float a = __uint_as_float(s0 << 16) - li * oo[4 * rg], b = __uint_as_float(s0 & 0xffff0000u) - li * oo[4 * rg + 1];
                    const float e = __uint_as_float(s1 << 16) - li * oo[4 * rg + 2], g = __uint_as_float(s1 & 0xffff0000u) - li * oo[4 * rg + 3];
                    c[db][4 * rg] = a; c[db][4 * rg + 1] = b; c[db][4 * rg + 2] = e; c[db][4 * rg + 3] = g; ss += (a * a + b * b) + (e * e + g * g); }
            ss += __shfl_xor(ss, 32);
            const float rs = (1.f - LAMBDA_INIT) / sqrtf(ss * (1.f / 128.f) + 1e-6f);
            const size_t orow = (size_t)row * d.opitch;
#pragma unroll
            for (int db = 0; db < NDB; ++db)
#pragma unroll
                for (int rg = 0; rg < 4; ++rg) { const int dc = 32 * db + 8 * rg + 4 * hi; const f32x4 gg = *(const f32x4*)(d.subg + dc);
                    *(u32x2*)(d.Ob + orow + dc) = (u32x2){pk2(c[db][4 * rg] * rs * gg[0], c[db][4 * rg + 1] * rs * gg[1]), pk2(c[db][4 * rg + 2] * rs * gg[2], c[db][4 * rg + 3] * rs * gg[3])}; }
        }
    }
}

__device__ __forceinline__ void p0_item(const float* W, int K, int N, bf16_t* WT, int mode, const float* ksc, LAS float* scr, int item, int lane) {
    const int nblk = N / 32, kb = item / nblk, nb = item % nblk, k0 = 64 * kb, n0 = 32 * nb;
#pragma unroll 8
    for (int i = 0; i < 32; ++i) { const int kk = 2 * i + (lane >> 5); float v = W[(size_t)(k0 + kk) * N + n0 + (lane & 31)]; if (ksc) v *= ksc[k0 + kk]; scr[kk * 33 + (lane & 31)] = v; }
    asm volatile("s_waitcnt lgkmcnt(0)" ::: "memory");
    int nd0 = n0;
    if (mode == 1) { nd0 = (n0 < FH) ? (n0 / 128) * 256 + (n0 % 128) : ((n0 - FH) / 128) * 256 + 128 + ((n0 - FH) % 128); }
    else if (mode == 2) { nd0 = (n0 < 672) ? n0 : n0 + 96; }
    const int c = lane & 7;
#pragma unroll
    for (int j = 0; j < 4; ++j) { const int n = (lane >> 3) + 8 * j; const LAS float* s = scr + (8 * c) * 33 + n;
        u32x4 o; o.x = pk2(s[0 * 33], s[1 * 33]); o.y = pk2(s[2 * 33], s[3 * 33]); o.z = pk2(s[4 * 33], s[5 * 33]); o.w = pk2(s[6 * 33], s[7 * 33]);
        *(u32x4*)(WT + (size_t)(nd0 + n) * K + k0 + 8 * c) = o; }
    asm volatile("s_waitcnt lgkmcnt(0)" ::: "memory");
}
__device__ __forceinline__ void sincos_small(float af, float& s, float& c) {
    const double a = (double)af; const double k = rint(a * 0.6366197723675814); const double r = a - k * 1.5707963267948966;
    const double r2 = r * r;
    const double sp = r * (1.0 + r2 * (-1.0 / 6 + r2 * (1.0 / 120 + r2 * (-1.0 / 5040 + r2 * (1.0 / 362880 + r2 * (-1.0 / 39916800 + r2 * (1.0 / 6227020800.0)))))));
    const double cp = 1.0 + r2 * (-0.5 + r2 * (1.0 / 24 + r2 * (-1.0 / 720 + r2 * (1.0 / 40320 + r2 * (-1.0 / 3628800 + r2 * (1.0 / 479001600.0))))));
    const int q = ((int)k) & 3;
    const double ss = (q == 0) ? sp : (q == 1) ? cp : (q == 2) ? -sp : -cp;
    const double cc = (q == 0) ? cp : (q == 1) ? -sp : (q == 2) ? -cp : sp;
    s = (float)ss; c = (float)cc;
}

#define XB_TMO      128
#define XB_XCNT(j)  (256  + 64 * (j))
#define XB_XSUB(j)  (1280 + 64 * (j))
#define XB_XGEN(j)  (2304 + 64 * (j))
#define XB_TOP      3328
#define XB_TOPGEN   3392
#define XCD_BAR_WORDS 3456
#define XB_SPIN_CAP (1u << 18)

__device__ __forceinline__ unsigned xb_ld(unsigned* p)              { return __hip_atomic_load(p, __ATOMIC_RELAXED, __HIP_MEMORY_SCOPE_AGENT); }
__device__ __forceinline__ unsigned xb_add(unsigned* p, unsigned v) { return __hip_atomic_fetch_add(p, v, __ATOMIC_RELAXED, __HIP_MEMORY_SCOPE_AGENT); }
__device__ __forceinline__ unsigned xb_xcc_id() { return (unsigned)__builtin_amdgcn_s_getreg((3 << 11) | 20) & 0xFu; }
#define XB_SPIN(cond, bar) do { unsigned _sp = 0; while (cond) { __builtin_amdgcn_s_sleep(1); \
    if ((++_sp & 255u) == 0u) { if (xb_ld(&(bar)[XB_TMO])) break; if (_sp > XB_SPIN_CAP) { atomicAdd(&(bar)[XB_TMO], 1u); break; } } } } while (0)

struct XcdBarrier {
    unsigned* bar; unsigned x;
    volatile LAS unsigned* st;
};

__device__ __forceinline__ XcdBarrier xcd_barrier_post(unsigned* bar, volatile LAS unsigned* st) {
    XcdBarrier b; b.bar = bar; b.x = xb_xcc_id(); b.st = st;
    if (threadIdx.x == 0) (void)xb_add(&bar[XB_XCNT(b.x)], 1u);
    return b;
}
__device__ __forceinline__ void xcd_barrier_complete(unsigned* bar, unsigned x, unsigned& nloc, unsigned& nx) {
    const unsigned G = gridDim.x * gridDim.y * gridDim.z;
    unsigned sum, cnt, mine, sp = 0u;
    for (;;) {
        sum = 0u; cnt = 0u; mine = 0u;
#pragma unroll
        for (unsigned j = 0; j < 16; ++j) { const unsigned c = xb_ld(&bar[XB_XCNT(j)]); sum += c; cnt += (c > 0u) ? 1u : 0u; mine = (j == x) ? c : mine; }
        if (sum == G) break;
        __builtin_amdgcn_s_sleep(1);
        if ((++sp & 255u) == 0u) { if (xb_ld(&bar[XB_TMO])) break; if (sp > XB_SPIN_CAP) { atomicAdd(&bar[XB_TMO], 1u); break; } }
    }
    nloc = mine > 0u ? mine : 1u; nx = cnt > 0u ? cnt : 1u;
}

__device__ __forceinline__ void xcd_barrier(const XcdBarrier& b) {
    asm volatile("s_waitcnt vmcnt(0)" ::: "memory");
    __syncthreads();
    if (threadIdx.x == 0) {
        unsigned* bar = b.bar;
        __builtin_amdgcn_s_waitcnt(0);
        unsigned nloc = b.st[0], nx = b.st[1];
        if (nloc == 0u) { xcd_barrier_complete(bar, b.x, nloc, nx); b.st[0] = nloc; b.st[1] = nx; }
        const unsigned old = xb_add(&bar[XB_XSUB(b.x)], 1u);
        const unsigned gen = old / nloc;
        if (old + 1u == (gen + 1u) * nloc) {
            __builtin_amdgcn_fence(__ATOMIC_RELEASE, "agent");
            asm volatile("s_waitcnt vmcnt(0)" ::: "memory");
            const unsigned og = xb_add(&bar[XB_TOP], 1u);
            const unsigned tg = og / nx;
            if (og + 1u == (tg + 1u) * nx) xb_add(&bar[XB_TOPGEN], 1u);
            else XB_SPIN(xb_ld(&bar[XB_TOPGEN]) == tg, bar);
            __builtin_amdgcn_fence(__ATOMIC_ACQUIRE, "agent");
            xb_add(&bar[XB_XGEN(b.x)], 1u);
            asm volatile("s_waitcnt vmcnt(0)" ::: "memory");
        } else {
            XB_SPIN(xb_ld(&bar[XB_XGEN(b.x)]) == gen, bar);
            __builtin_amdgcn_fence(__ATOMIC_ACQUIRE, "agent");
            asm volatile("s_waitcnt vmcnt(0)" ::: "memory");
        }
    }
    __syncthreads();
}

struct Params {
    const float *x, *c, *ctx, *c_ctx, *mod_w, *mod_b, *ln_mix_g, *ln_mix_b, *ln_ffn_g, *ln_ffn_b, *ffn_w_in, *ffn_w_out, *ev_w_in, *ev_w_out,
        *diff_lambda, *diff_subln_g, *na_rpb, *od_w_in, *od_w_out, *mla_q_norm_g, *mla_w_uq, *mla_kv_norm_g, *mla_w_ukv, *gmlp_ln_g, *gmlp_ln_b, *gmlp_ws, *gmlp_b;
    float* out; unsigned char* ws; int lo, hi;
};

__device__ __forceinline__ void ln_rows(float* Z, float* dst, const float* g, const float* b, bf16_t* U, const float* modl, int kmod, int nrows, int gw, int ngw, int lane) {
    for (int row = gw; row < nrows; row += ngw) {
        const f32x4* zr = (const f32x4*)(Z + (size_t)row * DM) + lane;
        f32x4 v[4]; float s = 0.f;
#pragma unroll
        for (int j = 0; j < 4; ++j) { v[j] = zr[64 * j]; s += (v[j][0] + v[j][1]) + (v[j][2] + v[j][3]); }
        const float mean = wave_sum(s) * (1.f / DM); float s2 = 0.f;
#pragma unroll
        for (int j = 0; j < 4; ++j) { v[j] = v[j] - mean; s2 += (v[j][0] * v[j][0] + v[j][1] * v[j][1]) + (v[j][2] * v[j][2] + v[j][3] * v[j][3]); }
        const float rstd = 1.f / sqrtf(wave_sum(s2) * (1.f / DM) + 1e-5f);
        const int set = row < 8192 ? 0 : (row < ML ? 1 : 2);
        const float* mp = modl ? modl + set * 6144 + kmod * 1024 : nullptr;
#pragma unroll
        for (int j = 0; j < 4; ++j) {
            const int col = 256 * j + 4 * lane;
            const f32x4 gg = *(const f32x4*)(g + col), bb = *(const f32x4*)(b + col);
            const f32x4 h = v[j] * rstd * gg + bb;
            *(f32x4*)(dst + (size_t)row * DM + col) = h;
            if (U) { const f32x4 sh = *(const f32x4*)(mp + col), sc = *(const f32x4*)(mp + 1024 + col);
                const f32x4 uu = h * (sc + 1.f) + sh;
                *(u32x2*)(U + (size_t)row * DM + col) = (u32x2){pk2(uu[0], uu[1]), pk2(uu[2], uu[3])}; }
        }
    }
}

typedef const __attribute__((address_space(4))) Params* kparams_t;
__device__ __forceinline__ kparams_t kparams() { kparams_t q = (kparams_t)__builtin_amdgcn_kernarg_segment_ptr(); asm volatile("" : "+s"(q)); return q; }
constexpr int NPHASE = 18;
constexpr int LDS_BYTES = 147456;

__global__ void __launch_bounds__(512) dit_fwd(Params p) {
    extern __shared__ __attribute__((aligned(16))) unsigned char lds_raw[];
    LAS unsigned char* lds = (LAS unsigned char*)lds_raw;
    const int G = gridDim.x, blk = blockIdx.x;
    const int tid = threadIdx.x, lane = tid & 63, wave = __builtin_amdgcn_readfirstlane(tid >> 6);
    const int gw = blk * 8 + wave, ngw = G * 8;
    const int gtid = blk * 512 + tid, ngt = G * 512;
#define Wevin ((bf16_t*)(ws + O_EVIN))
#define Wevout ((bf16_t*)(ws + O_EVOUT))
#define Wffin0 ((bf16_t*)(ws + O_FFIN0))
#define Wffout0 ((bf16_t*)(ws + O_FFOUT0))
#define Wffin1 ((bf16_t*)(ws + O_FFIN1))
#define Wffout1 ((bf16_t*)(ws + O_FFOUT1))
#define Wodin ((bf16_t*)(ws + O_ODIN))
#define Wodout ((bf16_t*)(ws + O_ODOUT))
#define Wuq ((bf16_t*)(ws + O_UQ))
#define Wukv ((bf16_t*)(ws + O_UKV))
#define Gws ((bf16_t*)(ws + O_GWS))
#define mod ((float*)(ws + O_MOD))
#define tab32 ((float*)(ws + O_TAB32))
#define tab16 ((float*)(ws + O_TAB16))
#define P ((bf16_t*)(ws + O_P))
#define H ((float*)(ws + O_H))
#define Hb ((bf16_t*)(ws + O_H))
#define U ((bf16_t*)(ws + O_U))
#define Odiff ((float*)(ws + O_ODIFF))
#define AMIX0 ((bf16_t*)(ws + O_AMIX0))
#define ACT ((bf16_t*)(ws + O_ACT))
#define P1 ((bf16_t*)(ws + O_P1))
#define AMIX1 ((bf16_t*)(ws + O_AMIX1))
#define stats ((float*)(ws + O_STATS))
#define KV1 ((bf16_t*)(ws + O_KV1))
#define Q1 ((bf16_t*)(ws + O_Q1))
#define PHASE_BEGIN kparams_t q = kparams(); unsigned char* ws = q->ws;
    const int lo = p.lo, hi = p.hi;
    volatile LAS unsigned* xst = (volatile LAS unsigned*)(lds + LDS_BYTES - 64);
    if (tid < 2) xst[tid] = 0u;
    __syncthreads();
    XcdBarrier xbar = xcd_barrier_post((unsigned*)(p.ws + O_BAR), xst);
    if (p.hi > 1000) cg::this_grid().sync();
#ifndef PH_MASK
#define PH_MASK 0x3ffff
#endif
#define IN(k) ((((PH_MASK) >> (k)) & 1) && lo <= (k) && (k) < hi)
#define SEAM(k) do { if (hi - lo > 1) xcd_barrier(xbar); } while (0)

    if (IN(0)) { PHASE_BEGIN
        if (blk < 96) {
            LAS float* sl = (LAS float*)lds;
            for (int i = tid; i < 3072; i += 512) { const int set = i >> 10, k = i & 1023; const float cv = set == 0 ? q->c[k] : (set == 1 ? q->c[1024 + k] : q->c_ctx[k]); sl[i] = cv / (1.f + __expf(-cv)); }
            __syncthreads();
            const int layer = blk / 48, chunk = blk % 48;
            const float* W = q->mod_w + (size_t)layer * 1024 * 6144 + chunk * 128 + 2 * lane;
            float a00 = 0.f, a01 = 0.f, a10 = 0.f, a11 = 0.f, a20 = 0.f, a21 = 0.f;
#pragma unroll 16
            for (int k = 128 * wave; k < 128 * wave + 128; ++k) { const f32x2v wv = *(const f32x2v*)(W + (size_t)k * 6144);
                const float s0 = sl[k], s1 = sl[1024 + k], s2 = sl[2048 + k];
                a00 += s0 * wv[0]; a01 += s0 * wv[1]; a10 += s1 * wv[0]; a11 += s1 * wv[1]; a20 += s2 * wv[0]; a21 += s2 * wv[1]; }
            LAS float* red = sl + 3072;
            red[(wave * 3 + 0) * 128 + 2 * lane] = a00; red[(wave * 3 + 0) * 128 + 2 * lane + 1] = a01;
            red[(wave * 3 + 1) * 128 + 2 * lane] = a10; red[(wave * 3 + 1) * 128 + 2 * lane + 1] = a11;
            red[(wave * 3 + 2) * 128 + 2 * lane] = a20; red[(wave * 3 + 2) * 128 + 2 * lane + 1] = a21;
            __syncthreads();
            if (tid < 384) { const int s = tid >> 7, n = tid & 127; float acc = q->mod_b[layer * 6144 + chunk * 128 + n];
#pragma unroll
                for (int w8 = 0; w8 < 8; ++w8) acc += red[(w8 * 3 + s) * 128 + n];
                mod[(layer * 3 + s) * 6144 + chunk * 128 + n] = acc; }
            __syncthreads();
        } else if (blk == 96) {
            for (int i = tid; i < 3072; i += 512) {
                if (i < 2048) { const int pos = i >> 4, f = i & 15; const float inv = exp2f(-(float)f * (13.287712379549449f / 16.f)); float s, c; sincos_small((float)pos * inv, s, c); tab32[2 * i] = c; tab32[2 * i + 1] = s; }
                else { const int j = i - 2048, pos = j >> 3, f = j & 7; const float inv = exp2f(-(float)f * (13.287712379549449f / 8.f)); float s, c; sincos_small((float)pos * inv, s, c); tab16[2 * j] = c; tab16[2 * j + 1] = s; }
            }
        }
        {
            LAS float* scr = (LAS float*)(lds + wave * 16384);
            constexpr int I0 = 16 * 96, I1 = 16 * 32, I2 = 16 * 176, I3 = 44 * 32, I4 = 16 * 53, I5 = 16 * 32, I6 = 6 * 24, I7 = 4 * 32;
            for (int it = gw; it < I0; it += ngw) p0_item(q->ev_w_in, 1024, 3072, Wevin, 0, nullptr, scr, it, lane);
            for (int i = gtid; i < 65536; i += ngt) Gws[i] = (bf16_t)f2bf(q->gmlp_ws[i]);
            for (int i = gtid; i < 96 * 1024 / 2; i += ngt) ((unsigned*)(Wodin + (size_t)672 * 1024))[i] = 0u;
        }
    }
    SEAM(0);
    if (IN(1)) { PHASE_BEGIN
        for (int idx = gtid; idx < MT * 128; idx += ngt) {
            const int row = idx >> 7, c8 = (idx & 127) * 8;
            const float* src = row < ML ? q->x + (size_t)row * DM : q->ctx + (size_t)(row - ML) * DM;
            const int set = row < 8192 ? 0 : (row < ML ? 1 : 2);
            const float* mp = mod + set * 6144;
            const f32x4 v0 = *(const f32x4*)(src + c8), v1 = *(const f32x4*)(src + c8 + 4);
            const f32x4 sh0 = *(const f32x4*)(mp + c8), sh1 = *(const f32x4*)(mp + c8 + 4), sc0 = *(const f32x4*)(mp + 1024 + c8), sc1 = *(const f32x4*)(mp + 1024 + c8 + 4);
            const f32x4 u0 = v0 * (sc0 + 1.f) + sh0, u1 = v1 * (sc1 + 1.f) + sh1;
            *(u32x4*)(U + (size_t)row * DM + c8) = (u32x4){pk2(u0[0], u0[1]), pk2(u0[2], u0[3]), pk2(u1[0], u1[1]), pk2(u1[2], u1[3])};
        }
    }
    SEAM(1);
    if (IN(2)) { PHASE_BEGIN
        pg8::Gemm g{U, Wevin, MT, PW0, 1024, 1024, 1024}; pg8::StaticOrder S; S.init(MT, PW0, G, blk);
        EpiIn0 E{P, tab32};
        pg8::gemm_phase<EpiIn0, pg8::StaticOrder, true, true>(lds, g, S, E);
        if (blk >= 24) {
            LAS float* scr = (LAS float*)(lds + wave * 16384);
            constexpr int I1 = 16 * 32, I2 = 16 * 176, I3 = 44 * 32, I4 = 16 * 53, I5 = 16 * 32, I6 = 6 * 24, I7 = 4 * 32;
            constexpr int NIT = I1 + 2 * I2 + 2 * I3 + I4 + I5 + I6 + I7;
            for (int it = (blk - 24) * 8 + wave; it < NIT; it += (G - 24) * 8) {
                int r = it;
                if (r < I1) { p0_item(q->ev_w_out, 1024, 1024, Wevout, 0, nullptr, scr, r, lane); continue; } r -= I1;
                if (r < I2) { p0_item(q->ffn_w_in, 1024, 5632, Wffin0, 1, nullptr, scr, r, lane); continue; } r -= I2;
                if (r < I2) { p0_item(q->ffn_w_in + (size_t)1024 * 5632, 1024, 5632, Wffin1, 1, nullptr, scr, r, lane); continue; } r -= I2;
                if (r < I3) { p0_item(q->ffn_w_out, 2816, 1024, Wffout0, 0, nullptr, scr, r, lane); continue; } r -= I3;
                if (r < I3) { p0_item(q->ffn_w_out + (size_t)2816 * 1024, 2816, 1024, Wffout1, 0, nullptr, scr, r, lane); continue; } r -= I3;
                if (r < I4) { p0_item(q->od_w_in, 1024, 1696, Wodin, 2, nullptr, scr, r, lane); continue; } r -= I4;
                if (r < I5) { p0_item(q->od_w_out, 1024, 1024, Wodout, 0, nullptr, scr, r, lane); continue; } r -= I5;
                if (r < I6) { p0_item(q->mla_w_uq, 384, 768, Wuq, 0, q->mla_q_norm_g, scr, r, lane); continue; } r -= I6;
                p0_item(q->mla_w_ukv, 256, 1024, Wukv, 0, q->mla_kv_norm_g, scr, r, lane);
            }
        }
    }
    SEAM(2);
    if (IN(3)) { PHASE_BEGIN
        const int xcd = blk & 7, idx = blk >> 3;
        float lam;
        { const float a = q->diff_lambda[lane] * q->diff_lambda[64 + lane], b2 = q->diff_lambda[128 + lane] * q->diff_lambda[192 + lane];
          lam = __expf(wave_sum(a)) - __expf(wave_sum(b2)) + LAMBDA_INIT; }
        {
            const int b = xcd >> 2, h = xcd & 3, part = idx >> 4, qb = idx & 15;
            AttnDesc d{};
            d.qpitch = PW0; d.kpitch = PW0; d.vpitch = PW0; d.V = P + 1024 + h * 128;
            d.Ob = AMIX0 + h * 128; d.opitch = 1024; d.lam = lam; d.subg = q->diff_subln_g;
            d.qrow0 = b * SEQ_ + qb * 512; d.ntiles = 132; d.nlat = 128; d.lat_row0 = b * SEQ_; d.ctx_row0 = ML + b * 256;
            d.Q = P + h * 128 + part * 64; d.K = P + 512 + h * 128 + part * 64;
            bf16_t* xch = (bf16_t*)(ws + O_ODIFF) + (size_t)h * MT * 128;
            unsigned* xcnt = (unsigned*)(ws + O_XCNT) + 64 * ((b * 4 + h) * 16 + qb);
            if (part == 0) attn_unit_diff2<0>(d, lds, xch, xcnt); else attn_unit_diff2<1>(d, lds, xch, xcnt);
        }
        for (int i = 0; i < 2; ++i) {
            const int combo = i * 8 + xcd, rb = idx;
            if (idx >= 32) break;
            const int b = combo >> 3, h = combo & 7;
            int rowlo = 4 * rb - 4; rowlo = rowlo < 0 ? 0 : (rowlo > 120 ? 120 : rowlo);
            int nrt = 128 - rowlo; nrt = nrt > 11 ? 11 : nrt;
            AttnDesc d{};
            d.Q = P + 1536 + h * 64; d.qpitch = PW0; d.K = P + 2048 + h * 64; d.kpitch = PW0; d.V = P + 2560 + h * 64; d.vpitch = PW0;
            d.Of = nullptr; d.Ob = AMIX0 + 512 + h * 64; d.opitch = 1024;
            d.qrow0 = b * SEQ_ + rb * 256; d.ntiles = nrt + 4; d.nlat = nrt; d.lat_row0 = b * SEQ_ + rowlo * 64; d.ctx_row0 = ML + b * 256;
            d.na_rowlo = rowlo; d.na_gr0 = 4 * rb; d.rpb = q->na_rpb + h * 465;
            attn_unit<64, 64, true, 0>(d, lds);
        }
        if (blk < 8) {
            const int b = blk >> 2, h = blk & 3;
            AttnDesc d{};
            d.qpitch = PW0; d.kpitch = PW0; d.vpitch = PW0; d.V = P + 1024 + h * 128;
            d.Ob = AMIX0 + h * 128; d.opitch = 1024; d.lam = lam; d.subg = q->diff_subln_g;
            d.qrow0 = ML + b * 256; d.ntiles = 4; d.nlat = 0; d.lat_row0 = 0; d.ctx_row0 = ML + b * 256;
            d.Q = P + h * 128; d.K = P + 512 + h * 128;
            attn_unit<64, 128, false, 2>(d, lds);
            d.Q = P + h * 128 + 64; d.K = P + 512 + h * 128 + 64;
            attn_unit<64, 128, false, 3>(d, lds);
        } else if (blk >= 16 && blk < 32) {
            const int b = (blk - 16) >> 3, h = (blk - 16) & 7;
            AttnDesc d{};
            d.Q = P + 1536 + h * 64; d.qpitch = PW0; d.K = P + 2048 + h * 64; d.kpitch = PW0; d.V = P + 2560 + h * 64; d.vpitch = PW0;
            d.Ob = AMIX0 + 512 + h * 64; d.opitch = 1024;
            d.qrow0 = ML + b * 256; d.ntiles = 4; d.nlat = 0; d.lat_row0 = 0; d.ctx_row0 = ML + b * 256;
            attn_unit<64, 64, false, 0>(d, lds);
        }
    }
    SEAM(3);
    if (IN(5)) { PHASE_BEGIN
        { pg8::Gemm g{AMIX0, Wevout, ML, 1024, 1024, 1024, 1024}; PanelOrder S; S.init(ML, blk);
          EpiResLN<false, true> E{q->x, q->ctx, mod + 2 * 1024, (unsigned*)(ws + O_CNT), (unsigned long long*)(ws + O_SLOT0), q->ln_mix_g, q->ln_mix_b, H, U, mod, 3, nullptr, nullptr, 0};
          pg8::gemm_phase<EpiResLN<false, true>, PanelOrder, true, true>(lds, g, S, E); }
        { const int part = blk & 3, k0 = part * 256;
          pg8::Gemm g{AMIX0 + k0, Wevout + k0, MT, 1024, 256, 1024, 1024}; TailOrder S{blk};
          EpiResLN<false, true> E{q->x, q->ctx, mod + 2 * 1024, (unsigned*)(ws + O_CNT), (unsigned long long*)(ws + O_SLOT0), q->ln_mix_g, q->ln_mix_b, H, U, mod, 3, (float*)(ws + O_P), (unsigned*)(ws + O_PCNT), part};
          pg8::gemm_phase<EpiResLN<false, true>, TailOrder, true, true>(lds, g, S, E); }
    }
    SEAM(5);
    if (IN(7)) { PHASE_BEGIN
        pg8::Gemm g{U, Wffin0, MT, 5632, 1024, 1024, 1024}; pg8::StaticOrder S; S.init(MT, 5632, G, blk);
        EpiFfn E{ACT};
        pg8::gemm_phase<EpiFfn, pg8::StaticOrder, true, true>(lds, g, S, E);
    }
    SEAM(7);
    if (IN(8)) { PHASE_BEGIN
        { pg8::Gemm g{ACT, Wffout0, ML, 1024, FH, FH, FH}; PanelOrder S; S.init(ML, blk);
          EpiResLN<true, true> E{Hb, Hb + (size_t)ML * DM, mod + 5 * 1024, (unsigned*)(ws + O_CNT) + 66 * 64, (unsigned long long*)(ws + O_SLOT1), q->ln_ffn_g, q->ln_ffn_b, Hb, U, mod + 3 * 6144, 0, nullptr, nullptr, 0};
          pg8::gemm_phase<EpiResLN<true, true>, PanelOrder, true, true>(lds, g, S, E); }
        { const int part = blk & 3, k0 = part < 2 ? part * 768 : 1536 + (part - 2) * 640, kl = part < 2 ? 768 : 640;
          pg8::Gemm g{ACT + k0, Wffout0 + k0, MT, 1024, kl, FH, FH}; TailOrder S{blk};
          EpiResLN<true, true> E{Hb, Hb + (size_t)ML * DM, mod + 5 * 1024, (unsigned*)(ws + O_CNT) + 66 * 64, (unsigned long long*)(ws + O_SLOT1), q->ln_ffn_g, q->ln_ffn_b, Hb, U, mod + 3 * 6144, 0, (float*)(ws + O_SLOT2), (unsigned*)(ws + O_PCNT) + 8 * 64, part};
          pg8::gemm_phase<EpiResLN<true, true>, TailOrder, true, true>(lds, g, S, E); }
    }
    SEAM(8);
    if (IN(10)) { PHASE_BEGIN
        pg8::Gemm g{U, Wodin, MT, PW1, 1024, 1024, 1024}; pg8::StaticOrder S; S.init(MT, PW1, G, blk);
        EpiIn1 E{P1, stats, tab16};
        pg8::gemm_phase<EpiIn1, pg8::StaticOrder, true, true>(lds, g, S, E);
    }
    SEAM(10);
    if (IN(11)) { PHASE_BEGIN
#ifndef NO_Q
        { pg8::Gemm g{P1, Wuq, ML, 768, 384, PW1, 384}; pg8::StaticOrder S; S.init(ML, 768, G, blk);
          EpiQ1 E{Q1, stats, tab16};
          pg8::gemm_phase<EpiQ1, pg8::StaticOrder, true, true>(lds, g, S, E); }
#endif
#ifndef NO_KV
        { pg8::Gemm g{P1 + 384, Wukv, MT, 1024, 256, PW1, 256}; pg8::StaticOrder S; S.init(MT, 1024, G, (blk + 64) & 255);
          EpiKV1 E{KV1, stats};
          pg8::gemm_phase<EpiKV1, pg8::StaticOrder, true, true>(lds, g, S, E); }
#endif
#ifndef NO_GMLP
        const int gm_n = blk >= 192 ? 3 : (blk < 128 ? 2 : 1);
        const int gm_0 = blk >= 192 ? (blk - 192) * 3 : (blk < 128 ? 192 + blk * 2 : 448 + (blk - 128));
        for (int un = gm_0; un < gm_0 + gm_n; ++un) {
            const int chunk = un >> 2, grp = un & 3;
            constexpr int RS = 272;
            LAS unsigned char* wsA = lds; LAS unsigned char* vnT = lds + 128 * RS; LAS float* tst = (LAS float*)(lds + 2 * 128 * RS);
            __syncthreads();
            {
                const int tok = tid >> 2, part = tid & 3; const float* sp = stats + (size_t)(chunk * 128 + tok) * STP + 80 + part * 8;
                float s = sp[0] + sp[2] + sp[4] + sp[6], q = sp[1] + sp[3] + sp[5] + sp[7];
                s += __shfl_xor(s, 1); s += __shfl_xor(s, 2); q += __shfl_xor(q, 1); q += __shfl_xor(q, 2);
                const float mean = s * (1.f / 512.f); const float var = q * (1.f / 512.f) - mean * mean;
                if (part == 0) { tst[2 * tok] = mean; tst[2 * tok + 1] = 1.f / sqrtf(fmaxf(var, 0.f) + 1e-5f); }
            }
#pragma unroll
            for (int i = 0; i < 4; ++i) { const int id = tid + 512 * i, r = id >> 4, ch = id & 15;
                *(LAS u32x4*)(wsA + r * RS + ch * 16) = *(const u32x4*)(Gws + (size_t)grp * 16384 + r * 128 + ch * 8); }
            __syncthreads();
#pragma unroll
            for (int i = 0; i < 4; ++i) { const int id = tid + 512 * i, j = id >> 4, cc = id & 15;
                const u32x4 raw = *(const u32x4*)(P1 + (size_t)(chunk * 128 + j) * PW1 + 1280 + grp * 128 + cc * 8);
                const float mean = tst[2 * j], rstd = tst[2 * j + 1];
                const f32x4 lg0 = *(const f32x4*)(q->gmlp_ln_g + grp * 128 + cc * 8), lg1 = *(const f32x4*)(q->gmlp_ln_g + grp * 128 + cc * 8 + 4);
                const f32x4 lb0 = *(const f32x4*)(q->gmlp_ln_b + grp * 128 + cc * 8), lb1 = *(const f32x4*)(q->gmlp_ln_b + grp * 128 + cc * 8 + 4);
#pragma unroll
                for (int e = 0; e < 8; ++e) { const unsigned wv = raw[e >> 1]; const float x = bf2f((unsigned short)((e & 1) ? (wv >> 16) : (wv & 0xffffu)));
                    const float y = (x - mean) * rstd * (e < 4 ? lg0[e & 3] : lg1[e & 3]) + (e < 4 ? lb0[e & 3] : lb1[e & 3]);
                    *(LAS unsigned short*)(vnT + (cc * 8 + e) * RS + j * 2) = (unsigned short)f2bf(y); } }
            __syncthreads();
            { const int r32 = lane & 31, hh = lane >> 5, ib = wave >> 1;
#pragma unroll
              for (int cbi = 0; cbi < 2; ++cbi) { const int cb = 2 * (wave & 1) + cbi;
                f32x16 dacc = (f32x16){};
#pragma unroll
                for (int ks = 0; ks < 8; ++ks) {
                    const bf16x8 a = *(const LAS bf16x8*)(wsA + (32 * ib + r32) * RS + (16 * ks + 8 * hh) * 2);
                    const bf16x8 bb = *(const LAS bf16x8*)(vnT + (32 * cb + r32) * RS + (16 * ks + 8 * hh) * 2);
                    dacc = __builtin_amdgcn_mfma_f32_32x32x16_bf16(a, bb, dacc, 0, 0, 0); }
                const int c = 32 * cb + r32;
#pragma unroll
                for (int r = 0; r < 16; ++r) { const int i = 32 * ib + (r & 3) + 8 * (r >> 2) + 4 * hh; const int tok = chunk * 128 + i;
                    const float gu = bf2f(P1[(size_t)tok * PW1 + 768 + grp * 128 + c]);
                    const float o = gu * (dacc[r] + q->gmlp_b[grp * 128 + i]);
                    AMIX1[(size_t)tok * 1024 + 512 + grp * 128 + c] = (bf16_t)f2bf(o); } } }
        }
#endif
    }
    SEAM(11);
    if (IN(12)) { PHASE_BEGIN
        const int xcd = blk & 7, idx = blk >> 3;
        {
            const int combo = (idx >> 4) * 8 + xcd, qb = idx & 15;
            const int b = combo >> 3, h = combo & 7;
            AttnDesc d{};
            d.Q = Q1 + h * 96; d.qpitch = 768; d.K = KV1 + h * 128; d.kpitch = 1024; d.K2 = P1 + 640; d.k2pitch = PW1;
            d.V = KV1 + h * 128 + 64; d.vpitch = 1024; d.Ob = AMIX1 + h * 64; d.opitch = 1024;
            d.qrow0 = b * SEQ_ + qb * 512; d.ntiles = 132; d.nlat = 128; d.lat_row0 = b * SEQ_; d.ctx_row0 = ML + b * 256;
            attn_unit_mla2(d, lds);
        }
    }
    SEAM(12);
    if (IN(13)) { PHASE_BEGIN
        pg8::Gemm g{AMIX1, Wodout, ML, 1024, 1024, 1024, 1024}; PanelOrder S; S.init(ML, blk);
        EpiResLN<true, true> E{Hb, Hb + (size_t)ML * DM, mod + 3 * 6144 + 2 * 1024, (unsigned*)(ws + O_CNT) + 2 * 66 * 64, (unsigned long long*)(ws + O_SLOT2), q->ln_mix_g + 1024, q->ln_mix_b + 1024, Hb, U, mod + 3 * 6144, 3, nullptr, nullptr, 0};
        pg8::gemm_phase<EpiResLN<true, true>, PanelOrder, true, true>(lds, g, S, E);
    }
    SEAM(13);
    if (IN(15)) { PHASE_BEGIN
        pg8::Gemm g{U, Wffin1, ML, 5632, 1024, 1024, 1024}; pg8::StaticOrder S; S.init(ML, 5632, G, blk);
        EpiFfn E{ACT};
        pg8::gemm_phase<EpiFfn, pg8::StaticOrder, true, true>(lds, g, S, E);
    }
    SEAM(15);
    if (IN(16)) { PHASE_BEGIN
        pg8::Gemm g{ACT, Wffout1, ML, 1024, FH, FH, FH}; PanelOrder S; S.init(ML, blk);
        EpiResLN<true, false> E{Hb, Hb + (size_t)ML * DM, mod + 3 * 6144 + 5 * 1024, (unsigned*)(ws + O_CNT) + 3 * 66 * 64, (unsigned long long*)(ws + O_SLOT3), q->ln_ffn_g + 1024, q->ln_ffn_b + 1024, q->out, nullptr, nullptr, 0, nullptr, nullptr, 0};
        pg8::gemm_phase<EpiResLN<true, false>, PanelOrder, true, true>(lds, g, S, E);
    }
#undef IN
#undef SEAM
}

#ifndef N_LAUNCH_MODE
#define N_LAUNCH_MODE 1
#endif
extern "C" void kernel_launch(void* const* d_in, const int* in_sizes, int n_in, void* d_out, int out_size, void* d_ws, size_t ws_size, hipStream_t stream) {
    static int grid = 0;
    if (grid == 0) {
        if (n_in != 27 || ws_size < WS_NEED) { fprintf(stderr, "kernel_launch: unexpected inputs (n_in %d, ws %zu)\n", n_in, ws_size); grid = -1; return; }
        int dev = 0, cus = 0, per_cu = 0;
        hipGetDevice(&dev); hipDeviceGetAttribute(&cus, hipDeviceAttributeMultiprocessorCount, dev);
        hipFuncSetAttribute((const void*)dit_fwd, hipFuncAttributeMaxDynamicSharedMemorySize, LDS_BYTES);
        hipOccupancyMaxActiveBlocksPerMultiprocessor(&per_cu, (const void*)dit_fwd, 512, LDS_BYTES);
        (void)hipGetLastError();
        if (per_cu < 1) per_cu = 1;
        grid = cus * per_cu; if (grid > 256) grid = 256;
    }
    if (grid < 0) return;
    if (hipMemsetAsync((char*)d_ws + O_BAR, 0, CTL_BYTES, stream) != hipSuccess) { fprintf(stderr, "memset failed\n"); return; }
    Params p{};
    const float** pp = (const float**)&p;
    for (int i = 0; i < 27; ++i) pp[i] = (const float*)d_in[i];
    p.out = (float*)d_out; p.ws = (unsigned char*)d_ws;
#if N_LAUNCH_MODE == 1
    p.lo = 0; p.hi = NPHASE;
    void* args[] = {&p};
    hipError_t e = hipLaunchCooperativeKernel((const void*)dit_fwd, dim3(grid), dim3(512), args, LDS_BYTES, stream);
    if (e != hipSuccess) fprintf(stderr, "cooperative launch failed: %s (grid %d)\n", hipGetErrorString(e), grid);
#else
    for (int ph = 0; ph < NPHASE; ++ph) { p.lo = ph; p.hi = ph + 1; hipLaunchKernelGGL(dit_fwd, dim3(grid), dim3(512), LDS_BYTES, stream, p); }
#endif
}
```

```cpp
#include <hip/hip_runtime.h>
#include <hip/hip_cooperative_groups.h>
#include <cstdio>
#include <cstdint>
#include <cmath>
namespace cg = cooperative_groups;
namespace pg8 {
#define PG8_LAS __attribute__((address_space(3)))
typedef unsigned short bf16_t;
typedef short bf16x8 __attribute__((ext_vector_type(8)));
typedef float f32x4 __attribute__((ext_vector_type(4)));
typedef unsigned u32x4 __attribute__((ext_vector_type(4)));
typedef float f32x2 __attribute__((ext_vector_type(2)));
constexpr int BM = 256, BK = 64, HALF = 128, HTB = HALF * BK * 2  , STAGE_BYTES = 8 * HTB, NXCD = 8, WGM = 8;

__host__ __device__ __forceinline__ int lds_byte(int r, int c) { const int st = (r >> 4) * 2 + (c >> 5), rr = r & 15, cc = c & 31, ob = rr * 64 + cc * 2; return st * 1024 + (ob ^ (((ob >> 9) & 1) << 5)); }
__host__ __device__ __forceinline__ void stage_rc(int b, int& R, int& C) { const int st = b / 1024, sb = b % 1024, swz = sb ^ (((sb >> 9) & 1) << 5); R = (st >> 1) * 16 + swz / 64; C = (st & 1) * 32 + (swz % 64) / 2; }
__host__ __device__ __forceinline__ int perm32(int rho) { const int n = rho >> 4, i = rho & 15; return 8 * (i >> 2) + 4 * n + (i & 3); }

struct Unit { int pm, pn; };
struct Gemm { const bf16_t* A; const bf16_t* Bt; int M, N, K, lda, ldb; };

struct StaticOrder {
    int nM, nN, nwg, G, c;
    __host__ __device__ void init(int M, int N, int G_, int c_) { nM = M / BM; nN = N / BM; nwg = nM * nN; G = G_; c = c_; }
    __host__ __device__ bool next(int i, Unit& u) const {
        const long L = (long)i * G + c; if (L >= nwg) return false;
        int wgid = (int)L; { const int q = nwg / NXCD, r = nwg % NXCD, xcd = wgid % NXCD, off = wgid / NXCD; wgid = (xcd < r ? xcd * (q + 1) : r * (q + 1) + (xcd - r) * q) + off; }
        const int nig = WGM * nN, gid = wgid / nig, fm = gid * WGM, gsz = (nM - fm) < WGM ? (nM - fm) : WGM;
        u.pm = fm + ((wgid % nig) % gsz); u.pn = (wgid % nig) / gsz; return true;
    }
    __device__ __forceinline__ void a_ready(const Unit&) const {}
    __device__ __forceinline__ void done(const Unit&) const {}
};

__device__ __forceinline__ unsigned cvt_pk_bf16(float lo, float hi) { unsigned r; asm volatile("v_cvt_pk_bf16_f32 %0, %1, %2" : "=v"(r) : "v"(lo), "v"(hi)); return r; }
__device__ __forceinline__ f32x2 gelu_pk(f32x2 v) {
    const f32x2 av = __builtin_elementwise_abs(v), d = av * 0.2316418882f + 1.0f;
    f32x2 t; t.x = __builtin_amdgcn_rcpf(d.x); t.y = __builtin_amdgcn_rcpf(d.y);
    f32x2 q = t * 0.5307027145f + (-0.7265760135f); q = q * t + 0.7107068705f; q = q * t + (-0.142248368f); q = q * t + 0.127414796f; q = q * t;
    const f32x2 s = (v * v) * (-0.72134752044f);
    f32x2 e; e.x = __builtin_amdgcn_exp2f(s.x); e.y = __builtin_amdgcn_exp2f(s.y);
    const f32x2 m = v * (q * e), r = v - m;
    f32x2 o; o.x = v.x < 0.f ? m.x : r.x; o.y = v.y < 0.f ? m.y : r.y; return o;
}
template <class Epi, class Sched, bool ALIGN_EPI = false, bool SP2 = false>
__device__ __forceinline__ void gemm_phase(PG8_LAS unsigned char* lds, const Gemm g, const Sched& S, const Epi& E) {
    int tid = threadIdx.x; asm volatile("" : "+v"(tid));
    const int wid = __builtin_amdgcn_readfirstlane(tid >> 6), lane = tid & 63, wr = wid >> 2, wc = wid & 3, fr = lane & 15, fq = lane >> 4;
    const int K = g.K, nt = K / BK;
    unsigned voffA[2], voffB[2];
#pragma unroll
    for (int i = 0; i < 2; ++i) { int R, C; stage_rc(tid * 16 + i * 8192, R, C); const int Rb = Epi::PERM ? ((R & ~31) + perm32(R & 31)) : R;
        voffA[i] = (unsigned)(R * g.lda + C) * 2u; voffB[i] = (unsigned)(Rb * g.ldb + C) * 2u; }
    const size_t kstep = (size_t)(BK * 2);
    const size_t hstep = (size_t)HALF * g.ldb * 2;
    const size_t tstep = 2 * hstep; const size_t hstepA = (size_t)HALF * g.lda * 2, tstepA = 2 * hstepA;
    const unsigned ldsw = (unsigned)wid * 1024u;
    const int aoff = lds_byte(wr * 64 + fr, fq * 8), boff = lds_byte(wc * 32 + fr, fq * 8);
#define PG8_SA(b, h) (((b) * 2 + (h)) * HTB)
#define PG8_SB(b, h) ((4 + (b) * 2 + (h)) * HTB)
#define PG8_STAGE(bufoff, gbase, voff) do { _Pragma("unroll") for (int _i = 0; _i < 2; ++_i) \
        __builtin_amdgcn_global_load_lds((const unsigned*)((const char*)(gbase) + (voff)[_i]), (PG8_LAS unsigned*)(lds + (bufoff) + ldsw + _i * 8192), 16, 0, 0); } while (0)
#define PG8_LDA(dst, b, h) do { _Pragma("unroll") for (int m = 0; m < 4; ++m) _Pragma("unroll") for (int k = 0; k < 2; ++k) dst[m][k] = *(const PG8_LAS bf16x8*)(lds + PG8_SA(b, h) + aoff + m * 2048 + k * 1024); } while (0)
#define PG8_LDB(dst, b, h) do { _Pragma("unroll") for (int n = 0; n < 2; ++n) _Pragma("unroll") for (int k = 0; k < 2; ++k) dst[n][k] = *(const PG8_LAS bf16x8*)(lds + PG8_SB(b, h) + boff + n * 2048 + k * 1024); } while (0)
#define PG8_MMA(ai, bj, At, Bt) do { __builtin_amdgcn_s_setprio(1); _Pragma("unroll") for (int m = 0; m < 4; ++m) _Pragma("unroll") for (int n = 0; n < 2; ++n) _Pragma("unroll") for (int k = 0; k < 2; ++k) \
        acc[ai][bj][m][n] = __builtin_amdgcn_mfma_f32_16x16x32_bf16(Bt[n][k], At[m][k], acc[ai][bj][m][n], 0, 0, 0); __builtin_amdgcn_s_setprio(0); } while (0)
#define PG8_WAIT_V(n) asm volatile("s_waitcnt vmcnt(" #n ")" ::: "memory")
#define PG8_WAIT_L(n) asm volatile("s_waitcnt lgkmcnt(" #n ")" ::: "memory")
#define PG8_BAR __builtin_amdgcn_s_barrier()
#define PG8_SCHED __builtin_amdgcn_sched_barrier(0)
    Unit cur, nxt; int ui = 0;
    if (!S.next(0, cur)) return;
    f32x4 acc[2][2][4][2];
#pragma unroll
    for (int a = 0; a < 2; ++a)
#pragma unroll
        for (int b = 0; b < 2; ++b)
#pragma unroll
            for (int m = 0; m < 4; ++m)
#pragma unroll
                for (int n = 0; n < 2; ++n) acc[a][b][m][n] = (f32x4){0.f, 0.f, 0.f, 0.f};
    bf16x8 At[4][2], B0[2][2], B1[2][2];
    const char* cA = (const char*)g.A + (size_t)cur.pm * tstepA; const char* cB = (const char*)g.Bt + (size_t)cur.pn * tstep;
    S.a_ready(cur);
    if constexpr (SP2) {
        PG8_STAGE(PG8_SB(0, 0), cB, voffB); PG8_STAGE(PG8_SB(0, 1), cB + hstep, voffB); PG8_STAGE(PG8_SA(0, 0), cA, voffA); PG8_STAGE(PG8_SA(0, 1), cA + hstepA, voffA);
        if (wr == 1) PG8_BAR;
        PG8_WAIT_V(2); PG8_BAR;
        PG8_STAGE(PG8_SB(1, 0), cB + kstep, voffB); PG8_STAGE(PG8_SA(1, 0), cA + kstep, voffA); PG8_STAGE(PG8_SB(1, 1), cB + hstep + kstep, voffB);
        PG8_WAIT_V(6); PG8_BAR;
    } else {
        PG8_STAGE(PG8_SB(0, 0), cB, voffB); PG8_STAGE(PG8_SA(0, 0), cA, voffA); PG8_STAGE(PG8_SB(0, 1), cB + hstep, voffB); PG8_STAGE(PG8_SA(0, 1), cA + hstepA, voffA);
        if (wr == 1) PG8_BAR;
        PG8_WAIT_V(4); PG8_BAR;
        PG8_STAGE(PG8_SB(1, 0), cB + kstep, voffB); PG8_STAGE(PG8_SA(1, 0), cA + kstep, voffA); PG8_STAGE(PG8_SB(1, 1), cB + hstep + kstep, voffB);
        PG8_WAIT_V(6); PG8_BAR;
    }
    for (;;) {
        const bool has_next = S.next(ui + 1, nxt);
        const char* nA = has_next ? (const char*)g.A + (size_t)nxt.pm * tstepA : cA; const char* nB = has_next ? (const char*)g.Bt + (size_t)nxt.pn * tstep : cB;
#pragma nounroll
        for (int t = 0; t < nt; t += 2) {
            const bool last = (t == nt - 2);
            const char* a1 = cA + (size_t)(t + 1) * kstep;
            const char* a2 = last ? nA : cA + (size_t)(t + 2) * kstep; const char* b2 = last ? nB : cB + (size_t)(t + 2) * kstep;
            const char* a3 = a2 + kstep; const char* b3 = b2 + kstep;
            if (last && has_next) S.a_ready(nxt);
            if constexpr (SP2) {
            PG8_LDB(B0, 0, 0); PG8_LDB(B1, 0, 1); PG8_SCHED; PG8_LDA(At, 0, 0); PG8_STAGE(PG8_SA(1, 1), a1 + hstepA, voffA);
            PG8_WAIT_V(8); PG8_WAIT_L(0); PG8_BAR; PG8_MMA(0, 0, At, B0); PG8_MMA(0, 1, At, B1); PG8_BAR; PG8_SCHED;
            PG8_LDA(At, 0, 1); PG8_STAGE(PG8_SB(0, 0), b2, voffB); PG8_STAGE(PG8_SB(0, 1), b2 + hstep, voffB); PG8_STAGE(PG8_SA(0, 0), a2, voffA);
            PG8_WAIT_V(8); PG8_WAIT_L(0); PG8_BAR; PG8_MMA(1, 0, At, B0); PG8_MMA(1, 1, At, B1); PG8_BAR; PG8_SCHED;
            PG8_LDB(B0, 1, 0); PG8_LDB(B1, 1, 1); PG8_SCHED; PG8_LDA(At, 1, 0); PG8_STAGE(PG8_SA(0, 1), a2 + hstepA, voffA);
            PG8_WAIT_V(8); PG8_WAIT_L(0); PG8_BAR; PG8_MMA(0, 0, At, B0); PG8_MMA(0, 1, At, B1); PG8_BAR; PG8_SCHED;
            PG8_LDA(At, 1, 1); PG8_STAGE(PG8_SB(1, 0), b3, voffB); PG8_STAGE(PG8_SB(1, 1), b3 + hstep, voffB); PG8_STAGE(PG8_SA(1, 0), a3, voffA);
            PG8_WAIT_V(8); PG8_WAIT_L(0); PG8_BAR; PG8_MMA(1, 0, At, B0); PG8_MMA(1, 1, At, B1); PG8_BAR; PG8_SCHED;
            } else {
            PG8_LDB(B0, 0, 0); PG8_SCHED; PG8_LDA(At, 0, 0); PG8_STAGE(PG8_SA(1, 1), a1 + hstepA, voffA);
            PG8_WAIT_L(8); PG8_BAR; PG8_WAIT_L(0); PG8_MMA(0, 0, At, B0); PG8_BAR; PG8_SCHED;
            PG8_LDB(B1, 0, 1); PG8_STAGE(PG8_SB(0, 0), b2, voffB);
            PG8_BAR; PG8_WAIT_L(0); PG8_MMA(0, 1, At, B1); PG8_BAR;
            PG8_LDA(At, 0, 1); PG8_STAGE(PG8_SA(0, 0), a2, voffA);
            PG8_BAR; PG8_WAIT_L(0); PG8_MMA(1, 0, At, B0); PG8_BAR; PG8_SCHED;
            PG8_STAGE(PG8_SB(0, 1), b2 + hstep, voffB);
            PG8_WAIT_V(6); PG8_BAR; PG8_MMA(1, 1, At, B1); PG8_BAR;
            PG8_LDB(B0, 1, 0); PG8_SCHED; PG8_LDA(At, 1, 0); PG8_STAGE(PG8_SA(0, 1), a2 + hstepA, voffA);
            PG8_WAIT_L(8); PG8_BAR; PG8_WAIT_L(0); PG8_MMA(0, 0, At, B0); PG8_BAR; PG8_SCHED;
            PG8_LDB(B1, 1, 1); PG8_STAGE(PG8_SB(1, 0), b3, voffB);
            PG8_BAR; PG8_WAIT_L(0); PG8_MMA(0, 1, At, B1); PG8_BAR;
            PG8_LDA(At, 1, 1); PG8_STAGE(PG8_SA(1, 0), a3, voffA);
            PG8_BAR; PG8_WAIT_L(0); PG8_MMA(1, 0, At, B0); PG8_BAR; PG8_SCHED;
            PG8_STAGE(PG8_SB(1, 1), b3 + hstep, voffB);
            PG8_WAIT_V(6); PG8_BAR; PG8_MMA(1, 1, At, B1); PG8_BAR;
            }
        }
        if constexpr (ALIGN_EPI) { if (wr == 0) PG8_BAR; }
        if constexpr (!Epi::AFTER_DRAIN) { E(acc, cur, wr, wc, fr, fq); S.done(cur); }
        if (!has_next) break;
#pragma unroll
        for (int a = 0; a < 2; ++a)
#pragma unroll
            for (int b = 0; b < 2; ++b)
#pragma unroll
                for (int m = 0; m < 4; ++m)
#pragma unroll
                    for (int n = 0; n < 2; ++n) acc[a][b][m][n] = (f32x4){0.f, 0.f, 0.f, 0.f};
        cur = nxt; cA = nA; cB = nB; ++ui;
        if constexpr (ALIGN_EPI) { if (wr == 1) PG8_BAR; }
    }
    PG8_WAIT_V(0);
    if constexpr (!ALIGN_EPI) { if (wr == 0) PG8_BAR; }
    PG8_BAR;
    if constexpr (Epi::AFTER_DRAIN) { E.fused(acc, cur, wr, wc, fr, fq, lds, wid, lane); S.done(cur); }
#undef PG8_SA
#undef PG8_SB
#undef PG8_STAGE
#undef PG8_LDA
#undef PG8_LDB
#undef PG8_MMA
#undef PG8_WAIT_V
#undef PG8_WAIT_L
#undef PG8_BAR
#undef PG8_SCHED
}
}

using pg8::bf16_t; using pg8::f32x4; using pg8::u32x4; using pg8::Unit;
#define LAS __attribute__((address_space(3)))
typedef unsigned u32x2 __attribute__((ext_vector_type(2)));
typedef float f32x2v __attribute__((ext_vector_type(2)));
typedef float f32x16 __attribute__((ext_vector_type(16)));
typedef short bf16x8 __attribute__((ext_vector_type(8)));
typedef short s16x4 __attribute__((ext_vector_type(4)));
typedef short v4i16_t __attribute__((ext_vector_type(4)));

constexpr int SEQ_ = 8192, DM = 1024, ML = 16384, MT = 16896, FH = 2816;
constexpr int PW0 = 3072;
constexpr int PW1 = 1792;
constexpr int STP = 112;
constexpr float ALPHA_ = 1.4142135623730951f;
constexpr float LOG2E_ = 1.4426950408889634f;
constexpr float QS64 = 0.125f * 1.4426950408889634f;
constexpr float QS96 = (float)(1.4426950408889634 / 9.797958971132712);
constexpr float LAMBDA_INIT = 0.2f;

constexpr size_t MiB_ = 1u << 20;
constexpr size_t O_EVIN = 0, O_EVOUT = O_EVIN + 6291456, O_FFIN0 = O_EVOUT + 2097152, O_FFOUT0 = O_FFIN0 + 11534336;
constexpr size_t O_FFIN1 = O_FFOUT0 + 5767168, O_FFOUT1 = O_FFIN1 + 11534336, O_ODIN = O_FFOUT1 + 5767168, O_ODOUT = O_ODIN + 3670016;
constexpr size_t O_UQ = O_ODOUT + 2097152, O_UKV = O_UQ + 589824, O_GWS = O_UKV + 524288, O_MOD = O_GWS + 131072, O_TAB32 = O_MOD + 147456, O_TAB16 = O_TAB32 + 16384;
constexpr size_t O_SLOT0 = 48 * MiB_, O_SLOT1 = 51 * MiB_, O_SLOT2 = 145 * MiB_, O_SLOT3 = 148 * MiB_;
static_assert(O_TAB16 + 8192 <= O_SLOT0 && O_SLOT1 + (size_t)16896 * 128 <= 54 * MiB_, "ws map");
constexpr size_t O_Q1 = 0;
static_assert((size_t)ML * 768 * 2 <= O_FFIN1, "Q1 overlay");
constexpr size_t O_P = 54 * MiB_, O_H = 153 * MiB_, O_U = 219 * MiB_, WS_NEED = 253 * MiB_, O_BAR = 252 * MiB_, O_CNT = O_BAR + 16384, O_PCNT = O_CNT + 4 * 66 * 256, O_XCNT = O_PCNT + 2 * 8 * 256, CTL_BYTES = 16384 + 4 * 66 * 256 + 2 * 8 * 256 + 128 * 256;
constexpr size_t O_ODIFF = O_H, O_AMIX0 = O_U, O_ACT = O_P, O_P1 = O_P, O_AMIX1 = 112 * MiB_, O_STATS = 144 * MiB_, O_KV1 = O_U;
static_assert(O_P1 + (size_t)MT * PW1 * 2 <= O_AMIX1 && O_STATS + (size_t)MT * STP * 4 <= O_H, "ws map 2");

__device__ __forceinline__ unsigned f2bf(float f) { unsigned u = __builtin_bit_cast(unsigned, f); return (u + 0x7fffu + ((u >> 16) & 1u)) >> 16; }
typedef __bf16 bf16x2_hw __attribute__((ext_vector_type(2)));
__device__ __forceinline__ unsigned pk2(float lo, float hi) { f32x2v v = {lo, hi}; bf16x2_hw b = __builtin_convertvector(v, bf16x2_hw); return __builtin_bit_cast(unsigned, b); }
__device__ __forceinline__ float bf2f(unsigned short b) { return __builtin_bit_cast(float, (unsigned)b << 16); }
__device__ __forceinline__ float wave_sum(float v) {
#pragma unroll
    for (int o = 1; o < 64; o <<= 1) v += __shfl_xor(v, o);
    return v;
}
__device__ __forceinline__ float gelu_exact(float v) { return 0.5f * v * (1.0f + erff(v * 0.70710678118654752f)); }
__device__ __forceinline__ int modset(int pm) { return pm < 32 ? 0 : (pm < 64 ? 1 : 2); }

struct EpiIn0 {
    static constexpr bool PERM = true, AFTER_DRAIN = false;
    bf16_t* P; const float* tab32;
    __device__ __forceinline__ void operator()(const f32x4 (&acc)[2][2][4][2], const Unit& u, int wr, int wc, int fr, int fq) const {
        asm volatile("" : "+v"(fr), "+v"(fq));
        const int region = u.pn >> 1;
        const bool rope = (region <= 1) && (u.pm < 64);
        const float sc = (region == 0 || region == 3) ? QS64 : 1.f;
        const float sgn = (fq < 2) ? -1.f : 1.f;
#pragma unroll
        for (int ai = 0; ai < 2; ++ai)
#pragma unroll
            for (int m = 0; m < 4; ++m) {
                const int row = u.pm * 256 + ai * 128 + wr * 64 + m * 16 + fr;
                const int t = row & 8191; const int pos = (wc & 1) ? (t & 63) : (t >> 6);
                const float* tb = tab32 + (pos * 16 + 8 * (fq & 1)) * 2;
#pragma unroll
                for (int bj = 0; bj < 2; ++bj) {
                    const int col = u.pn * 256 + bj * 128 + wc * 32 + 8 * fq;
                    float v[8];
#pragma unroll
                    for (int i = 0; i < 4; ++i) { v[i] = acc[ai][bj][m][0][i]; v[4 + i] = acc[ai][bj][m][1][i]; }
                    if (rope) {
                        const f32x4 t0 = *(const f32x4*)tb, t1 = *(const f32x4*)(tb + 4), t2 = *(const f32x4*)(tb + 8), t3 = *(const f32x4*)(tb + 12);
                        const float cs[8] = {t0[0], t0[2], t1[0], t1[2], t2[0], t2[2], t3[0], t3[2]};
                        const float sn[8] = {t0[1], t0[3], t1[1], t1[3], t2[1], t2[3], t3[1], t3[3]};
#pragma unroll
                        for (int i = 0; i < 8; ++i) { const float pr = __shfl_xor(v[i], 32); v[i] = v[i] * cs[i] + sgn * pr * sn[i]; }
                    }
                    u32x4 w; w.x = pk2(v[0] * sc, v[1] * sc); w.y = pk2(v[2] * sc, v[3] * sc); w.z = pk2(v[4] * sc, v[5] * sc); w.w = pk2(v[6] * sc, v[7] * sc);
                    *(u32x4*)(P + (size_t)row * PW0 + col) = w;
                }
            }
    }
};
struct EpiRes {
    static constexpr bool PERM = true, AFTER_DRAIN = false;
    const float* hx; const float* hc; float* Z; const float* gate;
    __device__ __forceinline__ void operator()(const f32x4 (&acc)[2][2][4][2], const Unit& u, int wr, int wc, int fr, int fq) const {
        asm volatile("" : "+v"(fr), "+v"(fq));
        const float* gp = gate + modset(u.pm) * 6144;
#pragma unroll
        for (int bj = 0; bj < 2; ++bj) {
            const int col = u.pn * 256 + bj * 128 + wc * 32 + 8 * fq;
            const f32x4 g0 = *(const f32x4*)(gp + col), g1 = *(const f32x4*)(gp + col + 4);
#pragma unroll
            for (int ai = 0; ai < 2; ++ai)
#pragma unroll
                for (int m = 0; m < 4; ++m) {
                    const int row = u.pm * 256 + ai * 128 + wr * 64 + m * 16 + fr;
                    const float* hb = (u.pm < 64) ? hx + (size_t)row * DM : hc + (size_t)(row - ML) * DM;
                    const f32x4 h0 = *(const f32x4*)(hb + col), h1 = *(const f32x4*)(hb + col + 4);
                    const f32x4 z0 = h0 * ALPHA_ + g0 * acc[ai][bj][m][0], z1 = h1 * ALPHA_ + g1 * acc[ai][bj][m][1];
                    float* zp = Z + (size_t)row * DM + col;
                    *(f32x4*)zp = z0; *(f32x4*)(zp + 4) = z1;
                }
        }
    }
};

struct PanelOrder {
    int nP, c;
    __device__ void init(int M, int c_) { nP = M / 256; c = c_; }
    __device__ bool next(int i, Unit& u) const {
        const int rem = nP - 64 * i;
        if (rem >= 64) { const int x = c & 7, j = c >> 3; u.pm = 64 * i + 8 * x + (j & 7); u.pn = j >> 3; return true; }
        if (rem > 0 && c < 4 * rem) { u.pm = 64 * i + (c >> 2); u.pn = c & 3; return true; }
        return false;
    }
    __device__ __forceinline__ void a_ready(const Unit&) const {}
    __device__ __forceinline__ void done(const Unit&) const {}
};
struct TailOrder {
    int c;
    __device__ bool next(int i, Unit& u) const { if (i > 0 || c >= 32) return false; u.pm = 64 + (c >> 4); u.pn = (c >> 2) & 3; return true; }
    __device__ __forceinline__ void a_ready(const Unit&) const {}
    __device__ __forceinline__ void done(const Unit&) const {}
};
template <bool HIN16, bool HOUT16>
struct EpiResLN {
    static constexpr bool PERM = true, AFTER_DRAIN = false;
    const void* hx; const void* hc; const float* gate;
    unsigned* cnt; unsigned long long* slots; const float* lg; const float* lb; void* dst; bf16_t* U; const float* modl; int kmod;
    float* part_buf; unsigned* part_cnt; int part;
    __device__ __forceinline__ void operator()(const f32x4 (&acc)[2][2][4][2], const Unit& u, int wr, int wc, int fr, int fq) const {
        asm volatile("" : "+v"(fr), "+v"(fq));
        const int set = modset(u.pm);
        const float* gp = gate + set * 6144;
        const int colb = u.pn * 256 + wc * 32 + 8 * fq;
        const int tunit = (u.pm - 64) * 4 + u.pn;
        int tid_ = threadIdx.x; asm volatile("" : "+v"(tid_));
        if (part_buf && part != 0) {
            float* pb = part_buf + ((size_t)(tunit * 3 + part - 1) * 32 * 512 + tid_) * 4;
#pragma unroll
            for (int ai = 0; ai < 2; ++ai)
#pragma unroll
                for (int bj = 0; bj < 2; ++bj)
#pragma unroll
                    for (int m = 0; m < 4; ++m)
#pragma unroll
                        for (int hf = 0; hf < 2; ++hf) {
                            const f32x4 v = acc[ai][bj][m][hf]; float* dp = pb + (size_t)((((ai * 2 + bj) * 4 + m) * 2 + hf) * 512) * 4;
                            asm volatile("global_store_dwordx4 %0, %1, off sc1" :: "v"(dp), "v"(v) : "memory");
                        }
            asm volatile("s_waitcnt vmcnt(0)" ::: "memory"); __builtin_amdgcn_s_barrier(); asm volatile("" ::: "memory");
            if (threadIdx.x == 0) __hip_atomic_fetch_add(part_cnt + 64 * tunit, 1u, __ATOMIC_RELAXED, __HIP_MEMORY_SCOPE_AGENT);
            return;
        }
        if (part_buf) {
            if (threadIdx.x == 0) {
                unsigned sp = 0;
                while (__hip_atomic_load(part_cnt + 64 * tunit, __ATOMIC_RELAXED, __HIP_MEMORY_SCOPE_AGENT) < 3u) { __builtin_amdgcn_s_sleep(1); if (++sp > (1u << 24)) break; }
                __builtin_amdgcn_fence(__ATOMIC_ACQUIRE, "agent"); asm volatile("s_waitcnt vmcnt(0)" ::: "memory");
            }
            asm volatile("s_waitcnt vmcnt(0) lgkmcnt(0)" ::: "memory"); __builtin_amdgcn_s_barrier(); asm volatile("" ::: "memory");
        }
        const float* pb0 = part_buf ? part_buf + ((size_t)(tunit * 3) * 32 * 512 + tid_) * 4 : nullptr;
        f32x4 z[2][4][2][2];
        {
            f32x4 g[2][2];
#pragma unroll
            for (int bj = 0; bj < 2; ++bj) { g[bj][0] = *(const f32x4*)(gp + colb + bj * 128); g[bj][1] = *(const f32x4*)(gp + colb + bj * 128 + 4); }
#pragma unroll
            for (int ai = 0; ai < 2; ++ai)
#pragma unroll
                for (int m = 0; m < 4; ++m) {
                    const int r = ai * 128 + wr * 64 + m * 16 + fr, row = u.pm * 256 + r;
                    const size_t hoff = ((u.pm < 64) ? (size_t)row * DM : (size_t)(row - ML) * DM) + colb;
                    const float* hb = (const float*)((u.pm < 64) ? hx : hc) + hoff;
                    const bf16_t* hb16 = (const bf16_t*)((u.pm < 64) ? hx : hc) + hoff;
                    float s = 0.f, q = 0.f;
#pragma unroll
                    for (int bj = 0; bj < 2; ++bj) {
                        f32x4 h0, h1;
                        if (HIN16) { const u32x4 hw = *(const u32x4*)(hb16 + bj * 128);
                            h0 = (f32x4){__uint_as_float(hw[0] << 16), __uint_as_float(hw[0] & 0xffff0000u), __uint_as_float(hw[1] << 16), __uint_as_float(hw[1] & 0xffff0000u)};
                            h1 = (f32x4){__uint_as_float(hw[2] << 16), __uint_as_float(hw[2] & 0xffff0000u), __uint_as_float(hw[3] << 16), __uint_as_float(hw[3] & 0xffff0000u)}; }
                        else { h0 = *(const f32x4*)(hb + bj * 128); h1 = *(const f32x4*)(hb + bj * 128 + 4); }
                        f32x4 a0 = acc[ai][bj][m][0], a1 = acc[ai][bj][m][1];
                        if (part_buf) {
#pragma unroll
                            for (int pp = 0; pp < 3; ++pp) { const float* pq = pb0 + (size_t)(pp * 32 + ((ai * 2 + bj) * 4 + m) * 2) * 512 * 4;
                                a0 += *(const f32x4*)pq; a1 += *(const f32x4*)(pq + 512 * 4); }
                        }
                        const f32x4 z0 = h0 * ALPHA_ + g[bj][0] * a0, z1 = h1 * ALPHA_ + g[bj][1] * a1;
                        z[ai][m][bj][0] = z0; z[ai][m][bj][1] = z1;
                        s += (z0[0] + z0[1]) + (z0[2] + z0[3]) + (z1[0] + z1[1]) + (z1[2] + z1[3]);
                        q += (z0[0] * z0[0] + z0[1] * z0[1]) + (z0[2] * z0[2] + z0[3] * z0[3]) + (z1[0] * z1[0] + z1[1] * z1[1]) + (z1[2] * z1[2] + z1[3] * z1[3]);
                    }
                    s += __shfl_xor(s, 16); s += __shfl_xor(s, 32); q += __shfl_xor(q, 16); q += __shfl_xor(q, 32);
                    if (fq == 0) __hip_atomic_store(slots + ((size_t)(u.pm * 256 + r) * 16 + u.pn * 4 + wc), ((unsigned long long)__float_as_uint(q) << 32) | __float_as_uint(s), __ATOMIC_RELAXED, __HIP_MEMORY_SCOPE_AGENT);
                    if (m == 3) asm volatile("" ::: "memory");
                }
        }
        asm volatile("s_waitcnt vmcnt(0)" ::: "memory"); __builtin_amdgcn_s_barrier(); asm volatile("" ::: "memory");
        if (threadIdx.x == 0) {
            unsigned* cw = cnt + 64 * u.pm;
            __hip_atomic_fetch_add(cw, 1u, __ATOMIC_RELAXED, __HIP_MEMORY_SCOPE_AGENT);
            unsigned sp = 0;
            while (__hip_atomic_load(cw, __ATOMIC_RELAXED, __HIP_MEMORY_SCOPE_AGENT) < 4u) { __builtin_amdgcn_s_sleep(1); if (++sp > (1u << 24)) break; }
            __builtin_amdgcn_fence(__ATOMIC_ACQUIRE, "agent"); asm volatile("s_waitcnt vmcnt(0)" ::: "memory");
        }
        asm volatile("s_waitcnt vmcnt(0) lgkmcnt(0)" ::: "memory"); __builtin_amdgcn_s_barrier(); asm volatile("" ::: "memory");
        const float* mp = U ? modl + set * 6144 + kmod * 1024 + colb : nullptr;
        f32x4 sv[2][4][2];
#pragma unroll
        for (int ai = 0; ai < 2; ++ai)
#pragma unroll
            for (int m = 0; m < 4; ++m) {
                const int r = ai * 128 + wr * 64 + m * 16 + fr;
                const f32x4* sl = (const f32x4*)(slots + ((size_t)(u.pm * 256 + r) * 16 + fq * 4));
                sv[ai][m][0] = sl[0]; sv[ai][m][1] = sl[1];
            }
        float mean_[2][4], rstd_[2][4];
#pragma unroll
        for (int ai = 0; ai < 2; ++ai)
#pragma unroll
            for (int m = 0; m < 4; ++m) {
                float s = (sv[ai][m][0][0] + sv[ai][m][0][2]) + (sv[ai][m][1][0] + sv[ai][m][1][2]);
                float q = (sv[ai][m][0][1] + sv[ai][m][0][3]) + (sv[ai][m][1][1] + sv[ai][m][1][3]);
                s += __shfl_xor(s, 16); s += __shfl_xor(s, 32); q += __shfl_xor(q, 16); q += __shfl_xor(q, 32);
                const float mean = s * (1.f / DM);
                mean_[ai][m] = mean; rstd_[ai][m] = 1.f / sqrtf(fmaxf(q * (1.f / DM) - mean * mean, 0.f) + 1e-5f);
            }
        asm volatile("" ::: "memory");
#pragma unroll
        for (int bj = 0; bj < 2; ++bj) {
            const int col = colb + bj * 128;
            const f32x4 lg0 = *(const f32x4*)(lg + col), lg1 = *(const f32x4*)(lg + col + 4), lb0 = *(const f32x4*)(lb + col), lb1 = *(const f32x4*)(lb + col + 4);
            f32x4 sh0 = {}, sh1 = {}, sc0 = {}, sc1 = {};
            if (U) { sh0 = *(const f32x4*)(mp + bj * 128); sh1 = *(const f32x4*)(mp + bj * 128 + 4); sc0 = *(const f32x4*)(mp + 1024 + bj * 128) + 1.f; sc1 = *(const f32x4*)(mp + 1024 + bj * 128 + 4) + 1.f; }
#pragma unroll
            for (int ai = 0; ai < 2; ++ai)
#pragma unroll
                for (int m = 0; m < 4; ++m) {
                    const int r = ai * 128 + wr * 64 + m * 16 + fr, row = u.pm * 256 + r;
                    const float mean = mean_[ai][m], rstd = rstd_[ai][m];
                    const f32x4 h0 = (z[ai][m][bj][0] - mean) * rstd * lg0 + lb0, h1 = (z[ai][m][bj][1] - mean) * rstd * lg1 + lb1;
                    if (HOUT16) *(u32x4*)((bf16_t*)dst + (size_t)row * DM + col) = (u32x4){pk2(h0[0], h0[1]), pk2(h0[2], h0[3]), pk2(h1[0], h1[1]), pk2(h1[2], h1[3])};
                    else { float* dp = (float*)dst + (size_t)row * DM + col; *(f32x4*)dp = h0; *(f32x4*)(dp + 4) = h1; }
                    if (U) { const f32x4 u0 = h0 * sc0 + sh0, u1 = h1 * sc1 + sh1;
                        *(u32x4*)(U + (size_t)row * DM + col) = (u32x4){pk2(u0[0], u0[1]), pk2(u0[2], u0[3]), pk2(u1[0], u1[1]), pk2(u1[2], u1[3])}; }
                }
            asm volatile("" ::: "memory");
        }
    }
};
struct EpiFfn {
    static constexpr bool PERM = true, AFTER_DRAIN = false;
    bf16_t* ACT;
    __device__ __forceinline__ void operator()(const f32x4 (&acc)[2][2][4][2], const Unit& u, int wr, int wc, int fr, int fq) const {
        asm volatile("" : "+v"(fr), "+v"(fq));
        const int hcol = u.pn * 128 + wc * 32 + 8 * fq;
#pragma unroll
        for (int ai = 0; ai < 2; ++ai)
#pragma unroll
            for (int m = 0; m < 4; ++m) {
                const int row = u.pm * 256 + ai * 128 + wr * 64 + m * 16 + fr;
                float o[8];
#pragma unroll
                for (int i = 0; i < 8; ++i) { const float g = acc[ai][0][m][i >> 2][i & 3], a = acc[ai][1][m][i >> 2][i & 3]; o[i] = g * __builtin_amdgcn_rcpf(1.f + __builtin_amdgcn_exp2f(-1.4426950408889634f * g)) * a; }
                u32x4 w; w.x = pk2(o[0], o[1]); w.y = pk2(o[2], o[3]); w.z = pk2(o[4], o[5]); w.w = pk2(o[6], o[7]);
                *(u32x4*)(ACT + (size_t)row * FH + hcol) = w;
            }
    }
};
struct EpiIn1 {
    static constexpr bool PERM = true, AFTER_DRAIN = false;
    bf16_t* P1; float* stats; const float* tab16;
    __device__ __forceinline__ void operator()(const f32x4 (&acc)[2][2][4][2], const Unit& u, int wr, int wc, int fr, int fq) const {
        asm volatile("" : "+v"(fr), "+v"(fq));
#pragma unroll
        for (int bj = 0; bj < 2; ++bj) {
            const int col32 = u.pn * 256 + bj * 128 + wc * 32, col = col32 + 8 * fq, grp = col32 >> 5;
            if (col32 >= 672 && col32 < 768) continue;
            const int kind = (col32 < 640) ? 0 : (col32 < 672 ? 1 : (col32 < 1280 ? 2 : 3));
#pragma unroll
            for (int ai = 0; ai < 2; ++ai)
#pragma unroll
                for (int m = 0; m < 4; ++m) {
                    const int row = u.pm * 256 + ai * 128 + wr * 64 + m * 16 + fr;
                    float v[8];
#pragma unroll
                    for (int i = 0; i < 4; ++i) { v[i] = acc[ai][bj][m][0][i]; v[4 + i] = acc[ai][bj][m][1][i]; }
                    if (kind == 1) {
                        if (u.pm < 64) {
                            const int t = row & 8191; const int pos = (fq & 2) ? (t & 63) : (t >> 6);
                            const float* tb = tab16 + pos * 16;
                            const f32x4 t0 = *(const f32x4*)tb, t1 = *(const f32x4*)(tb + 4), t2 = *(const f32x4*)(tb + 8), t3 = *(const f32x4*)(tb + 12);
                            const float cs[8] = {t0[0], t0[2], t1[0], t1[2], t2[0], t2[2], t3[0], t3[2]};
                            const float sn[8] = {t0[1], t0[3], t1[1], t1[3], t2[1], t2[3], t3[1], t3[3]};
                            const float sgn = (fq & 1) ? 1.f : -1.f;
#pragma unroll
                            for (int i = 0; i < 8; ++i) { const float pr = __shfl_xor(v[i], 16); v[i] = v[i] * cs[i] + sgn * pr * sn[i]; }
                        }
                    } else if (kind >= 2) {
#pragma unroll
                        for (int i = 0; i < 8; i += 2) { const pg8::f32x2 gv2 = pg8::gelu_pk((pg8::f32x2){v[i], v[i + 1]}); v[i] = gv2.x; v[i + 1] = gv2.y; }
                    }
                    if (kind == 0 || kind == 3) {
                        float s = 0.f, q = 0.f;
#pragma unroll
                        for (int i = 0; i < 8; ++i) { s += v[i]; q += v[i] * v[i]; }
                        s += __shfl_xor(s, 16); s += __shfl_xor(s, 32); q += __shfl_xor(q, 16); q += __shfl_xor(q, 32);
                        if (fq == 0) *(f32x2v*)(stats + (size_t)row * STP + grp * 2) = (f32x2v){s, q};
                    }
                    u32x4 w; w.x = pk2(v[0], v[1]); w.y = pk2(v[2], v[3]); w.z = pk2(v[4], v[5]); w.w = pk2(v[6], v[7]);
                    *(u32x4*)(P1 + (size_t)row * PW1 + col) = w;
                    asm volatile("" ::: "memory");
                }
        }
    }
};
struct EpiQ1 {
    static constexpr bool PERM = true, AFTER_DRAIN = false;
    bf16_t* Q1; const float* stats; const float* tab16;
    __device__ __forceinline__ void operator()(const f32x4 (&acc)[2][2][4][2], const Unit& u, int wr, int wc, int fr, int fq) const {
        asm volatile("" : "+v"(fr), "+v"(fq));
#pragma unroll
        for (int ai = 0; ai < 2; ++ai)
#pragma unroll
            for (int m = 0; m < 4; ++m) {
                const int row = u.pm * 256 + ai * 128 + wr * 64 + m * 16 + fr;
                const float* sp = stats + (size_t)row * STP + fq * 6;
                float q = sp[1] + sp[3] + sp[5];
                q += __shfl_xor(q, 16); q += __shfl_xor(q, 32);
                const float rs = QS96 / sqrtf(q * (1.f / 384.f) + 1e-6f);
                const int t = row & 8191; const int pos = (fq & 2) ? (t & 63) : (t >> 6);
                const float* tb = tab16 + pos * 16;
                const float sgn = (fq & 1) ? 1.f : -1.f;
#pragma unroll
                for (int bj = 0; bj < 2; ++bj) {
                    const int col32 = u.pn * 256 + bj * 128 + wc * 32, col = col32 + 8 * fq;
                    const bool rope = ((col32 >> 5) % 3) == 2;
                    float v[8];
#pragma unroll
                    for (int i = 0; i < 4; ++i) { v[i] = acc[ai][bj][m][0][i]; v[4 + i] = acc[ai][bj][m][1][i]; }
                    if (rope) {
                        const f32x4 t0 = *(const f32x4*)tb, t1 = *(const f32x4*)(tb + 4), t2 = *(const f32x4*)(tb + 8), t3 = *(const f32x4*)(tb + 12);
                        const float cs[8] = {t0[0], t0[2], t1[0], t1[2], t2[0], t2[2], t3[0], t3[2]};
                        const float sn[8] = {t0[1], t0[3], t1[1], t1[3], t2[1], t2[3], t3[1], t3[3]};
#pragma unroll
                        for (int i = 0; i < 8; ++i) { const float pr = __shfl_xor(v[i], 16); v[i] = v[i] * cs[i] + sgn * pr * sn[i]; }
                    }
                    u32x4 w; w.x = pk2(v[0] * rs, v[1] * rs); w.y = pk2(v[2] * rs, v[3] * rs); w.z = pk2(v[4] * rs, v[5] * rs); w.w = pk2(v[6] * rs, v[7] * rs);
                    *(u32x4*)(Q1 + (size_t)row * 768 + col) = w;
                }
                asm volatile("" ::: "memory");
            }
    }
};
struct EpiKV1 {
    static constexpr bool PERM = true, AFTER_DRAIN = false;
    bf16_t* KV1; const float* stats;
    __device__ __forceinline__ void operator()(const f32x4 (&acc)[2][2][4][2], const Unit& u, int wr, int wc, int fr, int fq) const {
        asm volatile("" : "+v"(fr), "+v"(fq));
#pragma unroll
        for (int ai = 0; ai < 2; ++ai)
#pragma unroll
            for (int m = 0; m < 4; ++m) {
                const int row = u.pm * 256 + ai * 128 + wr * 64 + m * 16 + fr;
                const float* sp = stats + (size_t)row * STP + 24 + fq * 4;
                float q = sp[1] + sp[3];
                q += __shfl_xor(q, 16); q += __shfl_xor(q, 32);
                const float rs = 1.f / sqrtf(q * (1.f / 256.f) + 1e-6f);
#pragma unroll
                for (int bj = 0; bj < 2; ++bj) {
                    const int col = u.pn * 256 + bj * 128 + wc * 32 + 8 * fq;
                    const f32x4 a = acc[ai][bj][m][0] * rs, b = acc[ai][bj][m][1] * rs;
                    u32x4 w; w.x = pk2(a[0], a[1]); w.y = pk2(a[2], a[3]); w.z = pk2(b[0], b[1]); w.w = pk2(b[2], b[3]);
                    *(u32x4*)(KV1 + (size_t)row * 1024 + col) = w;
                }
                asm volatile("" ::: "memory");
            }
    }
};

struct AttnDesc {
    const bf16_t* Q; int qpitch;
    const bf16_t* K; int kpitch;
    const bf16_t* K2; int k2pitch;
    const bf16_t* V; int vpitch;
    float* Of; bf16_t* Ob; int opitch;
    int qrow0;
    int ntiles, nlat, lat_row0, ctx_row0;
    int na_rowlo, na_gr0;
    const float* rpb;
    float lam; const float* subg;
};
__device__ __forceinline__ s16x4 tr_read(const LAS unsigned char* p) { return __builtin_bit_cast(s16x4, __builtin_amdgcn_ds_read_tr16_b64_v4i16((LAS v4i16_t*)p)); }


__device__ __forceinline__ void glds16(const void* gsrc, unsigned lds_dst) { unsigned keep;
    asm volatile("s_mov_b32 %0, m0\n\ts_mov_b32 m0, %2\n\ts_nop 0\n\tglobal_load_lds_dwordx4 %1, off\n\ts_mov_b32 m0, %0" : "=&s"(keep) : "v"(gsrc), "s"(lds_dst) : "memory"); }
template <int NDB>
__device__ __forceinline__ void att_softmax(f32x16& p0, f32x16& p1, f32x16 (&o)[NDB], float& mrun, float& lrun, bool& first, bf16x8 (&pf)[4]) {
    float ra = __builtin_fmaxf(__builtin_fmaxf(p0[0], p0[1]), p1[0]), rb = __builtin_fmaxf(__builtin_fmaxf(p0[2], p0[3]), p1[1]);
    ra = __builtin_fmaxf(__builtin_fmaxf(ra, p1[2]), p1[3]);
#pragma unroll
    for (int r = 4; r < 16; r += 4) { ra = __builtin_fmaxf(__builtin_fmaxf(ra, p0[r]), p0[r + 1]); rb = __builtin_fmaxf(__builtin_fmaxf(rb, p0[r + 2]), p0[r + 3]);
        ra = __builtin_fmaxf(__builtin_fmaxf(ra, p1[r]), p1[r + 1]); rb = __builtin_fmaxf(__builtin_fmaxf(rb, p1[r + 2]), p1[r + 3]); }
    float rm = __builtin_fmaxf(ra, rb);
    { auto rr = __builtin_amdgcn_permlane32_swap(__float_as_uint(rm), __float_as_uint(rm), false, false); rm = __builtin_fmaxf(__uint_as_float(rr[0]), __uint_as_float(rr[1])); }
    if (first || __any(rm > mrun + 8.f)) {
        const float mn = first ? rm : __builtin_fmaxf(mrun, rm);
        if (!first) { const float al = __builtin_amdgcn_exp2f(mrun - mn); lrun *= al;
#pragma unroll
            for (int i = 0; i < NDB; ++i) o[i] *= al; }
        mrun = mn; first = false;
    }
    float ls = 0.f;
#pragma unroll
    for (int r = 0; r < 16; ++r) { p0[r] = __builtin_amdgcn_exp2f(p0[r] - mrun); p1[r] = __builtin_amdgcn_exp2f(p1[r] - mrun); ls += p0[r] + p1[r]; }
    lrun += ls;
#pragma unroll
    for (int j = 0; j < 4; ++j) {
        u32x4 pw;
#pragma unroll
        for (int e = 0; e < 4; ++e) { const int r = 8 * (j & 1) + 2 * e; pw[e] = (j < 2) ? pk2(p0[r], p0[r + 1]) : pk2(p1[r], p1[r + 1]); }
        pf[j] = __builtin_bit_cast(bf16x8, pw);
    }
}
template <int NDB, int VS>
__device__ __forceinline__ void att_pv(f32x16 (&o)[NDB], const bf16x8 (&pf)[4], const LAS unsigned char* vb) {
#pragma unroll
    for (int j = 0; j < 4; ++j)
#pragma unroll
        for (int db = 0; db < NDB; ++db) {
            const s16x4 lo = tr_read(vb + (16 * j) * VS + db * 64), hh = tr_read(vb + (16 * j + 8) * VS + db * 64);
            const bf16x8 vf = (bf16x8){lo[0], lo[1], lo[2], lo[3], hh[0], hh[1], hh[2], hh[3]};
            o[db] = __builtin_amdgcn_mfma_f32_32x32x16_bf16(vf, pf[j], o[db], 0, 0, 0);
        }
}
template <int DQ, int DV, bool NA, int OMODE>
__device__ __forceinline__ void attn_unit(const AttnDesc d, LAS unsigned char* lds) {
    constexpr int KS = DQ * 2 + 16, VS = DV * 2 + 64;
    constexpr int KBUF = NA ? 64 * KS : (8192 + (DQ == 96 ? 4096 : 0)), VBUF = NA ? 64 * VS : 64 * DV * 2;
    constexpr int NBUF = NA ? 2 : 3;
    constexpr int OFF_K = 0, OFF_V = NBUF * KBUF, OFF_RPB = OFF_V + NBUF * VBUF;
    constexpr int NQF = DQ / 16, NDB = DV / 32;
    int tid = threadIdx.x; asm volatile("" : "+v"(tid));
    const int lane = tid & 63, w = __builtin_amdgcn_readfirstlane(tid >> 6), r32 = lane & 31, hi = lane >> 5;
    bf16x8 qf[NQF];
    { const bf16_t* qp = d.Q + (size_t)(d.qrow0 + 32 * w + r32) * d.qpitch + 8 * hi;
#pragma unroll
      for (int d0 = 0; d0 < NQF; ++d0) qf[d0] = *(const bf16x8*)(qp + 16 * d0); }
    LAS float* rpbL = (LAS float*)(lds + OFF_RPB);
    if (NA) { for (int i = tid; i < 465; i += 512) rpbL[i] = d.rpb[i] * LOG2E_; }
    const int kkey = tid >> 3, kch = tid & 7;
    const int k2key = tid >> 2, k2ch = tid & 3;
    u32x4 kA, kB, vA, vB;
#define ATT_TROW(i) ((i) < d.nlat ? d.lat_row0 + 64 * (i) : d.ctx_row0 + 64 * ((i) - d.nlat))
#define ATT_LOAD(i) do { const int tr_ = ATT_TROW(i); \
        kA = *(const u32x4*)(d.K + (size_t)(tr_ + kkey) * d.kpitch + kch * 8); \
        if (DQ == 96) { if (tid < 256) kB = *(const u32x4*)(d.K2 + (size_t)(tr_ + k2key) * d.k2pitch + k2ch * 8); } \
        if (DV == 128) { vA = *(const u32x4*)(d.V + (size_t)(tr_ + (tid >> 4)) * d.vpitch + (tid & 15) * 8); vB = *(const u32x4*)(d.V + (size_t)(tr_ + 32 + (tid >> 4)) * d.vpitch + (tid & 15) * 8); } \
        else { vA = *(const u32x4*)(d.V + (size_t)(tr_ + kkey) * d.vpitch + kch * 8); } } while (0)
#define ATT_STORE(b) do { \
        *(LAS u32x4*)(lds + OFF_K + (b) * KBUF + kkey * KS + kch * 16) = kA; \
        if (DQ == 96) { if (tid < 256) *(LAS u32x4*)(lds + OFF_K + (b) * KBUF + k2key * KS + 128 + k2ch * 16) = kB; } \
        if (DV == 128) { *(LAS u32x4*)(lds + OFF_V + (b) * VBUF + (tid >> 4) * VS + (tid & 15) * 16) = vA; *(LAS u32x4*)(lds + OFF_V + (b) * VBUF + (32 + (tid >> 4)) * VS + (tid & 15) * 16) = vB; } \
        else { *(LAS u32x4*)(lds + OFF_V + (b) * VBUF + kkey * VS + kch * 16) = vA; } } while (0)
    const int nt = d.ntiles;
    const unsigned ldsb = (unsigned)(uintptr_t)lds;
    int gko, gk2o = 0, gvo0, gvo1 = 0;
    { const int kr = 8 * w + (lane >> 3), kc = (lane & 7) ^ ((kr >> 1) & 7); gko = kr * d.kpitch + kc * 8;
      if (DQ == 96) { const int rr = 16 * (w & 3) + (lane >> 2), rc = (lane & 3) ^ ((rr >> 2) & 3); gk2o = rr * d.k2pitch + rc * 8; }
      if (DV == 128) { const int pos = lane & 15, sp = pos >> 2, sub = pos & 3;
          const int r0 = 8 * w + (lane >> 4), r1 = r0 + 4;
          gvo0 = r0 * d.vpitch + ((sp - r0) & 3) * 32 + sub * 8; gvo1 = r1 * d.vpitch + ((sp - r1) & 3) * 32 + sub * 8; }
      else { const int sr = 4 * w + (lane >> 4), pos = lane & 15, sp = pos >> 2, sub = pos & 3, x = (sp - sr) & 3;
          gvo0 = (2 * sr + (x >> 1)) * d.vpitch + (x & 1) * 32 + sub * 8; } }
#define ATT_DMA(i, slot) do { const int tr_ = ATT_TROW(i); \
        glds16(d.K + ((size_t)tr_ * d.kpitch + gko), (unsigned)__builtin_amdgcn_readfirstlane(ldsb + OFF_K + (slot) * KBUF + w * 1024)); \
        if (DQ == 96) { if (w < 4) glds16(d.K2 + ((size_t)tr_ * d.k2pitch + gk2o), (unsigned)__builtin_amdgcn_readfirstlane(ldsb + OFF_K + (slot) * KBUF + 8192 + w * 1024)); } \
        if (DV == 128) { glds16(d.V + ((size_t)tr_ * d.vpitch + gvo0), (unsigned)__builtin_amdgcn_readfirstlane(ldsb + OFF_V + (slot) * VBUF + w * 2048)); \
                         glds16(d.V + ((size_t)tr_ * d.vpitch + gvo1), (unsigned)__builtin_amdgcn_readfirstlane(ldsb + OFF_V + (slot) * VBUF + w * 2048 + 1024)); } \
        else glds16(d.V + ((size_t)tr_ * d.vpitch + gvo0), (unsigned)__builtin_amdgcn_readfirstlane(ldsb + OFF_V + (slot) * VBUF + w * 1024)); } while (0)
    if (NA) { ATT_LOAD(0); ATT_STORE(0); }
    else { ATT_DMA(0, 0); if (nt > 1) ATT_DMA(1, 1); asm volatile("s_waitcnt vmcnt(0)" ::: "memory"); }
    __syncthreads();
    f32x16 o[NDB];
#pragma unroll
    for (int i = 0; i < NDB; ++i) o[i] = (f32x16){};
    float mrun = 0.f, lrun = 0.f; bool first = true;
    const int gr = d.na_gr0 + (w >> 1);
    const int rs_ = gr - 4 < 0 ? 0 : (gr - 4 > 120 ? 120 : gr - 4);
    const int qc = 32 * (w & 1) + r32;
    const int cs_ = qc - 8 < 0 ? 0 : (qc - 8 > 48 ? 48 : qc - 8);
    unsigned namask0 = 0u, namask1 = 0u;
    if (NA) {
#pragma unroll
        for (int r = 0; r < 16; ++r) { const int kc0 = (r & 3) + 8 * (r >> 2) + 4 * hi, kc1 = kc0 + 32;
            namask0 |= (kc0 >= cs_ && kc0 < cs_ + 16) ? (1u << r) : 0u; namask1 |= (kc1 >= cs_ && kc1 < cs_ + 16) ? (1u << r) : 0u; }
    }
    const int koffr = r32 * KS + hi * 16;
    const int voffr = (4 * hi + ((lane & 15) >> 2)) * VS + ((lane >> 4) & 1) * 32 + (lane & 3) * 8;
    int kro[NQF], vro[NDB];
    { const int q_ = (lane & 15) >> 2, gi_ = (lane >> 4) & 1, p_ = lane & 3;
#pragma unroll
      for (int d0 = 0; d0 < NQF; ++d0) kro[d0] = d0 < 4 ? r32 * 128 + (((2 * d0 + hi) ^ ((r32 >> 1) & 7)) << 4) : 8192 + r32 * 64 + (((2 * (d0 - 4) + hi) ^ ((r32 >> 2) & 3)) << 4);
#pragma unroll
      for (int db = 0; db < NDB; ++db) vro[db] = DV == 128 ? (4 * hi + q_) * 256 + (((db + q_) & 3) << 6) + 32 * gi_ + 8 * p_
                                                             : (2 * hi + (q_ >> 1)) * 256 + (((2 * (q_ & 1) + db + 2 * hi + (q_ >> 1)) & 3) << 6) + 32 * gi_ + 8 * p_; }
    constexpr int VJ = DV == 128 ? 4096 : 2048, VE = DV == 128 ? 2048 : 1024;
    if constexpr (!NA) {
        f32x16 pA0, pA1, pB0, pB1; bf16x8 pf[4];
        int bc = 0, bn = 1, bn2 = 2;
#define ATT_BAR() asm volatile("s_waitcnt vmcnt(0) lgkmcnt(0)\n\ts_barrier" ::: "memory")
#define ATT_QK(P0, P1, slot) do { const LAS unsigned char* kb_ = lds + OFF_K + (slot) * KBUF; \
        bf16x8 ka_[NQF], kc_[NQF];       \
        _Pragma("unroll") for (int d0 = 0; d0 < NQF; ++d0) { ka_[d0] = *(const LAS bf16x8*)(kb_ + kro[d0]); kc_[d0] = *(const LAS bf16x8*)(kb_ + kro[d0] + (d0 < 4 ? 4096 : 2048)); } \
        __builtin_amdgcn_sched_barrier(0); \
        _Pragma("unroll") for (int d0 = 0; d0 < NQF; ++d0) { \
            const bf16x8 a0_ = ka_[d0], a1_ = kc_[d0]; \
            if (d0 == 0) { P0 = __builtin_amdgcn_mfma_f32_32x32x16_bf16(a0_, qf[0], (f32x16){}, 0, 0, 0); P1 = __builtin_amdgcn_mfma_f32_32x32x16_bf16(a1_, qf[0], (f32x16){}, 0, 0, 0); } \
            else { P0 = __builtin_amdgcn_mfma_f32_32x32x16_bf16(a0_, qf[d0], P0, 0, 0, 0); P1 = __builtin_amdgcn_mfma_f32_32x32x16_bf16(a1_, qf[d0], P1, 0, 0, 0); } } } while (0)
#define ATT_STEP(C0, C1, N0, N1, tt) do { \
        if ((tt) + 2 < nt) ATT_DMA((tt) + 2, bn2);        \
        if ((tt) + 1 < nt) ATT_QK(N0, N1, bn); \
        s16x4 vlo_[NDB][4], vhh_[NDB][4]; \
        if (DV == 64) { const LAS unsigned char* vb_ = lds + OFF_V + bc * VBUF;     \
            _Pragma("unroll") for (int db = 0; db < NDB; ++db) _Pragma("unroll") for (int j = 0; j < 4; ++j) { vlo_[db][j] = tr_read(vb_ + vro[db] + j * VJ); vhh_[db][j] = tr_read(vb_ + vro[db] + j * VJ + VE); } } \
        att_softmax<NDB>(C0, C1, o, mrun, lrun, first, pf); \
        if (DV == 64) { \
            _Pragma("unroll") for (int j = 0; j < 4; ++j) _Pragma("unroll") for (int db = 0; db < NDB; ++db) { \
                const bf16x8 vf_ = (bf16x8){vlo_[db][j][0], vlo_[db][j][1], vlo_[db][j][2], vlo_[db][j][3], vhh_[db][j][0], vhh_[db][j][1], vhh_[db][j][2], vhh_[db][j][3]}; \
                o[db] = __builtin_amdgcn_mfma_f32_32x32x16_bf16(vf_, pf[j], o[db], 0, 0, 0); } } \
        else { const LAS unsigned char* vb_ = lds + OFF_V + bc * VBUF; \
            _Pragma("unroll") for (int j = 0; j < 4; ++j) _Pragma("unroll") for (int db = 0; db < NDB; ++db) { \
                const s16x4 lo_ = tr_read(vb_ + vro[db] + j * VJ), hh_ = tr_read(vb_ + vro[db] + j * VJ + VE); \
                const bf16x8 vf_ = (bf16x8){lo_[0], lo_[1], lo_[2], lo_[3], hh_[0], hh_[1], hh_[2], hh_[3]}; \
                o[db] = __builtin_amdgcn_mfma_f32_32x32x16_bf16(vf_, pf[j], o[db], 0, 0, 0); } } \
        ATT_BAR(); \
        { const int t_ = bc; bc = bn; bn = bn2; bn2 = t_; } } while (0)
        ATT_QK(pA0, pA1, 0);
        int t = 0;
#pragma nounroll
        for (; t + 1 < nt; t += 2) {
            ATT_STEP(pA0, pA1, pB0, pB1, t);
            ATT_STEP(pB0, pB1, pA0, pA1, t + 1);
        }
        if (t < nt) ATT_STEP(pA0, pA1, pB0, pB1, t);
#undef ATT_STEP
#undef ATT_QK
#undef ATT_BAR
    } else {
#pragma nounroll
    for (int t = 0; t < nt; ++t) {
        const int cur = t & 1;
        if (t + 1 < nt) ATT_LOAD(t + 1);
        bool active = true;
        if (NA) { if (t < d.nlat) { const int krow = d.na_rowlo + t; active = (krow >= rs_) && (krow < rs_ + 8); } }
        if (active) {
            const LAS unsigned char* kb = lds + OFF_K + cur * KBUF + koffr;
            f32x16 p0, p1;
#pragma unroll
            for (int d0 = 0; d0 < NQF; ++d0) {
                const bf16x8 a0 = *(const LAS bf16x8*)(kb + d0 * 32), a1 = *(const LAS bf16x8*)(kb + 32 * KS + d0 * 32);
                if (d0 == 0) { p0 = __builtin_amdgcn_mfma_f32_32x32x16_bf16(a0, qf[0], (f32x16){}, 0, 0, 0); p1 = __builtin_amdgcn_mfma_f32_32x32x16_bf16(a1, qf[0], (f32x16){}, 0, 0, 0); }
                else { p0 = __builtin_amdgcn_mfma_f32_32x32x16_bf16(a0, qf[d0], p0, 0, 0, 0); p1 = __builtin_amdgcn_mfma_f32_32x32x16_bf16(a1, qf[d0], p1, 0, 0, 0); }
            }
            if (NA) { if (t < d.nlat) {
                const int roff = d.na_rowlo + t - gr + 7;
                const LAS float* bp = rpbL + roff * 31 + (4 * hi - qc + 15);
#pragma unroll
                for (int r = 0; r < 16; ++r) {
                    const int c0 = (r & 3) + 8 * (r >> 2);
                    const float b0 = bp[c0], b1 = bp[c0 + 32];
                    p0[r] = ((namask0 >> r) & 1u) ? p0[r] + b0 : -INFINITY;
                    p1[r] = ((namask1 >> r) & 1u) ? p1[r] + b1 : -INFINITY;
                }
            } }
            float ra = __builtin_fmaxf(__builtin_fmaxf(p0[0], p0[1]), p1[0]), rb = __builtin_fmaxf(__builtin_fmaxf(p0[2], p0[3]), p1[1]);
            ra = __builtin_fmaxf(__builtin_fmaxf(ra, p1[2]), p1[3]);
#pragma unroll
            for (int r = 4; r < 16; r += 4) { ra = __builtin_fmaxf(__builtin_fmaxf(ra, p0[r]), p0[r + 1]); rb = __builtin_fmaxf(__builtin_fmaxf(rb, p0[r + 2]), p0[r + 3]);
                ra = __builtin_fmaxf(__builtin_fmaxf(ra, p1[r]), p1[r + 1]); rb = __builtin_fmaxf(__builtin_fmaxf(rb, p1[r + 2]), p1[r + 3]); }
            float rm = __builtin_fmaxf(ra, rb);
            { auto rr = __builtin_amdgcn_permlane32_swap(__float_as_uint(rm), __float_as_uint(rm), false, false); rm = __builtin_fmaxf(__uint_as_float(rr[0]), __uint_as_float(rr[1])); }
            if (first || __any(rm > mrun + 8.f)) {
                const float mn = first ? rm : __builtin_fmaxf(mrun, rm);
                if (!first) { const float al = __builtin_amdgcn_exp2f(mrun - mn); lrun *= al;
#pragma unroll
                    for (int i = 0; i < NDB; ++i) o[i] *= al; }
                mrun = mn; first = false;
            }
            float ls = 0.f;
#pragma unroll
            for (int r = 0; r < 16; ++r) { p0[r] = __builtin_amdgcn_exp2f(p0[r] - mrun); p1[r] = __builtin_amdgcn_exp2f(p1[r] - mrun); ls += p0[r] + p1[r]; }
            lrun += ls;
            bf16x8 pf[4];
#pragma unroll
            for (int j = 0; j < 4; ++j) {
                u32x4 pw;
#pragma unroll
                for (int e = 0; e < 4; ++e) { const int r = 8 * (j & 1) + 2 * e; pw[e] = (j < 2) ? pk2(p0[r], p0[r + 1]) : pk2(p1[r], p1[r + 1]); }
                pf[j] = __builtin_bit_cast(bf16x8, pw);
            }
            const LAS unsigned char* vb = lds + OFF_V + cur * VBUF + voffr;
#pragma unroll
            for (int db = 0; db < NDB; ++db)
#pragma unroll
                for (int j = 0; j < 4; ++j) {
                    const s16x4 lo = tr_read(vb + (16 * j) * VS + db * 64), hh = tr_read(vb + (16 * j + 8) * VS + db * 64);
                    const bf16x8 vf = (bf16x8){lo[0], lo[1], lo[2], lo[3], hh[0], hh[1], hh[2], hh[3]};
                    o[db] = __builtin_amdgcn_mfma_f32_32x32x16_bf16(vf, pf[j], o[db], 0, 0, 0);
                }
        }
        if (t + 1 < nt) ATT_STORE(cur ^ 1);
        __syncthreads();
    }
    }
#undef ATT_TROW
#undef ATT_LOAD
#undef ATT_DMA
#undef ATT_STORE
    lrun += __shfl_xor(lrun, 32);
    const float inv = 1.f / lrun;
    const size_t orow = (size_t)(d.qrow0 + 32 * w + r32) * d.opitch;
    if (OMODE == 2) {
#pragma unroll
        for (int db = 0; db < NDB; ++db)
#pragma unroll
            for (int rg = 0; rg < 4; ++rg)
                *(u32x2*)(d.Ob + orow + 32 * db + 8 * rg + 4 * hi) = (u32x2){pk2(o[db][4 * rg] * inv, o[db][4 * rg + 1] * inv), pk2(o[db][4 * rg + 2] * inv, o[db][4 * rg + 3] * inv)};
    } else if (OMODE == 3) {
        float ss = 0.f;
#pragma unroll
        for (int db = 0; db < NDB; ++db)
#pragma unroll
            for (int rg = 0; rg < 4; ++rg) {
                const u32x2 st = *(const u32x2*)(d.Ob + orow + 32 * db + 8 * rg + 4 * hi);
                const float a1 = __uint_as_float(st[0] << 16), b1 = __uint_as_float(st[0] & 0xffff0000u), c1 = __uint_as_float(st[1] << 16), e1 = __uint_as_float(st[1] & 0xffff0000u);
                const float li = d.lam * inv;
                const float a = a1 - li * o[db][4 * rg], b = b1 - li * o[db][4 * rg + 1], c = c1 - li * o[db][4 * rg + 2], e = e1 - li * o[db][4 * rg + 3];
                o[db][4 * rg] = a; o[db][4 * rg + 1] = b; o[db][4 * rg + 2] = c; o[db][4 * rg + 3] = e;
                ss += (a * a + b * b) + (c * c + e * e);
            }
        ss += __shfl_xor(ss, 32);
        const float rs = (1.f - LAMBDA_INIT) / sqrtf(ss * (1.f / 128.f) + 1e-6f);
#pragma unroll
        for (int db = 0; db < NDB; ++db)
#pragma unroll
            for (int rg = 0; rg < 4; ++rg) {
                const int dc = 32 * db + 8 * rg + 4 * hi;
                const f32x4 g = *(const f32x4*)(d.subg + dc);
                *(u32x2*)(d.Ob + orow + dc) = (u32x2){pk2(o[db][4 * rg] * rs * g[0], o[db][4 * rg + 1] * rs * g[1]), pk2(o[db][4 * rg + 2] * rs * g[2], o[db][4 * rg + 3] * rs * g[3])};
            }
    } else {
#pragma unroll
        for (int db = 0; db < NDB; ++db)
#pragma unroll
            for (int rg = 0; rg < 4; ++rg) {
                const int dc = 32 * db + 8 * rg + 4 * hi;
                const float a = o[db][4 * rg] * inv, b = o[db][4 * rg + 1] * inv, c = o[db][4 * rg + 2] * inv, e = o[db][4 * rg + 3] * inv;
                if (OMODE == 1) *(f32x4*)(d.Of + orow + dc) = (f32x4){a, b, c, e};
                else *(u32x2*)(d.Ob + orow + dc) = (u32x2){pk2(a, b), pk2(c, e)};
            }
    }
}


__device__ __forceinline__ void attn_unit_mla2(const AttnDesc d, LAS unsigned char* lds) {
    constexpr int NQF = 6, NDB = 2, KBUF = 12288, VBUF = 8192, OFF_K = 0, OFF_V = 3 * KBUF, VJ = 2048, VE = 1024;
    int tid = threadIdx.x; asm volatile("" : "+v"(tid));
    const int lane = tid & 63, w = __builtin_amdgcn_readfirstlane(tid >> 6), r32 = lane & 31, hi = lane >> 5;
    bf16x8 qf[2][NQF];
#pragma unroll
    for (int qb = 0; qb < 2; ++qb) { const bf16_t* qp = d.Q + (size_t)(d.qrow0 + 64 * w + 32 * qb + r32) * d.qpitch + 8 * hi;
#pragma unroll
        for (int d0 = 0; d0 < NQF; ++d0) qf[qb][d0] = *(const bf16x8*)(qp + 16 * d0); }
    const unsigned ldsb = (unsigned)(uintptr_t)lds;
    int gko, gk2o, gvo0;
    { const int kr = 8 * w + (lane >> 3), kc = (lane & 7) ^ ((kr >> 1) & 7); gko = kr * d.kpitch + kc * 8;
      const int rr = 16 * (w & 3) + (lane >> 2), rc = (lane & 3) ^ ((rr >> 2) & 3); gk2o = rr * d.k2pitch + rc * 8;
      const int sr = 4 * w + (lane >> 4), pos = lane & 15, sp = pos >> 2, sub = pos & 3, x = (sp - sr) & 3;
      gvo0 = (2 * sr + (x >> 1)) * d.vpitch + (x & 1) * 32 + sub * 8; }
#define M2_TROW(i) ((i) < d.nlat ? d.lat_row0 + 64 * (i) : d.ctx_row0 + 64 * ((i) - d.nlat))
#define M2_DMA(i, slot) do { const int tr_ = M2_TROW(i); \
        glds16(d.K + ((size_t)tr_ * d.kpitch + gko), (unsigned)__builtin_amdgcn_readfirstlane(ldsb + OFF_K + (slot) * KBUF + w * 1024)); \
        if (w < 4) glds16(d.K2 + ((size_t)tr_ * d.k2pitch + gk2o), (unsigned)__builtin_amdgcn_readfirstlane(ldsb + OFF_K + (slot) * KBUF + 8192 + w * 1024)); \
        glds16(d.V + ((size_t)tr_ * d.vpitch + gvo0), (unsigned)__builtin_amdgcn_readfirstlane(ldsb + OFF_V + (slot) * VBUF + w * 1024)); } while (0)
    const int nt = d.ntiles;
    if (w >= 4) __builtin_amdgcn_s_setprio(1);
    M2_DMA(0, 0); if (nt > 1) M2_DMA(1, 1);
    asm volatile("s_waitcnt vmcnt(0)" ::: "memory");
    __syncthreads();
    int kro[NQF], vro[NDB];
    { const int q_ = (lane & 15) >> 2, gi_ = (lane >> 4) & 1, p_ = lane & 3;
#pragma unroll
      for (int d0 = 0; d0 < NQF; ++d0) kro[d0] = d0 < 4 ? r32 * 128 + (((2 * d0 + hi) ^ ((r32 >> 1) & 7)) << 4) : 8192 + r32 * 64 + (((2 * (d0 - 4) + hi) ^ ((r32 >> 2) & 3)) << 4);
#pragma unroll
      for (int db = 0; db < NDB; ++db) vro[db] = (2 * hi + (q_ >> 1)) * 256 + (((2 * (q_ & 1) + db + 2 * hi + (q_ >> 1)) & 3) << 6) + 32 * gi_ + 8 * p_; }
    f32x16 o0[NDB], o1[NDB];
#pragma unroll
    for (int i = 0; i < NDB; ++i) { o0[i] = (f32x16){}; o1[i] = (f32x16){}; }
    float m0 = 0.f, l0 = 0.f, m1 = 0.f, l1 = 0.f; bool f0 = true, f1 = true;
    int bc = 0, bn2 = 2;
#pragma nounroll
    for (int t = 0; t < nt; ++t) {
        if (t + 2 < nt) M2_DMA(t + 2, bn2);
        const LAS unsigned char* kb_ = lds + OFF_K + bc * KBUF;
        bf16x8 ka_[NQF], kc_[NQF];
#pragma unroll
        for (int d0 = 0; d0 < NQF; ++d0) { ka_[d0] = *(const LAS bf16x8*)(kb_ + kro[d0]); kc_[d0] = *(const LAS bf16x8*)(kb_ + kro[d0] + (d0 < 4 ? 4096 : 2048)); }
        __builtin_amdgcn_sched_barrier(0);
        f32x16 pa0, pa1, pb0, pb1;
#pragma unroll
        for (int d0 = 0; d0 < NQF; ++d0) {
            if (d0 == 0) { pa0 = __builtin_amdgcn_mfma_f32_32x32x16_bf16(ka_[0], qf[0][0], (f32x16){}, 0, 0, 0); pa1 = __builtin_amdgcn_mfma_f32_32x32x16_bf16(kc_[0], qf[0][0], (f32x16){}, 0, 0, 0);
                           pb0 = __builtin_amdgcn_mfma_f32_32x32x16_bf16(ka_[0], qf[1][0], (f32x16){}, 0, 0, 0); pb1 = __builtin_amdgcn_mfma_f32_32x32x16_bf16(kc_[0], qf[1][0], (f32x16){}, 0, 0, 0); }
            else { pa0 = __builtin_amdgcn_mfma_f32_32x32x16_bf16(ka_[d0], qf[0][d0], pa0, 0, 0, 0); pa1 = __builtin_amdgcn_mfma_f32_32x32x16_bf16(kc_[d0], qf[0][d0], pa1, 0, 0, 0);
                   pb0 = __builtin_amdgcn_mfma_f32_32x32x16_bf16(ka_[d0], qf[1][d0], pb0, 0, 0, 0); pb1 = __builtin_amdgcn_mfma_f32_32x32x16_bf16(kc_[d0], qf[1][d0], pb1, 0, 0, 0); }
        }
        s16x4 vlo_[NDB][4], vhh_[NDB][4];
        { const LAS unsigned char* vb_ = lds + OFF_V + bc * VBUF;
#pragma unroll
          for (int db = 0; db < NDB; ++db)
#pragma unroll
            for (int j = 0; j < 4; ++j) { vlo_[db][j] = tr_read(vb_ + vro[db] + j * VJ); vhh_[db][j] = tr_read(vb_ + vro[db] + j * VJ + VE); } }
        bf16x8 pf0[4], pf1[4];
        att_softmax<NDB>(pa0, pa1, o0, m0, l0, f0, pf0);
        att_softmax<NDB>(pb0, pb1, o1, m1, l1, f1, pf1);
#pragma unroll
        for (int j = 0; j < 4; ++j)
#pragma unroll
            for (int db = 0; db < NDB; ++db) {
                const bf16x8 vf_ = (bf16x8){vlo_[db][j][0], vlo_[db][j][1], vlo_[db][j][2], vlo_[db][j][3], vhh_[db][j][0], vhh_[db][j][1], vhh_[db][j][2], vhh_[db][j][3]};
                o0[db] = __builtin_amdgcn_mfma_f32_32x32x16_bf16(vf_, pf0[j], o0[db], 0, 0, 0);
                o1[db] = __builtin_amdgcn_mfma_f32_32x32x16_bf16(vf_, pf1[j], o1[db], 0, 0, 0);
            }
        asm volatile("s_waitcnt vmcnt(0) lgkmcnt(0)\n\ts_barrier" ::: "memory");
        bc = bc == 2 ? 0 : bc + 1; bn2 = bn2 == 2 ? 0 : bn2 + 1;
    }
    __builtin_amdgcn_s_setprio(0);
#undef M2_DMA
#undef M2_TROW
    l0 += __shfl_xor(l0, 32); l1 += __shfl_xor(l1, 32);
    const float inv0 = 1.f / l0, inv1 = 1.f / l1;
#pragma unroll
    for (int qb = 0; qb < 2; ++qb) {
        const size_t orow = (size_t)(d.qrow0 + 64 * w + 32 * qb + r32) * d.opitch; const float inv = qb ? inv1 : inv0;
#pragma unroll
        for (int db = 0; db < NDB; ++db)
#pragma unroll
            for (int rg = 0; rg < 4; ++rg) { const int dc = 32 * db + 8 * rg + 4 * hi;
                const f32x16& oo = qb ? o1[db] : o0[db];
                *(u32x2*)(d.Ob + orow + dc) = (u32x2){pk2(oo[4 * rg] * inv, oo[4 * rg + 1] * inv), pk2(oo[4 * rg + 2] * inv, oo[4 * rg + 3] * inv)}; }
    }
}


template <int PART>
__device__ __forceinline__ void attn_unit_diff2(const AttnDesc d, LAS unsigned char* lds, bf16_t* xch, unsigned* xcnt) {
    constexpr int NQF = 4, NDB = 4, KBUF = 8192, VBUF = 16384, OFF_K = 0, OFF_V = 3 * KBUF, OFF_Q = OFF_V + 3 * VBUF, VJ = 4096, VE = 2048;
    int tid = threadIdx.x; asm volatile("" : "+v"(tid));
    const int lane = tid & 63, w = __builtin_amdgcn_readfirstlane(tid >> 6), r32 = lane & 31, hi = lane >> 5;
    const unsigned ldsb = (unsigned)(uintptr_t)lds;
#pragma unroll
    for (int i = 0; i < 8; ++i) { const int r = 8 * i + (lane >> 3), c = (lane & 7) ^ ((r >> 1) & 7);
        glds16(d.Q + ((size_t)(d.qrow0 + 64 * w + r) * d.qpitch + c * 8), (unsigned)__builtin_amdgcn_readfirstlane(ldsb + OFF_Q + w * 8192 + i * 1024)); }
    int gko, gvo0, gvo1;
    { const int kr = 8 * w + (lane >> 3), kc = (lane & 7) ^ ((kr >> 1) & 7); gko = kr * d.kpitch + kc * 8;
      const int pos = lane & 15, sp = pos >> 2, sub = pos & 3, r0 = 8 * w + (lane >> 4), r1 = r0 + 4;
      gvo0 = r0 * d.vpitch + ((sp - r0) & 3) * 32 + sub * 8; gvo1 = r1 * d.vpitch + ((sp - r1) & 3) * 32 + sub * 8; }
#define D2_TROW(i) ((i) < d.nlat ? d.lat_row0 + 64 * (i) : d.ctx_row0 + 64 * ((i) - d.nlat))
#define D2_DMA(i, slot) do { const int tr_ = D2_TROW(i); \
        glds16(d.K + ((size_t)tr_ * d.kpitch + gko), (unsigned)__builtin_amdgcn_readfirstlane(ldsb + OFF_K + (slot) * KBUF + w * 1024)); \
        glds16(d.V + ((size_t)tr_ * d.vpitch + gvo0), (unsigned)__builtin_amdgcn_readfirstlane(ldsb + OFF_V + (slot) * VBUF + w * 2048)); \
        glds16(d.V + ((size_t)tr_ * d.vpitch + gvo1), (unsigned)__builtin_amdgcn_readfirstlane(ldsb + OFF_V + (slot) * VBUF + w * 2048 + 1024)); } while (0)
    const int nt = d.ntiles;
    if (w >= 4) __builtin_amdgcn_s_setprio(1);
    D2_DMA(0, 0); if (nt > 1) D2_DMA(1, 1);
    asm volatile("s_waitcnt vmcnt(0)" ::: "memory");
    __syncthreads();
    int kro[NQF], vro[NDB];
    { const int q_ = (lane & 15) >> 2, gi_ = (lane >> 4) & 1, p_ = lane & 3;
#pragma unroll
      for (int d0 = 0; d0 < NQF; ++d0) kro[d0] = r32 * 128 + (((2 * d0 + hi) ^ ((r32 >> 1) & 7)) << 4);
#pragma unroll
      for (int db = 0; db < NDB; ++db) vro[db] = (4 * hi + q_) * 256 + (((db + q_) & 3) << 6) + 32 * gi_ + 8 * p_; }
    f32x16 o0[NDB], o1[NDB];
#pragma unroll
    for (int i = 0; i < NDB; ++i) { o0[i] = (f32x16){}; o1[i] = (f32x16){}; }
    float m0 = 0.f, l0 = 0.f, m1 = 0.f, l1 = 0.f; bool f0 = true, f1 = true;
    int bc = 0, bn2 = 2;
    const LAS unsigned char* qim = lds + OFF_Q + w * 8192;
#pragma nounroll
    for (int t = 0; t < nt; ++t) {
        if (t + 2 < nt) D2_DMA(t + 2, bn2);
        const LAS unsigned char* kb_ = lds + OFF_K + bc * KBUF;
        f32x16 pa0, pa1, pb0, pb1;
#pragma unroll
        for (int dh = 0; dh < NQF; dh += 2) {
            bf16x8 ka[2], kc[2], qa[2], qb[2];
#pragma unroll
            for (int e = 0; e < 2; ++e) { ka[e] = *(const LAS bf16x8*)(kb_ + kro[dh + e]); kc[e] = *(const LAS bf16x8*)(kb_ + kro[dh + e] + 4096);
                                          qa[e] = *(const LAS bf16x8*)(qim + kro[dh + e]); qb[e] = *(const LAS bf16x8*)(qim + kro[dh + e] + 4096); }
            __builtin_amdgcn_sched_barrier(0);
#pragma unroll
            for (int e = 0; e < 2; ++e) {
                if (dh + e == 0) { pa0 = __builtin_amdgcn_mfma_f32_32x32x16_bf16(ka[e], qa[e], (f32x16){}, 0, 0, 0); pa1 = __builtin_amdgcn_mfma_f32_32x32x16_bf16(kc[e], qa[e], (f32x16){}, 0, 0, 0);
                                   pb0 = __builtin_amdgcn_mfma_f32_32x32x16_bf16(ka[e], qb[e], (f32x16){}, 0, 0, 0); pb1 = __builtin_amdgcn_mfma_f32_32x32x16_bf16(kc[e], qb[e], (f32x16){}, 0, 0, 0); }
                else { pa0 = __builtin_amdgcn_mfma_f32_32x32x16_bf16(ka[e], qa[e], pa0, 0, 0, 0); pa1 = __builtin_amdgcn_mfma_f32_32x32x16_bf16(kc[e], qa[e], pa1, 0, 0, 0);
                       pb0 = __builtin_amdgcn_mfma_f32_32x32x16_bf16(ka[e], qb[e], pb0, 0, 0, 0); pb1 = __builtin_amdgcn_mfma_f32_32x32x16_bf16(kc[e], qb[e], pb1, 0, 0, 0); }
            }
        }
        bf16x8 pf0[4], pf1[4];
        att_softmax<NDB>(pa0, pa1, o0, m0, l0, f0, pf0);
        att_softmax<NDB>(pb0, pb1, o1, m1, l1, f1, pf1);
        { const LAS unsigned char* vb_ = lds + OFF_V + bc * VBUF;
#pragma unroll
          for (int j = 0; j < 4; ++j)
#pragma unroll
            for (int db = 0; db < NDB; ++db) {
                const s16x4 lo_ = tr_read(vb_ + vro[db] + j * VJ), hh_ = tr_read(vb_ + vro[db] + j * VJ + VE);
                const bf16x8 vf_ = (bf16x8){lo_[0], lo_[1], lo_[2], lo_[3], hh_[0], hh_[1], hh_[2], hh_[3]};
                o0[db] = __builtin_amdgcn_mfma_f32_32x32x16_bf16(vf_, pf0[j], o0[db], 0, 0, 0);
                o1[db] = __builtin_amdgcn_mfma_f32_32x32x16_bf16(vf_, pf1[j], o1[db], 0, 0, 0);
            } }
        asm volatile("s_waitcnt vmcnt(0) lgkmcnt(0)\n\ts_barrier" ::: "memory");
        bc = bc == 2 ? 0 : bc + 1; bn2 = bn2 == 2 ? 0 : bn2 + 1;
    }
    __builtin_amdgcn_s_setprio(0);
#undef D2_DMA
#undef D2_TROW
    l0 += __shfl_xor(l0, 32); l1 += __shfl_xor(l1, 32);
    const float inv0 = 1.f / l0, inv1 = 1.f / l1;
    if (PART == 0) {
#pragma unroll
        for (int qb = 0; qb < 2; ++qb) { const size_t xrow = (size_t)(d.qrow0 + 64 * w + 32 * qb + r32) * 128; const float inv = qb ? inv1 : inv0;
#pragma unroll
            for (int db = 0; db < NDB; ++db)
#pragma unroll
                for (int rg = 0; rg < 4; ++rg) { const f32x16& oo = qb ? o1[db] : o0[db];
                    const unsigned long long v = (unsigned long long)pk2(oo[4 * rg] * inv, oo[4 * rg + 1] * inv) | ((unsigned long long)pk2(oo[4 * rg + 2] * inv, oo[4 * rg + 3] * inv) << 32);
                    __hip_atomic_store((unsigned long long*)(xch + xrow + 32 * db + 8 * rg + 4 * hi), v, __ATOMIC_RELAXED, __HIP_MEMORY_SCOPE_AGENT); } }
        asm volatile("s_waitcnt vmcnt(0)" ::: "memory"); __syncthreads();
        if (threadIdx.x == 0) __hip_atomic_fetch_add(xcnt, 1u, __ATOMIC_RELAXED, __HIP_MEMORY_SCOPE_AGENT);
    } else {
        if (threadIdx.x == 0) { unsigned sp = 0;
            while (__hip_atomic_load(xcnt, __ATOMIC_RELAXED, __HIP_MEMORY_SCOPE_AGENT) < 1u) { __builtin_amdgcn_s_sleep(2); if (++sp > (1u << 24)) break; }
            __builtin_amdgcn_fence(__ATOMIC_ACQUIRE, "agent"); asm volatile("s_waitcnt vmcnt(0)" ::: "memory"); }
        __syncthreads();
#pragma unroll
        for (int qb = 0; qb < 2; ++qb) {
            const int row = d.qrow0 + 64 * w + 32 * qb + r32; const size_t xrow = (size_t)row * 128; const float li = d.lam * (qb ? inv1 : inv0);
            float c[NDB][16]; float ss = 0.f;
#pragma unroll
            for (int db = 0; db < NDB; ++db)
#pragma unroll
                for (int rg = 0; rg < 4; ++rg) { const f32x16& oo = qb ? o1[db] : o0[db];
                    const unsigned long long st = __hip_atomic_load((unsigned long long*)(xch + xrow + 32 * db + 8 * rg + 4 * hi), __ATOMIC_RELAXED, __HIP_MEMORY_SCOPE_AGENT);
                    const unsigned s0 = (unsigned)st, s1 = (unsigned)(st >> 32);
                    const float a = __uint_as_float(s0 << 16) - li * oo[4 * rg], b = __uint_as_float(s0 & 0xffff0000u) - li * oo[4 * rg + 1];
                    const float e = __uint_as_float(s1 << 16) - li * oo[4 * rg + 2], g = __uint_as_float(s1 & 0xffff0000u) - li * oo[4 * rg + 3];
                    c[db][4 * rg] = a; c[db][4 * rg + 1] = b; c[db][4 * rg + 2] = e; c[db][4 * rg + 3] = g; ss += (a * a + b * b) + (e * e + g * g); }
            ss += __shfl_xor(ss, 32);
            const float rs = (1.f - LAMBDA_INIT) / sqrtf(ss * (1.f / 128.f) + 1e-6f);
            const size_t orow = (size_t)row * d.opitch;
#pragma unroll
            for (int db = 0; db < NDB; ++db)
#pragma unroll
                for (int rg = 0; rg < 4; ++rg) { const int dc = 32 * db + 8 * rg + 4 * hi; const f32x4 gg = *(const f32x4*)(d.subg + dc);
                    *(u32x2*)(d.Ob + orow + dc) = (u32x2){pk2(c[db][4 * rg] * rs * gg[0], c[db][4 * rg + 1] * rs * gg[1]), pk2(c[db][4 * rg + 2] * rs * gg[2], c[db][4 * rg + 3] * rs * gg[3])}; }
        }
    }
}

__device__ __forceinline__ void p0_item(const float* W, int K, int N, bf16_t* WT, int mode, const float* ksc, LAS float* scr, int item, int lane) {
    const int nblk = N / 32, kb = item / nblk, nb = item % nblk, k0 = 64 * kb, n0 = 32 * nb;
#pragma unroll 8
    for (int i = 0; i < 32; ++i) { const int kk = 2 * i + (lane >> 5); float v = W[(size_t)(k0 + kk) * N + n0 + (lane & 31)]; if (ksc) v *= ksc[k0 + kk]; scr[kk * 33 + (lane & 31)] = v; }
    asm volatile("s_waitcnt lgkmcnt(0)" ::: "memory");
    int nd0 = n0;
    if (mode == 1) { nd0 = (n0 < FH) ? (n0 / 128) * 256 + (n0 % 128) : ((n0 - FH) / 128) * 256 + 128 + ((n0 - FH) % 128); }
    else if (mode == 2) { nd0 = (n0 < 672) ? n0 : n0 + 96; }
    const int c = lane & 7;
#pragma unroll
    for (int j = 0; j < 4; ++j) { const int n = (lane >> 3) + 8 * j; const LAS float* s = scr + (8 * c) * 33 + n;
        u32x4 o; o.x = pk2(s[0 * 33], s[1 * 33]); o.y = pk2(s[2 * 33], s[3 * 33]); o.z = pk2(s[4 * 33], s[5 * 33]); o.w = pk2(s[6 * 33], s[7 * 33]);
        *(u32x4*)(WT + (size_t)(nd0 + n) * K + k0 + 8 * c) = o; }
    asm volatile("s_waitcnt lgkmcnt(0)" ::: "memory");
}
__device__ __forceinline__ void sincos_small(float af, float& s, float& c) {
    const double a = (double)af; const double k = rint(a * 0.6366197723675814); const double r = a - k * 1.5707963267948966;
    const double r2 = r * r;
    const double sp = r * (1.0 + r2 * (-1.0 / 6 + r2 * (1.0 / 120 + r2 * (-1.0 / 5040 + r2 * (1.0 / 362880 + r2 * (-1.0 / 39916800 + r2 * (1.0 / 6227020800.0)))))));
    const double cp = 1.0 + r2 * (-0.5 + r2 * (1.0 / 24 + r2 * (-1.0 / 720 + r2 * (1.0 / 40320 + r2 * (-1.0 / 3628800 + r2 * (1.0 / 479001600.0))))));
    const int q = ((int)k) & 3;
    const double ss = (q == 0) ? sp : (q == 1) ? cp : (q == 2) ? -sp : -cp;
    const double cc = (q == 0) ? cp : (q == 1) ? -sp : (q == 2) ? -cp : sp;
    s = (float)ss; c = (float)cc;
}

#define XB_TMO      128
#define XB_XCNT(j)  (256  + 64 * (j))
#define XB_XSUB(j)  (1280 + 64 * (j))
#define XB_XGEN(j)  (2304 + 64 * (j))
#define XB_TOP      3328
#define XB_TOPGEN   3392
#define XCD_BAR_WORDS 3456
#define XB_SPIN_CAP (1u << 18)

__device__ __forceinline__ unsigned xb_ld(unsigned* p)              { return __hip_atomic_load(p, __ATOMIC_RELAXED, __HIP_MEMORY_SCOPE_AGENT); }
__device__ __forceinline__ unsigned xb_add(unsigned* p, unsigned v) { return __hip_atomic_fetch_add(p, v, __ATOMIC_RELAXED, __HIP_MEMORY_SCOPE_AGENT); }
__device__ __forceinline__ unsigned xb_xcc_id() { return (unsigned)__builtin_amdgcn_s_getreg((3 << 11) | 20) & 0xFu; }
#define XB_SPIN(cond, bar) do { unsigned _sp = 0; while (cond) { __builtin_amdgcn_s_sleep(1); \
    if ((++_sp & 255u) == 0u) { if (xb_ld(&(bar)[XB_TMO])) break; if (_sp > XB_SPIN_CAP) { atomicAdd(&(bar)[XB_TMO], 1u); break; } } } } while (0)

struct XcdBarrier {
    unsigned* bar; unsigned x;
    volatile LAS unsigned* st;
};

__device__ __forceinline__ XcdBarrier xcd_barrier_post(unsigned* bar, volatile LAS unsigned* st) {
    XcdBarrier b; b.bar = bar; b.x = xb_xcc_id(); b.st = st;
    if (threadIdx.x == 0) (void)xb_add(&bar[XB_XCNT(b.x)], 1u);
    return b;
}
__device__ __forceinline__ void xcd_barrier_complete(unsigned* bar, unsigned x, unsigned& nloc, unsigned& nx) {
    const unsigned G = gridDim.x * gridDim.y * gridDim.z;
    unsigned sum, cnt, mine, sp = 0u;
    for (;;) {
        sum = 0u; cnt = 0u; mine = 0u;
#pragma unroll
        for (unsigned j = 0; j < 16; ++j) { const unsigned c = xb_ld(&bar[XB_XCNT(j)]); sum += c; cnt += (c > 0u) ? 1u : 0u; mine = (j == x) ? c : mine; }
        if (sum == G) break;
        __builtin_amdgcn_s_sleep(1);
        if ((++sp & 255u) == 0u) { if (xb_ld(&bar[XB_TMO])) break; if (sp > XB_SPIN_CAP) { atomicAdd(&bar[XB_TMO], 1u); break; } }
    }
    nloc = mine > 0u ? mine : 1u; nx = cnt > 0u ? cnt : 1u;
}

__device__ __forceinline__ void xcd_barrier(const XcdBarrier& b) {
    asm volatile("s_waitcnt vmcnt(0)" ::: "memory");
    __syncthreads();
    if (threadIdx.x == 0) {
        unsigned* bar = b.bar;
        __builtin_amdgcn_s_waitcnt(0);
        unsigned nloc = b.st[0], nx = b.st[1];
        if (nloc == 0u) { xcd_barrier_complete(bar, b.x, nloc, nx); b.st[0] = nloc; b.st[1] = nx; }
        const unsigned old = xb_add(&bar[XB_XSUB(b.x)], 1u);
        const unsigned gen = old / nloc;
        if (old + 1u == (gen + 1u) * nloc) {
            __builtin_amdgcn_fence(__ATOMIC_RELEASE, "agent");
            asm volatile("s_waitcnt vmcnt(0)" ::: "memory");
            const unsigned og = xb_add(&bar[XB_TOP], 1u);
            const unsigned tg = og / nx;
            if (og + 1u == (tg + 1u) * nx) xb_add(&bar[XB_TOPGEN], 1u);
            else XB_SPIN(xb_ld(&bar[XB_TOPGEN]) == tg, bar);
            __builtin_amdgcn_fence(__ATOMIC_ACQUIRE, "agent");
            xb_add(&bar[XB_XGEN(b.x)], 1u);
            asm volatile("s_waitcnt vmcnt(0)" ::: "memory");
        } else {
            XB_SPIN(xb_ld(&bar[XB_XGEN(b.x)]) == gen, bar);
            __builtin_amdgcn_fence(__ATOMIC_ACQUIRE, "agent");
            asm volatile("s_waitcnt vmcnt(0)" ::: "memory");
        }
    }
    __syncthreads();
}

struct Params {
    const float *x, *c, *ctx, *c_ctx, *mod_w, *mod_b, *ln_mix_g, *ln_mix_b, *ln_ffn_g, *ln_ffn_b, *ffn_w_in, *ffn_w_out, *ev_w_in, *ev_w_out,
        *diff_lambda, *diff_subln_g, *na_rpb, *od_w_in, *od_w_out, *mla_q_norm_g, *mla_w_uq, *mla_kv_norm_g, *mla_w_ukv, *gmlp_ln_g, *gmlp_ln_b, *gmlp_ws, *gmlp_b;
    float* out; unsigned char* ws; int lo, hi;
};

__device__ __forceinline__ void ln_rows(float* Z, float* dst, const float* g, const float* b, bf16_t* U, const float* modl, int kmod, int nrows, int gw, int ngw, int lane) {
    for (int row = gw; row < nrows; row += ngw) {
        const f32x4* zr = (const f32x4*)(Z + (size_t)row * DM) + lane;
        f32x4 v[4]; float s = 0.f;
#pragma unroll
        for (int j = 0; j < 4; ++j) { v[j] = zr[64 * j]; s += (v[j][0] + v[j][1]) + (v[j][2] + v[j][3]); }
        const float mean = wave_sum(s) * (1.f / DM); float s2 = 0.f;
#pragma unroll
        for (int j = 0; j < 4; ++j) { v[j] = v[j] - mean; s2 += (v[j][0] * v[j][0] + v[j][1] * v[j][1]) + (v[j][2] * v[j][2] + v[j][3] * v[j][3]); }
        const float rstd = 1.f / sqrtf(wave_sum(s2) * (1.f / DM) + 1e-5f);
        const int set = row < 8192 ? 0 : (row < ML ? 1 : 2);
        const float* mp = modl ? modl + set * 6144 + kmod * 1024 : nullptr;
#pragma unroll
        for (int j = 0; j < 4; ++j) {
            const int col = 256 * j + 4 * lane;
            const f32x4 gg = *(const f32x4*)(g + col), bb = *(const f32x4*)(b + col);
            const f32x4 h = v[j] * rstd * gg + bb;
            *(f32x4*)(dst + (size_t)row * DM + col) = h;
            if (U) { const f32x4 sh = *(const f32x4*)(mp + col), sc = *(const f32x4*)(mp + 1024 + col);
                const f32x4 uu = h * (sc + 1.f) + sh;
                *(u32x2*)(U + (size_t)row * DM + col) = (u32x2){pk2(uu[0], uu[1]), pk2(uu[2], uu[3])}; }
        }
    }
}

typedef const __attribute__((address_space(4))) Params* kparams_t;
__device__ __forceinline__ kparams_t kparams() { kparams_t q = (kparams_t)__builtin_amdgcn_kernarg_segment_ptr(); asm volatile("" : "+s"(q)); return q; }
constexpr int NPHASE = 18;
constexpr int LDS_BYTES = 147456;

__global__ void __launch_bounds__(512) dit_fwd(Params p) {
    extern __shared__ __attribute__((aligned(16))) unsigned char lds_raw[];
    LAS unsigned char* lds = (LAS unsigned char*)lds_raw;
    const int G = gridDim.x, blk = blockIdx.x;
    const int tid = threadIdx.x, lane = tid & 63, wave = __builtin_amdgcn_readfirstlane(tid >> 6);
    const int gw = blk * 8 + wave, ngw = G * 8;
    const int gtid = blk * 512 + tid, ngt = G * 512;
#define Wevin ((bf16_t*)(ws + O_EVIN))
#define Wevout ((bf16_t*)(ws + O_EVOUT))
#define Wffin0 ((bf16_t*)(ws + O_FFIN0))
#define Wffout0 ((bf16_t*)(ws + O_FFOUT0))
#define Wffin1 ((bf16_t*)(ws + O_FFIN1))
#define Wffout1 ((bf16_t*)(ws + O_FFOUT1))
#define Wodin ((bf16_t*)(ws + O_ODIN))
#define Wodout ((bf16_t*)(ws + O_ODOUT))
#define Wuq ((bf16_t*)(ws + O_UQ))
#define Wukv ((bf16_t*)(ws + O_UKV))
#define Gws ((bf16_t*)(ws + O_GWS))
#define mod ((float*)(ws + O_MOD))
#define tab32 ((float*)(ws + O_TAB32))
#define tab16 ((float*)(ws + O_TAB16))
#define P ((bf16_t*)(ws + O_P))
#define H ((float*)(ws + O_H))
#define Hb ((bf16_t*)(ws + O_H))
#define U ((bf16_t*)(ws + O_U))
#define Odiff ((float*)(ws + O_ODIFF))
#define AMIX0 ((bf16_t*)(ws + O_AMIX0))
#define ACT ((bf16_t*)(ws + O_ACT))
#define P1 ((bf16_t*)(ws + O_P1))
#define AMIX1 ((bf16_t*)(ws + O_AMIX1))
#define stats ((float*)(ws + O_STATS))
#define KV1 ((bf16_t*)(ws + O_KV1))
#define Q1 ((bf16_t*)(ws + O_Q1))
#define PHASE_BEGIN kparams_t q = kparams(); unsigned char* ws = q->ws;
    const int lo = p.lo, hi = p.hi;
    volatile LAS unsigned* xst = (volatile LAS unsigned*)(lds + LDS_BYTES - 64);
    if (tid < 2) xst[tid] = 0u;
    __syncthreads();
    XcdBarrier xbar = xcd_barrier_post((unsigned*)(p.ws + O_BAR), xst);
    if (p.hi > 1000) cg::this_grid().sync();
#ifndef PH_MASK
#define PH_MASK 0x3ffff
#endif
#define IN(k) ((((PH_MASK) >> (k)) & 1) && lo <= (k) && (k) < hi)
#define SEAM(k) do { if (hi - lo > 1) xcd_barrier(xbar); } while (0)

    if (IN(0)) { PHASE_BEGIN
        if (blk < 96) {
            LAS float* sl = (LAS float*)lds;
            for (int i = tid; i < 3072; i += 512) { const int set = i >> 10, k = i & 1023; const float cv = set == 0 ? q->c[k] : (set == 1 ? q->c[1024 + k] : q->c_ctx[k]); sl[i] = cv / (1.f + __expf(-cv)); }
            __syncthreads();
            const int layer = blk / 48, chunk = blk % 48;
            const float* W = q->mod_w + (size_t)layer * 1024 * 6144 + chunk * 128 + 2 * lane;
            float a00 = 0.f, a01 = 0.f, a10 = 0.f, a11 = 0.f, a20 = 0.f, a21 = 0.f;
#pragma unroll 16
            for (int k = 128 * wave; k < 128 * wave + 128; ++k) { const f32x2v wv = *(const f32x2v*)(W + (size_t)k * 6144);
                const float s0 = sl[k], s1 = sl[1024 + k], s2 = sl[2048 + k];
                a00 += s0 * wv[0]; a01 += s0 * wv[1]; a10 += s1 * wv[0]; a11 += s1 * wv[1]; a20 += s2 * wv[0]; a21 += s2 * wv[1]; }
            LAS float* red = sl + 3072;
            red[(wave * 3 + 0) * 128 + 2 * lane] = a00; red[(wave * 3 + 0) * 128 + 2 * lane + 1] = a01;
            red[(wave * 3 + 1) * 128 + 2 * lane] = a10; red[(wave * 3 + 1) * 128 + 2 * lane + 1] = a11;
            red[(wave * 3 + 2) * 128 + 2 * lane] = a20; red[(wave * 3 + 2) * 128 + 2 * lane + 1] = a21;
            __syncthreads();
            if (tid < 384) { const int s = tid >> 7, n = tid & 127; float acc = q->mod_b[layer * 6144 + chunk * 128 + n];
#pragma unroll
                for (int w8 = 0; w8 < 8; ++w8) acc += red[(w8 * 3 + s) * 128 + n];
                mod[(layer * 3 + s) * 6144 + chunk * 128 + n] = acc; }
            __syncthreads();
        } else if (blk == 96) {
            for (int i = tid; i < 3072; i += 512) {
                if (i < 2048) { const int pos = i >> 4, f = i & 15; const float inv = exp2f(-(float)f * (13.287712379549449f / 16.f)); float s, c; sincos_small((float)pos * inv, s, c); tab32[2 * i] = c; tab32[2 * i + 1] = s; }
                else { const int j = i - 2048, pos = j >> 3, f = j & 7; const float inv = exp2f(-(float)f * (13.287712379549449f / 8.f)); float s, c; sincos_small((float)pos * inv, s, c); tab16[2 * j] = c; tab16[2 * j + 1] = s; }
            }
        }
        {
            LAS float* scr = (LAS float*)(lds + wave * 16384);
            constexpr int I0 = 16 * 96, I1 = 16 * 32, I2 = 16 * 176, I3 = 44 * 32, I4 = 16 * 53, I5 = 16 * 32, I6 = 6 * 24, I7 = 4 * 32;
            for (int it = gw; it < I0; it += ngw) p0_item(q->ev_w_in, 1024, 3072, Wevin, 0, nullptr, scr, it, lane);
            for (int i = gtid; i < 65536; i += ngt) Gws[i] = (bf16_t)f2bf(q->gmlp_ws[i]);
            for (int i = gtid; i < 96 * 1024 / 2; i += ngt) ((unsigned*)(Wodin + (size_t)672 * 1024))[i] = 0u;
        }
    }
    SEAM(0);
    if (IN(1)) { PHASE_BEGIN
        for (int idx = gtid; idx < MT * 128; idx += ngt) {
            const int row = idx >> 7, c8 = (idx & 127) * 8;
            const float* src = row < ML ? q->x + (size_t)row * DM : q->ctx + (size_t)(row - ML) * DM;
            const int set = row < 8192 ? 0 : (row < ML ? 1 : 2);
            const float* mp = mod + set * 6144;
            const f32x4 v0 = *(const f32x4*)(src + c8), v1 = *(const f32x4*)(src + c8 + 4);
            const f32x4 sh0 = *(const f32x4*)(mp + c8), sh1 = *(const f32x4*)(mp + c8 + 4), sc0 = *(const f32x4*)(mp + 1024 + c8), sc1 = *(const f32x4*)(mp + 1024 + c8 + 4);
            const f32x4 u0 = v0 * (sc0 + 1.f) + sh0, u1 = v1 * (sc1 + 1.f) + sh1;
            *(u32x4*)(U + (size_t)row * DM + c8) = (u32x4){pk2(u0[0], u0[1]), pk2(u0[2], u0[3]), pk2(u1[0], u1[1]), pk2(u1[2], u1[3])};
        }
    }
    SEAM(1);
    if (IN(2)) { PHASE_BEGIN
        pg8::Gemm g{U, Wevin, MT, PW0, 1024, 1024, 1024}; pg8::StaticOrder S; S.init(MT, PW0, G, blk);
        EpiIn0 E{P, tab32};
        pg8::gemm_phase<EpiIn0, pg8::StaticOrder, true, true>(lds, g, S, E);
        if (blk >= 24) {
            LAS float* scr = (LAS float*)(lds + wave * 16384);
            constexpr int I1 = 16 * 32, I2 = 16 * 176, I3 = 44 * 32, I4 = 16 * 53, I5 = 16 * 32, I6 = 6 * 24, I7 = 4 * 32;
            constexpr int NIT = I1 + 2 * I2 + 2 * I3 + I4 + I5 + I6 + I7;
            for (int it = (blk - 24) * 8 + wave; it < NIT; it += (G - 24) * 8) {
                int r = it;
                if (r < I1) { p0_item(q->ev_w_out, 1024, 1024, Wevout, 0, nullptr, scr, r, lane); continue; } r -= I1;
                if (r < I2) { p0_item(q->ffn_w_in, 1024, 5632, Wffin0, 1, nullptr, scr, r, lane); continue; } r -= I2;
                if (r < I2) { p0_item(q->ffn_w_in + (size_t)1024 * 5632, 1024, 5632, Wffin1, 1, nullptr, scr, r, lane); continue; } r -= I2;
                if (r < I3) { p0_item(q->ffn_w_out, 2816, 1024, Wffout0, 0, nullptr, scr, r, lane); continue; } r -= I3;
                if (r < I3) { p0_item(q->ffn_w_out + (size_t)2816 * 1024, 2816, 1024, Wffout1, 0, nullptr, scr, r, lane); continue; } r -= I3;
                if (r < I4) { p0_item(q->od_w_in, 1024, 1696, Wodin, 2, nullptr, scr, r, lane); continue; } r -= I4;
                if (r < I5) { p0_item(q->od_w_out, 1024, 1024, Wodout, 0, nullptr, scr, r, lane); continue; } r -= I5;
                if (r < I6) { p0_item(q->mla_w_uq, 384, 768, Wuq, 0, q->mla_q_norm_g, scr, r, lane); continue; } r -= I6;
                p0_item(q->mla_w_ukv, 256, 1024, Wukv, 0, q->mla_kv_norm_g, scr, r, lane);
            }
        }
    }
    SEAM(2);
    if (IN(3)) { PHASE_BEGIN
        const int xcd = blk & 7, idx = blk >> 3;
        float lam;
        { const float a = q->diff_lambda[lane] * q->diff_lambda[64 + lane], b2 = q->diff_lambda[128 + lane] * q->diff_lambda[192 + lane];
          lam = __expf(wave_sum(a)) - __expf(wave_sum(b2)) + LAMBDA_INIT; }
        {
            const int b = xcd >> 2, h = xcd & 3, part = idx >> 4, qb = idx & 15;
            AttnDesc d{};
            d.qpitch = PW0; d.kpitch = PW0; d.vpitch = PW0; d.V = P + 1024 + h * 128;
            d.Ob = AMIX0 + h * 128; d.opitch = 1024; d.lam = lam; d.subg = q->diff_subln_g;
            d.qrow0 = b * SEQ_ + qb * 512; d.ntiles = 132; d.nlat = 128; d.lat_row0 = b * SEQ_; d.ctx_row0 = ML + b * 256;
            d.Q = P + h * 128 + part * 64; d.K = P + 512 + h * 128 + part * 64;
            bf16_t* xch = (bf16_t*)(ws + O_ODIFF) + (size_t)h * MT * 128;
            unsigned* xcnt = (unsigned*)(ws + O_XCNT) + 64 * ((b * 4 + h) * 16 + qb);
            if (part == 0) attn_unit_diff2<0>(d, lds, xch, xcnt); else attn_unit_diff2<1>(d, lds, xch, xcnt);
        }
        for (int i = 0; i < 2; ++i) {
            const int combo = i * 8 + xcd, rb = idx;
            if (idx >= 32) break;
            const int b = combo >> 3, h = combo & 7;
            int rowlo = 4 * rb - 4; rowlo = rowlo < 0 ? 0 : (rowlo > 120 ? 120 : rowlo);
            int nrt = 128 - rowlo; nrt = nrt > 11 ? 11 : nrt;
            AttnDesc d{};
            d.Q = P + 1536 + h * 64; d.qpitch = PW0; d.K = P + 2048 + h * 64; d.kpitch = PW0; d.V = P + 2560 + h * 64; d.vpitch = PW0;
            d.Of = nullptr; d.Ob = AMIX0 + 512 + h * 64; d.opitch = 1024;
            d.qrow0 = b * SEQ_ + rb * 256; d.ntiles = nrt + 4; d.nlat = nrt; d.lat_row0 = b * SEQ_ + rowlo * 64; d.ctx_row0 = ML + b * 256;
            d.na_rowlo = rowlo; d.na_gr0 = 4 * rb; d.rpb = q->na_rpb + h * 465;
            attn_unit<64, 64, true, 0>(d, lds);
        }
        if (blk < 8) {
            const int b = blk >> 2, h = blk & 3;
            AttnDesc d{};
            d.qpitch = PW0; d.kpitch = PW0; d.vpitch = PW0; d.V = P + 1024 + h * 128;
            d.Ob = AMIX0 + h * 128; d.opitch = 1024; d.lam = lam; d.subg = q->diff_subln_g;
            d.qrow0 = ML + b * 256; d.ntiles = 4; d.nlat = 0; d.lat_row0 = 0; d.ctx_row0 = ML + b * 256;
            d.Q = P + h * 128; d.K = P + 512 + h * 128;
            attn_unit<64, 128, false, 2>(d, lds);
            d.Q = P + h * 128 + 64; d.K = P + 512 + h * 128 + 64;
            attn_unit<64, 128, false, 3>(d, lds);
        } else if (blk >= 16 && blk < 32) {
            const int b = (blk - 16) >> 3, h = (blk - 16) & 7;
            AttnDesc d{};
            d.Q = P + 1536 + h * 64; d.qpitch = PW0; d.K = P + 2048 + h * 64; d.kpitch = PW0; d.V = P + 2560 + h * 64; d.vpitch = PW0;
            d.Ob = AMIX0 + 512 + h * 64; d.opitch = 1024;
            d.qrow0 = ML + b * 256; d.ntiles = 4; d.nlat = 0; d.lat_row0 = 0; d.ctx_row0 = ML + b * 256;
            attn_unit<64, 64, false, 0>(d, lds);
        }
    }
    SEAM(3);
    if (IN(5)) { PHASE_BEGIN
        { pg8::Gemm g{AMIX0, Wevout, ML, 1024, 1024, 1024, 1024}; PanelOrder S; S.init(ML, blk);
          EpiResLN<false, true> E{q->x, q->ctx, mod + 2 * 1024, (unsigned*)(ws + O_CNT), (unsigned long long*)(ws + O_SLOT0), q->ln_mix_g, q->ln_mix_b, H, U, mod, 3, nullptr, nullptr, 0};
          pg8::gemm_phase<EpiResLN<false, true>, PanelOrder, true, true>(lds, g, S, E); }
        { const int part = blk & 3, k0 = part * 256;
          pg8::Gemm g{AMIX0 + k0, Wevout + k0, MT, 1024, 256, 1024, 1024}; TailOrder S{blk};
          EpiResLN<false, true> E{q->x, q->ctx, mod + 2 * 1024, (unsigned*)(ws + O_CNT), (unsigned long long*)(ws + O_SLOT0), q->ln_mix_g, q->ln_mix_b, H, U, mod, 3, (float*)(ws + O_P), (unsigned*)(ws + O_PCNT), part};
          pg8::gemm_phase<EpiResLN<false, true>, TailOrder, true, true>(lds, g, S, E); }
    }
    SEAM(5);
    if (IN(7)) { PHASE_BEGIN
        pg8::Gemm g{U, Wffin0, MT, 5632, 1024, 1024, 1024}; pg8::StaticOrder S; S.init(MT, 5632, G, blk);
        EpiFfn E{ACT};
        pg8::gemm_phase<EpiFfn, pg8::StaticOrder, true, true>(lds, g, S, E);
    }
    SEAM(7);
    if (IN(8)) { PHASE_BEGIN
        { pg8::Gemm g{ACT, Wffout0, ML, 1024, FH, FH, FH}; PanelOrder S; S.init(ML, blk);
          EpiResLN<true, true> E{Hb, Hb + (size_t)ML * DM, mod + 5 * 1024, (unsigned*)(ws + O_CNT) + 66 * 64, (unsigned long long*)(ws + O_SLOT1), q->ln_ffn_g, q->ln_ffn_b, Hb, U, mod + 3 * 6144, 0, nullptr, nullptr, 0};
          pg8::gemm_phase<EpiResLN<true, true>, PanelOrder, true, true>(lds, g, S, E); }
        { const int part = blk & 3, k0 = part < 2 ? part * 768 : 1536 + (part - 2) * 640, kl = part < 2 ? 768 : 640;
          pg8::Gemm g{ACT + k0, Wffout0 + k0, MT, 1024, kl, FH, FH}; TailOrder S{blk};
          EpiResLN<true, true> E{Hb, Hb + (size_t)ML * DM, mod + 5 * 1024, (unsigned*)(ws + O_CNT) + 66 * 64, (unsigned long long*)(ws + O_SLOT1), q->ln_ffn_g, q->ln_ffn_b, Hb, U, mod + 3 * 6144, 0, (float*)(ws + O_SLOT2), (unsigned*)(ws + O_PCNT) + 8 * 64, part};
          pg8::gemm_phase<EpiResLN<true, true>, TailOrder, true, true>(lds, g, S, E); }
    }
    SEAM(8);
    if (IN(10)) { PHASE_BEGIN
        pg8::Gemm g{U, Wodin, MT, PW1, 1024, 1024, 1024}; pg8::StaticOrder S; S.init(MT, PW1, G, blk);
        EpiIn1 E{P1, stats, tab16};
        pg8::gemm_phase<EpiIn1, pg8::StaticOrder, true, true>(lds, g, S, E);
    }
    SEAM(10);
    if (IN(11)) { PHASE_BEGIN
#ifndef NO_Q
        { pg8::Gemm g{P1, Wuq, ML, 768, 384, PW1, 384}; pg8::StaticOrder S; S.init(ML, 768, G, blk);
          EpiQ1 E{Q1, stats, tab16};
          pg8::gemm_phase<EpiQ1, pg8::StaticOrder, true, true>(lds, g, S, E); }
#endif
#ifndef NO_KV
        { pg8::Gemm g{P1 + 384, Wukv, MT, 1024, 256, PW1, 256}; pg8::StaticOrder S; S.init(MT, 1024, G, (blk + 64) & 255);
          EpiKV1 E{KV1, stats};
          pg8::gemm_phase<EpiKV1, pg8::StaticOrder, true, true>(lds, g, S, E); }
#endif
#ifndef NO_GMLP
        const int gm_n = blk >= 192 ? 3 : (blk < 128 ? 2 : 1);
        const int gm_0 = blk >= 192 ? (blk - 192) * 3 : (blk < 128 ? 192 + blk * 2 : 448 + (blk - 128));
        for (int un = gm_0; un < gm_0 + gm_n; ++un) {
            const int chunk = un >> 2, grp = un & 3;
            constexpr int RS = 272;
            LAS unsigned char* wsA = lds; LAS unsigned char* vnT = lds + 128 * RS; LAS float* tst = (LAS float*)(lds + 2 * 128 * RS);
            __syncthreads();
            {
                const int tok = tid >> 2, part = tid & 3; const float* sp = stats + (size_t)(chunk * 128 + tok) * STP + 80 + part * 8;
                float s = sp[0] + sp[2] + sp[4] + sp[6], q = sp[1] + sp[3] + sp[5] + sp[7];
                s += __shfl_xor(s, 1); s += __shfl_xor(s, 2); q += __shfl_xor(q, 1); q += __shfl_xor(q, 2);
                const float mean = s * (1.f / 512.f); const float var = q * (1.f / 512.f) - mean * mean;
                if (part == 0) { tst[2 * tok] = mean; tst[2 * tok + 1] = 1.f / sqrtf(fmaxf(var, 0.f) + 1e-5f); }
            }
#pragma unroll
            for (int i = 0; i < 4; ++i) { const int id = tid + 512 * i, r = id >> 4, ch = id & 15;
                *(LAS u32x4*)(wsA + r * RS + ch * 16) = *(const u32x4*)(Gws + (size_t)grp * 16384 + r * 128 + ch * 8); }
            __syncthreads();
#pragma unroll
            for (int i = 0; i < 4; ++i) { const int id = tid + 512 * i, j = id >> 4, cc = id & 15;
                const u32x4 raw = *(const u32x4*)(P1 + (size_t)(chunk * 128 + j) * PW1 + 1280 + grp * 128 + cc * 8);
                const float mean = tst[2 * j], rstd = tst[2 * j + 1];
                const f32x4 lg0 = *(const f32x4*)(q->gmlp_ln_g + grp * 128 + cc * 8), lg1 = *(const f32x4*)(q->gmlp_ln_g + grp * 128 + cc * 8 + 4);
                const f32x4 lb0 = *(const f32x4*)(q->gmlp_ln_b + grp * 128 + cc * 8), lb1 = *(const f32x4*)(q->gmlp_ln_b + grp * 128 + cc * 8 + 4);
#pragma unroll
                for (int e = 0; e < 8; ++e) { const unsigned wv = raw[e >> 1]; const float x = bf2f((unsigned short)((e & 1) ? (wv >> 16) : (wv & 0xffffu)));
                    const float y = (x - mean) * rstd * (e < 4 ? lg0[e & 3] : lg1[e & 3]) + (e < 4 ? lb0[e & 3] : lb1[e & 3]);
                    *(LAS unsigned short*)(vnT + (cc * 8 + e) * RS + j * 2) = (unsigned short)f2bf(y); } }
            __syncthreads();
            { const int r32 = lane & 31, hh = lane >> 5, ib = wave >> 1;
#pragma unroll
              for (int cbi = 0; cbi < 2; ++cbi) { const int cb = 2 * (wave & 1) + cbi;
                f32x16 dacc = (f32x16){};
#pragma unroll
                for (int ks = 0; ks < 8; ++ks) {
                    const bf16x8 a = *(const LAS bf16x8*)(wsA + (32 * ib + r32) * RS + (16 * ks + 8 * hh) * 2);
                    const bf16x8 bb = *(const LAS bf16x8*)(vnT + (32 * cb + r32) * RS + (16 * ks + 8 * hh) * 2);
                    dacc = __builtin_amdgcn_mfma_f32_32x32x16_bf16(a, bb, dacc, 0, 0, 0); }
                const int c = 32 * cb + r32;
#pragma unroll
                for (int r = 0; r < 16; ++r) { const int i = 32 * ib + (r & 3) + 8 * (r >> 2) + 4 * hh; const int tok = chunk * 128 + i;
                    const float gu = bf2f(P1[(size_t)tok * PW1 + 768 + grp * 128 + c]);
                    const float o = gu * (dacc[r] + q->gmlp_b[grp * 128 + i]);
                    AMIX1[(size_t)tok * 1024 + 512 + grp * 128 + c] = (bf16_t)f2bf(o); } } }
        }
#endif
    }
    SEAM(11);
    if (IN(12)) { PHASE_BEGIN
        const int xcd = blk & 7, idx = blk >> 3;
        {
            const int combo = (idx >> 4) * 8 + xcd, qb = idx & 15;
            const int b = combo >> 3, h = combo & 7;
            AttnDesc d{};
            d.Q = Q1 + h * 96; d.qpitch = 768; d.K = KV1 + h * 128; d.kpitch = 1024; d.K2 = P1 + 640; d.k2pitch = PW1;
            d.V = KV1 + h * 128 + 64; d.vpitch = 1024; d.Ob = AMIX1 + h * 64; d.opitch = 1024;
            d.qrow0 = b * SEQ_ + qb * 512; d.ntiles = 132; d.nlat = 128; d.lat_row0 = b * SEQ_; d.ctx_row0 = ML + b * 256;
            attn_unit_mla2(d, lds);
        }
    }
    SEAM(12);
    if (IN(13)) { PHASE_BEGIN
        pg8::Gemm g{AMIX1, Wodout, ML, 1024, 1024, 1024, 1024}; PanelOrder S; S.init(ML, blk);
        EpiResLN<true, true> E{Hb, Hb + (size_t)ML * DM, mod + 3 * 6144 + 2 * 1024, (unsigned*)(ws + O_CNT) + 2 * 66 * 64, (unsigned long long*)(ws + O_SLOT2), q->ln_mix_g + 1024, q->ln_mix_b + 1024, Hb, U, mod + 3 * 6144, 3, nullptr, nullptr, 0};
        pg8::gemm_phase<EpiResLN<true, true>, PanelOrder, true, true>(lds, g, S, E);
    }
    SEAM(13);
    if (IN(15)) { PHASE_BEGIN
        pg8::Gemm g{U, Wffin1, ML, 5632, 1024, 1024, 1024}; pg8::StaticOrder S; S.init(ML, 5632, G, blk);
        EpiFfn E{ACT};
        pg8::gemm_phase<EpiFfn, pg8::StaticOrder, true, true>(lds, g, S, E);
    }
    SEAM(15);
    if (IN(16)) { PHASE_BEGIN
        pg8::Gemm g{ACT, Wffout1, ML, 1024, FH, FH, FH}; PanelOrder S; S.init(ML, blk);
        EpiResLN<true, false> E{Hb, Hb + (size_t)ML * DM, mod + 3 * 6144 + 5 * 1024, (unsigned*)(ws + O_CNT) + 3 * 66 * 64, (unsigned long long*)(ws + O_SLOT3), q->ln_ffn_g + 1024, q->ln_ffn_b + 1024, q->out, nullptr, nullptr, 0, nullptr, nullptr, 0};
        pg8::gemm_phase<EpiResLN<true, false>, PanelOrder, true, true>(lds, g, S, E);
    }
#undef IN
#undef SEAM
}

#ifndef N_LAUNCH_MODE
#define N_LAUNCH_MODE 1
#endif
extern "C" void kernel_launch(void* const* d_in, const int* in_sizes, int n_in, void* d_out, int out_size, void* d_ws, size_t ws_size, hipStream_t stream) {
    static int grid = 0;
    if (grid == 0) {
        if (n_in != 27 || ws_size < WS_NEED) { fprintf(stderr, "kernel_launch: unexpected inputs (n_in %d, ws %zu)\n", n_in, ws_size); grid = -1; return; }
        int dev = 0, cus = 0, per_cu = 0;
        hipGetDevice(&dev); hipDeviceGetAttribute(&cus, hipDeviceAttributeMultiprocessorCount, dev);
        hipFuncSetAttribute((const void*)dit_fwd, hipFuncAttributeMaxDynamicSharedMemorySize, LDS_BYTES);
        hipOccupancyMaxActiveBlocksPerMultiprocessor(&per_cu, (const void*)dit_fwd, 512, LDS_BYTES);
        (void)hipGetLastError();
        if (per_cu < 1) per_cu = 1;
        grid = cus * per_cu; if (grid > 256) grid = 256;
    }
    if (grid < 0) return;
    if (hipMemsetAsync((char*)d_ws + O_BAR, 0, CTL_BYTES, stream) != hipSuccess) { fprintf(stderr, "memset failed\n"); return; }
    Params p{};
    const float** pp = (const float**)&p;
    for (int i = 0; i < 27; ++i) pp[i] = (const float*)d_in[i];
    p.out = (float*)d_out; p.ws = (unsigned char*)d_ws;
#if N_LAUNCH_MODE == 1
    p.lo = 0; p.hi = NPHASE;
    void* args[] = {&p};
    hipError_t e = hipLaunchCooperativeKernel((const void*)dit_fwd, dim3(grid), dim3(512), args, LDS_BYTES, stream);
    if (e != hipSuccess) fprintf(stderr, "cooperative launch failed: %s (grid %d)\n", hipGetErrorString(e), grid);
#else
    for (int ph = 0; ph < NPHASE; ++ph) { p.lo = ph; p.hi = ph + 1; hipLaunchKernelGGL(dit_fwd, dim3(grid), dim3(512), LDS_BYTES, stream, p); }
#endif
}
```

```cpp
#include <hip/hip_runtime.h>
#include <hip/hip_cooperative_groups.h>
#include <cstdio>
#include <cstdint>
#include <cmath>
namespace cg = cooperative_groups;
namespace pg8 {
#define PG8_LAS __attribute__((address_space(3)))
typedef unsigned short bf16_t;
typedef short bf16x8 __attribute__((ext_vector_type(8)));
typedef float f32x4 __attribute__((ext_vector_type(4)));
typedef unsigned u32x4 __attribute__((ext_vector_type(4)));
typedef float f32x2 __attribute__((ext_vector_type(2)));
constexpr int BM = 256, BK = 64, HALF = 128, HTB = HALF * BK * 2  , STAGE_BYTES = 8 * HTB, NXCD = 8, WGM = 8;

__host__ __device__ __forceinline__ int lds_byte(int r, int c) { const int st = (r >> 4) * 2 + (c >> 5), rr = r & 15, cc = c & 31, ob = rr * 64 + cc * 2; return st * 1024 + (ob ^ (((ob >> 9) & 1) << 5)); }
__host__ __device__ __forceinline__ void stage_rc(int b, int& R, int& C) { const int st = b / 1024, sb = b % 1024, swz = sb ^ (((sb >> 9) & 1) << 5); R = (st >> 1) * 16 + swz / 64; C = (st & 1) * 32 + (swz % 64) / 2; }
__host__ __device__ __forceinline__ int perm32(int rho) { const int n = rho >> 4, i = rho & 15; return 8 * (i >> 2) + 4 * n + (i & 3); }

struct Unit { int pm, pn; };
struct Gemm { const bf16_t* A; const bf16_t* Bt; int M, N, K, lda, ldb; };

struct StaticOrder {
    int nM, nN, nwg, G, c;
    __host__ __device__ void init(int M, int N, int G_, int c_) { nM = M / BM; nN = N / BM; nwg = nM * nN; G = G_; c = c_; }
    __host__ __device__ bool next(int i, Unit& u) const {
        const long L = (long)i * G + c; if (L >= nwg) return false;
        int wgid = (int)L; { const int q = nwg / NXCD, r = nwg % NXCD, xcd = wgid % NXCD, off = wgid / NXCD; wgid = (xcd < r ? xcd * (q + 1) : r * (q + 1) + (xcd - r) * q) + off; }
        const int nig = WGM * nN, gid = wgid / nig, fm = gid * WGM, gsz = (nM - fm) < WGM ? (nM - fm) : WGM;
        u.pm = fm + ((wgid % nig) % gsz); u.pn = (wgid % nig) / gsz; return true;
    }
    __device__ __forceinline__ void a_ready(const Unit&) const {}
    __device__ __forceinline__ void done(const Unit&) const {}
};

__device__ __forceinline__ unsigned cvt_pk_bf16(float lo, float hi) { unsigned r; asm volatile("v_cvt_pk_bf16_f32 %0, %1, %2" : "=v"(r) : "v"(lo), "v"(hi)); return r; }
__device__ __forceinline__ f32x2 gelu_pk(f32x2 v) {
    const f32x2 av = __builtin_elementwise_abs(v), d = av * 0.2316418882f + 1.0f;
    f32x2 t; t.x = __builtin_amdgcn_rcpf(d.x); t.y = __builtin_amdgcn_rcpf(d.y);
    f32x2 q = t * 0.5307027145f + (-0.7265760135f); q = q * t + 0.7107068705f; q = q * t + (-0.142248368f); q = q * t + 0.127414796f; q = q * t;
    const f32x2 s = (v * v) * (-0.72134752044f);
    f32x2 e; e.x = __builtin_amdgcn_exp2f(s.x); e.y = __builtin_amdgcn_exp2f(s.y);
    const f32x2 m = v * (q * e), r = v - m;
    f32x2 o; o.x = v.x < 0.f ? m.x : r.x; o.y = v.y < 0.f ? m.y : r.y; return o;
}
template <class Epi, class Sched, bool ALIGN_EPI = false, bool SP2 = false>
__device__ __forceinline__ void gemm_phase(PG8_LAS unsigned char* lds, const Gemm g, const Sched& S, const Epi& E) {
    int tid = threadIdx.x; asm volatile("" : "+v"(tid));
    const int wid = __builtin_amdgcn_readfirstlane(tid >> 6), lane = tid & 63, wr = wid >> 2, wc = wid & 3, fr = lane & 15, fq = lane >> 4;
    const int K = g.K, nt = K / BK;
    unsigned voffA[2], voffB[2];
#pragma unroll
    for (int i = 0; i < 2; ++i) { int R, C; stage_rc(tid * 16 + i * 8192, R, C); const int Rb = Epi::PERM ? ((R & ~31) + perm32(R & 31)) : R;
        voffA[i] = (unsigned)(R * g.lda + C) * 2u; voffB[i] = (unsigned)(Rb * g.ldb + C) * 2u; }
    const size_t kstep = (size_t)(BK * 2);
    const size_t hstep = (size_t)HALF * g.ldb * 2;
    const size_t tstep = 2 * hstep; const size_t hstepA = (size_t)HALF * g.lda * 2, tstepA = 2 * hstepA;
    const unsigned ldsw = (unsigned)wid * 1024u;
    const int aoff = lds_byte(wr * 64 + fr, fq * 8), boff = lds_byte(wc * 32 + fr, fq * 8);
#define PG8_SA(b, h) (((b) * 2 + (h)) * HTB)
#define PG8_SB(b, h) ((4 + (b) * 2 + (h)) * HTB)
#define PG8_STAGE(bufoff, gbase, voff) do { _Pragma("unroll") for (int _i = 0; _i < 2; ++_i) \
        __builtin_amdgcn_global_load_lds((const unsigned*)((const char*)(gbase) + (voff)[_i]), (PG8_LAS unsigned*)(lds + (bufoff) + ldsw + _i * 8192), 16, 0, 0); } while (0)
#define PG8_LDA(dst, b, h) do { _Pragma("unroll") for (int m = 0; m < 4; ++m) _Pragma("unroll") for (int k = 0; k < 2; ++k) dst[m][k] = *(const PG8_LAS bf16x8*)(lds + PG8_SA(b, h) + aoff + m * 2048 + k * 1024); } while (0)
#define PG8_LDB(dst, b, h) do { _Pragma("unroll") for (int n = 0; n < 2; ++n) _Pragma("unroll") for (int k = 0; k < 2; ++k) dst[n][k] = *(const PG8_LAS bf16x8*)(lds + PG8_SB(b, h) + boff + n * 2048 + k * 1024); } while (0)
#define PG8_MMA(ai, bj, At, Bt) do { __builtin_amdgcn_s_setprio(1); _Pragma("unroll") for (int m = 0; m < 4; ++m) _Pragma("unroll") for (int n = 0; n < 2; ++n) _Pragma("unroll") for (int k = 0; k < 2; ++k) \
        acc[ai][bj][m][n] = __builtin_amdgcn_mfma_f32_16x16x32_bf16(Bt[n][k], At[m][k], acc[ai][bj][m][n], 0, 0, 0); __builtin_amdgcn_s_setprio(0); } while (0)
#define PG8_WAIT_V(n) asm volatile("s_waitcnt vmcnt(" #n ")" ::: "memory")
#define PG8_WAIT_L(n) asm volatile("s_waitcnt lgkmcnt(" #n ")" ::: "memory")
#define PG8_BAR __builtin_amdgcn_s_barrier()
#define PG8_SCHED __builtin_amdgcn_sched_barrier(0)
    Unit cur, nxt; int ui = 0;
    if (!S.next(0, cur)) return;
    f32x4 acc[2][2][4][2];
#pragma unroll
    for (int a = 0; a < 2; ++a)
#pragma unroll
        for (int b = 0; b < 2; ++b)
#pragma unroll
            for (int m = 0; m < 4; ++m)
#pragma unroll
                for (int n = 0; n < 2; ++n) acc[a][b][m][n] = (f32x4){0.f, 0.f, 0.f, 0.f};
    bf16x8 At[4][2], B0[2][2], B1[2][2];
    const char* cA = (const char*)g.A + (size_t)cur.pm * tstepA; const char* cB = (const char*)g.Bt + (size_t)cur.pn * tstep;
    S.a_ready(cur);
    if constexpr (SP2) {
        PG8_STAGE(PG8_SB(0, 0), cB, voffB); PG8_STAGE(PG8_SB(0, 1), cB + hstep, voffB); PG8_STAGE(PG8_SA(0, 0), cA, voffA); PG8_STAGE(PG8_SA(0, 1), cA + hstepA, voffA);
        if (wr == 1) PG8_BAR;
        PG8_WAIT_V(2); PG8_BAR;
        PG8_STAGE(PG8_SB(1, 0), cB + kstep, voffB); PG8_STAGE(PG8_SA(1, 0), cA + kstep, voffA); PG8_STAGE(PG8_SB(1, 1), cB + hstep + kstep, voffB);
        PG8_WAIT_V(6); PG8_BAR;
    } else {
        PG8_STAGE(PG8_SB(0, 0), cB, voffB); PG8_STAGE(PG8_SA(0, 0), cA, voffA); PG8_STAGE(PG8_SB(0, 1), cB + hstep, voffB); PG8_STAGE(PG8_SA(0, 1), cA + hstepA, voffA);
        if (wr == 1) PG8_BAR;
        PG8_WAIT_V(4); PG8_BAR;
        PG8_STAGE(PG8_SB(1, 0), cB + kstep, voffB); PG8_STAGE(PG8_SA(1, 0), cA + kstep, voffA); PG8_STAGE(PG8_SB(1, 1), cB + hstep + kstep, voffB);
        PG8_WAIT_V(6); PG8_BAR;
    }
    for (;;) {
        const bool has_next = S.next(ui + 1, nxt);
        const char* nA = has_next ? (const char*)g.A + (size_t)nxt.pm * tstepA : cA; const char* nB = has_next ? (const char*)g.Bt + (size_t)nxt.pn * tstep : cB;
#pragma nounroll
        for (int t = 0; t < nt; t += 2) {
            const bool last = (t == nt - 2);
            const char* a1 = cA + (size_t)(t + 1) * kstep;
            const char* a2 = last ? nA : cA + (size_t)(t + 2) * kstep; const char* b2 = last ? nB : cB + (size_t)(t + 2) * kstep;
            const char* a3 = a2 + kstep; const char* b3 = b2 + kstep;
            if (last && has_next) S.a_ready(nxt);
            if constexpr (SP2) {
            PG8_LDB(B0, 0, 0); PG8_LDB(B1, 0, 1); PG8_SCHED; PG8_LDA(At, 0, 0); PG8_STAGE(PG8_SA(1, 1), a1 + hstepA, voffA);
            PG8_WAIT_V(8); PG8_WAIT_L(0); PG8_BAR; PG8_MMA(0, 0, At, B0); PG8_MMA(0, 1, At, B1); PG8_BAR; PG8_SCHED;
            PG8_LDA(At, 0, 1); PG8_STAGE(PG8_SB(0, 0), b2, voffB); PG8_STAGE(PG8_SB(0, 1), b2 + hstep, voffB); PG8_STAGE(PG8_SA(0, 0), a2, voffA);
            PG8_WAIT_V(8); PG8_WAIT_L(0); PG8_BAR; PG8_MMA(1, 0, At, B0); PG8_MMA(1, 1, At, B1); PG8_BAR; PG8_SCHED;
            PG8_LDB(B0, 1, 0); PG8_LDB(B1, 1, 1); PG8_SCHED; PG8_LDA(At, 1, 0); PG8_STAGE(PG8_SA(0, 1), a2 + hstepA, voffA);
            PG8_WAIT_V(8); PG8_WAIT_L(0); PG8_BAR; PG8_MMA(0, 0, At, B0); PG8_MMA(0, 1, At, B1); PG8_BAR; PG8_SCHED;
            PG8_LDA(At, 1, 1); PG8_STAGE(PG8_SB(1, 0), b3, voffB); PG8_STAGE(PG8_SB(1, 1), b3 + hstep, voffB); PG8_STAGE(PG8_SA(1, 0), a3, voffA);
            PG8_WAIT_V(8); PG8_WAIT_L(0); PG8_BAR; PG8_MMA(1, 0, At, B0); PG8_MMA(1, 1, At, B1); PG8_BAR; PG8_SCHED;
            } else {
            PG8_LDB(B0, 0, 0); PG8_SCHED; PG8_LDA(At, 0, 0); PG8_STAGE(PG8_SA(1, 1), a1 + hstepA, voffA);
            PG8_WAIT_L(8); PG8_BAR; PG8_WAIT_L(0); PG8_MMA(0, 0, At, B0); PG8_BAR; PG8_SCHED;
            PG8_LDB(B1, 0, 1); PG8_STAGE(PG8_SB(0, 0), b2, voffB);
            PG8_BAR; PG8_WAIT_L(0); PG8_MMA(0, 1, At, B1); PG8_BAR;
            PG8_LDA(At, 0, 1); PG8_STAGE(PG8_SA(0, 0), a2, voffA);
            PG8_BAR; PG8_WAIT_L(0); PG8_MMA(1, 0, At, B0); PG8_BAR; PG8_SCHED;
            PG8_STAGE(PG8_SB(0, 1), b2 + hstep, voffB);
            PG8_WAIT_V(6); PG8_BAR; PG8_MMA(1, 1, At, B1); PG8_BAR;
            PG8_LDB(B0, 1, 0); PG8_SCHED; PG8_LDA(At, 1, 0); PG8_STAGE(PG8_SA(0, 1), a2 + hstepA, voffA);
            PG8_WAIT_L(8); PG8_BAR; PG8_WAIT_L(0); PG8_MMA(0, 0, At, B0); PG8_BAR; PG8_SCHED;
            PG8_LDB(B1, 1, 1); PG8_STAGE(PG8_SB(1, 0), b3, voffB);
            PG8_BAR; PG8_WAIT_L(0); PG8_MMA(0, 1, At, B1); PG8_BAR;
            PG8_LDA(At, 1, 1); PG8_STAGE(PG8_SA(1, 0), a3, voffA);
            PG8_BAR; PG8_WAIT_L(0); PG8_MMA(1, 0, At, B0); PG8_BAR; PG8_SCHED;
            PG8_STAGE(PG8_SB(1, 1), b3 + hstep, voffB);
            PG8_WAIT_V(6); PG8_BAR; PG8_MMA(1, 1, At, B1); PG8_BAR;
            }
        }
        if constexpr (ALIGN_EPI) { if (wr == 0) PG8_BAR; }
        if constexpr (!Epi::AFTER_DRAIN) { E(acc, cur, wr, wc, fr, fq); S.done(cur); }
        if (!has_next) break;
#pragma unroll
        for (int a = 0; a < 2; ++a)
#pragma unroll
            for (int b = 0; b < 2; ++b)
#pragma unroll
                for (int m = 0; m < 4; ++m)
#pragma unroll
                    for (int n = 0; n < 2; ++n) acc[a][b][m][n] = (f32x4){0.f, 0.f, 0.f, 0.f};
        cur = nxt; cA = nA; cB = nB; ++ui;
        if constexpr (ALIGN_EPI) { if (wr == 1) PG8_BAR; }
    }
    PG8_WAIT_V(0);
    if constexpr (!ALIGN_EPI) { if (wr == 0) PG8_BAR; }
    PG8_BAR;
    if constexpr (Epi::AFTER_DRAIN) { E.fused(acc, cur, wr, wc, fr, fq, lds, wid, lane); S.done(cur); }
#undef PG8_SA
#undef PG8_SB
#undef PG8_STAGE
#undef PG8_LDA
#undef PG8_LDB
#undef PG8_MMA
#undef PG8_WAIT_V
#undef PG8_WAIT_L
#undef PG8_BAR
#undef PG8_SCHED
}
}

using pg8::bf16_t; using pg8::f32x4; using pg8::u32x4; using pg8::Unit;
#define LAS __attribute__((address_space(3)))
typedef unsigned u32x2 __attribute__((ext_vector_type(2)));
typedef float f32x2v __attribute__((ext_vector_type(2)));
typedef float f32x16 __attribute__((ext_vector_type(16)));
typedef short bf16x8 __attribute__((ext_vector_type(8)));
typedef short s16x4 __attribute__((ext_vector_type(4)));
typedef short v4i16_t __attribute__((ext_vector_type(4)));

constexpr int SEQ_ = 8192, DM = 1024, ML = 16384, MT = 16896, FH = 2816;
constexpr int PW0 = 3072;
constexpr int PW1 = 1792;
constexpr int STP = 112;
constexpr float ALPHA_ = 1.4142135623730951f;
constexpr float LOG2E_ = 1.4426950408889634f;
constexpr float QS64 = 0.125f * 1.4426950408889634f;
constexpr float QS96 = (float)(1.4426950408889634 / 9.797958971132712);
constexpr float LAMBDA_INIT = 0.2f;

constexpr size_t MiB_ = 1u << 20;
constexpr size_t O_EVIN = 0, O_EVOUT = O_EVIN + 6291456, O_FFIN0 = O_EVOUT + 2097152, O_FFOUT0 = O_FFIN0 + 11534336;
constexpr size_t O_FFIN1 = O_FFOUT0 + 5767168, O_FFOUT1 = O_FFIN1 + 11534336, O_ODIN = O_FFOUT1 + 5767168, O_ODOUT = O_ODIN + 3670016;
constexpr size_t O_UQ = O_ODOUT + 2097152, O_UKV = O_UQ + 589824, O_GWS = O_UKV + 524288, O_MOD = O_GWS + 131072, O_TAB32 = O_MOD + 147456, O_TAB16 = O_TAB32 + 16384;
constexpr size_t O_SLOT0 = 48 * MiB_, O_SLOT1 = 51 * MiB_, O_SLOT2 = 145 * MiB_, O_SLOT3 = 148 * MiB_;
static_assert(O_TAB16 + 8192 <= O_SLOT0 && O_SLOT1 + (size_t)16896 * 128 <= 54 * MiB_, "ws map");
constexpr size_t O_Q1 = 0;
static_assert((size_t)ML * 768 * 2 <= O_FFIN1, "Q1 overlay");
constexpr size_t O_P = 54 * MiB_, O_H = 153 * MiB_, O_U = 219 * MiB_, WS_NEED = 253 * MiB_, O_BAR = 252 * MiB_, O_CNT = O_BAR + 16384, O_PCNT = O_CNT + 4 * 66 * 256, O_XCNT = O_PCNT + 2 * 8 * 256, CTL_BYTES = 16384 + 4 * 66 * 256 + 2 * 8 * 256 + 128 * 256;
constexpr size_t O_ODIFF = O_H, O_AMIX0 = O_U, O_ACT = O_P, O_P1 = O_P, O_AMIX1 = 112 * MiB_, O_STATS = 144 * MiB_, O_KV1 = O_U;
static_assert(O_P1 + (size_t)MT * PW1 * 2 <= O_AMIX1 && O_STATS + (size_t)MT * STP * 4 <= O_H, "ws map 2");

__device__ __forceinline__ unsigned f2bf(float f) { unsigned u = __builtin_bit_cast(unsigned, f); return (u + 0x7fffu + ((u >> 16) & 1u)) >> 16; }
typedef __bf16 bf16x2_hw __attribute__((ext_vector_type(2)));
__device__ __forceinline__ unsigned pk2(float lo, float hi) { f32x2v v = {lo, hi}; bf16x2_hw b = __builtin_convertvector(v, bf16x2_hw); return __builtin_bit_cast(unsigned, b); }
__device__ __forceinline__ float bf2f(unsigned short b) { return __builtin_bit_cast(float, (unsigned)b << 16); }
__device__ __forceinline__ float wave_sum(float v) {
#pragma unroll
    for (int o = 1; o < 64; o <<= 1) v += __shfl_xor(v, o);
    return v;
}
__device__ __forceinline__ float gelu_exact(float v) { return 0.5f * v * (1.0f + erff(v * 0.70710678118654752f)); }
__device__ __forceinline__ int modset(int pm) { return pm < 32 ? 0 : (pm < 64 ? 1 : 2); }

struct EpiIn0 {
    static constexpr bool PERM = true, AFTER_DRAIN = false;
    bf16_t* P; const float* tab32;
    __device__ __forceinline__ void operator()(const f32x4 (&acc)[2][2][4][2], const Unit& u, int wr, int wc, int fr, int fq) const {
        asm volatile("" : "+v"(fr), "+v"(fq));
        const int region = u.pn >> 1;
        const bool rope = (region <= 1) && (u.pm < 64);
        const float sc = (region == 0 || region == 3) ? QS64 : 1.f;
        const float sgn = (fq < 2) ? -1.f : 1.f;
#pragma unroll
        for (int ai = 0; ai < 2; ++ai)
#pragma unroll
            for (int m = 0; m < 4; ++m) {
                const int row = u.pm * 256 + ai * 128 + wr * 64 + m * 16 + fr;
                const int t = row & 8191; const int pos = (wc & 1) ? (t & 63) : (t >> 6);
                const float* tb = tab32 + (pos * 16 + 8 * (fq & 1)) * 2;
#pragma unroll
                for (int bj = 0; bj < 2; ++bj) {
                    const int col = u.pn * 256 + bj * 128 + wc * 32 + 8 * fq;
                    float v[8];
#pragma unroll
                    for (int i = 0; i < 4; ++i) { v[i] = acc[ai][bj][m][0][i]; v[4 + i] = acc[ai][bj][m][1][i]; }
                    if (rope) {
                        const f32x4 t0 = *(const f32x4*)tb, t1 = *(const f32x4*)(tb + 4), t2 = *(const f32x4*)(tb + 8), t3 = *(const f32x4*)(tb + 12);
                        const float cs[8] = {t0[0], t0[2], t1[0], t1[2], t2[0], t2[2], t3[0], t3[2]};
                        const float sn[8] = {t0[1], t0[3], t1[1], t1[3], t2[1], t2[3], t3[1], t3[3]};
#pragma unroll
                        for (int i = 0; i < 8; ++i) { const float pr = __shfl_xor(v[i], 32); v[i] = v[i] * cs[i] + sgn * pr * sn[i]; }
                    }
                    u32x4 w; w.x = pk2(v[0] * sc, v[1] * sc); w.y = pk2(v[2] * sc, v[3] * sc); w.z = pk2(v[4] * sc, v[5] * sc); w.w = pk2(v[6] * sc, v[7] * sc);
                    *(u32x4*)(P + (size_t)row * PW0 + col) = w;
                }
            }
    }
};
struct EpiRes {
    static constexpr bool PERM = true, AFTER_DRAIN = false;
    const float* hx; const float* hc; float* Z; const float* gate;
    __device__ __forceinline__ void operator()(const f32x4 (&acc)[2][2][4][2], const Unit& u, int wr, int wc, int fr, int fq) const {
        asm volatile("" : "+v"(fr), "+v"(fq));
        const float* gp = gate + modset(u.pm) * 6144;
#pragma unroll
        for (int bj = 0; bj < 2; ++bj) {
            const int col = u.pn * 256 + bj * 128 + wc * 32 + 8 * fq;
            const f32x4 g0 = *(const f32x4*)(gp + col), g1 = *(const f32x4*)(gp + col + 4);
#pragma unroll
            for (int ai = 0; ai < 2; ++ai)
#pragma unroll
                for (int m = 0; m < 4; ++m) {
                    const int row = u.pm * 256 + ai * 128 + wr * 64 + m * 16 + fr;
                    const float* hb = (u.pm < 64) ? hx + (size_t)row * DM : hc + (size_t)(row - ML) * DM;
                    const f32x4 h0 = *(const f32x4*)(hb + col), h1 = *(const f32x4*)(hb + col + 4);
                    const f32x4 z0 = h0 * ALPHA_ + g0 * acc[ai][bj][m][0], z1 = h1 * ALPHA_ + g1 * acc[ai][bj][m][1];
                    float* zp = Z + (size_t)row * DM + col;
                    *(f32x4*)zp = z0; *(f32x4*)(zp + 4) = z1;
                }
        }
    }
};

struct PanelOrder {
    int nP, c;
    __device__ void init(int M, int c_) { nP = M / 256; c = c_; }
    __device__ bool next(int i, Unit& u) const {
        const int rem = nP - 64 * i;
        if (rem >= 64) { const int x = c & 7, j = c >> 3; u.pm = 64 * i + 8 * x + (j & 7); u.pn = j >> 3; return true; }
        if (rem > 0 && c < 4 * rem) { u.pm = 64 * i + (c >> 2); u.pn = c & 3; return true; }
        return false;
    }
    __device__ __forceinline__ void a_ready(const Unit&) const {}
    __device__ __forceinline__ void done(const Unit&) const {}
};
struct TailOrder {
    int c;
    __device__ bool next(int i, Unit& u) const { if (i > 0 || c >= 32) return false; u.pm = 64 + (c >> 4); u.pn = (c >> 2) & 3; return true; }
    __device__ __forceinline__ void a_ready(const Unit&) const {}
    __device__ __forceinline__ void done(const Unit&) const {}
};
template <bool HIN16, bool HOUT16>
struct EpiResLN {
    static constexpr bool PERM = true, AFTER_DRAIN = false;
    const void* hx; const void* hc; const float* gate;
    unsigned* cnt; unsigned long long* slots; const float* lg; const float* lb; void* dst; bf16_t* U; const float* modl; int kmod;
    float* part_buf; unsigned* part_cnt; int part;
    __device__ __forceinline__ void operator()(const f32x4 (&acc)[2][2][4][2], const Unit& u, int wr, int wc, int fr, int fq) const {
        asm volatile("" : "+v"(fr), "+v"(fq));
        const int set = modset(u.pm);
        const float* gp = gate + set * 6144;
        const int colb = u.pn * 256 + wc * 32 + 8 * fq;
        const int tunit = (u.pm - 64) * 4 + u.pn;
        int tid_ = threadIdx.x; asm volatile("" : "+v"(tid_));
        if (part_buf && part != 0) {
            float* pb = part_buf + ((size_t)(tunit * 3 + part - 1) * 32 * 512 + tid_) * 4;
#pragma unroll
            for (int ai = 0; ai < 2; ++ai)
#pragma unroll
                for (int bj = 0; bj < 2; ++bj)
#pragma unroll
                    for (int m = 0; m < 4; ++m)
#pragma unroll
                        for (int hf = 0; hf < 2; ++hf) {
                            const f32x4 v = acc[ai][bj][m][hf]; float* dp = pb + (size_t)((((ai * 2 + bj) * 4 + m) * 2 + hf) * 512) * 4;
                            asm volatile("global_store_dwordx4 %0, %1, off sc1" :: "v"(dp), "v"(v) : "memory");
                        }
            asm volatile("s_waitcnt vmcnt(0)" ::: "memory"); __builtin_amdgcn_s_barrier(); asm volatile("" ::: "memory");
            if (threadIdx.x == 0) __hip_atomic_fetch_add(part_cnt + 64 * tunit, 1u, __ATOMIC_RELAXED, __HIP_MEMORY_SCOPE_AGENT);
            return;
        }
        if (part_buf) {
            if (threadIdx.x == 0) {
                unsigned sp = 0;
                while (__hip_atomic_load(part_cnt + 64 * tunit, __ATOMIC_RELAXED, __HIP_MEMORY_SCOPE_AGENT) < 3u) { __builtin_amdgcn_s_sleep(1); if (++sp > (1u << 24)) break; }
                __builtin_amdgcn_fence(__ATOMIC_ACQUIRE, "agent"); asm volatile("s_waitcnt vmcnt(0)" ::: "memory");
            }
            asm volatile("s_waitcnt vmcnt(0) lgkmcnt(0)" ::: "memory"); __builtin_amdgcn_s_barrier(); asm volatile("" ::: "memory");
        }
        const float* pb0 = part_buf ? part_buf + ((size_t)(tunit * 3) * 32 * 512 + tid_) * 4 : nullptr;
        f32x4 z[2][4][2][2];
        {
            f32x4 g[2][2];
#pragma unroll
            for (int bj = 0; bj < 2; ++bj) { g[bj][0] = *(const f32x4*)(gp + colb + bj * 128); g[bj][1] = *(const f32x4*)(gp + colb + bj * 128 + 4); }
#pragma unroll
            for (int ai = 0; ai < 2; ++ai)
#pragma unroll
                for (int m = 0; m < 4; ++m) {
                    const int r = ai * 128 + wr * 64 + m * 16 + fr, row = u.pm * 256 + r;
                    const size_t hoff = ((u.pm < 64) ? (size_t)row * DM : (size_t)(row - ML) * DM) + colb;
                    const float* hb = (const float*)((u.pm < 64) ? hx : hc) + hoff;
                    const bf16_t* hb16 = (const bf16_t*)((u.pm < 64) ? hx : hc) + hoff;
                    float s = 0.f, q = 0.f;
#pragma unroll
                    for (int bj = 0; bj < 2; ++bj) {
                        f32x4 h0, h1;
                        if (HIN16) { const u32x4 hw = *(const u32x4*)(hb16 + bj * 128);
                            h0 = (f32x4){__uint_as_float(hw[0] << 16), __uint_as_float(hw[0] & 0xffff0000u), __uint_as_float(hw[1] << 16), __uint_as_float(hw[1] & 0xffff0000u)};
                            h1 = (f32x4){__uint_as_float(hw[2] << 16), __uint_as_float(hw[2] & 0xffff0000u), __uint_as_float(hw[3] << 16), __uint_as_float(hw[3] & 0xffff0000u)}; }
                        else { h0 = *(const f32x4*)(hb + bj * 128); h1 = *(const f32x4*)(hb + bj * 128 + 4); }
                        f32x4 a0 = acc[ai][bj][m][0], a1 = acc[ai][bj][m][1];
                        if (part_buf) {
#pragma unroll
                            for (int pp = 0; pp < 3; ++pp) { const float* pq = pb0 + (size_t)(pp * 32 + ((ai * 2 + bj) * 4 + m) * 2) * 512 * 4;
                                a0 += *(const f32x4*)pq; a1 += *(const f32x4*)(pq + 512 * 4); }
                        }
                        const f32x4 z0 = h0 * ALPHA_ + g[bj][0] * a0, z1 = h1 * ALPHA_ + g[bj][1] * a1;
                        z[ai][m][bj][0] = z0; z[ai][m][bj][1] = z1;
                        s += (z0[0] + z0[1]) + (z0[2] + z0[3]) + (z1[0] + z1[1]) + (z1[2] + z1[3]);
                        q += (z0[0] * z0[0] + z0[1] * z0[1]) + (z0[2] * z0[2] + z0[3] * z0[3]) + (z1[0] * z1[0] + z1[1] * z1[1]) + (z1[2] * z1[2] + z1[3] * z1[3]);
                    }
                    s += __shfl_xor(s, 16); s += __shfl_xor(s, 32); q += __shfl_xor(q, 16); q += __shfl_xor(q, 32);
                    if (fq == 0) __hip_atomic_store(slots + ((size_t)(u.pm * 256 + r) * 16 + u.pn * 4 + wc), ((unsigned long long)__float_as_uint(q) << 32) | __float_as_uint(s), __ATOMIC_RELAXED, __HIP_MEMORY_SCOPE_AGENT);
                    if (m == 3) asm volatile("" ::: "memory");
                }
        }
        asm volatile("s_waitcnt vmcnt(0)" ::: "memory"); __builtin_amdgcn_s_barrier(); asm volatile("" ::: "memory");
        if (threadIdx.x == 0) {
            unsigned* cw = cnt + 64 * u.pm;
            __hip_atomic_fetch_add(cw, 1u, __ATOMIC_RELAXED, __HIP_MEMORY_SCOPE_AGENT);
            unsigned sp = 0;
            while (__hip_atomic_load(cw, __ATOMIC_RELAXED, __HIP_MEMORY_SCOPE_AGENT) < 4u) { __builtin_amdgcn_s_sleep(1); if (++sp > (1u << 24)) break; }
            __builtin_amdgcn_fence(__ATOMIC_ACQUIRE, "agent"); asm volatile("s_waitcnt vmcnt(0)" ::: "memory");
        }
        asm volatile("s_waitcnt vmcnt(0) lgkmcnt(0)" ::: "memory"); __builtin_amdgcn_s_barrier(); asm volatile("" ::: "memory");
        const float* mp = U ? modl + set * 6144 + kmod * 1024 + colb : nullptr;
        f32x4 sv[2][4][2];
#pragma unroll
        for (int ai = 0; ai < 2; ++ai)
#pragma unroll
            for (int m = 0; m < 4; ++m) {
                const int r = ai * 128 + wr * 64 + m * 16 + fr;
                const f32x4* sl = (const f32x4*)(slots + ((size_t)(u.pm * 256 + r) * 16 + fq * 4));
                sv[ai][m][0] = sl[0]; sv[ai][m][1] = sl[1];
            }
        float mean_[2][4], rstd_[2][4];
#pragma unroll
        for (int ai = 0; ai < 2; ++ai)
#pragma unroll
            for (int m = 0; m < 4; ++m) {
                float s = (sv[ai][m][0][0] + sv[ai][m][0][2]) + (sv[ai][m][1][0] + sv[ai][m][1][2]);
                float q = (sv[ai][m][0][1] + sv[ai][m][0][3]) + (sv[ai][m][1][1] + sv[ai][m][1][3]);
                s += __shfl_xor(s, 16); s += __shfl_xor(s, 32); q += __shfl_xor(q, 16); q += __shfl_xor(q, 32);
                const float mean = s * (1.f / DM);
                mean_[ai][m] = mean; rstd_[ai][m] = 1.f / sqrtf(fmaxf(q * (1.f / DM) - mean * mean, 0.f) + 1e-5f);
            }
        asm volatile("" ::: "memory");
#pragma unroll
        for (int bj = 0; bj < 2; ++bj) {
            const int col = colb + bj * 128;
            const f32x4 lg0 = *(const f32x4*)(lg + col), lg1 = *(const f32x4*)(lg + col + 4), lb0 = *(const f32x4*)(lb + col), lb1 = *(const f32x4*)(lb + col + 4);
            f32x4 sh0 = {}, sh1 = {}, sc0 = {}, sc1 = {};
            if (U) { sh0 = *(const f32x4*)(mp + bj * 128); sh1 = *(const f32x4*)(mp + bj * 128 + 4); sc0 = *(const f32x4*)(mp + 1024 + bj * 128) + 1.f; sc1 = *(const f32x4*)(mp + 1024 + bj * 128 + 4) + 1.f; }
#pragma unroll
            for (int ai = 0; ai < 2; ++ai)
#pragma unroll
                for (int m = 0; m < 4; ++m) {
                    const int r = ai * 128 + wr * 64 + m * 16 + fr, row = u.pm * 256 + r;
                    const float mean = mean_[ai][m], rstd = rstd_[ai][m];
                    const f32x4 h0 = (z[ai][m][bj][0] - mean) * rstd * lg0 + lb0, h1 = (z[ai][m][bj][1] - mean) * rstd * lg1 + lb1;
                    if (HOUT16) *(u32x4*)((bf16_t*)dst + (size_t)row * DM + col) = (u32x4){pk2(h0[0], h0[1]), pk2(h0[2], h0[3]), pk2(h1[0], h1[1]), pk2(h1[2], h1[3])};
                    else { float* dp = (float*)dst + (size_t)row * DM + col; *(f32x4*)dp = h0; *(f32x4*)(dp + 4) = h1; }
                    if (U) { const f32x4 u0 = h0 * sc0 + sh0, u1 = h1 * sc1 + sh1;
                        *(u32x4*)(U + (size_t)row * DM + col) = (u32x4){pk2(u0[0], u0[1]), pk2(u0[2], u0[3]), pk2(u1[0], u1[1]), pk2(u1[2], u1[3])}; }
                }
            asm volatile("" ::: "memory");
        }
    }
};
struct EpiFfn {
    static constexpr bool PERM = true, AFTER_DRAIN = false;
    bf16_t* ACT;
    __device__ __forceinline__ void operator()(const f32x4 (&acc)[2][2][4][2], const Unit& u, int wr, int wc, int fr, int fq) const {
        asm volatile("" : "+v"(fr), "+v"(fq));
        const int hcol = u.pn * 128 + wc * 32 + 8 * fq;
#pragma unroll
        for (int ai = 0; ai < 2; ++ai)
#pragma unroll
            for (int m = 0; m < 4; ++m) {
                const int row = u.pm * 256 + ai * 128 + wr * 64 + m * 16 + fr;
                float o[8];
#pragma unroll
                for (int i = 0; i < 8; ++i) { const float g = acc[ai][0][m][i >> 2][i & 3], a = acc[ai][1][m][i >> 2][i & 3]; o[i] = g * __builtin_amdgcn_rcpf(1.f + __builtin_amdgcn_exp2f(-1.4426950408889634f * g)) * a; }
                u32x4 w; w.x = pk2(o[0], o[1]); w.y = pk2(o[2], o[3]); w.z = pk2(o[4], o[5]); w.w = pk2(o[6], o[7]);
                *(u32x4*)(ACT + (size_t)row * FH + hcol) = w;
            }
    }
};
struct EpiIn1 {
    static constexpr bool PERM = true, AFTER_DRAIN = false;
    bf16_t* P1; float* stats; const float* tab16;
    __device__ __forceinline__ void operator()(const f32x4 (&acc)[2][2][4][2], const Unit& u, int wr, int wc, int fr, int fq) const {
        asm volatile("" : "+v"(fr), "+v"(fq));
#pragma unroll
        for (int bj = 0; bj < 2; ++bj) {
            const int col32 = u.pn * 256 + bj * 128 + wc * 32, col = col32 + 8 * fq, grp = col32 >> 5;
            if (col32 >= 672 && col32 < 768) continue;
            const int kind = (col32 < 640) ? 0 : (col32 < 672 ? 1 : (col32 < 1280 ? 2 : 3));
#pragma unroll
            for (int ai = 0; ai < 2; ++ai)
#pragma unroll
                for (int m = 0; m < 4; ++m) {
                    const int row = u.pm * 256 + ai * 128 + wr * 64 + m * 16 + fr;
                    float v[8];
#pragma unroll
                    for (int i = 0; i < 4; ++i) { v[i] = acc[ai][bj][m][0][i]; v[4 + i] = acc[ai][bj][m][1][i]; }
                    if (kind == 1) {
                        if (u.pm < 64) {
                            const int t = row & 8191; const int pos = (fq & 2) ? (t & 63) : (t >> 6);
                            const float* tb = tab16 + pos * 16;
                            const f32x4 t0 = *(const f32x4*)tb, t1 = *(const f32x4*)(tb + 4), t2 = *(const f32x4*)(tb + 8), t3 = *(const f32x4*)(tb + 12);
                            const float cs[8] = {t0[0], t0[2], t1[0], t1[2], t2[0], t2[2], t3[0], t3[2]};
                            const float sn[8] = {t0[1], t0[3], t1[1], t1[3], t2[1], t2[3], t3[1], t3[3]};
                            const float sgn = (fq & 1) ? 1.f : -1.f;
#pragma unroll
                            for (int i = 0; i < 8; ++i) { const float pr = __shfl_xor(v[i], 16); v[i] = v[i] * cs[i] + sgn * pr * sn[i]; }
                        }
                    } else if (kind >= 2) {
#pragma unroll
                        for (int i = 0; i < 8; i += 2) { const pg8::f32x2 gv2 = pg8::gelu_pk((pg8::f32x2){v[i], v[i + 1]}); v[i] = gv2.x; v[i + 1] = gv2.y; }
                    }
                    if (kind == 0 || kind == 3) {
                        float s = 0.f, q = 0.f;
#pragma unroll
                        for (int i = 0; i < 8; ++i) { s += v[i]; q += v[i] * v[i]; }
                        s += __shfl_xor(s, 16); s += __shfl_xor(s, 32); q += __shfl_xor(q, 16); q += __shfl_xor(q, 32);
                        if (fq == 0) *(f32x2v*)(stats + (size_t)row * STP + grp * 2) = (f32x2v){s, q};
                    }
                    u32x4 w; w.x = pk2(v[0], v[1]); w.y = pk2(v[2], v[3]); w.z = pk2(v[4], v[5]); w.w = pk2(v[6], v[7]);
                    *(u32x4*)(P1 + (size_t)row * PW1 + col) = w;
                    asm volatile("" ::: "memory");
                }
        }
    }
};
struct EpiQ1 {
    static constexpr bool PERM = true, AFTER_DRAIN = false;
    bf16_t* Q1; const float* stats; const float* tab16;
    __device__ __forceinline__ void operator()(const f32x4 (&acc)[2][2][4][2], const Unit& u, int wr, int wc, int fr, int fq) const {
        asm volatile("" : "+v"(fr), "+v"(fq));
#pragma unroll
        for (int ai = 0; ai < 2; ++ai)
#pragma unroll
            for (int m = 0; m < 4; ++m) {
                const int row = u.pm * 256 + ai * 128 + wr * 64 + m * 16 + fr;
                const float* sp = stats + (size_t)row * STP + fq * 6;
                float q = sp[1] + sp[3] + sp[5];
                q += __shfl_xor(q, 16); q += __shfl_xor(q, 32);
                const float rs = QS96 / sqrtf(q * (1.f / 384.f) + 1e-6f);
                const int t = row & 8191; const int pos = (fq & 2) ? (t & 63) : (t >> 6);
                const float* tb = tab16 + pos * 16;
                const float sgn = (fq & 1) ? 1.f : -1.f;
#pragma unroll
                for (int bj = 0; bj < 2; ++bj) {
                    const int col32 = u.pn * 256 + bj * 128 + wc * 32, col = col32 + 8 * fq;
                    const bool rope = ((col32 >> 5) % 3) == 2;
                    float v[8];
#pragma unroll
                    for (int i = 0; i < 4; ++i) { v[i] = acc[ai][bj][m][0][i]; v[4 + i] = acc[ai][bj][m][1][i]; }
                    if (rope) {
                        const f32x4 t0 = *(const f32x4*)tb, t1 = *(const f32x4*)(tb + 4), t2 = *(const f32x4*)(tb + 8), t3 = *(const f32x4*)(tb + 12);
                        const float cs[8] = {t0[0], t0[2], t1[0], t1[2], t2[0], t2[2], t3[0], t3[2]};
                        const float sn[8] = {t0[1], t0[3], t1[1], t1[3], t2[1], t2[3], t3[1], t3[3]};
#pragma unroll
                        for (int i = 0; i < 8; ++i) { const float pr = __shfl_xor(v[i], 16); v[i] = v[i] * cs[i] + sgn * pr * sn[i]; }
                    }
                    u32x4 w; w.x = pk2(v[0] * rs, v[1] * rs); w.y = pk2(v[2] * rs, v[3] * rs); w.z = pk2(v[4] * rs, v[5] * rs); w.w = pk2(v[6] * rs, v[7] * rs);
                    *(u32x4*)(Q1 + (size_t)row * 768 + col) = w;
                }
                asm volatile("" ::: "memory");
            }
    }
};
struct EpiKV1 {
    static constexpr bool PERM = true, AFTER_DRAIN = false;
    bf16_t* KV1; const float* stats;
    __device__ __forceinline__ void operator()(const f32x4 (&acc)[2][2][4][2], const Unit& u, int wr, int wc, int fr, int fq) const {
        asm volatile("" : "+v"(fr), "+v"(fq));
#pragma unroll
        for (int ai = 0; ai < 2; ++ai)
#pragma unroll
            for (int m = 0; m < 4; ++m) {
                const int row = u.pm * 256 + ai * 128 + wr * 64 + m * 16 + fr;
                const float* sp = stats + (size_t)row * STP + 24 + fq * 4;
                float q = sp[1] + sp[3];
                q += __shfl_xor(q, 16); q += __shfl_xor(q, 32);
                const float rs = 1.f / sqrtf(q * (1.f / 256.f) + 1e-6f);
#pragma unroll
                for (int bj = 0; bj < 2; ++bj) {
                    const int col = u.pn * 256 + bj * 128 + wc * 32 + 8 * fq;
                    const f32x4 a = acc[ai][bj][m][0] * rs, b = acc[ai][bj][m][1] * rs;
                    u32x4 w; w.x = pk2(a[0], a[1]); w.y = pk2(a[2], a[3]); w.z = pk2(b[0], b[1]); w.w = pk2(b[2], b[3]);
                    *(u32x4*)(KV1 + (size_t)row * 1024 + col) = w;
                }
                asm volatile("" ::: "memory");
            }
    }
};

struct AttnDesc {
    const bf16_t* Q; int qpitch;
    const bf16_t* K; int kpitch;
    const bf16_t* K2; int k2pitch;
    const bf16_t* V; int vpitch;
    float* Of; bf16_t* Ob; int opitch;
    int qrow0;
    int ntiles, nlat, lat_row0, ctx_row0;
    int na_rowlo, na_gr0;
    const float* rpb;
    float lam; const float* subg;
};
__device__ __forceinline__ s16x4 tr_read(const LAS unsigned char* p) { return __builtin_bit_cast(s16x4, __builtin_amdgcn_ds_read_tr16_b64_v4i16((LAS v4i16_t*)p)); }


__device__ __forceinline__ void glds16(const void* gsrc, unsigned lds_dst) { unsigned keep;
    asm volatile("s_mov_b32 %0, m0\n\ts_mov_b32 m0, %2\n\ts_nop 0\n\tglobal_load_lds_dwordx4 %1, off\n\ts_mov_b32 m0, %0" : "=&s"(keep) : "v"(gsrc), "s"(lds_dst) : "memory"); }
template <int NDB>
__device__ __forceinline__ void att_softmax(f32x16& p0, f32x16& p1, f32x16 (&o)[NDB], float& mrun, float& lrun, bool& first, bf16x8 (&pf)[4]) {
    float ra = __builtin_fmaxf(__builtin_fmaxf(p0[0], p0[1]), p1[0]), rb = __builtin_fmaxf(__builtin_fmaxf(p0[2], p0[3]), p1[1]);
    ra = __builtin_fmaxf(__builtin_fmaxf(ra, p1[2]), p1[3]);
#pragma unroll
    for (int r = 4; r < 16; r += 4) { ra = __builtin_fmaxf(__builtin_fmaxf(ra, p0[r]), p0[r + 1]); rb = __builtin_fmaxf(__builtin_fmaxf(rb, p0[r + 2]), p0[r + 3]);
        ra = __builtin_fmaxf(__builtin_fmaxf(ra, p1[r]), p1[r + 1]); rb = __builtin_fmaxf(__builtin_fmaxf(rb, p1[r + 2]), p1[r + 3]); }
    float rm = __builtin_fmaxf(ra, rb);
    { auto rr = __builtin_amdgcn_permlane32_swap(__float_as_uint(rm), __float_as_uint(rm), false, false); rm = __builtin_fmaxf(__uint_as_float(rr[0]), __uint_as_float(rr[1])); }
    if (first || __any(rm > mrun + 8.f)) {
        const float mn = first ? rm : __builtin_fmaxf(mrun, rm);
        if (!first) { const float al = __builtin_amdgcn_exp2f(mrun - mn); lrun *= al;
#pragma unroll
            for (int i = 0; i < NDB; ++i) o[i] *= al; }
        mrun = mn; first = false;
    }
    float ls = 0.f;
#pragma unroll
    for (int r = 0; r < 16; ++r) { p0[r] = __builtin_amdgcn_exp2f(p0[r] - mrun); p1[r] = __builtin_amdgcn_exp2f(p1[r] - mrun); ls += p0[r] + p1[r]; }
    lrun += ls;
#pragma unroll
    for (int j = 0; j < 4; ++j) {
        u32x4 pw;
#pragma unroll
        for (int e = 0; e < 4; ++e) { const int r = 8 * (j & 1) + 2 * e; pw[e] = (j < 2) ? pk2(p0[r], p0[r + 1]) : pk2(p1[r], p1[r + 1]); }
        pf[j] = __builtin_bit_cast(bf16x8, pw);
    }
}
template <int NDB, int VS>
__device__ __forceinline__ void att_pv(f32x16 (&o)[NDB], const bf16x8 (&pf)[4], const LAS unsigned char* vb) {
#pragma unroll
    for (int j = 0; j < 4; ++j)
#pragma unroll
        for (int db = 0; db < NDB; ++db) {
            const s16x4 lo = tr_read(vb + (16 * j) * VS + db * 64), hh = tr_read(vb + (16 * j + 8) * VS + db * 64);
            const bf16x8 vf = (bf16x8){lo[0], lo[1], lo[2], lo[3], hh[0], hh[1], hh[2], hh[3]};
            o[db] = __builtin_amdgcn_mfma_f32_32x32x16_bf16(vf, pf[j], o[db], 0, 0, 0);
        }
}
template <int DQ, int DV, bool NA, int OMODE>
__device__ __forceinline__ void attn_unit(const AttnDesc d, LAS unsigned char* lds) {
    constexpr int KS = DQ * 2 + 16, VS = DV * 2 + 64;
    constexpr int KBUF = NA ? 64 * KS : (8192 + (DQ == 96 ? 4096 : 0)), VBUF = NA ? 64 * VS : 64 * DV * 2;
    constexpr int NBUF = NA ? 2 : 3;
    constexpr int OFF_K = 0, OFF_V = NBUF * KBUF, OFF_RPB = OFF_V + NBUF * VBUF;
    constexpr int NQF = DQ / 16, NDB = DV / 32;
    int tid = threadIdx.x; asm volatile("" : "+v"(tid));
    const int lane = tid & 63, w = __builtin_amdgcn_readfirstlane(tid >> 6), r32 = lane & 31, hi = lane >> 5;
    if (w >= 4) __builtin_amdgcn_s_setprio(1);
    bf16x8 qf[NQF];
    { const bf16_t* qp = d.Q + (size_t)(d.qrow0 + 32 * w + r32) * d.qpitch + 8 * hi;
#pragma unroll
      for (int d0 = 0; d0 < NQF; ++d0) qf[d0] = *(const bf16x8*)(qp + 16 * d0); }
    LAS float* rpbL = (LAS float*)(lds + OFF_RPB);
    if (NA) { for (int i = tid; i < 465; i += 512) rpbL[i] = d.rpb[i] * LOG2E_; }
    const int kkey = tid >> 3, kch = tid & 7;
    const int k2key = tid >> 2, k2ch = tid & 3;
    u32x4 kA, kB, vA, vB;
#define ATT_TROW(i) ((i) < d.nlat ? d.lat_row0 + 64 * (i) : d.ctx_row0 + 64 * ((i) - d.nlat))
#define ATT_LOAD(i) do { const int tr_ = ATT_TROW(i); \
        kA = *(const u32x4*)(d.K + (size_t)(tr_ + kkey) * d.kpitch + kch * 8); \
        if (DQ == 96) { if (tid < 256) kB = *(const u32x4*)(d.K2 + (size_t)(tr_ + k2key) * d.k2pitch + k2ch * 8); } \
        if (DV == 128) { vA = *(const u32x4*)(d.V + (size_t)(tr_ + (tid >> 4)) * d.vpitch + (tid & 15) * 8); vB = *(const u32x4*)(d.V + (size_t)(tr_ + 32 + (tid >> 4)) * d.vpitch + (tid & 15) * 8); } \
        else { vA = *(const u32x4*)(d.V + (size_t)(tr_ + kkey) * d.vpitch + kch * 8); } } while (0)
#define ATT_STORE(b) do { \
        *(LAS u32x4*)(lds + OFF_K + (b) * KBUF + kkey * KS + kch * 16) = kA; \
        if (DQ == 96) { if (tid < 256) *(LAS u32x4*)(lds + OFF_K + (b) * KBUF + k2key * KS + 128 + k2ch * 16) = kB; } \
        if (DV == 128) { *(LAS u32x4*)(lds + OFF_V + (b) * VBUF + (tid >> 4) * VS + (tid & 15) * 16) = vA; *(LAS u32x4*)(lds + OFF_V + (b) * VBUF + (32 + (tid >> 4)) * VS + (tid & 15) * 16) = vB; } \
        else { *(LAS u32x4*)(lds + OFF_V + (b) * VBUF + kkey * VS + kch * 16) = vA; } } while (0)
    const int nt = d.ntiles;
    const unsigned ldsb = (unsigned)(uintptr_t)lds;
    int gko, gk2o = 0, gvo0, gvo1 = 0;
    { const int kr = 8 * w + (lane >> 3), kc = (lane & 7) ^ ((kr >> 1) & 7); gko = kr * d.kpitch + kc * 8;
      if (DQ == 96) { const int rr = 16 * (w & 3) + (lane >> 2), rc = (lane & 3) ^ ((rr >> 2) & 3); gk2o = rr * d.k2pitch + rc * 8; }
      if (DV == 128) { const int pos = lane & 15, sp = pos >> 2, sub = pos & 3;
          const int r0 = 8 * w + (lane >> 4), r1 = r0 + 4;
          gvo0 = r0 * d.vpitch + ((sp - r0) & 3) * 32 + sub * 8; gvo1 = r1 * d.vpitch + ((sp - r1) & 3) * 32 + sub * 8; }
      else { const int sr = 4 * w + (lane >> 4), pos = lane & 15, sp = pos >> 2, sub = pos & 3, x = (sp - sr) & 3;
          gvo0 = (2 * sr + (x >> 1)) * d.vpitch + (x & 1) * 32 + sub * 8; } }
#define ATT_DMA(i, slot) do { const int tr_ = ATT_TROW(i); \
        glds16(d.K + ((size_t)tr_ * d.kpitch + gko), (unsigned)__builtin_amdgcn_readfirstlane(ldsb + OFF_K + (slot) * KBUF + w * 1024)); \
        if (DQ == 96) { if (w < 4) glds16(d.K2 + ((size_t)tr_ * d.k2pitch + gk2o), (unsigned)__builtin_amdgcn_readfirstlane(ldsb + OFF_K + (slot) * KBUF + 8192 + w * 1024)); } \
        if (DV == 128) { glds16(d.V + ((size_t)tr_ * d.vpitch + gvo0), (unsigned)__builtin_amdgcn_readfirstlane(ldsb + OFF_V + (slot) * VBUF + w * 2048)); \
                         glds16(d.V + ((size_t)tr_ * d.vpitch + gvo1), (unsigned)__builtin_amdgcn_readfirstlane(ldsb + OFF_V + (slot) * VBUF + w * 2048 + 1024)); } \
        else glds16(d.V + ((size_t)tr_ * d.vpitch + gvo0), (unsigned)__builtin_amdgcn_readfirstlane(ldsb + OFF_V + (slot) * VBUF + w * 1024)); } while (0)
    if (NA) { ATT_LOAD(0); ATT_STORE(0); }
    else { ATT_DMA(0, 0); if (nt > 1) ATT_DMA(1, 1); asm volatile("s_waitcnt vmcnt(0)" ::: "memory"); }
    __syncthreads();
    f32x16 o[NDB];
#pragma unroll
    for (int i = 0; i < NDB; ++i) o[i] = (f32x16){};
    float mrun = 0.f, lrun = 0.f; bool first = true;
    const int gr = d.na_gr0 + (w >> 1);
    const int rs_ = gr - 4 < 0 ? 0 : (gr - 4 > 120 ? 120 : gr - 4);
    const int qc = 32 * (w & 1) + r32;
    const int cs_ = qc - 8 < 0 ? 0 : (qc - 8 > 48 ? 48 : qc - 8);
    unsigned namask0 = 0u, namask1 = 0u;
    if (NA) {
#pragma unroll
        for (int r = 0; r < 16; ++r) { const int kc0 = (r & 3) + 8 * (r >> 2) + 4 * hi, kc1 = kc0 + 32;
            namask0 |= (kc0 >= cs_ && kc0 < cs_ + 16) ? (1u << r) : 0u; namask1 |= (kc1 >= cs_ && kc1 < cs_ + 16) ? (1u << r) : 0u; }
    }
    const int koffr = r32 * KS + hi * 16;
    const int voffr = (4 * hi + ((lane & 15) >> 2)) * VS + ((lane >> 4) & 1) * 32 + (lane & 3) * 8;
    int kro[NQF], vro[NDB];
    { const int q_ = (lane & 15) >> 2, gi_ = (lane >> 4) & 1, p_ = lane & 3;
#pragma unroll
      for (int d0 = 0; d0 < NQF; ++d0) kro[d0] = d0 < 4 ? r32 * 128 + (((2 * d0 + hi) ^ ((r32 >> 1) & 7)) << 4) : 8192 + r32 * 64 + (((2 * (d0 - 4) + hi) ^ ((r32 >> 2) & 3)) << 4);
#pragma unroll
      for (int db = 0; db < NDB; ++db) vro[db] = DV == 128 ? (4 * hi + q_) * 256 + (((db + q_) & 3) << 6) + 32 * gi_ + 8 * p_
                                                             : (2 * hi + (q_ >> 1)) * 256 + (((2 * (q_ & 1) + db + 2 * hi + (q_ >> 1)) & 3) << 6) + 32 * gi_ + 8 * p_; }
    constexpr int VJ = DV == 128 ? 4096 : 2048, VE = DV == 128 ? 2048 : 1024;
    if constexpr (!NA) {
        f32x16 pA0, pA1, pB0, pB1; bf16x8 pf[4];
        int bc = 0, bn = 1, bn2 = 2;
#define ATT_BAR() asm volatile("s_waitcnt vmcnt(0) lgkmcnt(0)\n\ts_barrier" ::: "memory")
#define ATT_QK(P0, P1, slot) do { const LAS unsigned char* kb_ = lds + OFF_K + (slot) * KBUF; \
        bf16x8 ka_[NQF], kc_[NQF];       \
        _Pragma("unroll") for (int d0 = 0; d0 < NQF; ++d0) { ka_[d0] = *(const LAS bf16x8*)(kb_ + kro[d0]); kc_[d0] = *(const LAS bf16x8*)(kb_ + kro[d0] + (d0 < 4 ? 4096 : 2048)); } \
        __builtin_amdgcn_sched_barrier(0); \
        _Pragma("unroll") for (int d0 = 0; d0 < NQF; ++d0) { \
            const bf16x8 a0_ = ka_[d0], a1_ = kc_[d0]; \
            if (d0 == 0) { P0 = __builtin_amdgcn_mfma_f32_32x32x16_bf16(a0_, qf[0], (f32x16){}, 0, 0, 0); P1 = __builtin_amdgcn_mfma_f32_32x32x16_bf16(a1_, qf[0], (f32x16){}, 0, 0, 0); } \
            else { P0 = __builtin_amdgcn_mfma_f32_32x32x16_bf16(a0_, qf[d0], P0, 0, 0, 0); P1 = __builtin_amdgcn_mfma_f32_32x32x16_bf16(a1_, qf[d0], P1, 0, 0, 0); } } } while (0)
#define ATT_STEP(C0, C1, N0, N1, tt) do { \
        if ((tt) + 2 < nt) ATT_DMA((tt) + 2, bn2);        \
        if ((tt) + 1 < nt) ATT_QK(N0, N1, bn); \
        s16x4 vlo_[NDB][4], vhh_[NDB][4]; \
        if (DV == 64) { const LAS unsigned char* vb_ = lds + OFF_V + bc * VBUF;     \
            _Pragma("unroll") for (int db = 0; db < NDB; ++db) _Pragma("unroll") for (int j = 0; j < 4; ++j) { vlo_[db][j] = tr_read(vb_ + vro[db] + j * VJ); vhh_[db][j] = tr_read(vb_ + vro[db] + j * VJ + VE); } } \
        att_softmax<NDB>(C0, C1, o, mrun, lrun, first, pf); \
        if (DV == 64) { \
            _Pragma("unroll") for (int j = 0; j < 4; ++j) _Pragma("unroll") for (int db = 0; db < NDB; ++db) { \
                const bf16x8 vf_ = (bf16x8){vlo_[db][j][0], vlo_[db][j][1], vlo_[db][j][2], vlo_[db][j][3], vhh_[db][j][0], vhh_[db][j][1], vhh_[db][j][2], vhh_[db][j][3]}; \
                o[db] = __builtin_amdgcn_mfma_f32_32x32x16_bf16(vf_, pf[j], o[db], 0, 0, 0); } } \
        else { const LAS unsigned char* vb_ = lds + OFF_V + bc * VBUF; \
            _Pragma("unroll") for (int j = 0; j < 4; ++j) _Pragma("unroll") for (int db = 0; db < NDB; ++db) { \
                const s16x4 lo_ = tr_read(vb_ + vro[db] + j * VJ), hh_ = tr_read(vb_ + vro[db] + j * VJ + VE); \
                const bf16x8 vf_ = (bf16x8){lo_[0], lo_[1], lo_[2], lo_[3], hh_[0], hh_[1], hh_[2], hh_[3]}; \
                o[db] = __builtin_amdgcn_mfma_f32_32x32x16_bf16(vf_, pf[j], o[db], 0, 0, 0); } } \
        ATT_BAR(); \
        { const int t_ = bc; bc = bn; bn = bn2; bn2 = t_; } } while (0)
        ATT_QK(pA0, pA1, 0);
        int t = 0;
#pragma nounroll
        for (; t + 1 < nt; t += 2) {
            ATT_STEP(pA0, pA1, pB0, pB1, t);
            ATT_STEP(pB0, pB1, pA0, pA1, t + 1);
        }
        if (t < nt) ATT_STEP(pA0, pA1, pB0, pB1, t);
#undef ATT_STEP
#undef ATT_QK
#undef ATT_BAR
    } else {
#pragma nounroll
    for (int t = 0; t < nt; ++t) {
        const int cur = t & 1;
        if (t + 1 < nt) ATT_LOAD(t + 1);
        bool active = true;
        if (NA) { if (t < d.nlat) { const int krow = d.na_rowlo + t; active = (krow >= rs_) && (krow < rs_ + 8); } }
        if (active) {
            const LAS unsigned char* kb = lds + OFF_K + cur * KBUF + koffr;
            f32x16 p0, p1;
#pragma unroll
            for (int d0 = 0; d0 < NQF; ++d0) {
                const bf16x8 a0 = *(const LAS bf16x8*)(kb + d0 * 32), a1 = *(const LAS bf16x8*)(kb + 32 * KS + d0 * 32);
                if (d0 == 0) { p0 = __builtin_amdgcn_mfma_f32_32x32x16_bf16(a0, qf[0], (f32x16){}, 0, 0, 0); p1 = __builtin_amdgcn_mfma_f32_32x32x16_bf16(a1, qf[0], (f32x16){}, 0, 0, 0); }
                else { p0 = __builtin_amdgcn_mfma_f32_32x32x16_bf16(a0, qf[d0], p0, 0, 0, 0); p1 = __builtin_amdgcn_mfma_f32_32x32x16_bf16(a1, qf[d0], p1, 0, 0, 0); }
            }
            if (NA) { if (t < d.nlat) {
                const int roff = d.na_rowlo + t - gr + 7;
                const LAS float* bp = rpbL + roff * 31 + (4 * hi - qc + 15);
#pragma unroll
                for (int r = 0; r < 16; ++r) {
                    const int c0 = (r & 3) + 8 * (r >> 2);
                    const float b0 = bp[c0], b1 = bp[c0 + 32];
                    p0[r] = ((namask0 >> r) & 1u) ? p0[r] + b0 : -INFINITY;
                    p1[r] = ((namask1 >> r) & 1u) ? p1[r] + b1 : -INFINITY;
                }
            } }
            float ra = __builtin_fmaxf(__builtin_fmaxf(p0[0], p0[1]), p1[0]), rb = __builtin_fmaxf(__builtin_fmaxf(p0[2], p0[3]), p1[1]);
            ra = __builtin_fmaxf(__builtin_fmaxf(ra, p1[2]), p1[3]);
#pragma unroll
            for (int r = 4; r < 16; r += 4) { ra = __builtin_fmaxf(__builtin_fmaxf(ra, p0[r]), p0[r + 1]); rb = __builtin_fmaxf(__builtin_fmaxf(rb, p0[r + 2]), p0[r + 3]);
                ra = __builtin_fmaxf(__builtin_fmaxf(ra, p1[r]), p1[r + 1]); rb = __builtin_fmaxf(__builtin_fmaxf(rb, p1[r + 2]), p1[r + 3]); }
            float rm = __builtin_fmaxf(ra, rb);
            { auto rr = __builtin_amdgcn_permlane32_swap(__float_as_uint(rm), __float_as_uint(rm), false, false); rm = __builtin_fmaxf(__uint_as_float(rr[0]), __uint_as_float(rr[1])); }
            if (first || __any(rm > mrun + 8.f)) {
                const float mn = first ? rm : __builtin_fmaxf(mrun, rm);
                if (!first) { const float al = __builtin_amdgcn_exp2f(mrun - mn); lrun *= al;
#pragma unroll
                    for (int i = 0; i < NDB; ++i) o[i] *= al; }
                mrun = mn; first = false;
            }
            float ls = 0.f;
#pragma unroll
            for (int r = 0; r < 16; ++r) { p0[r] = __builtin_amdgcn_exp2f(p0[r] - mrun); p1[r] = __builtin_amdgcn_exp2f(p1[r] - mrun); ls += p0[r] + p1[r]; }
            lrun += ls;
            bf16x8 pf[4];
#pragma unroll
            for (int j = 0; j < 4; ++j) {
                u32x4 pw;
#pragma unroll
                for (int e = 0; e < 4; ++e) { const int r = 8 * (j & 1) + 2 * e; pw[e] = (j < 2) ? pk2(p0[r], p0[r + 1]) : pk2(p1[r], p1[r + 1]); }
                pf[j] = __builtin_bit_cast(bf16x8, pw);
            }
            const LAS unsigned char* vb = lds + OFF_V + cur * VBUF + voffr;
#pragma unroll
            for (int db = 0; db < NDB; ++db)
#pragma unroll
                for (int j = 0; j < 4; ++j) {
                    const s16x4 lo = tr_read(vb + (16 * j) * VS + db * 64), hh = tr_read(vb + (16 * j + 8) * VS + db * 64);
                    const bf16x8 vf = (bf16x8){lo[0], lo[1], lo[2], lo[3], hh[0], hh[1], hh[2], hh[3]};
                    o[db] = __builtin_amdgcn_mfma_f32_32x32x16_bf16(vf, pf[j], o[db], 0, 0, 0);
                }
        }
        if (t + 1 < nt) ATT_STORE(cur ^ 1);
        __syncthreads();
    }
    }
#undef ATT_TROW
#undef ATT_LOAD
#undef ATT_DMA
#undef ATT_STORE
    __builtin_amdgcn_s_setprio(0);
    lrun += __shfl_xor(lrun, 32);
    const float inv = 1.f / lrun;
    const size_t orow = (size_t)(d.qrow0 + 32 * w + r32) * d.opitch;
    if (OMODE == 2) {
#pragma unroll
        for (int db = 0; db < NDB; ++db)
#pragma unroll
            for (int rg = 0; rg < 4; ++rg)
                *(u32x2*)(d.Ob + orow + 32 * db + 8 * rg + 4 * hi) = (u32x2){pk2(o[db][4 * rg] * inv, o[db][4 * rg + 1] * inv), pk2(o[db][4 * rg + 2] * inv, o[db][4 * rg + 3] * inv)};
    } else if (OMODE == 3) {
        float ss = 0.f;
#pragma unroll
        for (int db = 0; db < NDB; ++db)
#pragma unroll
            for (int rg = 0; rg < 4; ++rg) {
                const u32x2 st = *(const u32x2*)(d.Ob + orow + 32 * db + 8 * rg + 4 * hi);
                const float a1 = __uint_as_float(st[0] << 16), b1 = __uint_as_float(st[0] & 0xffff0000u), c1 = __uint_as_float(st[1] << 16), e1 = __uint_as_float(st[1] & 0xffff0000u);
                const float li = d.lam * inv;
                const float a = a1 - li * o[db][4 * rg], b = b1 - li * o[db][4 * rg + 1], c = c1 - li * o[db][4 * rg + 2], e = e1 - li * o[db][4 * rg + 3];
                o[db][4 * rg] = a; o[db][4 * rg + 1] = b; o[db][4 * rg + 2] = c; o[db][4 * rg + 3] = e;
                ss += (a * a + b * b) + (c * c + e * e);
            }
        ss += __shfl_xor(ss, 32);
        const float rs = (1.f - LAMBDA_INIT) / sqrtf(ss * (1.f / 128.f) + 1e-6f);
#pragma unroll
        for (int db = 0; db < NDB; ++db)
#pragma unroll
            for (int rg = 0; rg < 4; ++rg) {
                const int dc = 32 * db + 8 * rg + 4 * hi;
                const f32x4 g = *(const f32x4*)(d.subg + dc);
                *(u32x2*)(d.Ob + orow + dc) = (u32x2){pk2(o[db][4 * rg] * rs * g[0], o[db][4 * rg + 1] * rs * g[1]), pk2(o[db][4 * rg + 2] * rs * g[2], o[db][4 * rg + 3] * rs * g[3])};
            }
    } else {
#pragma unroll
        for (int db = 0; db < NDB; ++db)
#pragma unroll
            for (int rg = 0; rg < 4; ++rg) {
                const int dc = 32 * db + 8 * rg + 4 * hi;
                const float a = o[db][4 * rg] * inv, b = o[db][4 * rg + 1] * inv, c = o[db][4 * rg + 2] * inv, e = o[db][4 * rg + 3] * inv;
                if (OMODE == 1) *(f32x4*)(d.Of + orow + dc) = (f32x4){a, b, c, e};
                else *(u32x2*)(d.Ob + orow + dc) = (u32x2){pk2(a, b), pk2(c, e)};
            }
    }
}


__device__ __forceinline__ void attn_unit_mla2(const AttnDesc d, LAS unsigned char* lds) {
    constexpr int NQF = 6, NDB = 2, KBUF = 12288, VBUF = 8192, OFF_K = 0, OFF_V = 3 * KBUF, VJ = 2048, VE = 1024;
    int tid = threadIdx.x; asm volatile("" : "+v"(tid));
    const int lane = tid & 63, w = __builtin_amdgcn_readfirstlane(tid >> 6), r32 = lane & 31, hi = lane >> 5;
    bf16x8 qf[2][NQF];
#pragma unroll
    for (int qb = 0; qb < 2; ++qb) { const bf16_t* qp = d.Q + (size_t)(d.qrow0 + 64 * w + 32 * qb + r32) * d.qpitch + 8 * hi;
#pragma unroll
        for (int d0 = 0; d0 < NQF; ++d0) qf[qb][d0] = *(const bf16x8*)(qp + 16 * d0); }
    const unsigned ldsb = (unsigned)(uintptr_t)lds;
    int gko, gk2o, gvo0;
    { const int kr = 8 * w + (lane >> 3), kc = (lane & 7) ^ ((kr >> 1) & 7); gko = kr * d.kpitch + kc * 8;
      const int rr = 16 * (w & 3) + (lane >> 2), rc = (lane & 3) ^ ((rr >> 2) & 3); gk2o = rr * d.k2pitch + rc * 8;
      const int sr = 4 * w + (lane >> 4), pos = lane & 15, sp = pos >> 2, sub = pos & 3, x = (sp - sr) & 3;
      gvo0 = (2 * sr + (x >> 1)) * d.vpitch + (x & 1) * 32 + sub * 8; }
#define M2_TROW(i) ((i) < d.nlat ? d.lat_row0 + 64 * (i) : d.ctx_row0 + 64 * ((i) - d.nlat))
#define M2_DMA(i, slot) do { const int tr_ = M2_TROW(i); \
        glds16(d.K + ((size_t)tr_ * d.kpitch + gko), (unsigned)__builtin_amdgcn_readfirstlane(ldsb + OFF_K + (slot) * KBUF + w * 1024)); \
        if (w < 4) glds16(d.K2 + ((size_t)tr_ * d.k2pitch + gk2o), (unsigned)__builtin_amdgcn_readfirstlane(ldsb + OFF_K + (slot) * KBUF + 8192 + w * 1024)); \
        glds16(d.V + ((size_t)tr_ * d.vpitch + gvo0), (unsigned)__builtin_amdgcn_readfirstlane(ldsb + OFF_V + (slot) * VBUF + w * 1024)); } while (0)
    const int nt = d.ntiles;
    if (w >= 4) __builtin_amdgcn_s_setprio(1);
    M2_DMA(0, 0); if (nt > 1) M2_DMA(1, 1);
    asm volatile("s_waitcnt vmcnt(0)" ::: "memory");
    __syncthreads();
    int kro[NQF], vro[NDB];
    { const int q_ = (lane & 15) >> 2, gi_ = (lane >> 4) & 1, p_ = lane & 3;
#pragma unroll
      for (int d0 = 0; d0 < NQF; ++d0) kro[d0] = d0 < 4 ? r32 * 128 + (((2 * d0 + hi) ^ ((r32 >> 1) & 7)) << 4) : 8192 + r32 * 64 + (((2 * (d0 - 4) + hi) ^ ((r32 >> 2) & 3)) << 4);
#pragma unroll
      for (int db = 0; db < NDB; ++db) vro[db] = (2 * hi + (q_ >> 1)) * 256 + (((2 * (q_ & 1) + db + 2 * hi + (q_ >> 1)) & 3) << 6) + 32 * gi_ + 8 * p_; }
    f32x16 o0[NDB], o1[NDB];
#pragma unroll
    for (int i = 0; i < NDB; ++i) { o0[i] = (f32x16){}; o1[i] = (f32x16){}; }
    float m0 = 0.f, l0 = 0.f, m1 = 0.f, l1 = 0.f; bool f0 = true, f1 = true;
    int bc = 0, bn2 = 2;
#pragma nounroll
    for (int t = 0; t < nt; ++t) {
        if (t + 2 < nt) M2_DMA(t + 2, bn2);
        const LAS unsigned char* kb_ = lds + OFF_K + bc * KBUF;
        bf16x8 ka_[NQF], kc_[NQF];
#pragma unroll
        for (int d0 = 0; d0 < NQF; ++d0) { ka_[d0] = *(const LAS bf16x8*)(kb_ + kro[d0]); kc_[d0] = *(const LAS bf16x8*)(kb_ + kro[d0] + (d0 < 4 ? 4096 : 2048)); }
        __builtin_amdgcn_sched_barrier(0);
        f32x16 pa0, pa1, pb0, pb1;
#pragma unroll
        for (int d0 = 0; d0 < NQF; ++d0) {
            if (d0 == 0) { pa0 = __builtin_amdgcn_mfma_f32_32x32x16_bf16(ka_[0], qf[0][0], (f32x16){}, 0, 0, 0); pa1 = __builtin_amdgcn_mfma_f32_32x32x16_bf16(kc_[0], qf[0][0], (f32x16){}, 0, 0, 0);
                           pb0 = __builtin_amdgcn_mfma_f32_32x32x16_bf16(ka_[0], qf[1][0], (f32x16){}, 0, 0, 0); pb1 = __builtin_amdgcn_mfma_f32_32x32x16_bf16(kc_[0], qf[1][0], (f32x16){}, 0, 0, 0); }
            else { pa0 = __builtin_amdgcn_mfma_f32_32x32x16_bf16(ka_[d0], qf[0][d0], pa0, 0, 0, 0); pa1 = __builtin_amdgcn_mfma_f32_32x32x16_bf16(kc_[d0], qf[0][d0], pa1, 0, 0, 0);
                   pb0 = __builtin_amdgcn_mfma_f32_32x32x16_bf16(ka_[d0], qf[1][d0], pb0, 0, 0, 0); pb1 = __builtin_amdgcn_mfma_f32_32x32x16_bf16(kc_[d0], qf[1][d0], pb1, 0, 0, 0); }
        }
        s16x4 vlo_[NDB][4], vhh_[NDB][4];
        { const LAS unsigned char* vb_ = lds + OFF_V + bc * VBUF;
#pragma unroll
          for (int db = 0; db < NDB; ++db)
#pragma unroll
            for (int j = 0; j < 4; ++j) { vlo_[db][j] = tr_read(vb_ + vro[db] + j * VJ); vhh_[db][j] = tr_read(vb_ + vro[db] + j * VJ + VE); } }
        bf16x8 pf0[4], pf1[4];
        att_softmax<NDB>(pa0, pa1, o0, m0, l0, f0, pf0);
        att_softmax<NDB>(pb0, pb1, o1, m1, l1, f1, pf1);
#pragma unroll
        for (int j = 0; j < 4; ++j)
#pragma unroll
            for (int db = 0; db < NDB; ++db) {
                const bf16x8 vf_ = (bf16x8){vlo_[db][j][0], vlo_[db][j][1], vlo_[db][j][2], vlo_[db][j][3], vhh_[db][j][0], vhh_[db][j][1], vhh_[db][j][2], vhh_[db][j][3]};
                o0[db] = __builtin_amdgcn_mfma_f32_32x32x16_bf16(vf_, pf0[j], o0[db], 0, 0, 0);
                o1[db] = __builtin_amdgcn_mfma_f32_32x32x16_bf16(vf_, pf1[j], o1[db], 0, 0, 0);
            }
        asm volatile("s_waitcnt vmcnt(0) lgkmcnt(0)\n\ts_barrier" ::: "memory");
        bc = bc == 2 ? 0 : bc + 1; bn2 = bn2 == 2 ? 0 : bn2 + 1;
    }
    __builtin_amdgcn_s_setprio(0);
#undef M2_DMA
#undef M2_TROW
    l0 += __shfl_xor(l0, 32); l1 += __shfl_xor(l1, 32);
    const float inv0 = 1.f / l0, inv1 = 1.f / l1;
#pragma unroll
    for (int qb = 0; qb < 2; ++qb) {
        const size_t orow = (size_t)(d.qrow0 + 64 * w + 32 * qb + r32) * d.opitch; const float inv = qb ? inv1 : inv0;
#pragma unroll
        for (int db = 0; db < NDB; ++db)
#pragma unroll
            for (int rg = 0; rg < 4; ++rg) { const int dc = 32 * db + 8 * rg + 4 * hi;
                const f32x16& oo = qb ? o1[db] : o0[db];
                *(u32x2*)(d.Ob + orow + dc) = (u32x2){pk2(oo[4 * rg] * inv, oo[4 * rg + 1] * inv), pk2(oo[4 * rg + 2] * inv, oo[4 * rg + 3] * inv)}; }
    }
}


template <int PART>
__device__ __forceinline__ void attn_unit_diff2(const AttnDesc d, LAS unsigned char* lds, bf16_t* xch, unsigned* xcnt) {
    constexpr int NQF = 4, NDB = 4, KBUF = 8192, VBUF = 16384, OFF_K = 0, OFF_V = 3 * KBUF, OFF_Q = OFF_V + 3 * VBUF, VJ = 4096, VE = 2048;
    int tid = threadIdx.x; asm volatile("" : "+v"(tid));
    const int lane = tid & 63, w = __builtin_amdgcn_readfirstlane(tid >> 6), r32 = lane & 31, hi = lane >> 5;
    const unsigned ldsb = (unsigned)(uintptr_t)lds;
#pragma unroll
    for (int i = 0; i < 8; ++i) { const int r = 8 * i + (lane >> 3), c = (lane & 7) ^ ((r >> 1) & 7);
        glds16(d.Q + ((size_t)(d.qrow0 + 64 * w + r) * d.qpitch + c * 8), (unsigned)__builtin_amdgcn_readfirstlane(ldsb + OFF_Q + w * 8192 + i * 1024)); }
    int gko, gvo0, gvo1;
    { const int kr = 8 * w + (lane >> 3), kc = (lane & 7) ^ ((kr >> 1) & 7); gko = kr * d.kpitch + kc * 8;
      const int pos = lane & 15, sp = pos >> 2, sub = pos & 3, r0 = 8 * w + (lane >> 4), r1 = r0 + 4;
      gvo0 = r0 * d.vpitch + ((sp - r0) & 3) * 32 + sub * 8; gvo1 = r1 * d.vpitch + ((sp - r1) & 3) * 32 + sub * 8; }
#define D2_TROW(i) ((i) < d.nlat ? d.lat_row0 + 64 * (i) : d.ctx_row0 + 64 * ((i) - d.nlat))
#define D2_DMA(i, slot) do { const int tr_ = D2_TROW(i); \
        glds16(d.K + ((size_t)tr_ * d.kpitch + gko), (unsigned)__builtin_amdgcn_readfirstlane(ldsb + OFF_K + (slot) * KBUF + w * 1024)); \
        glds16(d.V + ((size_t)tr_ * d.vpitch + gvo0), (unsigned)__builtin_amdgcn_readfirstlane(ldsb + OFF_V + (slot) * VBUF + w * 2048)); \
        glds16(d.V + ((size_t)tr_ * d.vpitch + gvo1), (unsigned)__builtin_amdgcn_readfirstlane(ldsb + OFF_V + (slot) * VBUF + w * 2048 + 1024)); } while (0)
    const int nt = d.ntiles;
    if (w >= 4) __builtin_amdgcn_s_setprio(1);
    D2_DMA(0, 0); if (nt > 1) D2_DMA(1, 1);
    asm volatile("s_waitcnt vmcnt(0)" ::: "memory");
    __syncthreads();
    int kro[NQF], vro[NDB];
    { const int q_ = (lane & 15) >> 2, gi_ = (lane >> 4) & 1, p_ = lane & 3;
#pragma unroll
      for (int d0 = 0; d0 < NQF; ++d0) kro[d0] = r32 * 128 + (((2 * d0 + hi) ^ ((r32 >> 1) & 7)) << 4);
#pragma unroll
      for (int db = 0; db < NDB; ++db) vro[db] = (4 * hi + q_) * 256 + (((db + q_) & 3) << 6) + 32 * gi_ + 8 * p_; }
    f32x16 o0[NDB], o1[NDB];
#pragma unroll
    for (int i = 0; i < NDB; ++i) { o0[i] = (f32x16){}; o1[i] = (f32x16){}; }
    float m0 = 0.f, l0 = 0.f, m1 = 0.f, l1 = 0.f; bool f0 = true, f1 = true;
    int bc = 0, bn2 = 2;
    const LAS unsigned char* qim = lds + OFF_Q + w * 8192;
#pragma nounroll
    for (int t = 0; t < nt; ++t) {
        if (t + 2 < nt) D2_DMA(t + 2, bn2);
        const LAS unsigned char* kb_ = lds + OFF_K + bc * KBUF;
        f32x16 pa0, pa1, pb0, pb1;
#pragma unroll
        for (int dh = 0; dh < NQF; dh += 2) {
            bf16x8 ka[2], kc[2], qa[2], qb[2];
#pragma unroll
            for (int e = 0; e < 2; ++e) { ka[e] = *(const LAS bf16x8*)(kb_ + kro[dh + e]); kc[e] = *(const LAS bf16x8*)(kb_ + kro[dh + e] + 4096);
                                          qa[e] = *(const LAS bf16x8*)(qim + kro[dh + e]); qb[e] = *(const LAS bf16x8*)(qim + kro[dh + e] + 4096); }
            __builtin_amdgcn_sched_barrier(0);
#pragma unroll
            for (int e = 0; e < 2; ++e) {
                if (dh + e == 0) { pa0 = __builtin_amdgcn_mfma_f32_32x32x16_bf16(ka[e], qa[e], (f32x16){}, 0, 0, 0); pa1 = __builtin_amdgcn_mfma_f32_32x32x16_bf16(kc[e], qa[e], (f32x16){}, 0, 0, 0);
                                   pb0 = __builtin_amdgcn_mfma_f32_32x32x16_bf16(ka[e], qb[e], (f32x16){}, 0, 0, 0); pb1 = __builtin_amdgcn_mfma_f32_32x32x16_bf16(kc[e], qb[e], (f32x16){}, 0, 0, 0); }
                else { pa0 = __builtin_amdgcn_mfma_f32_32x32x16_bf16(ka[e], qa[e], pa0, 0, 0, 0); pa1 = __builtin_amdgcn_mfma_f32_32x32x16_bf16(kc[e], qa[e], pa1, 0, 0, 0);
                       pb0 = __builtin_amdgcn_mfma_f32_32x32x16_bf16(ka[e], qb[e], pb0, 0, 0, 0); pb1 = __builtin_amdgcn_mfma_f32_32x32x16_bf16(kc[e], qb[e], pb1, 0, 0, 0); }
            }
        }
        bf16x8 pf0[4], pf1[4];
        att_softmax<NDB>(pa0, pa1, o0, m0, l0, f0, pf0);
        att_softmax<NDB>(pb0, pb1, o1, m1, l1, f1, pf1);
        { const LAS unsigned char* vb_ = lds + OFF_V + bc * VBUF;
#pragma unroll
          for (int j = 0; j < 4; ++j)
#pragma unroll
            for (int db = 0; db < NDB; ++db) {
                const s16x4 lo_ = tr_read(vb_ + vro[db] + j * VJ), hh_ = tr_read(vb_ + vro[db] + j * VJ + VE);
                const bf16x8 vf_ = (bf16x8){lo_[0], lo_[1], lo_[2], lo_[3], hh_[0], hh_[1], hh_[2], hh_[3]};
                o0[db] = __builtin_amdgcn_mfma_f32_32x32x16_bf16(vf_, pf0[j], o0[db], 0, 0, 0);
                o1[db] = __builtin_amdgcn_mfma_f32_32x32x16_bf16(vf_, pf1[j], o1[db], 0, 0, 0);
            } }
        asm volatile("s_waitcnt vmcnt(0) lgkmcnt(0)\n\ts_barrier" ::: "memory");
        bc = bc == 2 ? 0 : bc + 1; bn2 = bn2 == 2 ? 0 : bn2 + 1;
    }
    __builtin_amdgcn_s_setprio(0);
#undef D2_DMA
#undef D2_TROW
    l0 += __shfl_xor(l0, 32); l1 += __shfl_xor(l1, 32);
    const float inv0 = 1.f / l0, inv1 = 1.f / l1;
    if (PART == 0) {
#pragma unroll
        for (int qb = 0; qb < 2; ++qb) { const size_t xrow = (size_t)(d.qrow0 + 64 * w + 32 * qb + r32) * 128; const float inv = qb ? inv1 : inv0;
#pragma unroll
            for (int db = 0; db < NDB; ++db)
#pragma unroll
                for (int rg = 0; rg < 4; ++rg) { const f32x16& oo = qb ? o1[db] : o0[db];
                    const unsigned long long v = (unsigned long long)pk2(oo[4 * rg] * inv, oo[4 * rg + 1] * inv) | ((unsigned long long)pk2(oo[4 * rg + 2] * inv, oo[4 * rg + 3] * inv) << 32);
                    __hip_atomic_store((unsigned long long*)(xch + xrow + 32 * db + 8 * rg + 4 * hi), v, __ATOMIC_RELAXED, __HIP_MEMORY_SCOPE_AGENT); } }
        asm volatile("s_waitcnt vmcnt(0)" ::: "memory"); __syncthreads();
        if (threadIdx.x == 0) __hip_atomic_fetch_add(xcnt, 1u, __ATOMIC_RELAXED, __HIP_MEMORY_SCOPE_AGENT);
    } else {
        if (threadIdx.x == 0) { unsigned sp = 0;
            while (__hip_atomic_load(xcnt, __ATOMIC_RELAXED, __HIP_MEMORY_SCOPE_AGENT) < 1u) { __builtin_amdgcn_s_sleep(2); if (++sp > (1u << 24)) break; }
            __builtin_amdgcn_fence(__ATOMIC_ACQUIRE, "agent"); asm volatile("s_waitcnt vmcnt(0)" ::: "memory"); }
        __syncthreads();
#pragma unroll
        for (int qb = 0; qb < 2; ++qb) {
            const int row = d.qrow0 + 64 * w + 32 * qb + r32; const size_t xrow = (size_t)row * 128; const float li = d.lam * (qb ? inv1 : inv0);
            float c[NDB][16]; float ss = 0.f;
#pragma unroll
            for (int db = 0; db < NDB; ++db)
#pragma unroll
                for (int rg = 0; rg < 4; ++rg) { const f32x16& oo = qb ? o1[db] : o0[db];
                    const unsigned long long st = __hip_atomic_load((unsigned long long*)(xch + xrow + 32 * db + 8 * rg + 4 * hi), __ATOMIC_RELAXED, __HIP_MEMORY_SCOPE_AGENT);
                    const unsigned s0 = (unsigned)st, s1 = (unsigned)(st >> 32);
                    const float a = __uint_as_float(s0 << 16) - li * oo[4 * rg], b = __uint_as_float(s0 & 0xffff0000u) - li * oo[4 * rg + 1];
                    const float e = __uint_as_float(s1 << 16) - li * oo[4 * rg + 2], g = __uint_as_float(s1 & 0xffff0000u) - li * oo[4 * rg + 3];
                    c[db][4 * rg] = a; c[db][4 * rg + 1] = b; c[db][4 * rg + 2] = e; c[db][4 * rg + 3] = g; ss += (a * a + b * b) + (e * e + g * g); }
            ss += __shfl_xor(ss, 32);
            const float rs = (1.f - LAMBDA_INIT) / sqrtf(ss * (1.f / 128.f) + 1e-6f);
            const size_t orow = (size_t)row * d.opitch;
#pragma unroll
            for (int db = 0; db < NDB; ++db)
#pragma unroll
                for (int rg = 0; rg < 4; ++rg) { const int dc = 32 * db + 8 * rg + 4 * hi; const f32x4 gg = *(const f32x4*)(d.subg + dc);
                    *(u32x2*)(d.Ob + orow + dc) = (u32x2){pk2(c[db][4 * rg] * rs * gg[0], c[db][4 * rg + 1] * rs * gg[1]), pk2(c[db][4 * rg + 2] * rs * gg[2], c[db][4 * rg + 3] * rs * gg[3])}; }
        }
    }
}

__device__ __forceinline__ void p0_item(const float* W, int K, int N, bf16_t* WT, int mode, const float* ksc, LAS float* scr, int item, int lane) {
    const int nblk = N / 32, kb = item / nblk, nb = item % nblk, k0 = 64 * kb, n0 = 32 * nb;
#pragma unroll 8
    for (int i = 0; i < 32; ++i) { const int kk = 2 * i + (lane >> 5); float v = W[(size_t)(k0 + kk) * N + n0 + (lane & 31)]; if (ksc) v *= ksc[k0 + kk]; scr[kk * 33 + (lane & 31)] = v; }
    asm volatile("s_waitcnt lgkmcnt(0)" ::: "memory");
    int nd0 = n0;
    if (mode == 1) { nd0 = (n0 < FH) ? (n0 / 128) * 256 + (n0 % 128) : ((n0 - FH) / 128) * 256 + 128 + ((n0 - FH) % 128); }
    else if (mode == 2) { nd0 = (n0 < 672) ? n0 : n0 + 96; }
    const int c = lane & 7;
#pragma unroll
    for (int j = 0; j < 4; ++j) { const int n = (lane >> 3) + 8 * j; const LAS float* s = scr + (8 * c) * 33 + n;
        u32x4 o; o.x = pk2(s[0 * 33], s[1 * 33]); o.y = pk2(s[2 * 33], s[3 * 33]); o.z = pk2(s[4 * 33], s[5 * 33]); o.w = pk2(s[6 * 33], s[7 * 33]);
        *(u32x4*)(WT + (size_t)(nd0 + n) * K + k0 + 8 * c) = o; }
    asm volatile("s_waitcnt lgkmcnt(0)" ::: "memory");
}
__device__ __forceinline__ void sincos_small(float af, float& s, float& c) {
    const double a = (double)af; const double k = rint(a * 0.6366197723675814); const double r = a - k * 1.5707963267948966;
    const double r2 = r * r;
    const double sp = r * (1.0 + r2 * (-1.0 / 6 + r2 * (1.0 / 120 + r2 * (-1.0 / 5040 + r2 * (1.0 / 362880 + r2 * (-1.0 / 39916800 + r2 * (1.0 / 6227020800.0)))))));
    const double cp = 1.0 + r2 * (-0.5 + r2 * (1.0 / 24 + r2 * (-1.0 / 720 + r2 * (1.0 / 40320 + r2 * (-1.0 / 3628800 + r2 * (1.0 / 479001600.0))))));
    const int q = ((int)k) & 3;
    const double ss = (q == 0) ? sp : (q == 1) ? cp : (q == 2) ? -sp : -cp;
    const double cc = (q == 0) ? cp : (q == 1) ? -sp : (q == 2) ? -cp : sp;
    s = (float)ss; c = (float)cc;
}

#define XB_TMO      128
#define XB_XCNT(j)  (256  + 64 * (j))
#define XB_XSUB(j)  (1280 + 64 * (j))
#define XB_XGEN(j)  (2304 + 64 * (j))
#define XB_TOP      3328
#define XB_TOPGEN   3392
#define XCD_BAR_WORDS 3456
#define XB_SPIN_CAP (1u << 18)

__device__ __forceinline__ unsigned xb_ld(unsigned* p)              { return __hip_atomic_load(p, __ATOMIC_RELAXED, __HIP_MEMORY_SCOPE_AGENT); }
__device__ __forceinline__ unsigned xb_add(unsigned* p, unsigned v) { return __hip_atomic_fetch_add(p, v, __ATOMIC_RELAXED, __HIP_MEMORY_SCOPE_AGENT); }
__device__ __forceinline__ unsigned xb_xcc_id() { return (unsigned)__builtin_amdgcn_s_getreg((3 << 11) | 20) & 0xFu; }
#define XB_SPIN(cond, bar) do { unsigned _sp = 0; while (cond) { __builtin_amdgcn_s_sleep(1); \
    if ((++_sp & 255u) == 0u) { if (xb_ld(&(bar)[XB_TMO])) break; if (_sp > XB_SPIN_CAP) { atomicAdd(&(bar)[XB_TMO], 1u); break; } } } } while (0)

struct XcdBarrier {
    unsigned* bar; unsigned x;
    volatile LAS unsigned* st;
};

__device__ __forceinline__ XcdBarrier xcd_barrier_post(unsigned* bar, volatile LAS unsigned* st) {
    XcdBarrier b; b.bar = bar; b.x = xb_xcc_id(); b.st = st;
    if (threadIdx.x == 0) (void)xb_add(&bar[XB_XCNT(b.x)], 1u);
    return b;
}
__device__ __forceinline__ void xcd_barrier_complete(unsigned* bar, unsigned x, unsigned& nloc, unsigned& nx) {
    const unsigned G = gridDim.x * gridDim.y * gridDim.z;
    unsigned sum, cnt, mine, sp = 0u;
    for (;;) {
        sum = 0u; cnt = 0u; mine = 0u;
#pragma unroll
        for (unsigned j = 0; j < 16; ++j) { const unsigned c = xb_ld(&bar[XB_XCNT(j)]); sum += c; cnt += (c > 0u) ? 1u : 0u; mine = (j == x) ? c : mine; }
        if (sum == G) break;
        __builtin_amdgcn_s_sleep(1);
        if ((++sp & 255u) == 0u) { if (xb_ld(&bar[XB_TMO])) break; if (sp > XB_SPIN_CAP) { atomicAdd(&bar[XB_TMO], 1u); break; } }
    }
    nloc = mine > 0u ? mine : 1u; nx = cnt > 0u ? cnt : 1u;
}

__device__ __forceinline__ void xcd_barrier(const XcdBarrier& b) {
    asm volatile("s_waitcnt vmcnt(0)" ::: "memory");
    __syncthreads();
    if (threadIdx.x == 0) {
        unsigned* bar = b.bar;
        __builtin_amdgcn_s_waitcnt(0);
        unsigned nloc = b.st[0], nx = b.st[1];
        if (nloc == 0u) { xcd_barrier_complete(bar, b.x, nloc, nx); b.st[0] = nloc; b.st[1] = nx; }
        const unsigned old = xb_add(&bar[XB_XSUB(b.x)], 1u);
        const unsigned gen = old / nloc;
        if (old + 1u == (gen + 1u) * nloc) {
            __builtin_amdgcn_fence(__ATOMIC_RELEASE, "agent");
            asm volatile("s_waitcnt vmcnt(0)" ::: "memory");
            const unsigned og = xb_add(&bar[XB_TOP], 1u);
            const unsigned tg = og / nx;
            if (og + 1u == (tg + 1u) * nx) xb_add(&bar[XB_TOPGEN], 1u);
            else XB_SPIN(xb_ld(&bar[XB_TOPGEN]) == tg, bar);
            __builtin_amdgcn_fence(__ATOMIC_ACQUIRE, "agent");
            xb_add(&bar[XB_XGEN(b.x)], 1u);
            asm volatile("s_waitcnt vmcnt(0)" ::: "memory");
        } else {
            XB_SPIN(xb_ld(&bar[XB_XGEN(b.x)]) == gen, bar);
            __builtin_amdgcn_fence(__ATOMIC_ACQUIRE, "agent");
            asm volatile("s_waitcnt vmcnt(0)" ::: "memory");
        }
    }
    __syncthreads();
}

struct Params {
    const float *x, *c, *ctx, *c_ctx, *mod_w, *mod_b, *ln_mix_g, *ln_mix_b, *ln_ffn_g, *ln_ffn_b, *ffn_w_in, *ffn_w_out, *ev_w_in, *ev_w_out,
        *diff_lambda, *diff_subln_g, *na_rpb, *od_w_in, *od_w_out, *mla_q_norm_g, *mla_w_uq, *mla_kv_norm_g, *mla_w_ukv, *gmlp_ln_g, *gmlp_ln_b, *gmlp_ws, *gmlp_b;
    float* out; unsigned char* ws; int lo, hi;
};

__device__ __forceinline__ void ln_rows(float* Z, float* dst, const float* g, const float* b, bf16_t* U, const float* modl, int kmod, int nrows, int gw, int ngw, int lane) {
    for (int row = gw; row < nrows; row += ngw) {
        const f32x4* zr = (const f32x4*)(Z + (size_t)row * DM) + lane;
        f32x4 v[4]; float s = 0.f;
#pragma unroll
        for (int j = 0; j < 4; ++j) { v[j] = zr[64 * j]; s += (v[j][0] + v[j][1]) + (v[j][2] + v[j][3]); }
        const float mean = wave_sum(s) * (1.f / DM); float s2 = 0.f;
#pragma unroll
        for (int j = 0; j < 4; ++j) { v[j] = v[j] - mean; s2 += (v[j][0] * v[j][0] + v[j][1] * v[j][1]) + (v[j][2] * v[j][2] + v[j][3] * v[j][3]); }
        const float rstd = 1.f / sqrtf(wave_sum(s2) * (1.f / DM) + 1e-5f);
        const int set = row < 8192 ? 0 : (row < ML ? 1 : 2);
        const float* mp = modl ? modl + set * 6144 + kmod * 1024 : nullptr;
#pragma unroll
        for (int j = 0; j < 4; ++j) {
            const int col = 256 * j + 4 * lane;
            const f32x4 gg = *(const f32x4*)(g + col), bb = *(const f32x4*)(b + col);
            const f32x4 h = v[j] * rstd * gg + bb;
            *(f32x4*)(dst + (size_t)row * DM + col) = h;
            if (U) { const f32x4 sh = *(const f32x4*)(mp + col), sc = *(const f32x4*)(mp + 1024 + col);
                const f32x4 uu = h * (sc + 1.f) + sh;
                *(u32x2*)(U + (size_t)row * DM + col) = (u32x2){pk2(uu[0], uu[1]), pk2(uu[2], uu[3])}; }
        }
    }
}

typedef const __attribute__((address_space(4))) Params* kparams_t;
__device__ __forceinline__ kparams_t kparams() { kparams_t q = (kparams_t)__builtin_amdgcn_kernarg_segment_ptr(); asm volatile("" : "+s"(q)); return q; }
constexpr int NPHASE = 18;
constexpr int LDS_BYTES = 147456;

__global__ void __launch_bounds__(512) dit_fwd(Params p) {
    extern __shared__ __attribute__((aligned(16))) unsigned char lds_raw[];
    LAS unsigned char* lds = (LAS unsigned char*)lds_raw;
    const int G = gridDim.x, blk = blockIdx.x;
    const int tid = threadIdx.x, lane = tid & 63, wave = __builtin_amdgcn_readfirstlane(tid >> 6);
    const int gw = blk * 8 + wave, ngw = G * 8;
    const int gtid = blk * 512 + tid, ngt = G * 512;
#define Wevin ((bf16_t*)(ws + O_EVIN))
#define Wevout ((bf16_t*)(ws + O_EVOUT))
#define Wffin0 ((bf16_t*)(ws + O_FFIN0))
#define Wffout0 ((bf16_t*)(ws + O_FFOUT0))
#define Wffin1 ((bf16_t*)(ws + O_FFIN1))
#define Wffout1 ((bf16_t*)(ws + O_FFOUT1))
#define Wodin ((bf16_t*)(ws + O_ODIN))
#define Wodout ((bf16_t*)(ws + O_ODOUT))
#define Wuq ((bf16_t*)(ws + O_UQ))
#define Wukv ((bf16_t*)(ws + O_UKV))
#define Gws ((bf16_t*)(ws + O_GWS))
#define mod ((float*)(ws + O_MOD))
#define tab32 ((float*)(ws + O_TAB32))
#define tab16 ((float*)(ws + O_TAB16))
#define P ((bf16_t*)(ws + O_P))
#define H ((float*)(ws + O_H))
#define Hb ((bf16_t*)(ws + O_H))
#define U ((bf16_t*)(ws + O_U))
#define Odiff ((float*)(ws + O_ODIFF))
#define AMIX0 ((bf16_t*)(ws + O_AMIX0))
#define ACT ((bf16_t*)(ws + O_ACT))
#define P1 ((bf16_t*)(ws + O_P1))
#define AMIX1 ((bf16_t*)(ws + O_AMIX1))
#define stats ((float*)(ws + O_STATS))
#define KV1 ((bf16_t*)(ws + O_KV1))
#define Q1 ((bf16_t*)(ws + O_Q1))
#define PHASE_BEGIN kparams_t q = kparams(); unsigned char* ws = q->ws;
    const int lo = p.lo, hi = p.hi;
    volatile LAS unsigned* xst = (volatile LAS unsigned*)(lds + LDS_BYTES - 64);
    if (tid < 2) xst[tid] = 0u;
    __syncthreads();
    XcdBarrier xbar = xcd_barrier_post((unsigned*)(p.ws + O_BAR), xst);
    if (p.hi > 1000) cg::this_grid().sync();
#ifndef PH_MASK
#define PH_MASK 0x3ffff
#endif
#define IN(k) ((((PH_MASK) >> (k)) & 1) && lo <= (k) && (k) < hi)
#define SEAM(k) do { if (hi - lo > 1) xcd_barrier(xbar); } while (0)

    if (IN(0)) { PHASE_BEGIN
        if (blk < 96) {
            LAS float* sl = (LAS float*)lds;
            for (int i = tid; i < 3072; i += 512) { const int set = i >> 10, k = i & 1023; const float cv = set == 0 ? q->c[k] : (set == 1 ? q->c[1024 + k] : q->c_ctx[k]); sl[i] = cv / (1.f + __expf(-cv)); }
            __syncthreads();
            const int layer = blk / 48, chunk = blk % 48;
            const float* W = q->mod_w + (size_t)layer * 1024 * 6144 + chunk * 128 + 2 * lane;
            float a00 = 0.f, a01 = 0.f, a10 = 0.f, a11 = 0.f, a20 = 0.f, a21 = 0.f;
#pragma unroll 16
            for (int k = 128 * wave; k < 128 * wave + 128; ++k) { const f32x2v wv = *(const f32x2v*)(W + (size_t)k * 6144);
                const float s0 = sl[k], s1 = sl[1024 + k], s2 = sl[2048 + k];
                a00 += s0 * wv[0]; a01 += s0 * wv[1]; a10 += s1 * wv[0]; a11 += s1 * wv[1]; a20 += s2 * wv[0]; a21 += s2 * wv[1]; }
            LAS float* red = sl + 3072;
            red[(wave * 3 + 0) * 128 + 2 * lane] = a00; red[(wave * 3 + 0) * 128 + 2 * lane + 1] = a01;
            red[(wave * 3 + 1) * 128 + 2 * lane] = a10; red[(wave * 3 + 1) * 128 + 2 * lane + 1] = a11;
            red[(wave * 3 + 2) * 128 + 2 * lane] = a20; red[(wave * 3 + 2) * 128 + 2 * lane + 1] = a21;
            __syncthreads();
            if (tid < 384) { const int s = tid >> 7, n = tid & 127; float acc = q->mod_b[layer * 6144 + chunk * 128 + n];
#pragma unroll
                for (int w8 = 0; w8 < 8; ++w8) acc += red[(w8 * 3 + s) * 128 + n];
                mod[(layer * 3 + s) * 6144 + chunk * 128 + n] = acc; }
            __syncthreads();
        } else if (blk == 96) {
            for (int i = tid; i < 3072; i += 512) {
                if (i < 2048) { const int pos = i >> 4, f = i & 15; const float inv = exp2f(-(float)f * (13.287712379549449f / 16.f)); float s, c; sincos_small((float)pos * inv, s, c); tab32[2 * i] = c; tab32[2 * i + 1] = s; }
                else { const int j = i - 2048, pos = j >> 3, f = j & 7; const float inv = exp2f(-(float)f * (13.287712379549449f / 8.f)); float s, c; sincos_small((float)pos * inv, s, c); tab16[2 * j] = c; tab16[2 * j + 1] = s; }
            }
        }
        {
            LAS float* scr = (LAS float*)(lds + wave * 16384);
            constexpr int I0 = 16 * 96, I1 = 16 * 32, I2 = 16 * 176, I3 = 44 * 32, I4 = 16 * 53, I5 = 16 * 32, I6 = 6 * 24, I7 = 4 * 32;
            for (int it = gw; it < I0; it += ngw) p0_item(q->ev_w_in, 1024, 3072, Wevin, 0, nullptr, scr, it, lane);
            for (int i = gtid; i < 65536; i += ngt) Gws[i] = (bf16_t)f2bf(q->gmlp_ws[i]);
            for (int i = gtid; i < 96 * 1024 / 2; i += ngt) ((unsigned*)(Wodin + (size_t)672 * 1024))[i] = 0u;
        }
    }
    SEAM(0);
    if (IN(1)) { PHASE_BEGIN
        for (int idx = gtid; idx < MT * 128; idx += ngt) {
            const int row = idx >> 7, c8 = (idx & 127) * 8;
            const float* src = row < ML ? q->x + (size_t)row * DM : q->ctx + (size_t)(row - ML) * DM;
            const int set = row < 8192 ? 0 : (row < ML ? 1 : 2);
            const float* mp = mod + set * 6144;
            const f32x4 v0 = *(const f32x4*)(src + c8), v1 = *(const f32x4*)(src + c8 + 4);
            const f32x4 sh0 = *(const f32x4*)(mp + c8), sh1 = *(const f32x4*)(mp + c8 + 4), sc0 = *(const f32x4*)(mp + 1024 + c8), sc1 = *(const f32x4*)(mp + 1024 + c8 + 4);
            const f32x4 u0 = v0 * (sc0 + 1.f) + sh0, u1 = v1 * (sc1 + 1.f) + sh1;
            *(u32x4*)(U + (size_t)row * DM + c8) = (u32x4){pk2(u0[0], u0[1]), pk2(u0[2], u0[3]), pk2(u1[0], u1[1]), pk2(u1[2], u1[3])};
        }
    }
    SEAM(1);
    if (IN(2)) { PHASE_BEGIN
        pg8::Gemm g{U, Wevin, MT, PW0, 1024, 1024, 1024}; pg8::StaticOrder S; S.init(MT, PW0, G, blk);
        EpiIn0 E{P, tab32};
        pg8::gemm_phase<EpiIn0, pg8::StaticOrder, true, true>(lds, g, S, E);
        if (blk >= 24) {
            LAS float* scr = (LAS float*)(lds + wave * 16384);
            constexpr int I1 = 16 * 32, I2 = 16 * 176, I3 = 44 * 32, I4 = 16 * 53, I5 = 16 * 32, I6 = 6 * 24, I7 = 4 * 32;
            constexpr int NIT = I1 + 2 * I2 + 2 * I3 + I4 + I5 + I6 + I7;
            for (int it = (blk - 24) * 8 + wave; it < NIT; it += (G - 24) * 8) {
                int r = it;
                if (r < I1) { p0_item(q->ev_w_out, 1024, 1024, Wevout, 0, nullptr, scr, r, lane); continue; } r -= I1;
                if (r < I2) { p0_item(q->ffn_w_in, 1024, 5632, Wffin0, 1, nullptr, scr, r, lane); continue; } r -= I2;
                if (r < I2) { p0_item(q->ffn_w_in + (size_t)1024 * 5632, 1024, 5632, Wffin1, 1, nullptr, scr, r, lane); continue; } r -= I2;
                if (r < I3) { p0_item(q->ffn_w_out, 2816, 1024, Wffout0, 0, nullptr, scr, r, lane); continue; } r -= I3;
                if (r < I3) { p0_item(q->ffn_w_out + (size_t)2816 * 1024, 2816, 1024, Wffout1, 0, nullptr, scr, r, lane); continue; } r -= I3;
                if (r < I4) { p0_item(q->od_w_in, 1024, 1696, Wodin, 2, nullptr, scr, r, lane); continue; } r -= I4;
                if (r < I5) { p0_item(q->od_w_out, 1024, 1024, Wodout, 0, nullptr, scr, r, lane); continue; } r -= I5;
                if (r < I6) { p0_item(q->mla_w_uq, 384, 768, Wuq, 0, q->mla_q_norm_g, scr, r, lane); continue; } r -= I6;
                p0_item(q->mla_w_ukv, 256, 1024, Wukv, 0, q->mla_kv_norm_g, scr, r, lane);
            }
        }
    }
    SEAM(2);
    if (IN(3)) { PHASE_BEGIN
        const int xcd = blk & 7, idx = blk >> 3;
        float lam;
        { const float a = q->diff_lambda[lane] * q->diff_lambda[64 + lane], b2 = q->diff_lambda[128 + lane] * q->diff_lambda[192 + lane];
          lam = __expf(wave_sum(a)) - __expf(wave_sum(b2)) + LAMBDA_INIT; }
        {
            const int b = xcd >> 2, h = xcd & 3, part = idx >> 4, qb = idx & 15;
            AttnDesc d{};
            d.qpitch = PW0; d.kpitch = PW0; d.vpitch = PW0; d.V = P + 1024 + h * 128;
            d.Ob = AMIX0 + h * 128; d.opitch = 1024; d.lam = lam; d.subg = q->diff_subln_g;
            d.qrow0 = b * SEQ_ + qb * 512; d.ntiles = 132; d.nlat = 128; d.lat_row0 = b * SEQ_; d.ctx_row0 = ML + b * 256;
            d.Q = P + h * 128 + part * 64; d.K = P + 512 + h * 128 + part * 64;
            bf16_t* xch = (bf16_t*)(ws + O_ODIFF) + (size_t)h * MT * 128;
            unsigned* xcnt = (unsigned*)(ws + O_XCNT) + 64 * ((b * 4 + h) * 16 + qb);
            if (part == 0) attn_unit_diff2<0>(d, lds, xch, xcnt); else attn_unit_diff2<1>(d, lds, xch, xcnt);
        }
        for (int i = 0; i < 2; ++i) {
            const int combo = i * 8 + xcd, rb = idx;
            if (idx >= 32) break;
            const int b = combo >> 3, h = combo & 7;
            int rowlo = 4 * rb - 4; rowlo = rowlo < 0 ? 0 : (rowlo > 120 ? 120 : rowlo);
            int nrt = 128 - rowlo; nrt = nrt > 11 ? 11 : nrt;
            AttnDesc d{};
            d.Q = P + 1536 + h * 64; d.qpitch = PW0; d.K = P + 2048 + h * 64; d.kpitch = PW0; d.V = P + 2560 + h * 64; d.vpitch = PW0;
            d.Of = nullptr; d.Ob = AMIX0 + 512 + h * 64; d.opitch = 1024;
            d.qrow0 = b * SEQ_ + rb * 256; d.ntiles = nrt + 4; d.nlat = nrt; d.lat_row0 = b * SEQ_ + rowlo * 64; d.ctx_row0 = ML + b * 256;
            d.na_rowlo = rowlo; d.na_gr0 = 4 * rb; d.rpb = q->na_rpb + h * 465;
            attn_unit<64, 64, true, 0>(d, lds);
        }
        if (blk < 8) {
            const int b = blk >> 2, h = blk & 3;
            AttnDesc d{};
            d.qpitch = PW0; d.kpitch = PW0; d.vpitch = PW0; d.V = P + 1024 + h * 128;
            d.Ob = AMIX0 + h * 128; d.opitch = 1024; d.lam = lam; d.subg = q->diff_subln_g;
            d.qrow0 = ML + b * 256; d.ntiles = 4; d.nlat = 0; d.lat_row0 = 0; d.ctx_row0 = ML + b * 256;
            d.Q = P + h * 128; d.K = P + 512 + h * 128;
            attn_unit<64, 128, false, 2>(d, lds);
            d.Q = P + h * 128 + 64; d.K = P + 512 + h * 128 + 64;
            attn_unit<64, 128, false, 3>(d, lds);
        } else if (blk >= 16 && blk < 32) {
            const int b = (blk - 16) >> 3, h = (blk - 16) & 7;
            AttnDesc d{};
            d.Q = P + 1536 + h * 64; d.qpitch = PW0; d.K = P + 2048 + h * 64; d.kpitch = PW0; d.V = P + 2560 + h * 64; d.vpitch = PW0;
            d.Ob = AMIX0 + 512 + h * 64; d.opitch = 1024;
            d.qrow0 = ML + b * 256; d.ntiles = 4; d.nlat = 0; d.lat_row0 = 0; d.ctx_row0 = ML + b * 256;
            attn_unit<64, 64, false, 0>(d, lds);
        }
    }
    SEAM(3);
    if (IN(5)) { PHASE_BEGIN
        { pg8::Gemm g{AMIX0, Wevout, ML, 1024, 1024, 1024, 1024}; PanelOrder S; S.init(ML, blk);
          EpiResLN<false, true> E{q->x, q->ctx, mod + 2 * 1024, (unsigned*)(ws + O_CNT), (unsigned long long*)(ws + O_SLOT0), q->ln_mix_g, q->ln_mix_b, H, U, mod, 3, nullptr, nullptr, 0};
          pg8::gemm_phase<EpiResLN<false, true>, PanelOrder, true, true>(lds, g, S, E); }
        { const int part = blk & 3, k0 = part * 256;
          pg8::Gemm g{AMIX0 + k0, Wevout + k0, MT, 1024, 256, 1024, 1024}; TailOrder S{blk};
          EpiResLN<false, true> E{q->x, q->ctx, mod + 2 * 1024, (unsigned*)(ws + O_CNT), (unsigned long long*)(ws + O_SLOT0), q->ln_mix_g, q->ln_mix_b, H, U, mod, 3, (float*)(ws + O_P), (unsigned*)(ws + O_PCNT), part};
          pg8::gemm_phase<EpiResLN<false, true>, TailOrder, true, true>(lds, g, S, E); }
    }
    SEAM(5);
    if (IN(7)) { PHASE_BEGIN
        pg8::Gemm g{U, Wffin0, MT, 5632, 1024, 1024, 1024}; pg8::StaticOrder S; S.init(MT, 5632, G, blk);
        EpiFfn E{ACT};
        pg8::gemm_phase<EpiFfn, pg8::StaticOrder, true, true>(lds, g, S, E);
    }
    SEAM(7);
    if (IN(8)) { PHASE_BEGIN
        { pg8::Gemm g{ACT, Wffout0, ML, 1024, FH, FH, FH}; PanelOrder S; S.init(ML, blk);
          EpiResLN<true, true> E{Hb, Hb + (size_t)ML * DM, mod + 5 * 1024, (unsigned*)(ws + O_CNT) + 66 * 64, (unsigned long long*)(ws + O_SLOT1), q->ln_ffn_g, q->ln_ffn_b, Hb, U, mod + 3 * 6144, 0, nullptr, nullptr, 0};
          pg8::gemm_phase<EpiResLN<true, true>, PanelOrder, true, true>(lds, g, S, E); }
        { const int part = blk & 3, k0 = part < 2 ? part * 768 : 1536 + (part - 2) * 640, kl = part < 2 ? 768 : 640;
          pg8::Gemm g{ACT + k0, Wffout0 + k0, MT, 1024, kl, FH, FH}; TailOrder S{blk};
          EpiResLN<true, true> E{Hb, Hb + (size_t)ML * DM, mod + 5 * 1024, (unsigned*)(ws + O_CNT) + 66 * 64, (unsigned long long*)(ws + O_SLOT1), q->ln_ffn_g, q->ln_ffn_b, Hb, U, mod + 3 * 6144, 0, (float*)(ws + O_SLOT2), (unsigned*)(ws + O_PCNT) + 8 * 64, part};
          pg8::gemm_phase<EpiResLN<true, true>, TailOrder, true, true>(lds, g, S, E); }
    }
    SEAM(8);
    if (IN(10)) { PHASE_BEGIN
        pg8::Gemm g{U, Wodin, MT, PW1, 1024, 1024, 1024}; pg8::StaticOrder S; S.init(MT, PW1, G, blk);
        EpiIn1 E{P1, stats, tab16};
        pg8::gemm_phase<EpiIn1, pg8::StaticOrder, true, true>(lds, g, S, E);
    }
    SEAM(10);
    if (IN(11)) { PHASE_BEGIN
#ifndef NO_Q
        { pg8::Gemm g{P1, Wuq, ML, 768, 384, PW1, 384}; pg8::StaticOrder S; S.init(ML, 768, G, blk);
          EpiQ1 E{Q1, stats, tab16};
          pg8::gemm_phase<EpiQ1, pg8::StaticOrder, true, true>(lds, g, S, E); }
#endif
#ifndef NO_KV
        { pg8::Gemm g{P1 + 384, Wukv, MT, 1024, 256, PW1, 256}; pg8::StaticOrder S; S.init(MT, 1024, G, (blk + 64) & 255);
          EpiKV1 E{KV1, stats};
          pg8::gemm_phase<EpiKV1, pg8::StaticOrder, true, true>(lds, g, S, E); }
#endif
#ifndef NO_GMLP
        const int gm_n = blk >= 192 ? 3 : (blk < 128 ? 2 : 1);
        const int gm_0 = blk >= 192 ? (blk - 192) * 3 : (blk < 128 ? 192 + blk * 2 : 448 + (blk - 128));
        for (int un = gm_0; un < gm_0 + gm_n; ++un) {
            const int chunk = un >> 2, grp = un & 3;
            constexpr int RS = 272;
            LAS unsigned char* wsA = lds; LAS unsigned char* vnT = lds + 128 * RS; LAS float* tst = (LAS float*)(lds + 2 * 128 * RS);
            __syncthreads();
            {
                const int tok = tid >> 2, part = tid & 3; const float* sp = stats + (size_t)(chunk * 128 + tok) * STP + 80 + part * 8;
                float s = sp[0] + sp[2] + sp[4] + sp[6], q = sp[1] + sp[3] + sp[5] + sp[7];
                s += __shfl_xor(s, 1); s += __shfl_xor(s, 2); q += __shfl_xor(q, 1); q += __shfl_xor(q, 2);
                const float mean = s * (1.f / 512.f); const float var = q * (1.f / 512.f) - mean * mean;
                if (part == 0) { tst[2 * tok] = mean; tst[2 * tok + 1] = 1.f / sqrtf(fmaxf(var, 0.f) + 1e-5f); }
            }
#pragma unroll
            for (int i = 0; i < 4; ++i) { const int id = tid + 512 * i, r = id >> 4, ch = id & 15;
                *(LAS u32x4*)(wsA + r * RS + ch * 16) = *(const u32x4*)(Gws + (size_t)grp * 16384 + r * 128 + ch * 8); }
            __syncthreads();
#pragma unroll
            for (int i = 0; i < 4; ++i) { const int id = tid + 512 * i, j = id >> 4, cc = id & 15;
                const u32x4 raw = *(const u32x4*)(P1 + (size_t)(chunk * 128 + j) * PW1 + 1280 + grp * 128 + cc * 8);
                const float mean = tst[2 * j], rstd = tst[2 * j + 1];
                const f32x4 lg0 = *(const f32x4*)(q->gmlp_ln_g + grp * 128 + cc * 8), lg1 = *(const f32x4*)(q->gmlp_ln_g + grp * 128 + cc * 8 + 4);
                const f32x4 lb0 = *(const f32x4*)(q->gmlp_ln_b + grp * 128 + cc * 8), lb1 = *(const f32x4*)(q->gmlp_ln_b + grp * 128 + cc * 8 + 4);
#pragma unroll
                for (int e = 0; e < 8; ++e) { const unsigned wv = raw[e >> 1]; const float x = bf2f((unsigned short)((e & 1) ? (wv >> 16) : (wv & 0xffffu)));
                    const float y = (x - mean) * rstd * (e < 4 ? lg0[e & 3] : lg1[e & 3]) + (e < 4 ? lb0[e & 3] : lb1[e & 3]);
                    *(LAS unsigned short*)(vnT + (cc * 8 + e) * RS + j * 2) = (unsigned short)f2bf(y); } }
            __syncthreads();
            { const int r32 = lane & 31, hh = lane >> 5, ib = wave >> 1;
#pragma unroll
              for (int cbi = 0; cbi < 2; ++cbi) { const int cb = 2 * (wave & 1) + cbi;
                f32x16 dacc = (f32x16){};
#pragma unroll
                for (int ks = 0; ks < 8; ++ks) {
                    const bf16x8 a = *(const LAS bf16x8*)(wsA + (32 * ib + r32) * RS + (16 * ks + 8 * hh) * 2);
                    const bf16x8 bb = *(const LAS bf16x8*)(vnT + (32 * cb + r32) * RS + (16 * ks + 8 * hh) * 2);
                    dacc = __builtin_amdgcn_mfma_f32_32x32x16_bf16(a, bb, dacc, 0, 0, 0); }
                const int c = 32 * cb + r32;
#pragma unroll
                for (int r = 0; r < 16; ++r) { const int i = 32 * ib + (r & 3) + 8 * (r >> 2) + 4 * hh; const int tok = chunk * 128 + i;
                    const float gu = bf2f(P1[(size_t)tok * PW1 + 768 + grp * 128 + c]);
                    const float o = gu * (dacc[r] + q->gmlp_b[grp * 128 + i]);
                    AMIX1[(size_t)tok * 1024 + 512 + grp * 128 + c] = (bf16_t)f2bf(o); } } }
        }
#endif
    }
    SEAM(11);
    if (IN(12)) { PHASE_BEGIN
        const int xcd = blk & 7, idx = blk >> 3;
        {
            const int combo = (idx >> 4) * 8 + xcd, qb = idx & 15;
            const int b = combo >> 3, h = combo & 7;
            AttnDesc d{};
            d.Q = Q1 + h * 96; d.qpitch = 768; d.K = KV1 + h * 128; d.kpitch = 1024; d.K2 = P1 + 640; d.k2pitch = PW1;
            d.V = KV1 + h * 128 + 64; d.vpitch = 1024; d.Ob = AMIX1 + h * 64; d.opitch = 1024;
            d.qrow0 = b * SEQ_ + qb * 512; d.ntiles = 132; d.nlat = 128; d.lat_row0 = b * SEQ_; d.ctx_row0 = ML + b * 256;
            attn_unit_mla2(d, lds);
        }
    }
    SEAM(12);
    if (IN(13)) { PHASE_BEGIN
        pg8::Gemm g{AMIX1, Wodout, ML, 1024, 1024, 1024, 1024}; PanelOrder S; S.init(ML, blk);
        EpiResLN<true, true> E{Hb, Hb + (size_t)ML * DM, mod + 3 * 6144 + 2 * 1024, (unsigned*)(ws + O_CNT) + 2 * 66 * 64, (unsigned long long*)(ws + O_SLOT2), q->ln_mix_g + 1024, q->ln_mix_b + 1024, Hb, U, mod + 3 * 6144, 3, nullptr, nullptr, 0};
        pg8::gemm_phase<EpiResLN<true, true>, PanelOrder, true, true>(lds, g, S, E);
    }
    SEAM(13);
    if (IN(15)) { PHASE_BEGIN
        pg8::Gemm g{U, Wffin1, ML, 5632, 1024, 1024, 1024}; pg8::StaticOrder S; S.init(ML, 5632, G, blk);
        EpiFfn E{ACT};
        pg8::gemm_phase<EpiFfn, pg8::StaticOrder, true, true>(lds, g, S, E);
    }
    SEAM(15);
    if (IN(16)) { PHASE_BEGIN
        pg8::Gemm g{ACT, Wffout1, ML, 1024, FH, FH, FH}; PanelOrder S; S.init(ML, blk);
        EpiResLN<true, false> E{Hb, Hb + (size_t)ML * DM, mod + 3 * 6144 + 5 * 1024, (unsigned*)(ws + O_CNT) + 3 * 66 * 64, (unsigned long long*)(ws + O_SLOT3), q->ln_ffn_g + 1024, q->ln_ffn_b + 1024, q->out, nullptr, nullptr, 0, nullptr, nullptr, 0};
        pg8::gemm_phase<EpiResLN<true, false>, PanelOrder, true, true>(lds, g, S, E);
    }
#undef IN
#undef SEAM
}

#ifndef N_LAUNCH_MODE
#define N_LAUNCH_MODE 1
#endif
extern "C" void kernel_launch(void* const* d_in, const int* in_sizes, int n_in, void* d_out, int out_size, void* d_ws, size_t ws_size, hipStream_t stream) {
    static int grid = 0;
    if (grid == 0) {
        if (n_in != 27 || ws_size < WS_NEED) { fprintf(stderr, "kernel_launch: unexpected inputs (n_in %d, ws %zu)\n", n_in, ws_size); grid = -1; return; }
        int dev = 0, cus = 0, per_cu = 0;
        hipGetDevice(&dev); hipDeviceGetAttribute(&cus, hipDeviceAttributeMultiprocessorCount, dev);
        hipFuncSetAttribute((const void*)dit_fwd, hipFuncAttributeMaxDynamicSharedMemorySize, LDS_BYTES);
        hipOccupancyMaxActiveBlocksPerMultiprocessor(&per_cu, (const void*)dit_fwd, 512, LDS_BYTES);
        (void)hipGetLastError();
        if (per_cu < 1) per_cu = 1;
        grid = cus * per_cu; if (grid > 256) grid = 256;
    }
    if (grid < 0) return;
    if (hipMemsetAsync((char*)d_ws + O_BAR, 0, CTL_BYTES, stream) != hipSuccess) { fprintf(stderr, "memset failed\n"); return; }
    Params p{};
    const float** pp = (const float**)&p;
    for (int i = 0; i < 27; ++i) pp[i] = (const float*)d_in[i];
    p.out = (float*)d_out; p.ws = (unsigned char*)d_ws;
#if N_LAUNCH_MODE == 1
    p.lo = 0; p.hi = NPHASE;
    void* args[] = {&p};
    hipError_t e = hipLaunchCooperativeKernel((const void*)dit_fwd, dim3(grid), dim3(512), args, LDS_BYTES, stream);
    if (e != hipSuccess) fprintf(stderr, "cooperative launch failed: %s (grid %d)\n", hipGetErrorString(e), grid);
#else
    for (int ph = 0; ph < NPHASE; ++ph) { p.lo = ph; p.hi = ph + 1; hipLaunchKernelGGL(dit_fwd, dim3(grid), dim3(512), LDS_BYTES, stream, p); }
#endif
}
```
